# Optimizing an MI355X kernel written in HIP

```python
import math
import jax, jax.numpy as jnp
from jax import lax
import numpy as np

D_MODEL = 1024
BATCH = 16
SEQ = 4096
DEPTH = 1

N_META = 16
CHUNK = 128
RET_HEADS = 4
RET_DK = 128
RET_DV = 128
DSA_HEADS = 8
DSA_DH = 64
IDX_HEADS = 8
IDX_DH = 64
TOPK_MAX = 256
D_FF = 4 * D_MODEL
N_BUCKETS = 32
MAX_DISTANCE = 128
ROPE_BASE = 10000.0
EPS = 1e-6
NEG = -1e30

RET_W = RET_HEADS * RET_DV
DSA_W = DSA_HEADS * DSA_DH
D_MIX = RET_W + DSA_W
COL_SIZES = (RET_HEADS * RET_DK, RET_HEADS * RET_DK, RET_W, RET_W,
             DSA_W, DSA_DH, DSA_DH, IDX_HEADS * IDX_DH, IDX_DH, IDX_HEADS)
D_IN = sum(COL_SIZES)
SPLIT_POINTS = tuple(int(v) for v in np.cumsum(COL_SIZES)[:-1])

kernel_name = "hymba_retention_dsa_hybrid"


def rmsnorm(x, w):
    xf = x.astype(jnp.float32)
    y = xf * lax.rsqrt(jnp.mean(xf * xf, axis=-1, keepdims=True) + EPS)
    return y * w.astype(jnp.float32)


def rotary(x, pos):
    half = x.shape[-1] // 2
    inv = ROPE_BASE ** (-jnp.arange(half, dtype=jnp.float32) / half)
    ang = pos.astype(jnp.float32)[:, None] * inv[None, :]
    cos = jnp.cos(ang)[None, :, None, :]
    sin = jnp.sin(ang)[None, :, None, :]
    x1, x2 = x[..., :half], x[..., half:]
    return jnp.concatenate([x1 * cos - x2 * sin, x1 * sin + x2 * cos], axis=-1)


def retention(q, k, v, g, gain, pos):
    B, T, H, _ = q.shape
    pad = CHUNK - N_META
    q = rotary(q.astype(jnp.float32), pos)
    k = rotary(k.astype(jnp.float32), pos) * (RET_DK ** -0.5)
    v = v.astype(jnp.float32)
    padw = ((0, 0), (pad, 0), (0, 0), (0, 0))
    nc = (T + pad) // CHUNK
    qc = jnp.pad(q, padw).reshape(B, nc, CHUNK, H, RET_DK)
    kc = jnp.pad(k, padw).reshape(B, nc, CHUNK, H, RET_DK)
    vc = jnp.pad(v, padw).reshape(B, nc, CHUNK, H, RET_DV)

    log_gamma = jnp.log(1.0 - jnp.exp2(-5.0 - jnp.arange(H, dtype=jnp.float32)))
    idx = jnp.arange(CHUNK, dtype=jnp.float32)
    diff = idx[:, None] - idx[None, :]
    decay_mask = jnp.where(diff[None] >= 0,
                           jnp.exp(log_gamma[:, None, None] * jnp.maximum(diff, 0.0)[None]),
                           0.0)
    scores = jnp.einsum('bnchd,bnmhd->bnhcm', qc, kc) * decay_mask[None, None]
    o_inner = jnp.einsum('bnhcm,bnmhe->bnche', scores, vc)
    zeta = jnp.exp(log_gamma[None, :] * (CHUNK - 1 - idx)[:, None])
    kv = jnp.einsum('bnmhd,bnmhe,mh->bnhde', kc, vc, zeta)
    chunk_decay = jnp.exp(log_gamma * CHUNK)[None, :, None, None]

    def step(S, kv_c):
        return S * chunk_decay + kv_c, S

    _, s_prev = lax.scan(step, jnp.zeros_like(kv[:, 0]), jnp.moveaxis(kv, 1, 0))
    s_prev = jnp.moveaxis(s_prev, 0, 1)
    xi = jnp.exp(log_gamma[None, :] * (idx + 1.0)[:, None])
    o_cross = jnp.einsum('bnchd,ch,bnhde->bnche', qc, xi, s_prev)
    o = (o_inner + o_cross).reshape(B, nc * CHUNK, H, RET_DV)[:, pad:]
    o = rmsnorm(o, gain.reshape(H, RET_DV))
    o = jax.nn.silu(g.astype(jnp.float32)) * o
    return o.reshape(B, T, H * RET_DV)


def t5_bucket(dist):
    max_exact = N_BUCKETS // 2
    d_f = jnp.maximum(dist, 1).astype(jnp.float32)
    large = max_exact + (jnp.log(d_f / max_exact) / math.log(MAX_DISTANCE / max_exact)
                         * (N_BUCKETS - max_exact)).astype(jnp.int32)
    large = jnp.minimum(large, N_BUCKETS - 1)
    return jnp.where(dist < max_exact, dist, large)


def sparse_attention(q, k, v, iq, ik, iw, q_gain, k_gain, rel_bias, pos, topk):
    B, T, H, dh = q.shape
    pad = CHUNK - N_META
    nb = (T + pad) // CHUNK
    qn = rmsnorm(q, q_gain) * (dh ** -0.5)
    kn = rmsnorm(k, k_gain)
    vf = v.astype(jnp.float32)
    ikf = ik.astype(jnp.float32)
    iqf = iq.astype(jnp.float32) * (IDX_DH ** -0.5)
    iwf = iw.astype(jnp.float32) * (IDX_HEADS ** -0.5)

    def to_blocks(a):
        a = jnp.pad(a, ((0, 0), (pad, 0)) + ((0, 0),) * (a.ndim - 2))
        a = a.reshape((B, nb, CHUNK) + a.shape[2:])
        return jnp.moveaxis(a, 1, 0)

    pos_blocks = jnp.pad(pos, (pad, 0), constant_values=-1).reshape(nb, CHUNK)
    key_pos = pos
    gather = jax.vmap(lambda arr, ii: arr[ii])

    def block(args):
        qb, iqb, iwb, pb = args
        s = jnp.einsum('bchd,bsd->bchs', iqb, ikf)
        score = jnp.einsum('bch,bchs->bcs', iwb, jax.nn.relu(s))
        causal = key_pos[None, :] <= pb[:, None]
        score = jnp.where(causal[None], score, NEG)
        _, sel = lax.top_k(score, topk)
        sel_pos = key_pos[sel]
        valid = sel_pos <= pb[None, :, None]
        k_sel = gather(kn, sel)
        v_sel = gather(vf, sel)
        logits = jnp.einsum('bchd,bckd->bchk', qb, k_sel)
        dist = jnp.maximum(pb[None, :, None] - sel_pos, 0)
        bias = jnp.transpose(rel_bias.astype(jnp.float32)[t5_bucket(dist)], (0, 1, 3, 2))
        logits = jnp.where(valid[:, :, None, :], logits + bias, NEG)
        p = jax.nn.softmax(logits, axis=-1)
        return jnp.einsum('bchk,bckd->bchd', p, v_sel)

    out = lax.map(block, (to_blocks(qn), to_blocks(iqf), to_blocks(iwf), pos_blocks))
    out = jnp.moveaxis(out, 0, 1).reshape(B, nb * CHUNK, H * dh)[:, pad:]
    return out


def setup_inputs(seed: int = 0) -> dict:
    key = jax.random.key(seed)
    ks = jax.random.split(key, 12)
    f32 = jnp.float32
    nrm = lambda k, s: jax.random.normal(k, s, dtype=f32)
    return {
        "x": nrm(ks[0], (BATCH, SEQ, D_MODEL)),
        "meta_tokens": nrm(ks[1], (N_META, D_MODEL)),
        "norm1_w": 1.0 + 0.02 * nrm(ks[2], (DEPTH, D_MODEL)),
        "w_in": nrm(ks[3], (DEPTH, D_MODEL, D_IN)) * D_MODEL ** -0.5,
        "ret_norm_w": 1.0 + 0.02 * nrm(ks[4], (DEPTH, RET_W)),
        "q_norm_w": 1.0 + 0.02 * nrm(ks[5], (DEPTH, DSA_DH)),
        "k_norm_w": 1.0 + 0.02 * nrm(ks[6], (DEPTH, DSA_DH)),
        "rel_bias": 0.5 * nrm(ks[7], (N_BUCKETS, DSA_HEADS)),
        "w_out": nrm(ks[8], (DEPTH, D_MIX, D_MODEL)) * D_MIX ** -0.5,
        "norm2_w": 1.0 + 0.02 * nrm(ks[9], (DEPTH, D_MODEL)),
        "w_ff1": nrm(ks[10], (DEPTH, D_MODEL, D_FF)) * D_MODEL ** -0.5,
        "w_ff2": nrm(ks[11], (DEPTH, D_FF, D_MODEL)) * D_FF ** -0.5,
    }


def reference(x, meta_tokens, norm1_w, w_in, ret_norm_w, q_norm_w, k_norm_w,
              rel_bias, w_out, norm2_w, w_ff1, w_ff2):
    B, L, D = x.shape
    topk = min(TOPK_MAX, L // 4)
    meta = jnp.broadcast_to(meta_tokens.astype(x.dtype)[None], (B, N_META, D))
    h = jnp.concatenate([meta, x], axis=1)
    T = h.shape[1]
    pos = jnp.arange(T, dtype=jnp.int32)
    for l in range(DEPTH):
        u = rmsnorm(h, norm1_w[l]).astype(h.dtype)
        proj = u @ w_in[l]
        rq, rk, rv, rg, dq, dk, dv, iq, ik, iw = jnp.split(proj, SPLIT_POINTS, axis=-1)
        y_ret = retention(rq.reshape(B, T, RET_HEADS, RET_DK),
                          rk.reshape(B, T, RET_HEADS, RET_DK),
                          rv.reshape(B, T, RET_HEADS, RET_DV),
                          rg.reshape(B, T, RET_HEADS, RET_DV),
                          ret_norm_w[l], pos)
        y_dsa = sparse_attention(dq.reshape(B, T, DSA_HEADS, DSA_DH), dk, dv,
                                 iq.reshape(B, T, IDX_HEADS, IDX_DH), ik, iw,
                                 q_norm_w[l], k_norm_w[l], rel_bias, pos, topk)
        y = jnp.concatenate([y_ret, y_dsa], axis=-1).astype(h.dtype)
        h = h + y @ w_out[l]
        u = rmsnorm(h, norm2_w[l]).astype(h.dtype)
        h = h + jnp.square(jax.nn.relu(u @ w_ff1[l])) @ w_ff2[l]
    return h[:, N_META:]
```

```cpp
#include <hip/hip_runtime.h>
#include <cstdio>
#include <cstdint>
namespace pg8 {
#define PG8_LAS __attribute__((address_space(3)))
typedef unsigned short bf16_t;
typedef short bf16x8 __attribute__((ext_vector_type(8)));
typedef float f32x4 __attribute__((ext_vector_type(4)));
typedef unsigned u32x4 __attribute__((ext_vector_type(4)));
constexpr int BM = 256, BK = 64, HALF = 128, HTB = HALF * BK * 2  , STAGE_BYTES = 8 * HTB, NXCD = 8, WGM = 8;

__host__ __device__ __forceinline__ int lds_byte(int r, int c) { const int st = (r >> 4) * 2 + (c >> 5), rr = r & 15, cc = c & 31, ob = rr * 64 + cc * 2; return st * 1024 + (ob ^ (((ob >> 9) & 1) << 5)); }
__host__ __device__ __forceinline__ void stage_rc(int b, int& R, int& C) { const int st = b / 1024, sb = b % 1024, swz = sb ^ (((sb >> 9) & 1) << 5); R = (st >> 1) * 16 + swz / 64; C = (st & 1) * 32 + (swz % 64) / 2; }
__host__ __device__ __forceinline__ int perm32(int rho) { const int n = rho >> 4, i = rho & 15; return 8 * (i >> 2) + 4 * n + (i & 3); }

struct Unit { int pm, pn; };
struct Gemm { const bf16_t* A; const bf16_t* Bt; int M, N, K; };

struct StaticOrder {
    int nM, nN, nwg, G, c;
    __host__ __device__ void init(int M, int N, int G_, int c_) { nM = M / BM; nN = N / BM; nwg = nM * nN; G = G_; c = c_; }
    __host__ __device__ bool next(int i, Unit& u) const {
        const long L = (long)i * G + c; if (L >= nwg) return false;
        int wgid = (int)L; { const int q = nwg / NXCD, r = nwg % NXCD, xcd = wgid % NXCD, off = wgid / NXCD; wgid = (xcd < r ? xcd * (q + 1) : r * (q + 1) + (xcd - r) * q) + off; }
        const int nig = WGM * nN, gid = wgid / nig, fm = gid * WGM, gsz = (nM - fm) < WGM ? (nM - fm) : WGM;
        u.pm = fm + ((wgid % nig) % gsz); u.pn = (wgid % nig) / gsz; return true;
    }
    __device__ __forceinline__ void a_ready(const Unit&) const {}
    __device__ __forceinline__ void done(const Unit&) const {}
};

typedef float f32x2c __attribute__((ext_vector_type(2))); typedef __bf16 bf16x2c __attribute__((ext_vector_type(2)));
__device__ __forceinline__ unsigned cvt_pk_bf16(float lo, float hi) { const f32x2c v = {lo, hi}; const bf16x2c b = __builtin_convertvector(v, bf16x2c); return __builtin_bit_cast(unsigned, b); }

template <int ACT  > struct EpiBf16 {
    static constexpr bool PERM = true, AFTER_DRAIN = false;
    bf16_t* O; int ldc;
    __device__ __forceinline__ void operator()(const f32x4 (&acc)[2][2][4][2], const Unit& u, int wr, int wc, int fr, int fq) const {
        const int row0 = u.pm * BM + wr * 64 + fr; const int col0 = u.pn * BM + wc * 32 + 8 * fq;
#pragma unroll
        for (int ai = 0; ai < 2; ++ai)
#pragma unroll
            for (int m = 0; m < 4; ++m) { bf16_t* rowp = O + (size_t)(row0 + ai * HALF + m * 16) * ldc + col0;
#pragma unroll
                for (int bj = 0; bj < 2; ++bj) { f32x4 v0 = acc[ai][bj][m][0], v1 = acc[ai][bj][m][1];
                    if (ACT == 2) {
#pragma unroll
                        for (int e = 0; e < 4; ++e) { const float a = fmaxf(v0[e], 0.f), b = fmaxf(v1[e], 0.f); v0[e] = a * a; v1[e] = b * b; } }
                    u32x4 w; w.x = cvt_pk_bf16(v0[0], v0[1]); w.y = cvt_pk_bf16(v0[2], v0[3]); w.z = cvt_pk_bf16(v1[0], v1[1]); w.w = cvt_pk_bf16(v1[2], v1[3]);
                    *(u32x4*)(rowp + bj * HALF) = w; } }
    }
};

struct EpiResF32 {
    static constexpr bool PERM = false, AFTER_DRAIN = false;
    const float* base; float* out; int ldc;
    __device__ __forceinline__ void operator()(const f32x4 (&acc)[2][2][4][2], const Unit& u, int wr, int wc, int fr, int fq) const {
        const int col0 = u.pn * BM + wc * 32 + 4 * fq;
#pragma unroll
        for (int ai = 0; ai < 2; ++ai)
#pragma unroll
            for (int m = 0; m < 4; ++m) { const size_t off = (size_t)(u.pm * BM + ai * HALF + wr * 64 + m * 16 + fr) * ldc + col0;
#pragma unroll
                for (int bj = 0; bj < 2; ++bj)
#pragma unroll
                    for (int n = 0; n < 2; ++n) { const f32x4 bs = *(const f32x4*)(base + off + bj * HALF + n * 16); *(f32x4*)(out + off + bj * HALF + n * 16) = bs + acc[ai][bj][m][n]; }
                if (m & 1) asm volatile("" ::: "memory"); }
    }
};

template <class Epi, class Sched, bool ALIGN_EPI = false, bool SP2 = false>
__device__ __forceinline__ void gemm_phase(PG8_LAS unsigned char* lds, const Gemm g, const Sched& S, const Epi& E) {
    const int tid = threadIdx.x, wid = __builtin_amdgcn_readfirstlane(tid >> 6), lane = tid & 63, wr = wid >> 2, wc = wid & 3, fr = lane & 15, fq = lane >> 4;
    const int K = g.K, nt = K / BK;
    unsigned voffA[2], voffB[2];
#pragma unroll
    for (int i = 0; i < 2; ++i) { int R, C; stage_rc(tid * 16 + i * 8192, R, C); const int Rb = Epi::PERM ? ((R & ~31) + perm32(R & 31)) : R;
        voffA[i] = (unsigned)(R * K + C) * 2u; voffB[i] = (unsigned)(Rb * K + C) * 2u; }
    const size_t kstep = (size_t)(BK * 2);
    const size_t hstep = (size_t)HALF * K * 2;
    const size_t tstep = 2 * hstep;
    const unsigned ldsw = (unsigned)wid * 1024u;
    const int aoff = lds_byte(wr * 64 + fr, fq * 8), boff = lds_byte(wc * 32 + fr, fq * 8);
#define PG8_SA(b, h) (((b) * 2 + (h)) * HTB)
#define PG8_SB(b, h) ((4 + (b) * 2 + (h)) * HTB)
#define PG8_STAGE(bufoff, gbase, voff) do { _Pragma("unroll") for (int _i = 0; _i < 2; ++_i) \
        __builtin_amdgcn_global_load_lds((const unsigned*)((const char*)(gbase) + (voff)[_i]), (PG8_LAS unsigned*)(lds + (bufoff) + ldsw + _i * 8192), 16, 0, 0); } while (0)
#define PG8_LDA(dst, b, h) do { _Pragma("unroll") for (int m = 0; m < 4; ++m) _Pragma("unroll") for (int k = 0; k < 2; ++k) dst[m][k] = *(const PG8_LAS bf16x8*)(lds + PG8_SA(b, h) + aoff + m * 2048 + k * 1024); } while (0)
#define PG8_LDB(dst, b, h) do { _Pragma("unroll") for (int n = 0; n < 2; ++n) _Pragma("unroll") for (int k = 0; k < 2; ++k) dst[n][k] = *(const PG8_LAS bf16x8*)(lds + PG8_SB(b, h) + boff + n * 2048 + k * 1024); } while (0)
#define PG8_MMA(ai, bj, At, Bt) do { __builtin_amdgcn_s_setprio(1); _Pragma("unroll") for (int m = 0; m < 4; ++m) _Pragma("unroll") for (int n = 0; n < 2; ++n) _Pragma("unroll") for (int k = 0; k < 2; ++k) \
        acc[ai][bj][m][n] = __builtin_amdgcn_mfma_f32_16x16x32_bf16(Bt[n][k], At[m][k], acc[ai][bj][m][n], 0, 0, 0); __builtin_amdgcn_s_setprio(0); } while (0)
#define PG8_WAIT_V(n) asm volatile("s_waitcnt vmcnt(" #n ")" ::: "memory")
#define PG8_WAIT_L(n) asm volatile("s_waitcnt lgkmcnt(" #n ")" ::: "memory")
#define PG8_BAR __builtin_amdgcn_s_barrier()
#define PG8_SCHED __builtin_amdgcn_sched_barrier(0)
    Unit cur, nxt; int ui = 0;
    if (!S.next(0, cur)) return;
    f32x4 acc[2][2][4][2];
#pragma unroll
    for (int a = 0; a < 2; ++a)
#pragma unroll
        for (int b = 0; b < 2; ++b)
#pragma unroll
            for (int m = 0; m < 4; ++m)
#pragma unroll
                for (int n = 0; n < 2; ++n) acc[a][b][m][n] = (f32x4){0.f, 0.f, 0.f, 0.f};
    bf16x8 At[4][2], B0[2][2], B1[2][2];
    const char* cA = (const char*)g.A + (size_t)cur.pm * tstep; const char* cB = (const char*)g.Bt + (size_t)cur.pn * tstep;
    S.a_ready(cur);
    if constexpr (SP2) {
        PG8_STAGE(PG8_SB(0, 0), cB, voffB); PG8_STAGE(PG8_SB(0, 1), cB + hstep, voffB); PG8_STAGE(PG8_SA(0, 0), cA, voffA); PG8_STAGE(PG8_SA(0, 1), cA + hstep, voffA);
        if (wr == 1) PG8_BAR;
        PG8_WAIT_V(2); PG8_BAR;
        PG8_STAGE(PG8_SB(1, 0), cB + kstep, voffB); PG8_STAGE(PG8_SA(1, 0), cA + kstep, voffA); PG8_STAGE(PG8_SB(1, 1), cB + hstep + kstep, voffB);
        PG8_WAIT_V(6); PG8_BAR;
    } else {
        PG8_STAGE(PG8_SB(0, 0), cB, voffB); PG8_STAGE(PG8_SA(0, 0), cA, voffA); PG8_STAGE(PG8_SB(0, 1), cB + hstep, voffB); PG8_STAGE(PG8_SA(0, 1), cA + hstep, voffA);
        if (wr == 1) PG8_BAR;
        PG8_WAIT_V(4); PG8_BAR;
        PG8_STAGE(PG8_SB(1, 0), cB + kstep, voffB); PG8_STAGE(PG8_SA(1, 0), cA + kstep, voffA); PG8_STAGE(PG8_SB(1, 1), cB + hstep + kstep, voffB);
        PG8_WAIT_V(6); PG8_BAR;
    }
    for (;;) {
        const bool has_next = S.next(ui + 1, nxt);
        const char* nA = has_next ? (const char*)g.A + (size_t)nxt.pm * tstep : cA; const char* nB = has_next ? (const char*)g.Bt + (size_t)nxt.pn * tstep : cB;
        for (int t = 0; t < nt; t += 2) {
            const bool last = (t == nt - 2);
            const char* a1 = cA + (size_t)(t + 1) * kstep;
            const char* a2 = last ? nA : cA + (size_t)(t + 2) * kstep; const char* b2 = last ? nB : cB + (size_t)(t + 2) * kstep;
            const char* a3 = a2 + kstep; const char* b3 = b2 + kstep;
            if (last && has_next) S.a_ready(nxt);
            if constexpr (SP2) {
            PG8_LDB(B0, 0, 0); PG8_LDB(B1, 0, 1); PG8_SCHED; PG8_LDA(At, 0, 0); PG8_STAGE(PG8_SA(1, 1), a1 + hstep, voffA);
            PG8_WAIT_V(8); PG8_WAIT_L(0); PG8_BAR; PG8_MMA(0, 0, At, B0); PG8_MMA(0, 1, At, B1); PG8_BAR; PG8_SCHED;
            PG8_LDA(At, 0, 1); PG8_STAGE(PG8_SB(0, 0), b2, voffB); PG8_STAGE(PG8_SB(0, 1), b2 + hstep, voffB); PG8_STAGE(PG8_SA(0, 0), a2, voffA);
            PG8_WAIT_V(8); PG8_WAIT_L(0); PG8_BAR; PG8_MMA(1, 0, At, B0); PG8_MMA(1, 1, At, B1); PG8_BAR; PG8_SCHED;
            PG8_LDB(B0, 1, 0); PG8_LDB(B1, 1, 1); PG8_SCHED; PG8_LDA(At, 1, 0); PG8_STAGE(PG8_SA(0, 1), a2 + hstep, voffA);
            PG8_WAIT_V(8); PG8_WAIT_L(0); PG8_BAR; PG8_MMA(0, 0, At, B0); PG8_MMA(0, 1, At, B1); PG8_BAR; PG8_SCHED;
            PG8_LDA(At, 1, 1); PG8_STAGE(PG8_SB(1, 0), b3, voffB); PG8_STAGE(PG8_SB(1, 1), b3 + hstep, voffB); PG8_STAGE(PG8_SA(1, 0), a3, voffA);
            PG8_WAIT_V(8); PG8_WAIT_L(0); PG8_BAR; PG8_MMA(1, 0, At, B0); PG8_MMA(1, 1, At, B1); PG8_BAR; PG8_SCHED;
            } else {
            PG8_LDB(B0, 0, 0); PG8_SCHED; PG8_LDA(At, 0, 0); PG8_STAGE(PG8_SA(1, 1), a1 + hstep, voffA);
            PG8_WAIT_L(8); PG8_BAR; PG8_WAIT_L(0); PG8_MMA(0, 0, At, B0); PG8_BAR; PG8_SCHED;
            PG8_LDB(B1, 0, 1); PG8_STAGE(PG8_SB(0, 0), b2, voffB);
            PG8_BAR; PG8_WAIT_L(0); PG8_MMA(0, 1, At, B1); PG8_BAR;
            PG8_LDA(At, 0, 1); PG8_STAGE(PG8_SA(0, 0), a2, voffA);
            PG8_BAR; PG8_WAIT_L(0); PG8_MMA(1, 0, At, B0); PG8_BAR; PG8_SCHED;
            PG8_STAGE(PG8_SB(0, 1), b2 + hstep, voffB);
            PG8_WAIT_V(6); PG8_BAR; PG8_MMA(1, 1, At, B1); PG8_BAR;
            PG8_LDB(B0, 1, 0); PG8_SCHED; PG8_LDA(At, 1, 0); PG8_STAGE(PG8_SA(0, 1), a2 + hstep, voffA);
            PG8_WAIT_L(8); PG8_BAR; PG8_WAIT_L(0); PG8_MMA(0, 0, At, B0); PG8_BAR; PG8_SCHED;
            PG8_LDB(B1, 1, 1); PG8_STAGE(PG8_SB(1, 0), b3, voffB);
            PG8_BAR; PG8_WAIT_L(0); PG8_MMA(0, 1, At, B1); PG8_BAR;
            PG8_LDA(At, 1, 1); PG8_STAGE(PG8_SA(1, 0), a3, voffA);
            PG8_BAR; PG8_WAIT_L(0); PG8_MMA(1, 0, At, B0); PG8_BAR; PG8_SCHED;
            PG8_STAGE(PG8_SB(1, 1), b3 + hstep, voffB);
            PG8_WAIT_V(6); PG8_BAR; PG8_MMA(1, 1, At, B1); PG8_BAR;
            }
        }
        if constexpr (ALIGN_EPI) { if (wr == 0) PG8_BAR; }
        if constexpr (!Epi::AFTER_DRAIN) { E(acc, cur, wr, wc, fr, fq); S.done(cur); }
        if (!has_next) break;
#pragma unroll
        for (int a = 0; a < 2; ++a)
#pragma unroll
            for (int b = 0; b < 2; ++b)
#pragma unroll
                for (int m = 0; m < 4; ++m)
#pragma unroll
                    for (int n = 0; n < 2; ++n) acc[a][b][m][n] = (f32x4){0.f, 0.f, 0.f, 0.f};
        cur = nxt; cA = nA; cB = nB; ++ui;
        if constexpr (ALIGN_EPI) { if (wr == 1) PG8_BAR; }
    }
    PG8_WAIT_V(0);
    if constexpr (!ALIGN_EPI) { if (wr == 0) PG8_BAR; }
    PG8_BAR;
    if constexpr (Epi::AFTER_DRAIN) { E.fused(acc, cur, wr, wc, fr, fq, lds, wid, lane); S.done(cur); }
#undef PG8_SA
#undef PG8_SB
#undef PG8_STAGE
#undef PG8_LDA
#undef PG8_LDB
#undef PG8_MMA
#undef PG8_WAIT_V
#undef PG8_WAIT_L
#undef PG8_BAR
#undef PG8_SCHED
}
}
constexpr int NWAVES = 8;
#ifndef MK_N_LAUNCHES
#define MK_N_LAUNCHES 8
#endif
constexpr int N_PHASES = 8;
constexpr bool ONE_LAUNCH = (MK_N_LAUNCHES == 1);

constexpr int BATCH = 16, SEQ = 4096, D = 1024, NMETA = 16, TK = SEQ + NMETA, FF = 4096;
constexpr int M = BATCH * SEQ;
constexpr int DIN = 3272, DINP = 3328;
constexpr int C_RQ = 0, C_RK = 512, C_RV = 1024, C_RG = 1536, C_DQ = 2048, C_DK = 2560, C_DV = 2624, C_IQ = 2688, C_IK = 3200, C_IW = 3264;
constexpr float EPS = 1e-6f;
constexpr int KROWS = 4160;

constexpr size_t MiB = 1u << 20;
constexpr size_t WS_CTL = 0, CTL_ZERO_BYTES = 1 * MiB;
constexpr size_t WS_WIN = 2 * MiB;
constexpr size_t WS_WOUT = 9 * MiB;
constexpr size_t WS_W1 = 11 * MiB;
constexpr size_t WS_W2 = 19 * MiB;
constexpr size_t WS_ROPE = 27 * MiB;
constexpr size_t WS_PMETA = 30 * MiB;
constexpr size_t WS_KC = 32 * MiB;
constexpr size_t WS_IKC = 41 * MiB;
constexpr size_t WS_VT = 50 * MiB;
constexpr size_t WS_U = 64 * MiB;
constexpr size_t WS_PROJ = 192 * MiB;
constexpr size_t WS_QN = 608 * MiB;
constexpr size_t WS_SPT = 672 * MiB;
constexpr size_t WS_Y = 736 * MiB;
constexpr size_t WS_H = 192 * MiB;
constexpr size_t WS_END = 864 * MiB;
static_assert(WS_H + (size_t)M * FF * 2 <= WS_Y && WS_Y + (size_t)M * D * 2 <= WS_END, "d_ws map");
constexpr int CW_TMO = 0, CW_CODE = 1;
constexpr int CW_BAR = 4096;

constexpr int RING_OFF = 0, RING_BYTES = 131072;
constexpr int LDS_BYTES = 163840;
constexpr int LDSCTL_OFF = LDS_BYTES - 512, MISC_OFF = LDSCTL_OFF + 320;
static_assert(MISC_OFF + 128 <= LDS_BYTES, "LDS map");
#define GAS __attribute__((address_space(1)))
#define LAS __attribute__((address_space(3)))
typedef unsigned short bf16;
typedef unsigned v4u __attribute__((ext_vector_type(4)));
typedef float f32x4 __attribute__((ext_vector_type(4)));
typedef short bf16x8 __attribute__((ext_vector_type(8)));
typedef GAS unsigned gu32;
typedef GAS unsigned long long gu64;
#define RLX_AGENT __ATOMIC_RELAXED, __HIP_MEMORY_SCOPE_AGENT
#define LDS_WAIT() asm volatile("s_waitcnt lgkmcnt(0)" ::: "memory")
#define VM_WAIT() asm volatile("s_waitcnt vmcnt(0)" ::: "memory")
__device__ __forceinline__ unsigned long long rt() { return __builtin_amdgcn_s_memrealtime(); }
__device__ __forceinline__ unsigned f2bf(float f) { unsigned u = __builtin_bit_cast(unsigned, f); return (u + 0x7fffu + ((u >> 16) & 1u)) >> 16; }
__device__ __forceinline__ unsigned pk2(float lo, float hi) { return f2bf(lo) | (f2bf(hi) << 16); }

#define XB_TMO      128
#define XB_XCNT(j)  (256  + 64 * (j))
#define XB_XSUB(j)  (1280 + 64 * (j))
#define XB_XGEN(j)  (2304 + 64 * (j))
#define XB_TOP      3328
#define XB_TOPGEN   3392
#define XCD_BAR_WORDS 3456
#define XB_SPIN_CAP (1u << 22)

__device__ __forceinline__ unsigned xb_ld(unsigned* p)              { return __hip_atomic_load(p, __ATOMIC_RELAXED, __HIP_MEMORY_SCOPE_AGENT); }
__device__ __forceinline__ unsigned xb_add(unsigned* p, unsigned v) { return __hip_atomic_fetch_add(p, v, __ATOMIC_RELAXED, __HIP_MEMORY_SCOPE_AGENT); }
__device__ __forceinline__ unsigned xb_xcc_id() { return (unsigned)__builtin_amdgcn_s_getreg((3 << 11) | 20) & 0xFu; }
#define XB_SPIN(cond, bar) do { unsigned _sp = 0; while (cond) { __builtin_amdgcn_s_sleep(1); \
    if ((++_sp & 255u) == 0u) { if (xb_ld(&(bar)[XB_TMO])) break; if (_sp > XB_SPIN_CAP) { atomicAdd(&(bar)[XB_TMO], 1u); break; } } } } while (0)

struct XcdBarrier {
    unsigned* bar; unsigned x;
    volatile LAS unsigned* st;
};

__device__ __forceinline__ XcdBarrier xcd_barrier_post(unsigned* bar, volatile LAS unsigned* st) {
    XcdBarrier b; b.bar = bar; b.x = xb_xcc_id(); b.st = st;
    if (threadIdx.x == 0) (void)xb_add(&bar[XB_XCNT(b.x)], 1u);
    return b;
}
__device__ __forceinline__ void xcd_barrier_complete(unsigned* bar, unsigned x, unsigned& nloc, unsigned& nx) {
    const unsigned G = gridDim.x * gridDim.y * gridDim.z;
    unsigned sum, cnt, mine, sp = 0u;
    for (;;) {
        sum = 0u; cnt = 0u; mine = 0u;
#pragma unroll
        for (unsigned j = 0; j < 16; ++j) { const unsigned c = xb_ld(&bar[XB_XCNT(j)]); sum += c; cnt += (c > 0u) ? 1u : 0u; mine = (j == x) ? c : mine; }
        if (sum == G) break;
        __builtin_amdgcn_s_sleep(1);
        if ((++sp & 255u) == 0u) { if (xb_ld(&bar[XB_TMO])) break; if (sp > XB_SPIN_CAP) { atomicAdd(&bar[XB_TMO], 1u); break; } }
    }
    nloc = mine > 0u ? mine : 1u; nx = cnt > 0u ? cnt : 1u;
}

__device__ __forceinline__ void xcd_barrier(const XcdBarrier& b) {
    asm volatile("s_waitcnt vmcnt(0)" ::: "memory");
    __syncthreads();
    if (threadIdx.x == 0) {
        unsigned* bar = b.bar;
        __builtin_amdgcn_s_waitcnt(0);
        unsigned nloc = b.st[0], nx = b.st[1];
        if (nloc == 0u) { xcd_barrier_complete(bar, b.x, nloc, nx); b.st[0] = nloc; b.st[1] = nx; }
        const unsigned old = xb_add(&bar[XB_XSUB(b.x)], 1u);
        const unsigned gen = old / nloc;
        if (old + 1u == (gen + 1u) * nloc) {
            __builtin_amdgcn_fence(__ATOMIC_RELEASE, "agent");
            asm volatile("s_waitcnt vmcnt(0)" ::: "memory");
            const unsigned og = xb_add(&bar[XB_TOP], 1u);
            const unsigned tg = og / nx;
            if (og + 1u == (tg + 1u) * nx) xb_add(&bar[XB_TOPGEN], 1u);
            else XB_SPIN(xb_ld(&bar[XB_TOPGEN]) == tg, bar);
            __builtin_amdgcn_fence(__ATOMIC_ACQUIRE, "agent");
            xb_add(&bar[XB_XGEN(b.x)], 1u);
            asm volatile("s_waitcnt vmcnt(0)" ::: "memory");
        } else {
            XB_SPIN(xb_ld(&bar[XB_XGEN(b.x)]) == gen, bar);
            __builtin_amdgcn_fence(__ATOMIC_ACQUIRE, "agent");
            asm volatile("s_waitcnt vmcnt(0)" ::: "memory");
        }
    }
    __syncthreads();
}

typedef short v4i16_t __attribute__((ext_vector_type(4)));
typedef float f32x2v __attribute__((ext_vector_type(2)));
typedef unsigned u32x2v __attribute__((ext_vector_type(2)));
#define MFMA16(a, b, c) __builtin_amdgcn_mfma_f32_16x16x32_bf16((a), (b), (c), 0, 0, 0)
__device__ __forceinline__ float bf2f(unsigned short u) { return __uint_as_float((unsigned)u << 16); }
__device__ __forceinline__ bf16x8 frag_n(const LAS unsigned char* img, int stride, int rowsel, int k0, int lane) {
    return *(const LAS bf16x8*)(img + rowsel * stride + (k0 + 8 * (lane >> 4)) * 2);
}
__device__ __forceinline__ bf16x8 frag_t(const LAS unsigned char* img, int stride, int row0, int k0, int lane) {
    const int g = lane >> 4, q = (lane >> 2) & 3, p = lane & 3;
    const LAS unsigned char* a = img + (k0 + 8 * g + q) * stride + (row0 + 4 * p) * 2;
    const v4i16_t lo = __builtin_amdgcn_ds_read_tr16_b64_v4i16((LAS v4i16_t*)a);
    const v4i16_t hi = __builtin_amdgcn_ds_read_tr16_b64_v4i16((LAS v4i16_t*)(a + 4 * stride));
    return (bf16x8){lo[0], lo[1], lo[2], lo[3], hi[0], hi[1], hi[2], hi[3]};
}
__device__ __forceinline__ unsigned pkbf(float lo, float hi) { return pg8::cvt_pk_bf16(lo, hi); }

constexpr int IMG_STRIDE = 288;
constexpr float RET_KSCALE = 0.08838834764831845f;

__device__ __forceinline__ void rot8(const v4u a, const v4u b, const f32x4 (&cs)[4], float sc, v4u& o1, v4u& o2) {
    float x1[8], x2[8], c[8], s[8];
#pragma unroll
    for (int i = 0; i < 4; ++i) { x1[2 * i] = __uint_as_float(a[i] << 16); x1[2 * i + 1] = __uint_as_float(a[i] & 0xffff0000u); x2[2 * i] = __uint_as_float(b[i] << 16); x2[2 * i + 1] = __uint_as_float(b[i] & 0xffff0000u);
        c[2 * i] = cs[i][0]; s[2 * i] = cs[i][1]; c[2 * i + 1] = cs[i][2]; s[2 * i + 1] = cs[i][3]; }
    float r1[8], r2[8];
#pragma unroll
    for (int i = 0; i < 8; ++i) { r1[i] = (x1[i] * c[i] - x2[i] * s[i]) * sc; r2[i] = (x1[i] * s[i] + x2[i] * c[i]) * sc; }
#pragma unroll
    for (int i = 0; i < 4; ++i) { o1[i] = pkbf(r1[2 * i], r1[2 * i + 1]); o2[i] = pkbf(r2[2 * i], r2[2 * i + 1]); }
}
constexpr int DSA_CAP = 64;
constexpr int DSA_MSTR = 132;
constexpr int L_HIST = 0, L_MASK = 65536, L_QPAR = L_MASK + 128 * DSA_MSTR * 4, L_CCNT = L_QPAR + 128 * 16, L_BIAS = L_CCNT + 512, L_DSA_END = L_BIAS + 128 * 8 * 4;
static_assert(L_DSA_END <= LDSCTL_OFF, "DSA LDS map");
constexpr float LOG2E = 1.4426950408889634f;

__device__ __forceinline__ void idx_tile(const bf16* ikb, int kt, const bf16x8 (&iq)[8][2], const float (&w)[8], int lane, f32x4 (&sc)[2]) {
    const int i = lane & 15, g = lane >> 4;
#pragma unroll
    for (int u = 0; u < 2; ++u) {
        const bf16* rp = ikb + (size_t)(32 * kt + 8 * (i >> 2) + 4 * u + (i & 3)) * 64 + 8 * g;
        const bf16x8 a0 = *(const GAS bf16x8*)rp, a1 = *(const GAS bf16x8*)(rp + 32);
        f32x4 acc = (f32x4){0.f, 0.f, 0.f, 0.f};
#pragma unroll
        for (int h = 0; h < 8; ++h) {
            f32x4 s = MFMA16(a0, iq[h][0], ((f32x4){0.f, 0.f, 0.f, 0.f})); s = MFMA16(a1, iq[h][1], s);
#pragma unroll
            for (int r = 0; r < 4; ++r) acc[r] = __builtin_fmaf(w[h], __builtin_fmaxf(s[r], 0.f), acc[r]);
        }
        sc[u] = acc;
    }
}
__device__ __forceinline__ int bin_of(float s, float lo, float invw) {
    const float t = __fmul_rn(__fsub_rn(s, lo), invw);
    return (int)__builtin_fminf(__builtin_fmaxf(t, 0.f), 255.f);
}
__device__ __forceinline__ float wave_sum(float v) {
#pragma unroll
    for (int o = 1; o < 64; o <<= 1) v += __shfl_xor(v, o);
    return v;
}
__device__ __forceinline__ void p0_transpose_item(const float* W, int K, int N, int NP, bf16* WT, LAS float* scr, int item, int lane) {
    const int nblk = NP / 32, kb = item / nblk, nb = item % nblk, k0 = 64 * kb, n0 = 32 * nb;
    const int nn = n0 + (lane & 31); const bool ok = nn < N;
#pragma unroll 8
    for (int i = 0; i < 32; ++i) { const int kk = 2 * i + (lane >> 5); scr[kk * 33 + (lane & 31)] = ok ? W[(size_t)(k0 + kk) * N + nn] : 0.f; }
    LDS_WAIT(); asm volatile("" ::: "memory");
    const int c = lane & 7;
#pragma unroll
    for (int j = 0; j < 4; ++j) { const int n = (lane >> 3) + 8 * j; const LAS float* s = scr + (8 * c) * 33 + n;
        v4u o; o.x = pk2(s[0 * 33], s[1 * 33]); o.y = pk2(s[2 * 33], s[3 * 33]); o.z = pk2(s[4 * 33], s[5 * 33]); o.w = pk2(s[6 * 33], s[7 * 33]);
        *(GAS v4u*)(WT + (size_t)(n0 + n) * K + k0 + 8 * c) = o; }
    LDS_WAIT(); asm volatile("" ::: "memory");
}
__device__ __forceinline__ void rms_row_to_bf16(const float* xrow, const float* w, bf16* orow, int lane) {
    const GAS f32x4* xr = (const GAS f32x4*)xrow + lane; const GAS f32x4* wr = (const GAS f32x4*)w + lane;
    f32x4 v[4]; float s = 0.f;
#pragma unroll
    for (int j = 0; j < 4; ++j) { v[j] = xr[64 * j]; s += (v[j].x * v[j].x + v[j].y * v[j].y) + (v[j].z * v[j].z + v[j].w * v[j].w); }
    const float r = 1.f / sqrtf(wave_sum(s) * (1.f / D) + EPS);
    GAS unsigned long long* o8 = (GAS unsigned long long*)orow + lane;
#pragma unroll
    for (int j = 0; j < 4; ++j) { const f32x4 g = wr[64 * j];
        o8[64 * j] = (unsigned long long)pk2(v[j].x * r * g.x, v[j].y * r * g.y) | ((unsigned long long)pk2(v[j].z * r * g.z, v[j].w * r * g.w) << 32); }
}

struct Args { const float* in[12]; float* out; unsigned char* ws; int ph_lo, ph_hi; };
__global__ void __launch_bounds__(NWAVES * 64, 2) mk_fwd(Args args) {
    extern __shared__ __attribute__((aligned(16))) unsigned char lds_raw[];
    LAS unsigned char* lds = (LAS unsigned char*)lds_raw;
    volatile LAS unsigned* MISC = (volatile LAS unsigned*)(lds + MISC_OFF);
    const int tid = threadIdx.x, lane = tid & 63, wave = __builtin_amdgcn_readfirstlane(tid >> 6);
    const int G = gridDim.x; const int bx = blockIdx.x; const int vcu = (G % 8 == 0) ? (bx % 8) * (G / 8) + bx / 8 : bx;
    unsigned char* ws = args.ws;
    gu32* ctl = (gu32*)(ws + WS_CTL);
    const float* x = args.in[0]; const float* meta = args.in[1]; const float* norm1_w = args.in[2]; const float* w_in = args.in[3];
    const float* ret_norm_w = args.in[4]; const float* q_norm_w = args.in[5]; const float* k_norm_w = args.in[6]; const float* rel_bias = args.in[7];
    const float* w_out = args.in[8]; const float* norm2_w = args.in[9]; const float* w_ff1 = args.in[10]; const float* w_ff2 = args.in[11];
    float* out = args.out;
    bf16* WIN_T = (bf16*)(ws + WS_WIN); bf16* WOUT_T = (bf16*)(ws + WS_WOUT); bf16* W1_T = (bf16*)(ws + WS_W1); bf16* W2_T = (bf16*)(ws + WS_W2);
    bf16* U = (bf16*)(ws + WS_U); bf16* PROJ = (bf16*)(ws + WS_PROJ); bf16* Y = (bf16*)(ws + WS_Y); bf16* HB = (bf16*)(ws + WS_H);
    float* ROPE = (float*)(ws + WS_ROPE); float* PMETA = (float*)(ws + WS_PMETA); bf16* PM16 = (bf16*)(ws + WS_PMETA + 512 * 1024); bf16* SPT = (bf16*)(ws + WS_SPT);
    bf16* KC = (bf16*)(ws + WS_KC); bf16* IKC = (bf16*)(ws + WS_IKC); bf16* VT = (bf16*)(ws + WS_VT); bf16* QN = (bf16*)(ws + WS_QN);
    for (int u = tid; u < (LDS_BYTES - LDSCTL_OFF) / 4; u += NWAVES * 64) ((LAS unsigned*)(lds + LDSCTL_OFF))[u] = 0u;
    __syncthreads();
    XcdBarrier bar; bar.bar = (unsigned*)(ctl + CW_BAR); bar.x = 0; bar.st = nullptr;
    if (ONE_LAUNCH) bar = xcd_barrier_post((unsigned*)(ctl + CW_BAR), MISC + 8);
#define GRID_BAR() do { if (ONE_LAUNCH) xcd_barrier(bar); } while (0)
    const int lo = args.ph_lo, hi = args.ph_hi;
#define IN(k) (lo <= (k) && (k) < hi)
#define BOTH(k) (IN(k) && IN((k) + 1))
    const int gw = vcu * NWAVES + wave, NGW = G * NWAVES;

    if (IN(0)) {
        LAS float* scr = (LAS float*)(lds + RING_OFF + wave * 16384);
        constexpr int I_IN = (D / 64) * (DINP / 32), I_O = (D / 64) * (D / 32), I_1 = (D / 64) * (FF / 32), I_2 = (FF / 64) * (D / 32);
        constexpr int NITEMS = I_IN + I_O + I_1 + I_2;
        for (int it = gw; it < NITEMS; it += NGW) {
            int r = it;
            if (r < I_IN) { p0_transpose_item(w_in, D, DIN, DINP, WIN_T, scr, r, lane); continue; } r -= I_IN;
            if (r < I_O) { p0_transpose_item(w_out, D, D, D, WOUT_T, scr, r, lane); continue; } r -= I_O;
            if (r < I_1) { p0_transpose_item(w_ff1, D, FF, FF, W1_T, scr, r, lane); continue; } r -= I_1;
            p0_transpose_item(w_ff2, FF, D, D, W2_T, scr, r, lane);
        }
        for (int m = gw; m < M; m += NGW) rms_row_to_bf16(x + (size_t)m * D, norm1_w, U + (size_t)m * D, lane);

        for (int i = bx * 512 + tid; i < TK * 64; i += G * 512) {
            const int t = i >> 6, fi = i & 63;
            const double inv = exp2(-(double)fi * (13.287712379549449 / 64.0));
            const double ang = (double)t * inv;
            const double nrev = rint(ang * 0.15915494309189535);
            double r = fma(-nrev, 6.283185307179586, ang); r = fma(-nrev, 2.4492935982947064e-16, r);
            const double r2 = r * r; double sn = 1.0, cn = 1.0;
#pragma unroll
            for (int k = 12; k >= 1; --k) { sn = 1.0 - r2 / (double)((2 * k) * (2 * k + 1)) * sn; cn = 1.0 - r2 / (double)((2 * k - 1) * (2 * k)) * cn; }
            sn *= r;
            ((GAS f32x2v*)ROPE)[i] = (f32x2v){(float)cn, (float)sn};
        }
        for (int i = bx * 512 + tid; i < 112 * DINP * 2 / 16; i += G * 512) ((GAS v4u*)PM16)[i] = (v4u){0u, 0u, 0u, 0u};
        {
            __syncthreads();
            LAS float* un = (LAS float*)(lds + RING_OFF);
            LAS float* red = (LAS float*)(lds + RING_OFF + 16 * 1025 * 4);
#pragma unroll
            for (int rr = 0; rr < 2; ++rr) { const int r = 2 * wave + rr; const GAS f32x4* xr = (const GAS f32x4*)(meta + (size_t)r * D) + lane; const GAS f32x4* wr = (const GAS f32x4*)norm1_w + lane;
                f32x4 v[4]; float s = 0.f;
#pragma unroll
                for (int j = 0; j < 4; ++j) { v[j] = xr[64 * j]; s += (v[j].x * v[j].x + v[j].y * v[j].y) + (v[j].z * v[j].z + v[j].w * v[j].w); }
                const float ri = 1.f / sqrtf(wave_sum(s) * (1.f / D) + EPS);
#pragma unroll
                for (int j = 0; j < 4; ++j) { const f32x4 g = wr[64 * j]; const int k = 4 * lane + 256 * j;
                    un[r * 1025 + k] = v[j].x * ri * g.x; un[r * 1025 + k + 1] = v[j].y * ri * g.y; un[r * 1025 + k + 2] = v[j].z * ri * g.z; un[r * 1025 + k + 3] = v[j].w * ri * g.w; } }
            __syncthreads();
            const int c0 = 13 * vcu; float acc[13];
#pragma unroll
            for (int cc = 0; cc < 13; ++cc) acc[cc] = 0.f;
            for (int i = 0; i < 32; ++i) { const int k = 128 * wave + (lane >> 4) + 4 * i; const float uv = un[(lane & 15) * 1025 + k]; const float* wp = w_in + (size_t)k * DIN + c0;
#pragma unroll
                for (int cc = 0; cc < 13; ++cc) { const float wv = (c0 + cc < DIN) ? wp[cc] : 0.f; acc[cc] = fmaf(uv, wv, acc[cc]); } }
#pragma unroll
            for (int cc = 0; cc < 13; ++cc) { acc[cc] += __shfl_xor(acc[cc], 16); acc[cc] += __shfl_xor(acc[cc], 32); if (lane < 16) red[(wave * 16 + lane) * 13 + cc] = acc[cc]; }
            __syncthreads();
            if (tid < 208) { const int r = tid / 13, cc = tid % 13; float s = 0.f;
#pragma unroll
                for (int w8 = 0; w8 < 8; ++w8) s += red[(w8 * 16 + r) * 13 + cc];
                const int c = c0 + cc; if (c >= DIN) s = 0.f;
                PMETA[r * DINP + c] = s; PM16[(size_t)(112 + r) * DINP + c] = (bf16)f2bf(s); }
            __syncthreads();
        }
        if (BOTH(0)) GRID_BAR();
    }
    if (IN(1)) {
        pg8::Gemm g{U, WIN_T, M, DINP, D}; pg8::StaticOrder S; S.init(M, DINP, G, (int)blockIdx.x);
        pg8::EpiBf16<0> E{PROJ, DINP};
        pg8::gemm_phase<pg8::EpiBf16<0>, pg8::StaticOrder, true, true>(lds + RING_OFF, g, S, E);
        if (BOTH(1)) GRID_BAR();
    }
    if (IN(2)) {
        {
            LAS unsigned char* vscr = lds + RING_OFF + 65536 + wave * 1024;
            for (int unit = gw; unit < BATCH * 520; unit += NGW) {
                const int b = unit / 520, gidx = unit % 520; const bool isx = gidx >= 2 && gidx < 514, ismeta = gidx < 2;
                const int part = lane >> 3, sub = lane & 7;
#pragma unroll 2
                for (int r = 0; r < 8; ++r) {
                    const bf16* src = ismeta ? PM16 + (size_t)(112 + 8 * gidx + r) * DINP : PROJ + ((size_t)b * SEQ + (isx ? 8 * (gidx - 2) + r : 0)) * DINP;
                    const int kk = 8 * gidx + r;
                    if (isx) {
                        const v4u qv = *(const GAS v4u*)(src + C_DQ + 8 * lane); float xq[8]; float ss = 0.f;
#pragma unroll
                        for (int i = 0; i < 4; ++i) { xq[2 * i] = __uint_as_float(qv[i] << 16); xq[2 * i + 1] = __uint_as_float(qv[i] & 0xffff0000u); ss += xq[2 * i] * xq[2 * i] + xq[2 * i + 1] * xq[2 * i + 1]; }
                        ss += __shfl_xor(ss, 1); ss += __shfl_xor(ss, 2); ss += __shfl_xor(ss, 4);
                        const float scq = (1.f / sqrtf(ss * (1.f / 64.f) + EPS)) * (0.125f * LOG2E);
                        const f32x4 g0 = *(const GAS f32x4*)(q_norm_w + 8 * sub), g1 = *(const GAS f32x4*)(q_norm_w + 8 * sub + 4);
                        v4u o; o[0] = pkbf(xq[0] * scq * g0[0], xq[1] * scq * g0[1]); o[1] = pkbf(xq[2] * scq * g0[2], xq[3] * scq * g0[3]); o[2] = pkbf(xq[4] * scq * g1[0], xq[5] * scq * g1[1]); o[3] = pkbf(xq[6] * scq * g1[2], xq[7] * scq * g1[3]);
                        *(GAS v4u*)(QN + ((size_t)b * SEQ + 8 * (gidx - 2) + r) * 512 + 8 * lane) = o;
                    }
                    const int col = part == 0 ? C_DK : (part == 1 ? C_IK : C_DV);
                    v4u kv = (v4u){0u, 0u, 0u, 0u};
                    if ((isx || ismeta) && lane < 24) kv = *(const GAS v4u*)(src + col + 8 * sub);
                    float xk[8]; float sk = 0.f;
#pragma unroll
                    for (int i = 0; i < 4; ++i) { xk[2 * i] = __uint_as_float(kv[i] << 16); xk[2 * i + 1] = __uint_as_float(kv[i] & 0xffff0000u); sk += xk[2 * i] * xk[2 * i] + xk[2 * i + 1] * xk[2 * i + 1]; }
                    sk += __shfl_xor(sk, 1); sk += __shfl_xor(sk, 2); sk += __shfl_xor(sk, 4);
                    if (lane < 8) { const float sck = 1.f / sqrtf(sk * (1.f / 64.f) + EPS);
                        const f32x4 g0 = *(const GAS f32x4*)(k_norm_w + 8 * sub), g1 = *(const GAS f32x4*)(k_norm_w + 8 * sub + 4);
                        v4u o; o[0] = pkbf(xk[0] * sck * g0[0], xk[1] * sck * g0[1]); o[1] = pkbf(xk[2] * sck * g0[2], xk[3] * sck * g0[3]); o[2] = pkbf(xk[4] * sck * g1[0], xk[5] * sck * g1[1]); o[3] = pkbf(xk[6] * sck * g1[2], xk[7] * sck * g1[3]);
                        *(GAS v4u*)(KC + ((size_t)b * KROWS + kk) * 64 + 8 * sub) = o; }
                    else if (lane < 16) *(GAS v4u*)(IKC + ((size_t)b * KROWS + kk) * 64 + 8 * sub) = kv;
                    else if (lane < 24) *(LAS v4u*)(vscr + r * 128 + 16 * sub) = kv;
                }
                LDS_WAIT(); asm volatile("" ::: "memory");
                { const LAS unsigned short* vs = (const LAS unsigned short*)vscr + lane; v4u o;
#pragma unroll
                  for (int i = 0; i < 4; ++i) o[i] = (unsigned)vs[(2 * i) * 64] | ((unsigned)vs[(2 * i + 1) * 64] << 16);
                  *(GAS v4u*)(VT + ((size_t)b * 64 + lane) * KROWS + 8 * gidx) = o; }
                LDS_WAIT(); asm volatile("" ::: "memory");
            }
            __syncthreads();
        }
        if (vcu < 256) {
            const int b = vcu >> 4, h = (vcu >> 2) & 3, eq = vcu & 3;
            const float lg2 = log2f(1.f - exp2f(-5.f - (float)h));
            const float cdec = exp2f(lg2 * 128.f);
            LAS unsigned char* Kimg = lds + RING_OFF; LAS unsigned char* Vimg = lds + RING_OFF + 128 * IMG_STRIDE;
            f32x4 acc[2]; acc[0] = (f32x4){0.f, 0.f, 0.f, 0.f}; acc[1] = acc[0];
            v4u ka[2], kb[2], vv; f32x4 cs[2][4];
#define R12_LOAD(n) do { _Pragma("unroll") for (int i_ = 0; i_ < 2; ++i_) { const int item = tid + 512 * i_, c = item >> 3, j = item & 7; \
                const bf16* rp = ((n) == 0 ? PM16 + (size_t)c * DINP : PROJ + ((size_t)b * SEQ + 128 * ((n) - 1) + c) * DINP) + C_RK + 128 * h + 8 * j; \
                ka[i_] = *(const GAS v4u*)rp; kb[i_] = *(const GAS v4u*)(rp + 64); int t = 128 * (n) - 112 + c; t = t < 0 ? 0 : t; \
                const GAS f32x4* rq = (const GAS f32x4*)(ROPE + ((size_t)t * 64 + 8 * j) * 2); cs[i_][0] = rq[0]; cs[i_][1] = rq[1]; cs[i_][2] = rq[2]; cs[i_][3] = rq[3]; } \
            { const int c = tid >> 2, part = tid & 3; const bf16* rp = ((n) == 0 ? PM16 + (size_t)c * DINP : PROJ + ((size_t)b * SEQ + 128 * ((n) - 1) + c) * DINP) + C_RV + 128 * h + 32 * eq + 8 * part; vv = *(const GAS v4u*)rp; } } while (0)
            R12_LOAD(0);
            for (int n = 0; n < 32; ++n) {
#pragma unroll
                for (int i_ = 0; i_ < 2; ++i_) { const int item = tid + 512 * i_, c = item >> 3, j = item & 7; v4u o1, o2;
                    rot8(ka[i_], kb[i_], cs[i_], RET_KSCALE * exp2f(lg2 * (float)(127 - c)), o1, o2);
                    *(LAS v4u*)(Kimg + c * IMG_STRIDE + 16 * j) = o1; *(LAS v4u*)(Kimg + c * IMG_STRIDE + 128 + 16 * j) = o2; }
                *(LAS v4u*)(Vimg + (tid >> 2) * 96 + 16 * (tid & 3)) = vv;
                __syncthreads();
                if (n + 1 < 32) R12_LOAD(n + 1);
                acc[0] = acc[0] * cdec; acc[1] = acc[1] * cdec;
#pragma unroll
                for (int ks = 0; ks < 4; ++ks) { const bf16x8 ak = frag_t(Kimg, IMG_STRIDE, 16 * wave, 32 * ks, lane);
                    const bf16x8 b0 = frag_t(Vimg, 96, 0, 32 * ks, lane), b1 = frag_t(Vimg, 96, 16, 32 * ks, lane);
                    acc[0] = MFMA16(ak, b0, acc[0]); acc[1] = MFMA16(ak, b1, acc[1]); }
                bf16* sp = SPT + ((size_t)((b * 4 + h) * 32 + n)) * 16384;
#pragma unroll
                for (int et = 0; et < 2; ++et) { const int e = 32 * eq + 16 * et + (lane & 15), d = 16 * wave + 4 * (lane >> 4);
                    *(GAS u32x2v*)(sp + e * 128 + d) = (u32x2v){pkbf(acc[et][0], acc[et][1]), pkbf(acc[et][2], acc[et][3])}; }
                __syncthreads();
            }
#undef R12_LOAD
        }
        if (BOTH(2)) GRID_BAR();
    }
    if (IN(3)) {
        {
            for (int i = tid; i < 128 * 8; i += 512) { const int d = i >> 3, h = i & 7;
                int bk = d; if (d >= 16) { bk = 16 + (int)(logf((float)d * (1.f / 16.f)) / logf(8.f) * 16.f); bk = bk > 31 ? 31 : bk; }
                ((LAS float*)(lds + L_BIAS))[i] = (rel_bias[bk * 8 + h] - rel_bias[31 * 8 + h]) * LOG2E; }
            __syncthreads();
            LAS unsigned* HIST = (LAS unsigned*)(lds + L_HIST); LAS unsigned* MASK = (LAS unsigned*)(lds + L_MASK); LAS unsigned* QPAR = (LAS unsigned*)(lds + L_QPAR);
            LAS unsigned* CCNT = (LAS unsigned*)(lds + L_CCNT); const LAS float* BIAS = (const LAS float*)(lds + L_BIAS);
            const int ql = lane & 15, g4 = lane >> 4;
            for (int uu = 0; uu < 2; ++uu) {
                const int pairi = vcu & 15, b = vcu >> 4; if (vcu >= 256) break;
                const int j = uu == 0 ? pairi : 31 - pairi;
                const int nt = 5 + 4 * j;
                const int qloc = 16 * wave + ql;
                const size_t mrow = (size_t)b * SEQ + 128 * j + qloc;
                const int p = 16 + 128 * j + qloc;
                const bf16* ikb = IKC + (size_t)b * KROWS * 64; const bf16* kcb = KC + (size_t)b * KROWS * 64; const bf16* vtb = VT + (size_t)b * 64 * KROWS;
                LAS unsigned* hrow = HIST + qloc * 128;
                bf16x8 iq[8][2]; float wq[8];
                { const bf16* rp = PROJ + mrow * DINP + C_IQ + 8 * g4;
#pragma unroll
                  for (int h = 0; h < 8; ++h) { iq[h][0] = *(const GAS bf16x8*)(rp + 64 * h); iq[h][1] = *(const GAS bf16x8*)(rp + 64 * h + 32); }
                  const v4u wv = *(const GAS v4u*)(PROJ + mrow * DINP + C_IW);
#pragma unroll
                  for (int i = 0; i < 4; ++i) { wq[2 * i] = __uint_as_float(wv[i] << 16) * (0.35355339059327373f * 0.125f); wq[2 * i + 1] = __uint_as_float(wv[i] & 0xffff0000u) * (0.35355339059327373f * 0.125f); } }
                float lo, invw;
                { float s1 = 0.f, s2 = 0.f;
                  for (int kt = 0; kt < 2; ++kt) { f32x4 sc[2]; idx_tile(ikb, kt, iq, wq, lane, sc);
#pragma unroll
                      for (int u = 0; u < 2; ++u)
#pragma unroll
                          for (int r = 0; r < 4; ++r) { s1 += sc[u][r]; s2 += sc[u][r] * sc[u][r]; } }
                  s1 += __shfl_xor(s1, 16); s1 += __shfl_xor(s1, 32); s2 += __shfl_xor(s2, 16); s2 += __shfl_xor(s2, 32);
                  const float mean = s1 * (1.f / 64.f); float var = s2 * (1.f / 64.f) - mean * mean; var = var > 1e-30f ? var : 1e-30f;
                  const float sd = sqrtf(var); lo = mean - 5.f * sd; invw = 25.6f / sd; }
                { LAS v4u* hz = (LAS v4u*)(HIST + 16 * wave * 128);
#pragma unroll
                  for (int i = 0; i < 8; ++i) hz[lane + 64 * i] = (v4u){0u, 0u, 0u, 0u}; }
                for (int kt = 0; kt < nt; ++kt) { f32x4 sc[2]; idx_tile(ikb, kt, iq, wq, lane, sc);
#pragma unroll
                    for (int u = 0; u < 2; ++u)
#pragma unroll
                        for (int r = 0; r < 4; ++r) { const int kk = 32 * kt + 8 * g4 + 4 * u + r;
                            if (kk <= p) { const int bn = bin_of(sc[u][r], lo, invw); __hip_atomic_fetch_add(hrow + (bn >> 1), 1u << (16 * (bn & 1)), __ATOMIC_RELAXED, __HIP_MEMORY_SCOPE_WORKGROUP); } } }
                for (int qq = 0; qq < 16; ++qq) { const int q = 16 * wave + qq; const int pq = 16 + 128 * j + q; const int kq = pq + 1 < 256 ? pq + 1 : 256;
                    const u32x2v wv = *(const LAS u32x2v*)(HIST + q * 128 + 2 * lane);
                    const int c0 = wv[0] & 0xffff, c1 = wv[0] >> 16, c2 = wv[1] & 0xffff, c3 = wv[1] >> 16; const int sl = c0 + c1 + c2 + c3;
                    int incl = sl;
#pragma unroll
                    for (int off = 1; off < 64; off <<= 1) { const int t = __shfl_down(incl, off); if (lane + off < 64) incl += t; }
                    int cum = incl - sl; int bst = -1, ngt = 0;
                    if (cum < kq && cum + c3 >= kq) { bst = 4 * lane + 3; ngt = cum; } cum += c3;
                    if (cum < kq && cum + c2 >= kq) { bst = 4 * lane + 2; ngt = cum; } cum += c2;
                    if (cum < kq && cum + c1 >= kq) { bst = 4 * lane + 1; ngt = cum; } cum += c1;
                    if (cum < kq && cum + c0 >= kq) { bst = 4 * lane + 0; ngt = cum; }
                    if (bst >= 0) { QPAR[q * 4 + 0] = (unsigned)bst; QPAR[q * 4 + 1] = (unsigned)(kq - ngt); } }
                LDS_WAIT(); asm volatile("" ::: "memory");
                const int bstar = (int)QPAR[qloc * 4 + 0];
                if (lane < 16) CCNT[16 * wave + lane] = 0u;
                LAS float* cands = (LAS float*)hrow; LAS unsigned* candk = hrow + 64;
                for (int kt = 0; kt < nt; ++kt) { f32x4 sc[2]; idx_tile(ikb, kt, iq, wq, lane, sc); unsigned bits = 0u;
#pragma unroll
                    for (int u = 0; u < 2; ++u)
#pragma unroll
                        for (int r = 0; r < 4; ++r) { const int kk = 32 * kt + 8 * g4 + 4 * u + r;
                            if (kk <= p) { const int bn = bin_of(sc[u][r], lo, invw);
                                if (bn > bstar) bits |= 1u << (8 * g4 + 4 * u + r);
                                else if (bn == bstar) { const unsigned ix = __hip_atomic_fetch_add(CCNT + qloc, 1u, __ATOMIC_RELAXED, __HIP_MEMORY_SCOPE_WORKGROUP);
                                    if (ix < (unsigned)DSA_CAP) { cands[ix] = sc[u][r]; candk[ix] = (unsigned)kk; } } } }
                    bits |= __shfl_xor(bits, 16); bits |= __shfl_xor(bits, 32);
                    if (g4 == 0) MASK[qloc * DSA_MSTR + kt] = bits; }
                LDS_WAIT(); asm volatile("" ::: "memory");
                for (int qq = 0; qq < 16; ++qq) { const int q = 16 * wave + qq;
                    int cnt = (int)CCNT[q]; cnt = cnt < DSA_CAP ? cnt : DSA_CAP; cnt = __builtin_amdgcn_readfirstlane(cnt);
                    const int need = (int)QPAR[q * 4 + 1];
                    const LAS float* cs_ = (const LAS float*)(HIST + q * 128); const LAS unsigned* ck_ = HIST + q * 128 + 64;
                    const float sme = lane < cnt ? cs_[lane] : 0.f; const unsigned kme = lane < cnt ? ck_[lane] : 0u; int rank = 0;
                    for (int t = 0; t < cnt; ++t) { const float so = cs_[t]; const unsigned ko = ck_[t]; rank += (so > sme || (so == sme && ko < kme)) ? 1 : 0; }
                    if (lane < cnt && rank < need) __hip_atomic_fetch_or(MASK + q * DSA_MSTR + (kme >> 5), 1u << (kme & 31u), __ATOMIC_RELAXED, __HIP_MEMORY_SCOPE_WORKGROUP); }
                LDS_WAIT(); asm volatile("" ::: "memory");
                const int pmin = 16 + 128 * j + 16 * wave;
                for (int hg = 0; hg < 4; ++hg) {
                    bf16x8 qf[2][2];
                    { const bf16* rp = QN + mrow * 512 + 128 * hg + 8 * g4;
#pragma unroll
                      for (int hh = 0; hh < 2; ++hh) { qf[hh][0] = *(const GAS bf16x8*)(rp + 64 * hh); qf[hh][1] = *(const GAS bf16x8*)(rp + 64 * hh + 32); } }
                    f32x4 oacc[2][4]; float lsum[2];
#pragma unroll
                    for (int hh = 0; hh < 2; ++hh) { lsum[hh] = 0.f;
#pragma unroll
                        for (int dt = 0; dt < 4; ++dt) oacc[hh][dt] = (f32x4){0.f, 0.f, 0.f, 0.f}; }
                    for (int kt = 0; kt < nt; ++kt) {
                        const unsigned mw = (MASK[qloc * DSA_MSTR + kt] >> (8 * g4)) & 0xffu;
                        bf16x8 ka[2][2], vt[4];
#pragma unroll
                        for (int u = 0; u < 2; ++u) { const bf16* rp = kcb + (size_t)(32 * kt + 8 * (ql >> 2) + 4 * u + (ql & 3)) * 64 + 8 * g4; ka[u][0] = *(const GAS bf16x8*)rp; ka[u][1] = *(const GAS bf16x8*)(rp + 32); }
#pragma unroll
                        for (int dt = 0; dt < 4; ++dt) vt[dt] = *(const GAS bf16x8*)(vtb + (size_t)(16 * dt + ql) * KROWS + 32 * kt + 8 * g4);
                        const bool near = 32 * kt + 31 + 112 >= pmin;
#pragma unroll
                        for (int hh = 0; hh < 2; ++hh) {
                            f32x4 st[2];
#pragma unroll
                            for (int u = 0; u < 2; ++u) { st[u] = MFMA16(ka[u][0], qf[hh][0], ((f32x4){0.f, 0.f, 0.f, 0.f})); st[u] = MFMA16(ka[u][1], qf[hh][1], st[u]); }
                            if (near) {
#pragma unroll
                                for (int u = 0; u < 2; ++u)
#pragma unroll
                                    for (int r = 0; r < 4; ++r) { int dd = p - (32 * kt + 8 * g4 + 4 * u + r); dd = dd < 0 ? 0 : (dd > 127 ? 127 : dd); st[u][r] += BIAS[dd * 8 + 2 * hg + hh]; } }
                            float pe[8];
#pragma unroll
                            for (int u = 0; u < 2; ++u)
#pragma unroll
                                for (int r = 0; r < 4; ++r) { const float e = __builtin_amdgcn_exp2f(st[u][r]); pe[4 * u + r] = ((mw >> (4 * u + r)) & 1u) ? e : 0.f; lsum[hh] += pe[4 * u + r]; }
                            const v4u pw = (v4u){pkbf(pe[0], pe[1]), pkbf(pe[2], pe[3]), pkbf(pe[4], pe[5]), pkbf(pe[6], pe[7])};
                            const bf16x8 pf = __builtin_bit_cast(bf16x8, pw);
#pragma unroll
                            for (int dt = 0; dt < 4; ++dt) oacc[hh][dt] = MFMA16(vt[dt], pf, oacc[hh][dt]);
                        }
                    }
#pragma unroll
                    for (int hh = 0; hh < 2; ++hh) { float l = lsum[hh]; l += __shfl_xor(l, 16); l += __shfl_xor(l, 32); const float il = 1.f / l;
                        bf16* yp = Y + mrow * D + 512 + 64 * (2 * hg + hh) + 4 * g4;
#pragma unroll
                        for (int dt = 0; dt < 4; ++dt) *(GAS u32x2v*)(yp + 16 * dt) = (u32x2v){pkbf(oacc[hh][dt][0] * il, oacc[hh][dt][1] * il), pkbf(oacc[hh][dt][2] * il, oacc[hh][dt][3] * il)}; }
                }
            }
            __syncthreads();
        }
        {
            LAS unsigned char* Kimg = lds + RING_OFF; LAS unsigned char* Vimg = Kimg + 128 * IMG_STRIDE; LAS unsigned char* Simg = Vimg + 128 * IMG_STRIDE;
            for (int unit = vcu; unit < BATCH * 4 * 32; unit += G) {
                const int b = unit >> 7, h = (unit >> 5) & 3, n = (unit & 31) + 1;
                const float lg2 = log2f(1.f - exp2f(-5.f - (float)h));
                const size_t row0 = (size_t)b * SEQ + 128 * (n - 1);
#pragma unroll
                for (int i_ = 0; i_ < 2; ++i_) { const int item = tid + 512 * i_, c = item >> 3, j = item & 7;
                    const bf16* rp = PROJ + (row0 + c) * DINP + C_RK + 128 * h + 8 * j; const v4u a = *(const GAS v4u*)rp, bq = *(const GAS v4u*)(rp + 64);
                    const int t = 128 * n - 112 + c; const GAS f32x4* rq = (const GAS f32x4*)(ROPE + ((size_t)t * 64 + 8 * j) * 2); f32x4 cs[4]; cs[0] = rq[0]; cs[1] = rq[1]; cs[2] = rq[2]; cs[3] = rq[3];
                    v4u o1, o2; rot8(a, bq, cs, RET_KSCALE, o1, o2);
                    *(LAS v4u*)(Kimg + c * IMG_STRIDE + 16 * j) = o1; *(LAS v4u*)(Kimg + c * IMG_STRIDE + 128 + 16 * j) = o2; }
                const bf16* sp = SPT + ((size_t)((b * 4 + h) * 32 + (n - 1))) * 16384;
#pragma unroll
                for (int i_ = 0; i_ < 4; ++i_) { const int item = tid + 512 * i_, c = item >> 4, part = item & 15;
                    *(LAS v4u*)(Vimg + c * IMG_STRIDE + 16 * part) = *(const GAS v4u*)(PROJ + (row0 + c) * DINP + C_RV + 128 * h + 8 * part);
                    *(LAS v4u*)(Simg + c * IMG_STRIDE + 16 * part) = *(const GAS v4u*)(sp + c * 128 + 8 * part); }
                const int cq = 16 * wave + (lane & 15), g4 = lane >> 4;
                bf16x8 qf[4];
                { const bf16* rp = PROJ + (row0 + cq) * DINP + C_RQ + 128 * h + 8 * g4; const int t = 128 * n - 112 + cq;
                  const v4u q0 = *(const GAS v4u*)rp, q1 = *(const GAS v4u*)(rp + 32), q2 = *(const GAS v4u*)(rp + 64), q3 = *(const GAS v4u*)(rp + 96);
                  const GAS f32x4* ra = (const GAS f32x4*)(ROPE + ((size_t)t * 64 + 8 * g4) * 2); f32x4 c0[4], c1[4];
#pragma unroll
                  for (int i_ = 0; i_ < 4; ++i_) { c0[i_] = ra[i_]; c1[i_] = ra[16 + i_]; }
                  v4u o0, o1, o2, o3; rot8(q0, q2, c0, 1.f, o0, o2); rot8(q1, q3, c1, 1.f, o1, o3);
                  qf[0] = __builtin_bit_cast(bf16x8, o0); qf[1] = __builtin_bit_cast(bf16x8, o1); qf[2] = __builtin_bit_cast(bf16x8, o2); qf[3] = __builtin_bit_cast(bf16x8, o3); }
                __syncthreads();
                f32x4 oin[8], ocr[8];
#pragma unroll
                for (int et = 0; et < 8; ++et) { oin[et] = (f32x4){0.f, 0.f, 0.f, 0.f}; ocr[et] = oin[et]; }
#pragma unroll
                for (int et = 0; et < 8; ++et)
#pragma unroll
                    for (int ks = 0; ks < 4; ++ks) ocr[et] = MFMA16(frag_n(Simg, IMG_STRIDE, 16 * et + (lane & 15), 32 * ks, lane), qf[ks], ocr[et]);
                const int kgmax = wave >> 1;
                for (int kg = 0; kg <= kgmax; ++kg) {
                    f32x4 st[2];
#pragma unroll
                    for (int u = 0; u < 2; ++u) { st[u] = (f32x4){0.f, 0.f, 0.f, 0.f};
                        const int mrow = 32 * kg + 8 * ((lane & 15) >> 2) + 4 * u + (lane & 3);
#pragma unroll
                        for (int ks = 0; ks < 4; ++ks) st[u] = MFMA16(frag_n(Kimg, IMG_STRIDE, mrow, 32 * ks, lane), qf[ks], st[u]); }
                    float pv[8];
#pragma unroll
                    for (int u = 0; u < 2; ++u)
#pragma unroll
                        for (int r = 0; r < 4; ++r) { const int m = 32 * kg + 8 * g4 + 4 * u + r; const int dd = cq - m; pv[4 * u + r] = dd >= 0 ? st[u][r] * exp2f(lg2 * (float)dd) : 0.f; }
                    const v4u pw = (v4u){pkbf(pv[0], pv[1]), pkbf(pv[2], pv[3]), pkbf(pv[4], pv[5]), pkbf(pv[6], pv[7])};
                    const bf16x8 pf = __builtin_bit_cast(bf16x8, pw);
#pragma unroll
                    for (int et = 0; et < 8; ++et) oin[et] = MFMA16(frag_t(Vimg, IMG_STRIDE, 16 * et, 32 * kg, lane), pf, oin[et]);
                }
                const float xi = exp2f(lg2 * (float)(cq + 1)); float ss = 0.f;
#pragma unroll
                for (int et = 0; et < 8; ++et) { oin[et] = oin[et] + ocr[et] * xi; ss += (oin[et][0] * oin[et][0] + oin[et][1] * oin[et][1]) + (oin[et][2] * oin[et][2] + oin[et][3] * oin[et][3]); }
                ss += __shfl_xor(ss, 16); ss += __shfl_xor(ss, 32);
                const float rinv = 1.f / sqrtf(ss * (1.f / 128.f) + EPS);
                const bf16* gp = PROJ + (row0 + cq) * DINP + C_RG + 128 * h + 4 * g4; bf16* yp = Y + (row0 + cq) * D + 128 * h + 4 * g4; const float* wn = ret_norm_w + 128 * h + 4 * g4;
#pragma unroll
                for (int et = 0; et < 8; ++et) { const u32x2v gw2 = *(const GAS u32x2v*)(gp + 16 * et); const f32x4 gn = *(const GAS f32x4*)(wn + 16 * et);
                    float gt[4] = {__uint_as_float(gw2[0] << 16), __uint_as_float(gw2[0] & 0xffff0000u), __uint_as_float(gw2[1] << 16), __uint_as_float(gw2[1] & 0xffff0000u)}; float o[4];
#pragma unroll
                    for (int r = 0; r < 4; ++r) { const float sg = gt[r] / (1.f + __expf(-gt[r])); o[r] = oin[et][r] * rinv * gn[r] * sg; }
                    *(GAS u32x2v*)(yp + 16 * et) = (u32x2v){pkbf(o[0], o[1]), pkbf(o[2], o[3])}; }
                __syncthreads();
            }
        }
        if (BOTH(3)) GRID_BAR();
    }
    if (IN(4)) {
        pg8::Gemm g{Y, WOUT_T, M, D, D}; pg8::StaticOrder S; S.init(M, D, G, (int)blockIdx.x);
        pg8::EpiResF32 E{x, out, D};
        pg8::gemm_phase<pg8::EpiResF32, pg8::StaticOrder, true, true>(lds + RING_OFF, g, S, E);
        if (BOTH(4)) GRID_BAR();
    }
    if (IN(5)) {
        for (int m = gw; m < M; m += NGW) rms_row_to_bf16(out + (size_t)m * D, norm2_w, U + (size_t)m * D, lane);
        if (BOTH(5)) GRID_BAR();
    }
    if (IN(6)) {
        pg8::Gemm g{U, W1_T, M, FF, D}; pg8::StaticOrder S; S.init(M, FF, G, (int)blockIdx.x);
        pg8::EpiBf16<2> E{HB, FF};
        pg8::gemm_phase<pg8::EpiBf16<2>, pg8::StaticOrder, true, true>(lds + RING_OFF, g, S, E);
        if (BOTH(6)) GRID_BAR();
    }
    if (IN(7)) {
        pg8::Gemm g{HB, W2_T, M, D, FF}; pg8::StaticOrder S; S.init(M, D, G, (int)blockIdx.x);
        pg8::EpiResF32 E{out, out, D};
        pg8::gemm_phase<pg8::EpiResF32, pg8::StaticOrder, true, true>(lds + RING_OFF, g, S, E);
    }
#undef IN
#undef BOTH
}

extern "C" void kernel_launch(void* const* d_in, const int* in_sizes, int n_in, void* d_out, int out_size, void* d_ws, size_t ws_size, hipStream_t stream) {
    static int grid = 0;
    if (grid == 0) {
        if (n_in != 12 || in_sizes[0] != M * D || out_size != M * D || ws_size < WS_END) { fprintf(stderr, "kernel_launch: unexpected shapes (n_in %d, in0 %d, out %d, ws %zu); nothing launched\n", n_in, n_in > 0 ? in_sizes[0] : -1, out_size, ws_size); grid = -1; return; }
        int dev = 0, cus = 0, per_cu = 0;
        if (hipGetDevice(&dev) != hipSuccess || hipDeviceGetAttribute(&cus, hipDeviceAttributeMultiprocessorCount, dev) != hipSuccess) { grid = -1; return; }
        if (hipFuncSetAttribute((const void*)mk_fwd, hipFuncAttributeMaxDynamicSharedMemorySize, LDS_BYTES) != hipSuccess) { fprintf(stderr, "kernel_launch: hipFuncSetAttribute failed\n"); grid = -1; return; }
        if (hipOccupancyMaxActiveBlocksPerMultiprocessor(&per_cu, (const void*)mk_fwd, NWAVES * 64, LDS_BYTES) != hipSuccess || per_cu < 1)
            fprintf(stderr, "kernel_launch: note: occupancy query reports %d workgroups per CU\n", per_cu);
        (void)hipGetLastError();
        grid = cus;
    }
    if (grid < 0) return;
    if (hipMemsetAsync((char*)d_ws + WS_CTL, 0, CTL_ZERO_BYTES, stream) != hipSuccess) return;
    Args a{};
    for (int i = 0; i < 12; ++i) a.in[i] = (const float*)d_in[i];
    a.out = (float*)d_out; a.ws = (unsigned char*)d_ws;
    if (ONE_LAUNCH) { a.ph_lo = 0; a.ph_hi = N_PHASES; hipLaunchKernelGGL(mk_fwd, dim3(grid), dim3(NWAVES * 64), LDS_BYTES, stream, a); }
    else for (int p = 0; p < N_PHASES; ++p) { a.ph_lo = p; a.ph_hi = p + 1; hipLaunchKernelGGL(mk_fwd, dim3(grid), dim3(NWAVES * 64), LDS_BYTES, stream, a); }
    const hipError_t le = hipPeekAtLastError();
    if (le != hipSuccess) fprintf(stderr, "kernel_launch: launch failed: %s\n", hipGetErrorName(le));
}
```

```cpp
#include <hip/hip_runtime.h>
#include <cstdio>
#include <cstdint>
namespace pg8 {
#define PG8_LAS __attribute__((address_space(3)))
typedef unsigned short bf16_t;
typedef short bf16x8 __attribute__((ext_vector_type(8)));
typedef float f32x4 __attribute__((ext_vector_type(4)));
typedef unsigned u32x4 __attribute__((ext_vector_type(4)));
constexpr int BM = 256, BK = 64, HALF = 128, HTB = HALF * BK * 2  , STAGE_BYTES = 8 * HTB, NXCD = 8, WGM = 8;

__host__ __device__ __forceinline__ int lds_byte(int r, int c) { const int st = (r >> 4) * 2 + (c >> 5), rr = r & 15, cc = c & 31, ob = rr * 64 + cc * 2; return st * 1024 + (ob ^ (((ob >> 9) & 1) << 5)); }
__host__ __device__ __forceinline__ void stage_rc(int b, int& R, int& C) { const int st = b / 1024, sb = b % 1024, swz = sb ^ (((sb >> 9) & 1) << 5); R = (st >> 1) * 16 + swz / 64; C = (st & 1) * 32 + (swz % 64) / 2; }
__host__ __device__ __forceinline__ int perm32(int rho) { const int n = rho >> 4, i = rho & 15; return 8 * (i >> 2) + 4 * n + (i & 3); }

struct Unit { int pm, pn; };
struct Gemm { const bf16_t* A; const bf16_t* Bt; int M, N, K; };

struct StaticOrder {
    int nM, nN, nwg, G, c;
    __host__ __device__ void init(int M, int N, int G_, int c_) { nM = M / BM; nN = N / BM; nwg = nM * nN; G = G_; c = c_; }
    __host__ __device__ bool next(int i, Unit& u) const {
        const long L = (long)i * G + c; if (L >= nwg) return false;
        int wgid = (int)L; { const int q = nwg / NXCD, r = nwg % NXCD, xcd = wgid % NXCD, off = wgid / NXCD; wgid = (xcd < r ? xcd * (q + 1) : r * (q + 1) + (xcd - r) * q) + off; }
        const int nig = WGM * nN, gid = wgid / nig, fm = gid * WGM, gsz = (nM - fm) < WGM ? (nM - fm) : WGM;
        u.pm = fm + ((wgid % nig) % gsz); u.pn = (wgid % nig) / gsz; return true;
    }
    __device__ __forceinline__ void a_ready(const Unit&) const {}
    __device__ __forceinline__ void done(const Unit&) const {}
};

typedef float f32x2c __attribute__((ext_vector_type(2))); typedef __bf16 bf16x2c __attribute__((ext_vector_type(2)));
__device__ __forceinline__ unsigned cvt_pk_bf16(float lo, float hi) { const f32x2c v = {lo, hi}; const bf16x2c b = __builtin_convertvector(v, bf16x2c); return __builtin_bit_cast(unsigned, b); }

template <int ACT  > struct EpiBf16 {
    static constexpr bool PERM = true, AFTER_DRAIN = false;
    bf16_t* O; int ldc;
    __device__ __forceinline__ void operator()(const f32x4 (&acc)[2][2][4][2], const Unit& u, int wr, int wc, int fr, int fq) const {
        const int row0 = u.pm * BM + wr * 64 + fr; const int col0 = u.pn * BM + wc * 32 + 8 * fq;
#pragma unroll
        for (int ai = 0; ai < 2; ++ai)
#pragma unroll
            for (int m = 0; m < 4; ++m) { bf16_t* rowp = O + (size_t)(row0 + ai * HALF + m * 16) * ldc + col0;
#pragma unroll
                for (int bj = 0; bj < 2; ++bj) { f32x4 v0 = acc[ai][bj][m][0], v1 = acc[ai][bj][m][1];
                    if (ACT == 2) {
#pragma unroll
                        for (int e = 0; e < 4; ++e) { const float a = fmaxf(v0[e], 0.f), b = fmaxf(v1[e], 0.f); v0[e] = a * a; v1[e] = b * b; } }
                    u32x4 w; w.x = cvt_pk_bf16(v0[0], v0[1]); w.y = cvt_pk_bf16(v0[2], v0[3]); w.z = cvt_pk_bf16(v1[0], v1[1]); w.w = cvt_pk_bf16(v1[2], v1[3]);
                    __builtin_nontemporal_store(w, (u32x4*)(rowp + bj * HALF)); } }
    }
};

struct EpiProj {
    static constexpr bool PERM = true, AFTER_DRAIN = false;
    bf16_t* O; int ldc; bf16_t* R; int mrows;
    __device__ __forceinline__ void operator()(const f32x4 (&acc)[2][2][4][2], const Unit& u, int wr, int wc, int fr, int fq) const {
        const int row0 = u.pm * BM + wr * 64 + fr; const int col0 = (u.pn - 8) * BM + wc * 32 + 8 * fq; const bool hm = u.pn < 8;
#pragma unroll
        for (int ai = 0; ai < 2; ++ai)
#pragma unroll
            for (int m = 0; m < 4; ++m) { const int row = row0 + ai * HALF + m * 16;
#pragma unroll
                for (int bj = 0; bj < 2; ++bj) { const f32x4 v0 = acc[ai][bj][m][0], v1 = acc[ai][bj][m][1];
                    u32x4 w; w.x = cvt_pk_bf16(v0[0], v0[1]); w.y = cvt_pk_bf16(v0[2], v0[3]); w.z = cvt_pk_bf16(v1[0], v1[1]); w.w = cvt_pk_bf16(v1[2], v1[3]);
                    bf16_t* p = hm ? R + ((size_t)(u.pn * 2 + bj) * mrows + row) * 128 + wc * 32 + 8 * fq : O + (size_t)row * ldc + col0 + bj * HALF;
                    __builtin_nontemporal_store(w, (u32x4*)p); } }
    }
};

struct EpiResF32 {
    static constexpr bool PERM = true, AFTER_DRAIN = false;
    const float* base; float* out; int ldc;
    __device__ __forceinline__ void operator()(const f32x4 (&acc)[2][2][4][2], const Unit& u, int wr, int wc, int fr, int fq) const {
        const int col0 = u.pn * BM + wc * 32 + 8 * fq;
#pragma unroll
        for (int ai = 0; ai < 2; ++ai)
#pragma unroll
            for (int m = 0; m < 4; ++m) { const size_t off = (size_t)(u.pm * BM + ai * HALF + wr * 64 + m * 16 + fr) * ldc + col0;
#pragma unroll
                for (int bj = 0; bj < 2; ++bj)
#pragma unroll
                    for (int n = 0; n < 2; ++n) { const f32x4 bs = *(const f32x4*)(base + off + bj * HALF + n * 4); *(f32x4*)(out + off + bj * HALF + n * 4) = bs + acc[ai][bj][m][n]; }
                if (m & 1) asm volatile("" ::: "memory"); }
    }
};
struct EpiResF32Stats {
    static constexpr bool PERM = true, AFTER_DRAIN = false;
    const float* base; float* out; bf16_t* xn; const float* w; float* ss; int ldc;
    __device__ __forceinline__ void operator()(const f32x4 (&acc)[2][2][4][2], const Unit& u, int wr, int wc, int fr, int fq) const {
        const int col0 = u.pn * BM + wc * 32 + 8 * fq;
        f32x4 wv[2][2];
#pragma unroll
        for (int bj = 0; bj < 2; ++bj)
#pragma unroll
            for (int n = 0; n < 2; ++n) wv[bj][n] = *(const f32x4*)(w + col0 + bj * HALF + n * 4);
#pragma unroll
        for (int ai = 0; ai < 2; ++ai)
#pragma unroll
            for (int m = 0; m < 4; ++m) { const int row = u.pm * BM + ai * HALF + wr * 64 + m * 16 + fr; const size_t off = (size_t)row * ldc + col0; float s = 0.f;
#pragma unroll
                for (int bj = 0; bj < 2; ++bj) { f32x4 a[2];
#pragma unroll
                    for (int n = 0; n < 2; ++n) { const f32x4 h = *(const f32x4*)(base + off + bj * HALF + n * 4) + acc[ai][bj][m][n]; *(f32x4*)(out + off + bj * HALF + n * 4) = h;
                        s += (h[0] * h[0] + h[1] * h[1]) + (h[2] * h[2] + h[3] * h[3]); a[n] = h * wv[bj][n]; }
                    u32x4 o; o.x = cvt_pk_bf16(a[0][0], a[0][1]); o.y = cvt_pk_bf16(a[0][2], a[0][3]); o.z = cvt_pk_bf16(a[1][0], a[1][1]); o.w = cvt_pk_bf16(a[1][2], a[1][3]);
                    *(u32x4*)(xn + off + bj * HALF) = o; }
                s += __shfl_xor(s, 16); s += __shfl_xor(s, 32);
                if (fq == 0) __hip_atomic_fetch_add(ss + row, s, __ATOMIC_RELAXED, __HIP_MEMORY_SCOPE_AGENT);
                if (m & 1) asm volatile("" ::: "memory"); }
    }
};
struct EpiBf16RowScaleRelu2 {
    static constexpr bool PERM = true, AFTER_DRAIN = false;
    bf16_t* O; int ldc; const float* ss; float inv_n, eps;
    __device__ __forceinline__ void operator()(const f32x4 (&acc)[2][2][4][2], const Unit& u, int wr, int wc, int fr, int fq) const {
        const int row0 = u.pm * BM + wr * 64 + fr; const int col0 = u.pn * BM + wc * 32 + 8 * fq;
#pragma unroll
        for (int ai = 0; ai < 2; ++ai)
#pragma unroll
            for (int m = 0; m < 4; ++m) { const int row = row0 + ai * HALF + m * 16; bf16_t* rowp = O + (size_t)row * ldc + col0; const float ri = 1.f / sqrtf(ss[row] * inv_n + eps);
#pragma unroll
                for (int bj = 0; bj < 2; ++bj) { f32x4 v0 = acc[ai][bj][m][0], v1 = acc[ai][bj][m][1];
#pragma unroll
                    for (int e = 0; e < 4; ++e) { const float a = fmaxf(v0[e] * ri, 0.f), b = fmaxf(v1[e] * ri, 0.f); v0[e] = a * a; v1[e] = b * b; }
                    u32x4 w; w.x = cvt_pk_bf16(v0[0], v0[1]); w.y = cvt_pk_bf16(v0[2], v0[3]); w.z = cvt_pk_bf16(v1[0], v1[1]); w.w = cvt_pk_bf16(v1[2], v1[3]);
                    __builtin_nontemporal_store(w, (u32x4*)(rowp + bj * HALF)); } }
    }
};

struct EpiResBf16Stats {
    static constexpr bool PERM = true, AFTER_DRAIN = false;
    bf16_t* xn; const float* xs; const float* w1; float* ss; int ldc;
    __device__ __forceinline__ void operator()(const f32x4 (&acc)[2][2][4][2], const Unit& u, int wr, int wc, int fr, int fq) const {
        const int col0 = u.pn * BM + wc * 32 + 8 * fq;
        f32x4 iw[2][2];
#pragma unroll
        for (int bj = 0; bj < 2; ++bj)
#pragma unroll
            for (int n = 0; n < 2; ++n) { const f32x4 g = *(const f32x4*)(w1 + col0 + bj * HALF + n * 4); iw[bj][n] = (f32x4){1.f / g[0], 1.f / g[1], 1.f / g[2], 1.f / g[3]}; }
#pragma unroll
        for (int ai = 0; ai < 2; ++ai)
#pragma unroll
            for (int m = 0; m < 4; ++m) { const int row = u.pm * BM + ai * HALF + wr * 64 + m * 16 + fr; const size_t off = (size_t)row * ldc + col0; float s = 0.f; const float xr = xs[row];
#pragma unroll
                for (int bj = 0; bj < 2; ++bj) { const u32x4 b = *(const u32x4*)(xn + off + bj * HALF); f32x4 h[2];
                    h[0] = (f32x4){__uint_as_float(b.x << 16), __uint_as_float(b.x & 0xffff0000u), __uint_as_float(b.y << 16), __uint_as_float(b.y & 0xffff0000u)} * iw[bj][0] * xr + acc[ai][bj][m][0];
                    h[1] = (f32x4){__uint_as_float(b.z << 16), __uint_as_float(b.z & 0xffff0000u), __uint_as_float(b.w << 16), __uint_as_float(b.w & 0xffff0000u)} * iw[bj][1] * xr + acc[ai][bj][m][1];
#pragma unroll
                    for (int n = 0; n < 2; ++n) s += (h[n][0] * h[n][0] + h[n][1] * h[n][1]) + (h[n][2] * h[n][2] + h[n][3] * h[n][3]);
                    u32x4 o; o.x = cvt_pk_bf16(h[0][0], h[0][1]); o.y = cvt_pk_bf16(h[0][2], h[0][3]); o.z = cvt_pk_bf16(h[1][0], h[1][1]); o.w = cvt_pk_bf16(h[1][2], h[1][3]);
                    *(u32x4*)(xn + off + bj * HALF) = o; }
                s += __shfl_xor(s, 16); s += __shfl_xor(s, 32);
                if (fq == 0) __hip_atomic_fetch_add(ss + row, s, __ATOMIC_RELAXED, __HIP_MEMORY_SCOPE_AGENT);
                if (m & 1) asm volatile("" ::: "memory"); }
    }
};
struct EpiResFromBf16 {
    static constexpr bool PERM = true, AFTER_DRAIN = false;
    const bf16_t* base; float* out; int ldc;
    __device__ __forceinline__ void operator()(const f32x4 (&acc)[2][2][4][2], const Unit& u, int wr, int wc, int fr, int fq) const {
        const int col0 = u.pn * BM + wc * 32 + 8 * fq;
#pragma unroll
        for (int ai = 0; ai < 2; ++ai)
#pragma unroll
            for (int m = 0; m < 4; ++m) { const size_t off = (size_t)(u.pm * BM + ai * HALF + wr * 64 + m * 16 + fr) * ldc + col0;
#pragma unroll
                for (int bj = 0; bj < 2; ++bj) { const u32x4 b = *(const u32x4*)(base + off + bj * HALF);
                    const f32x4 b0 = (f32x4){__uint_as_float(b.x << 16), __uint_as_float(b.x & 0xffff0000u), __uint_as_float(b.y << 16), __uint_as_float(b.y & 0xffff0000u)};
                    const f32x4 b1 = (f32x4){__uint_as_float(b.z << 16), __uint_as_float(b.z & 0xffff0000u), __uint_as_float(b.w << 16), __uint_as_float(b.w & 0xffff0000u)};
                    __builtin_nontemporal_store(b0 + acc[ai][bj][m][0], (f32x4*)(out + off + bj * HALF)); __builtin_nontemporal_store(b1 + acc[ai][bj][m][1], (f32x4*)(out + off + bj * HALF + 4)); }
                if (m & 1) asm volatile("" ::: "memory"); }
    }
};
template <class Epi, class Sched, bool ALIGN_EPI = false, bool SP2 = false>
__device__ __forceinline__ void gemm_phase(PG8_LAS unsigned char* lds, const Gemm g, const Sched& S, const Epi& E) {
    const int tid = threadIdx.x, wid = __builtin_amdgcn_readfirstlane(tid >> 6), lane = tid & 63, wr = wid >> 2, wc = wid & 3, fr = lane & 15, fq = lane >> 4;
    const int K = g.K, nt = K / BK;
    unsigned voffA[2], voffB[2];
#pragma unroll
    for (int i = 0; i < 2; ++i) { int R, C; stage_rc(tid * 16 + i * 8192, R, C); const int Rb = Epi::PERM ? ((R & ~31) + perm32(R & 31)) : R;
        voffA[i] = (unsigned)(R * K + C) * 2u; voffB[i] = (unsigned)(Rb * K + C) * 2u; }
    const size_t kstep = (size_t)(BK * 2);
    const size_t hstep = (size_t)HALF * K * 2;
    const size_t tstep = 2 * hstep;
    const unsigned ldsw = (unsigned)wid * 1024u;
    const int aoff = lds_byte(wr * 64 + fr, fq * 8), boff = lds_byte(wc * 32 + fr, fq * 8);
#define PG8_SA(b, h) (((b) * 2 + (h)) * HTB)
#define PG8_SB(b, h) ((4 + (b) * 2 + (h)) * HTB)
#define PG8_STAGE(bufoff, gbase, voff) do { _Pragma("unroll") for (int _i = 0; _i < 2; ++_i) \
        __builtin_amdgcn_global_load_lds((const unsigned*)((const char*)(gbase) + (voff)[_i]), (PG8_LAS unsigned*)(lds + (bufoff) + ldsw + _i * 8192), 16, 0, 0); } while (0)
#define PG8_LDA(dst, b, h) do { _Pragma("unroll") for (int m = 0; m < 4; ++m) _Pragma("unroll") for (int k = 0; k < 2; ++k) dst[m][k] = *(const PG8_LAS bf16x8*)(lds + PG8_SA(b, h) + aoff + m * 2048 + k * 1024); } while (0)
#define PG8_LDB(dst, b, h) do { _Pragma("unroll") for (int n = 0; n < 2; ++n) _Pragma("unroll") for (int k = 0; k < 2; ++k) dst[n][k] = *(const PG8_LAS bf16x8*)(lds + PG8_SB(b, h) + boff + n * 2048 + k * 1024); } while (0)
#define PG8_MMA(ai, bj, At, Bt) do { __builtin_amdgcn_s_setprio(1); _Pragma("unroll") for (int m = 0; m < 4; ++m) _Pragma("unroll") for (int n = 0; n < 2; ++n) _Pragma("unroll") for (int k = 0; k < 2; ++k) \
        acc[ai][bj][m][n] = __builtin_amdgcn_mfma_f32_16x16x32_bf16(Bt[n][k], At[m][k], acc[ai][bj][m][n], 0, 0, 0); __builtin_amdgcn_s_setprio(0); } while (0)
#define PG8_WAIT_V(n) asm volatile("s_waitcnt vmcnt(" #n ")" ::: "memory")
#define PG8_WAIT_L(n) asm volatile("s_waitcnt lgkmcnt(" #n ")" ::: "memory")
#define PG8_BAR __builtin_amdgcn_s_barrier()
#define PG8_SCHED __builtin_amdgcn_sched_barrier(0)
    Unit cur, nxt; int ui = 0;
    if (!S.next(0, cur)) return;
    f32x4 acc[2][2][4][2];
#pragma unroll
    for (int a = 0; a < 2; ++a)
#pragma unroll
        for (int b = 0; b < 2; ++b)
#pragma unroll
            for (int m = 0; m < 4; ++m)
#pragma unroll
                for (int n = 0; n < 2; ++n) acc[a][b][m][n] = (f32x4){0.f, 0.f, 0.f, 0.f};
    bf16x8 At[4][2], B0[2][2], B1[2][2];
    const char* cA = (const char*)g.A + (size_t)cur.pm * tstep; const char* cB = (const char*)g.Bt + (size_t)cur.pn * tstep;
    S.a_ready(cur);
    if constexpr (SP2) {
        PG8_STAGE(PG8_SB(0, 0), cB, voffB); PG8_STAGE(PG8_SB(0, 1), cB + hstep, voffB); PG8_STAGE(PG8_SA(0, 0), cA, voffA); PG8_STAGE(PG8_SA(0, 1), cA + hstep, voffA);
        if (wr == 1) PG8_BAR;
        PG8_WAIT_V(2); PG8_BAR;
        PG8_STAGE(PG8_SB(1, 0), cB + kstep, voffB); PG8_STAGE(PG8_SA(1, 0), cA + kstep, voffA); PG8_STAGE(PG8_SB(1, 1), cB + hstep + kstep, voffB);
        PG8_WAIT_V(6); PG8_BAR;
    } else {
        PG8_STAGE(PG8_SB(0, 0), cB, voffB); PG8_STAGE(PG8_SA(0, 0), cA, voffA); PG8_STAGE(PG8_SB(0, 1), cB + hstep, voffB); PG8_STAGE(PG8_SA(0, 1), cA + hstep, voffA);
        if (wr == 1) PG8_BAR;
        PG8_WAIT_V(4); PG8_BAR;
        PG8_STAGE(PG8_SB(1, 0), cB + kstep, voffB); PG8_STAGE(PG8_SA(1, 0), cA + kstep, voffA); PG8_STAGE(PG8_SB(1, 1), cB + hstep + kstep, voffB);
        PG8_WAIT_V(6); PG8_BAR;
    }
    for (;;) {
        const bool has_next = S.next(ui + 1, nxt);
        const char* nA = has_next ? (const char*)g.A + (size_t)nxt.pm * tstep : cA; const char* nB = has_next ? (const char*)g.Bt + (size_t)nxt.pn * tstep : cB;
        for (int t = 0; t < nt; t += 2) {
            const bool last = (t == nt - 2);
            const char* a1 = cA + (size_t)(t + 1) * kstep;
            const char* a2 = last ? nA : cA + (size_t)(t + 2) * kstep; const char* b2 = last ? nB : cB + (size_t)(t + 2) * kstep;
            const char* a3 = a2 + kstep; const char* b3 = b2 + kstep;
            if (last && has_next) S.a_ready(nxt);
            if constexpr (SP2) {
            PG8_LDB(B0, 0, 0); PG8_LDB(B1, 0, 1); PG8_SCHED; PG8_LDA(At, 0, 0); PG8_STAGE(PG8_SA(1, 1), a1 + hstep, voffA);
            PG8_WAIT_V(8); PG8_WAIT_L(0); PG8_BAR; PG8_MMA(0, 0, At, B0); PG8_MMA(0, 1, At, B1); PG8_BAR; PG8_SCHED;
            PG8_LDA(At, 0, 1); PG8_STAGE(PG8_SB(0, 0), b2, voffB); PG8_STAGE(PG8_SB(0, 1), b2 + hstep, voffB); PG8_STAGE(PG8_SA(0, 0), a2, voffA);
            PG8_WAIT_V(8); PG8_WAIT_L(0); PG8_BAR; PG8_MMA(1, 0, At, B0); PG8_MMA(1, 1, At, B1); PG8_BAR; PG8_SCHED;
            PG8_LDB(B0, 1, 0); PG8_LDB(B1, 1, 1); PG8_SCHED; PG8_LDA(At, 1, 0); PG8_STAGE(PG8_SA(0, 1), a2 + hstep, voffA);
            PG8_WAIT_V(8); PG8_WAIT_L(0); PG8_BAR; PG8_MMA(0, 0, At, B0); PG8_MMA(0, 1, At, B1); PG8_BAR; PG8_SCHED;
            PG8_LDA(At, 1, 1); PG8_STAGE(PG8_SB(1, 0), b3, voffB); PG8_STAGE(PG8_SB(1, 1), b3 + hstep, voffB); PG8_STAGE(PG8_SA(1, 0), a3, voffA);
            PG8_WAIT_V(8); PG8_WAIT_L(0); PG8_BAR; PG8_MMA(1, 0, At, B0); PG8_MMA(1, 1, At, B1); PG8_BAR; PG8_SCHED;
            } else {
            PG8_LDB(B0, 0, 0); PG8_SCHED; PG8_LDA(At, 0, 0); PG8_STAGE(PG8_SA(1, 1), a1 + hstep, voffA);
            PG8_WAIT_L(8); PG8_BAR; PG8_WAIT_L(0); PG8_MMA(0, 0, At, B0); PG8_BAR; PG8_SCHED;
            PG8_LDB(B1, 0, 1); PG8_STAGE(PG8_SB(0, 0), b2, voffB);
            PG8_BAR; PG8_WAIT_L(0); PG8_MMA(0, 1, At, B1); PG8_BAR;
            PG8_LDA(At, 0, 1); PG8_STAGE(PG8_SA(0, 0), a2, voffA);
            PG8_BAR; PG8_WAIT_L(0); PG8_MMA(1, 0, At, B0); PG8_BAR; PG8_SCHED;
            PG8_STAGE(PG8_SB(0, 1), b2 + hstep, voffB);
            PG8_WAIT_V(6); PG8_BAR; PG8_MMA(1, 1, At, B1); PG8_BAR;
            PG8_LDB(B0, 1, 0); PG8_SCHED; PG8_LDA(At, 1, 0); PG8_STAGE(PG8_SA(0, 1), a2 + hstep, voffA);
            PG8_WAIT_L(8); PG8_BAR; PG8_WAIT_L(0); PG8_MMA(0, 0, At, B0); PG8_BAR; PG8_SCHED;
            PG8_LDB(B1, 1, 1); PG8_STAGE(PG8_SB(1, 0), b3, voffB);
            PG8_BAR; PG8_WAIT_L(0); PG8_MMA(0, 1, At, B1); PG8_BAR;
            PG8_LDA(At, 1, 1); PG8_STAGE(PG8_SA(1, 0), a3, voffA);
            PG8_BAR; PG8_WAIT_L(0); PG8_MMA(1, 0, At, B0); PG8_BAR; PG8_SCHED;
            PG8_STAGE(PG8_SB(1, 1), b3 + hstep, voffB);
            PG8_WAIT_V(6); PG8_BAR; PG8_MMA(1, 1, At, B1); PG8_BAR;
            }
        }
        if constexpr (ALIGN_EPI) { if (wr == 0) PG8_BAR; }
        if constexpr (!Epi::AFTER_DRAIN) { E(acc, cur, wr, wc, fr, fq); S.done(cur); }
        if (!has_next) break;
#pragma unroll
        for (int a = 0; a < 2; ++a)
#pragma unroll
            for (int b = 0; b < 2; ++b)
#pragma unroll
                for (int m = 0; m < 4; ++m)
#pragma unroll
                    for (int n = 0; n < 2; ++n) acc[a][b][m][n] = (f32x4){0.f, 0.f, 0.f, 0.f};
        cur = nxt; cA = nA; cB = nB; ++ui;
        if constexpr (ALIGN_EPI) { if (wr == 1) PG8_BAR; }
    }
    PG8_WAIT_V(0);
    if constexpr (!ALIGN_EPI) { if (wr == 0) PG8_BAR; }
    PG8_BAR;
    if constexpr (Epi::AFTER_DRAIN) { E.fused(acc, cur, wr, wc, fr, fq, lds, wid, lane); S.done(cur); }
#undef PG8_SA
#undef PG8_SB
#undef PG8_STAGE
#undef PG8_LDA
#undef PG8_LDB
#undef PG8_MMA
#undef PG8_WAIT_V
#undef PG8_WAIT_L
#undef PG8_BAR
#undef PG8_SCHED
}
}
constexpr int NWAVES = 8;
#ifndef MK_N_LAUNCHES
#define MK_N_LAUNCHES 1
#endif
constexpr int N_PHASES = 8;
constexpr bool ONE_LAUNCH = (MK_N_LAUNCHES == 1);

constexpr int BATCH = 16, SEQ = 4096, D = 1024, NMETA = 16, TK = SEQ + NMETA, FF = 4096;
constexpr int M = BATCH * SEQ;
constexpr int DIN = 3272, DINP = 3328;
constexpr int C_RQ = 0, C_RK = 512, C_RV = 1024, C_RG = 1536, C_DQ = 2048, C_DK = 2560, C_DV = 2624, C_IQ = 2688, C_IK = 3200, C_IW = 3264;
constexpr int DP2 = 1280;
constexpr int C2_DQ = C_DQ - 2048, C2_DK = C_DK - 2048, C2_DV = C_DV - 2048, C2_IQ = C_IQ - 2048, C2_IK = C_IK - 2048, C2_IW = C_IW - 2048;
constexpr float EPS = 1e-6f;
constexpr int KROWS = 4160;

constexpr size_t MiB = 1u << 20;
constexpr size_t WS_CTL = 0, CTL_ZERO_BYTES = 1 * MiB;
constexpr size_t WS_WIN = 2 * MiB;
constexpr size_t WS_WOUT = 9 * MiB;
constexpr size_t WS_W1 = 11 * MiB;
constexpr size_t WS_W2 = 19 * MiB;
constexpr size_t WS_ROPE = 27 * MiB;
constexpr size_t WS_PMETA = 30 * MiB;
constexpr size_t WS_KC = 32 * MiB;
constexpr size_t WS_IKC = 41 * MiB;
constexpr size_t WS_VT = 50 * MiB;
constexpr size_t WS_U = 64 * MiB;
constexpr size_t WS_PROJ = 192 * MiB;
constexpr size_t WS_RET = 352 * MiB;
constexpr size_t WS_QN = 608 * MiB;
constexpr size_t WS_SPT = 672 * MiB;
constexpr size_t WS_Y = 736 * MiB;
constexpr size_t WS_H = 192 * MiB;
constexpr size_t WS_TQ2 = 864 * MiB;
constexpr size_t WS_LIST = 864 * MiB;
constexpr size_t WS_END = 1024 * MiB;
static_assert(WS_H + (size_t)M * FF * 2 <= WS_Y && WS_Y + (size_t)M * D * 2 <= WS_END, "d_ws map");
constexpr int CW_TMO = 0, CW_CODE = 1;
constexpr int CW_BAR = 4096;

constexpr int RING_OFF = 0, RING_BYTES = 131072;
constexpr int LDS_BYTES = 163840;
constexpr int LDSCTL_OFF = LDS_BYTES - 512, MISC_OFF = LDSCTL_OFF + 320;
static_assert(MISC_OFF + 128 <= LDS_BYTES, "LDS map");
#define GAS __attribute__((address_space(1)))
#define LAS __attribute__((address_space(3)))
typedef unsigned short bf16;
typedef unsigned v4u __attribute__((ext_vector_type(4)));
typedef float f32x4 __attribute__((ext_vector_type(4)));
typedef short bf16x8 __attribute__((ext_vector_type(8)));
typedef GAS unsigned gu32;
typedef GAS unsigned long long gu64;
#define RLX_AGENT __ATOMIC_RELAXED, __HIP_MEMORY_SCOPE_AGENT
#define LDS_WAIT() asm volatile("s_waitcnt lgkmcnt(0)" ::: "memory")
#define VM_WAIT() asm volatile("s_waitcnt vmcnt(0)" ::: "memory")
__device__ __forceinline__ unsigned long long rt() { return __builtin_amdgcn_s_memrealtime(); }
__device__ __forceinline__ unsigned f2bf(float f) { unsigned u = __builtin_bit_cast(unsigned, f); return (u + 0x7fffu + ((u >> 16) & 1u)) >> 16; }
__device__ __forceinline__ unsigned pk2(float lo, float hi) { return f2bf(lo) | (f2bf(hi) << 16); }

#define XB_TMO      128
#define XB_XCNT(j)  (256  + 64 * (j))
#define XB_XSUB(j)  (1280 + 64 * (j))
#define XB_XGEN(j)  (2304 + 64 * (j))
#define XB_TOP      3328
#define XB_TOPGEN   3392
#define XCD_BAR_WORDS 3456
#define XB_SPIN_CAP (1u << 22)

__device__ __forceinline__ unsigned xb_ld(unsigned* p)              { return __hip_atomic_load(p, __ATOMIC_RELAXED, __HIP_MEMORY_SCOPE_AGENT); }
__device__ __forceinline__ unsigned xb_add(unsigned* p, unsigned v) { return __hip_atomic_fetch_add(p, v, __ATOMIC_RELAXED, __HIP_MEMORY_SCOPE_AGENT); }
__device__ __forceinline__ unsigned xb_xcc_id() { return (unsigned)__builtin_amdgcn_s_getreg((3 << 11) | 20) & 0xFu; }
#define XB_SPIN(cond, bar) do { unsigned _sp = 0; while (cond) { __builtin_amdgcn_s_sleep(1); \
    if ((++_sp & 255u) == 0u) { if (xb_ld(&(bar)[XB_TMO])) break; if (_sp > XB_SPIN_CAP) { atomicAdd(&(bar)[XB_TMO], 1u); break; } } } } while (0)

struct XcdBarrier {
    unsigned* bar; unsigned x;
    volatile LAS unsigned* st;
};

__device__ __forceinline__ XcdBarrier xcd_barrier_post(unsigned* bar, volatile LAS unsigned* st) {
    XcdBarrier b; b.bar = bar; b.x = xb_xcc_id(); b.st = st;
    if (threadIdx.x == 0) (void)xb_add(&bar[XB_XCNT(b.x)], 1u);
    return b;
}
__device__ __forceinline__ void xcd_barrier_complete(unsigned* bar, unsigned x, unsigned& nloc, unsigned& nx) {
    const unsigned G = gridDim.x * gridDim.y * gridDim.z;
    unsigned sum, cnt, mine, sp = 0u;
    for (;;) {
        sum = 0u; cnt = 0u; mine = 0u;
#pragma unroll
        for (unsigned j = 0; j < 16; ++j) { const unsigned c = xb_ld(&bar[XB_XCNT(j)]); sum += c; cnt += (c > 0u) ? 1u : 0u; mine = (j == x) ? c : mine; }
        if (sum == G) break;
        __builtin_amdgcn_s_sleep(1);
        if ((++sp & 255u) == 0u) { if (xb_ld(&bar[XB_TMO])) break; if (sp > XB_SPIN_CAP) { atomicAdd(&bar[XB_TMO], 1u); break; } }
    }
    nloc = mine > 0u ? mine : 1u; nx = cnt > 0u ? cnt : 1u;
}

__device__ __forceinline__ void xcd_barrier(const XcdBarrier& b) {
    asm volatile("s_waitcnt vmcnt(0)" ::: "memory");
    __syncthreads();
    if (threadIdx.x == 0) {
        unsigned* bar = b.bar;
        __builtin_amdgcn_s_waitcnt(0);
        unsigned nloc = b.st[0], nx = b.st[1];
        if (nloc == 0u) { xcd_barrier_complete(bar, b.x, nloc, nx); b.st[0] = nloc; b.st[1] = nx; }
        const unsigned old = xb_add(&bar[XB_XSUB(b.x)], 1u);
        const unsigned gen = old / nloc;
        if (old + 1u == (gen + 1u) * nloc) {
            __builtin_amdgcn_fence(__ATOMIC_RELEASE, "agent");
            asm volatile("s_waitcnt vmcnt(0)" ::: "memory");
            const unsigned og = xb_add(&bar[XB_TOP], 1u);
            const unsigned tg = og / nx;
            if (og + 1u == (tg + 1u) * nx) xb_add(&bar[XB_TOPGEN], 1u);
            else XB_SPIN(xb_ld(&bar[XB_TOPGEN]) == tg, bar);
            __builtin_amdgcn_fence(__ATOMIC_ACQUIRE, "agent");
            xb_add(&bar[XB_XGEN(b.x)], 1u);
            asm volatile("s_waitcnt vmcnt(0)" ::: "memory");
        } else {
            XB_SPIN(xb_ld(&bar[XB_XGEN(b.x)]) == gen, bar);
            __builtin_amdgcn_fence(__ATOMIC_ACQUIRE, "agent");
            asm volatile("s_waitcnt vmcnt(0)" ::: "memory");
        }
    }
    __syncthreads();
}

typedef short v4i16_t __attribute__((ext_vector_type(4)));
typedef float f32x2v __attribute__((ext_vector_type(2)));
typedef unsigned u32x2v __attribute__((ext_vector_type(2)));
#define MFMA16(a, b, c) __builtin_amdgcn_mfma_f32_16x16x32_bf16((a), (b), (c), 0, 0, 0)
__device__ __forceinline__ float bf2f(unsigned short u) { return __uint_as_float((unsigned)u << 16); }
__device__ __forceinline__ bf16x8 frag_n(const LAS unsigned char* img, int stride, int rowsel, int k0, int lane) {
    return *(const LAS bf16x8*)(img + rowsel * stride + (k0 + 8 * (lane >> 4)) * 2);
}
__device__ __forceinline__ bf16x8 frag_t(const LAS unsigned char* img, int stride, int row0, int k0, int lane) {
    const int g = lane >> 4, q = (lane >> 2) & 3, p = lane & 3;
    const LAS unsigned char* a = img + (k0 + 8 * g + q) * stride + (row0 + 4 * p) * 2;
    const v4i16_t lo = __builtin_amdgcn_ds_read_tr16_b64_v4i16((LAS v4i16_t*)a);
    const v4i16_t hi = __builtin_amdgcn_ds_read_tr16_b64_v4i16((LAS v4i16_t*)(a + 4 * stride));
    return (bf16x8){lo[0], lo[1], lo[2], lo[3], hi[0], hi[1], hi[2], hi[3]};
}
__device__ __forceinline__ unsigned pkbf(float lo, float hi) { return pg8::cvt_pk_bf16(lo, hi); }
#define TR_RD "ds_read_b64_tr_b16 "
__device__ __forceinline__ bf16x8 tr_pack(u32x2v lo, u32x2v hi) { const v4u w = (v4u){lo[0], lo[1], hi[0], hi[1]}; return __builtin_bit_cast(bf16x8, w); }

constexpr int IMG_STRIDE = 288;
constexpr float RET_KSCALE = 0.08838834764831845f;

__device__ __forceinline__ void rot8(const v4u a, const v4u b, const f32x4 (&cs)[4], float sc, v4u& o1, v4u& o2) {
    float x1[8], x2[8], c[8], s[8];
#pragma unroll
    for (int i = 0; i < 4; ++i) { x1[2 * i] = __uint_as_float(a[i] << 16); x1[2 * i + 1] = __uint_as_float(a[i] & 0xffff0000u); x2[2 * i] = __uint_as_float(b[i] << 16); x2[2 * i + 1] = __uint_as_float(b[i] & 0xffff0000u);
        c[2 * i] = cs[i][0]; s[2 * i] = cs[i][1]; c[2 * i + 1] = cs[i][2]; s[2 * i + 1] = cs[i][3]; }
    float r1[8], r2[8];
#pragma unroll
    for (int i = 0; i < 8; ++i) { r1[i] = (x1[i] * c[i] - x2[i] * s[i]) * sc; r2[i] = (x1[i] * s[i] + x2[i] * c[i]) * sc; }
#pragma unroll
    for (int i = 0; i < 4; ++i) { o1[i] = pkbf(r1[2 * i], r1[2 * i + 1]); o2[i] = pkbf(r2[2 * i], r2[2 * i + 1]); }
}
#define DSA_OPAQUE(x) asm volatile("" : "+v"(x))
constexpr int DSA_CAP = 64;
constexpr int DSA_MSTR = 132;
constexpr int L_HIST = 0, L_MASK = 65536, L_QPAR = L_MASK + 128 * DSA_MSTR * 4, L_CCNT = L_QPAR + 128 * 16, L_BIAS = L_CCNT + 512, L_STAGE = L_BIAS + 8 * 144 * 4, L_DSA_END = L_STAGE + 2 * 8192;
static_assert(L_DSA_END <= LDSCTL_OFF, "DSA LDS map");
constexpr float LOG2E = 1.4426950408889634f;

constexpr int DSA_NB = 128;
#define DSA_SCORE_BODY \
        f32x4 acc = MFMA16(a0, cq[0], ((f32x4){0.f, 0.f, 0.f, 0.f})); acc = MFMA16(a1, cq[1], acc); \
        _Pragma("unroll") for (int h = 0; h < 8; ++h) { \
            f32x4 s = MFMA16(a0, iq[h][0], ((f32x4){0.f, 0.f, 0.f, 0.f})); s = MFMA16(a1, iq[h][1], s); \
            _Pragma("unroll") for (int r = 0; r < 4; ++r) acc[r] = __builtin_fmaf(wh[h], __builtin_fabsf(s[r]), acc[r]); } \
        sc[u] = acc;
__device__ __forceinline__ void idx_tile(const bf16* ikb, int kt, const bf16x8 (&iq)[8][2], const bf16x8 (&cq)[2], const float (&wh)[8], int lane, f32x4 (&sc)[2]) {
    const int i = lane & 15, g = lane >> 4;
#pragma unroll
    for (int u = 0; u < 2; ++u) {
        const bf16* rp = ikb + (size_t)(32 * kt + 8 * (i >> 2) + 4 * u + (i & 3)) * 64 + 8 * g;
        const bf16x8 a0 = *(const GAS bf16x8*)rp, a1 = *(const GAS bf16x8*)(rp + 32);
        DSA_SCORE_BODY
    }
}
__device__ __forceinline__ void idx_tile_lds(const LAS unsigned char* tb, const bf16x8 (&iq)[8][2], const bf16x8 (&cq)[2], const float (&wh)[8], int lane, f32x4 (&sc)[2]) {
#pragma unroll
    for (int u = 0; u < 2; ++u) {
        const bf16x8 a0 = *(const LAS bf16x8*)(tb + (u * 2 + 0) * 1024 + lane * 16), a1 = *(const LAS bf16x8*)(tb + (u * 2 + 1) * 1024 + lane * 16);
        DSA_SCORE_BODY
    }
}
__device__ __forceinline__ float bin_t(float s, float binc, float invw) { return __builtin_fmaf(s, invw, binc); }
__device__ __forceinline__ int bin_of_t(float t) { return (int)__builtin_amdgcn_fmed3f(t, 0.f, (float)(DSA_NB - 1)); }

__device__ __forceinline__ f32x4 idx_sub_lds2(const LAS unsigned char* tb, int u, const bf16x8 (&iq)[8][2], const bf16x8 (&cq)[2], const float (&wh)[8], int lane) {
    const bf16x8 a0 = *(const LAS bf16x8*)(tb + (u * 2 + 0) * 1024 + lane * 16), a1 = *(const LAS bf16x8*)(tb + (u * 2 + 1) * 1024 + lane * 16);
    f32x4 s[9];
#pragma unroll
    for (int h = 0; h < 8; ++h) s[h] = MFMA16(a0, iq[h][0], ((f32x4){0.f, 0.f, 0.f, 0.f}));
    s[8] = MFMA16(a0, cq[0], ((f32x4){0.f, 0.f, 0.f, 0.f}));
#pragma unroll
    for (int h = 0; h < 8; ++h) s[h] = MFMA16(a1, iq[h][1], s[h]);
    s[8] = MFMA16(a1, cq[1], s[8]);
    f32x4 acc = s[8];
#pragma unroll
    for (int h = 0; h < 8; ++h)
#pragma unroll
        for (int r = 0; r < 4; ++r) acc[r] = __builtin_fmaf(wh[h], __builtin_fabsf(s[h][r]), acc[r]);
    __builtin_amdgcn_sched_group_barrier(0x100, 2, 0);
    __builtin_amdgcn_sched_group_barrier(0x008, 18, 0);
    __builtin_amdgcn_sched_group_barrier(0x002, 32, 0);
    return acc;
}
struct IdxAcc { f32x4 s[9]; };
__device__ __forceinline__ IdxAcc idx_mfma_group(const LAS unsigned char* tb, int sub, const bf16x8 (&iq)[8][2], const bf16x8 (&cq)[2], int lane) {
    const LAS unsigned char* ab = tb + (sub >> 1) * 4096 + (sub & 1) * 2048 + lane * 16;
    const bf16x8 a0 = *(const LAS bf16x8*)ab, a1 = *(const LAS bf16x8*)(ab + 1024);
    IdxAcc r;
#pragma unroll
    for (int h = 0; h < 8; ++h) r.s[h] = MFMA16(a0, iq[h][0], ((f32x4){0.f, 0.f, 0.f, 0.f}));
    r.s[8] = MFMA16(a0, cq[0], ((f32x4){0.f, 0.f, 0.f, 0.f}));
#pragma unroll
    for (int h = 0; h < 8; ++h) r.s[h] = MFMA16(a1, iq[h][1], r.s[h]);
    r.s[8] = MFMA16(a1, cq[1], r.s[8]);
    return r;
}
__device__ __forceinline__ f32x4 idx_combine(const IdxAcc& a, const float (&wh)[8]) {
    f32x4 acc = a.s[8];
#pragma unroll
    for (int h = 0; h < 8; ++h)
#pragma unroll
        for (int r = 0; r < 4; ++r) acc[r] = __builtin_fmaf(wh[h], __builtin_fabsf(a.s[h][r]), acc[r]);
    return acc;
}
#define DSA_DMA_K(base, step, buf) __builtin_amdgcn_global_load_lds((const unsigned*)((base) + (size_t)(64 * (step) + dk_row) * 64 + dk_col), (LAS unsigned*)((buf) + wave * 1024), 16, 0, 0)
#define DSA_WAITBAR(N) asm volatile("s_waitcnt vmcnt(" #N ") lgkmcnt(0)\n\ts_barrier" ::: "memory")
#define DSA_LDS_ADDR(p) ((unsigned)(unsigned long long)(p))
#define DSA_PB1(i) (lds + L_MASK + ((i) & 3) * 8192)
#define DSA_PB2(i) (lds + (((i) & 2) ? L_STAGE : 49152) + ((i) & 1) * 8192)
#define DSA_PB3(i) (lds + L_HIST + ((i) & 3) * 16384)
#define DSA_DMA_V(base, step, buf) __builtin_amdgcn_global_load_lds((const unsigned*)((base) + (size_t)dv_row * KROWS + 64 * (step) + dv_col), (LAS unsigned*)((buf) + 8192 + wave * 1024), 16, 0, 0)

template <int NH>
__device__ __forceinline__ void dsa_sweep(LAS unsigned char* lds, int h0, const bf16* kcb, const bf16* vtb, const bf16* qrow, const float* qgain, bf16* yrow, int ns, int p, int pmin, int qloc, int wave, int lane) {
    DSA_OPAQUE(lane);
    const int ql = lane & 15, g4 = lane >> 4;
    const int dk_row = 32 * (wave >> 2) + 8 * (ql >> 2) + 4 * ((wave >> 1) & 1) + (ql & 3), dk_col = 32 * (wave & 1) + 8 * g4;
    const int dv_row = 16 * (wave & 3) + ql, dv_col = 32 * (wave >> 2) + 8 * g4;
    const LAS unsigned* MASK = (const LAS unsigned*)(lds + L_MASK); const LAS float* BIAS = (const LAS float*)(lds + L_BIAS);
    bf16x8 qf[NH][2];
#pragma unroll 1
    for (int pass_ = 0; pass_ < 1; ++pass_) {
#pragma unroll
      for (int hh = 0; hh < NH; ++hh) { v4u qv[2]; float ss = 0.f;
#pragma unroll
          for (int sx = 0; sx < 2; ++sx) { qv[sx] = *(const GAS v4u*)(qrow + 64 * (h0 + hh) + 32 * sx + 8 * g4);
#pragma unroll
              for (int e = 0; e < 4; ++e) { const float a = __uint_as_float(qv[sx][e] << 16), c = __uint_as_float(qv[sx][e] & 0xffff0000u); ss += a * a + c * c; } }
          ss += __shfl_xor(ss, 16); ss += __shfl_xor(ss, 32);
          const float scq = (1.f / sqrtf(ss * (1.f / 64.f) + 1e-6f)) * (0.125f * LOG2E);
#pragma unroll
          for (int sx = 0; sx < 2; ++sx) { const f32x4 g0 = *(const GAS f32x4*)(qgain + 32 * sx + 8 * g4), g1 = *(const GAS f32x4*)(qgain + 32 * sx + 8 * g4 + 4); v4u o;
#pragma unroll
              for (int e = 0; e < 4; ++e) { const float a = __uint_as_float(qv[sx][e] << 16), c = __uint_as_float(qv[sx][e] & 0xffff0000u);
                  const float ga = e < 2 ? g0[2 * e] : g1[2 * e - 4], gc = e < 2 ? g0[2 * e + 1] : g1[2 * e - 3]; o[e] = pkbf(a * scq * ga, c * scq * gc); }
              qf[hh][sx] = __builtin_bit_cast(bf16x8, o); } } }
    f32x4 oacc[NH][4]; float lsum[NH];
#pragma unroll
    for (int hh = 0; hh < NH; ++hh) { lsum[hh] = 0.f;
#pragma unroll
        for (int dt = 0; dt < 4; ++dt) oacc[hh][dt] = (f32x4){0.f, 0.f, 0.f, 0.f}; }
    DSA_DMA_K(kcb, 0, DSA_PB3(0)); DSA_DMA_V(vtb, 0, DSA_PB3(0));
    { const int s1 = ns > 1 ? 1 : ns - 1, s2 = ns > 2 ? 2 : ns - 1; DSA_DMA_K(kcb, s1, DSA_PB3(1)); DSA_DMA_V(vtb, s1, DSA_PB3(1)); DSA_DMA_K(kcb, s2, DSA_PB3(2)); DSA_DMA_V(vtb, s2, DSA_PB3(2)); }
    DSA_WAITBAR(4);
    for (int step = 0; step < ns; ++step) {
        { const int sn = step + 3 < ns ? step + 3 : ns - 1; DSA_DMA_K(kcb, sn, DSA_PB3(step + 3)); DSA_DMA_V(vtb, sn, DSA_PB3(step + 3)); }
        const LAS unsigned char* tb = DSA_PB3(step);
#pragma unroll 1
        for (int tt = 0; tt < 2; ++tt) { const int kt = 2 * step + tt; if (32 * kt > pmin + 15) continue;
            const unsigned mw = (MASK[qloc * DSA_MSTR + kt] >> (8 * g4)) & 0xffu;
            bf16x8 ka[2][2], vt[4];
#pragma unroll
            for (int u = 0; u < 2; ++u) { ka[u][0] = *(const LAS bf16x8*)(tb + tt * 4096 + (u * 2 + 0) * 1024 + lane * 16); ka[u][1] = *(const LAS bf16x8*)(tb + tt * 4096 + (u * 2 + 1) * 1024 + lane * 16); }
#pragma unroll
            for (int dt = 0; dt < 4; ++dt) vt[dt] = *(const LAS bf16x8*)(tb + 8192 + tt * 4096 + dt * 1024 + lane * 16);
            f32x4 cm[2];
#pragma unroll
            for (int u = 0; u < 2; ++u)
#pragma unroll
                for (int r = 0; r < 4; ++r) cm[u][r] = ((mw >> (4 * u + r)) & 1u) ? 0.f : -30000.f;
            const bool near = 32 * kt + 31 + 112 >= pmin;
#pragma unroll
            for (int hh = 0; hh < NH; ++hh) {
                f32x4 st[2]; st[0] = cm[0]; st[1] = cm[1];
                if (near) {
                    int d0 = p - (32 * kt + 8 * g4); d0 = d0 < 0 ? 0 : (d0 > 135 ? 135 : d0);
                    const LAS float* bt = BIAS + (h0 + hh) * 144 + 8 + d0 - 7;
#pragma unroll
                    for (int u = 0; u < 2; ++u)
#pragma unroll
                        for (int r = 0; r < 4; ++r) st[u][r] += bt[7 - (4 * u + r)]; }
#pragma unroll
                for (int u = 0; u < 2; ++u) { st[u] = MFMA16(ka[u][0], qf[hh][0], st[u]); st[u] = MFMA16(ka[u][1], qf[hh][1], st[u]); }
                float pe[8];
#pragma unroll
                for (int u = 0; u < 2; ++u)
#pragma unroll
                    for (int r = 0; r < 4; ++r) { pe[4 * u + r] = __builtin_amdgcn_exp2f(st[u][r]); lsum[hh] += pe[4 * u + r]; }
                const v4u pw = (v4u){pkbf(pe[0], pe[1]), pkbf(pe[2], pe[3]), pkbf(pe[4], pe[5]), pkbf(pe[6], pe[7])};
                const bf16x8 pf = __builtin_bit_cast(bf16x8, pw);
#pragma unroll
                for (int dt = 0; dt < 4; ++dt) oacc[hh][dt] = MFMA16(vt[dt], pf, oacc[hh][dt]);
            }
        }
        DSA_WAITBAR(4);
    }
#pragma unroll
    for (int hh = 0; hh < NH; ++hh) { float l = lsum[hh]; l += __shfl_xor(l, 16); l += __shfl_xor(l, 32); const float il = 1.f / l;
        bf16* yp = yrow + 64 * (h0 + hh) + 4 * g4;
#pragma unroll
        for (int dt = 0; dt < 4; ++dt) *(GAS u32x2v*)(yp + 16 * dt) = (u32x2v){pkbf(oacc[hh][dt][0] * il, oacc[hh][dt][1] * il), pkbf(oacc[hh][dt][2] * il, oacc[hh][dt][3] * il)}; }
}

__device__ __forceinline__ void dsa_gather(LAS unsigned char* gbuf, LAS unsigned char* lstb, const LAS float* BIAS, const bf16* kc, const bf16* vc, const unsigned short* lst,
                                           const LAS unsigned* qcnt  , const bf16* projq  , const float* qgain, bf16* y  , int p0  , int lane) {
    DSA_OPAQUE(lane);
    const int h = lane & 15, g4 = lane >> 4, hv = h & 7;
    f32x4 gq[2][2];
#pragma unroll
    for (int sx = 0; sx < 2; ++sx) { gq[sx][0] = *(const GAS f32x4*)(qgain + 32 * sx + 8 * g4); gq[sx][1] = *(const GAS f32x4*)(qgain + 32 * sx + 8 * g4 + 4); }
    u32x2v lwn = *(const GAS u32x2v*)(lst + 4 * lane); v4u qvn[2];
    { const bf16* qp = projq + 64 * hv + 8 * g4; qvn[0] = *(const GAS v4u*)qp; qvn[1] = *(const GAS v4u*)(qp + 32); }
#pragma unroll 1
    for (int qq = 0; qq < 16; ++qq) {
        const int pq = p0 + qq; int nsel = pq + 1 < 256 ? pq + 1 : 256; { const int nl = (int)qcnt[4 * qq]; nsel = nl < nsel ? nl : nsel; }
        nsel = __builtin_amdgcn_readfirstlane(nsel); const int nch = (nsel + 31) >> 5;
        { u32x2v lw = lwn;
          if (4 * lane + 0 >= nsel) lw[0] &= 0xffff0000u; if (4 * lane + 1 >= nsel) lw[0] &= 0x0000ffffu; if (4 * lane + 2 >= nsel) lw[1] &= 0xffff0000u; if (4 * lane + 3 >= nsel) lw[1] &= 0x0000ffffu;
          *(LAS u32x2v*)(lstb + 8 * lane) = lw; }
        bf16x8 qf[2];
        { v4u qv[2]; qv[0] = qvn[0]; qv[1] = qvn[1]; float ss = 0.f;
#pragma unroll
          for (int sx = 0; sx < 2; ++sx) {
#pragma unroll
              for (int e = 0; e < 4; ++e) { const float a = __uint_as_float(qv[sx][e] << 16), c = __uint_as_float(qv[sx][e] & 0xffff0000u); ss += a * a + c * c; } }
          ss += __shfl_xor(ss, 16); ss += __shfl_xor(ss, 32);
          const float scq = (1.f / sqrtf(ss * (1.f / 64.f) + 1e-6f)) * (0.125f * LOG2E);
#pragma unroll
          for (int sx = 0; sx < 2; ++sx) { const f32x4 g0 = gq[sx][0], g1 = gq[sx][1]; v4u o;
#pragma unroll
              for (int e = 0; e < 4; ++e) { const float a = __uint_as_float(qv[sx][e] << 16), c = __uint_as_float(qv[sx][e] & 0xffff0000u);
                  const float ga = e < 2 ? g0[2 * e] : g1[2 * e - 4], gc = e < 2 ? g0[2 * e + 1] : g1[2 * e - 3]; o[e] = pkbf(a * scq * ga, c * scq * gc); }
              qf[sx] = __builtin_bit_cast(bf16x8, o); } }
        LDS_WAIT(); asm volatile("" ::: "memory");
        f32x4 oacc[4]; float lsum = 0.f;
#pragma unroll
        for (int dt = 0; dt < 4; ++dt) oacc[dt] = (f32x4){0.f, 0.f, 0.f, 0.f};
#define DSA_GDMA(c, buf) do { _Pragma("unroll") for (int i = 0; i < 4; ++i) { const int r_ = 8 * i + (lane >> 3); unsigned ki_ = *(const LAS unsigned short*)(lstb + 2 * (32 * (c) + r_)); ki_ = ki_ < (unsigned)KROWS ? ki_ : 0u; \
            const int pc_ = (lane & 7) ^ (r_ & 7); \
            __builtin_amdgcn_global_load_lds((const unsigned*)(kc + (size_t)ki_ * 64 + 8 * pc_), (LAS unsigned*)((buf) + i * 1024), 16, 0, 0); \
            __builtin_amdgcn_global_load_lds((const unsigned*)(vc + (size_t)ki_ * 64 + 8 * pc_), (LAS unsigned*)((buf) + 4096 + i * 1024), 16, 0, 0); } } while (0)
        DSA_GDMA(0, gbuf); if (nch > 1) DSA_GDMA(1, gbuf + 8192);
        __builtin_amdgcn_sched_barrier(0);
        { const int qn = qq < 15 ? qq + 1 : 15; lwn = *(const GAS u32x2v*)(lst + qn * 256 + 4 * lane); const bf16* qp = projq + (size_t)qn * DP2 + 64 * hv + 8 * g4; qvn[0] = *(const GAS v4u*)qp; qvn[1] = *(const GAS v4u*)(qp + 32); }
        __builtin_amdgcn_sched_barrier(0);
        const int qd = (lane >> 2) & 3, pp = lane & 3, R0 = 4 * g4 + qd, pcl = (lane & 7) ^ (lane >> 3);
        const unsigned gb0 = DSA_LDS_ADDR(gbuf), kof0 = (unsigned)(h * 128 + 16 * (g4 ^ (h & 7))), kof1 = (unsigned)(h * 128 + 16 * ((4 + g4) ^ (h & 7)));
        const unsigned vofb = (unsigned)(R0 * 128 + 8 * (pp & 1)), vsw = (unsigned)((pp >> 1) ^ (R0 & 7));
        const unsigned lsa = DSA_LDS_ADDR(lstb);
#pragma unroll 1
        for (int c = 0; c < nch; ++c) {
            if (c < 2) { if (c + 1 < nch) asm volatile("s_waitcnt vmcnt(11)" ::: "memory"); else asm volatile("s_waitcnt vmcnt(3)" ::: "memory"); }
            else { if (c + 1 < nch) asm volatile("s_waitcnt vmcnt(8)" ::: "memory"); else asm volatile("s_waitcnt vmcnt(0)" ::: "memory"); }
            const unsigned gb = gb0 + (unsigned)(c & 1) * 8192u;
            v4u kf[2][2]; u32x2v kiw[2], tv[4][2]; unsigned nk[4];
            { const unsigned ka0 = gb + kof0, ka1 = gb + kof1, va0 = gb + vofb + 16u * (vsw ^ 0u), va1 = gb + vofb + 16u * (vsw ^ 2u), va2 = gb + vofb + 16u * (vsw ^ 4u), va3 = gb + vofb + 16u * (vsw ^ 6u);
              const unsigned kwa = lsa + 2u * (unsigned)(32 * c + 4 * g4), nka = lsa + 2u * (unsigned)(32 * (c + 2) + (lane >> 3));
              asm volatile("ds_read_b128 %0, %18\n\tds_read_b128 %1, %19\n\tds_read_b128 %2, %18 offset:2048\n\tds_read_b128 %3, %19 offset:2048\n\tds_read_b64 %4, %24\n\tds_read_b64 %5, %24 offset:32\n\t"
                           TR_RD "%6, %20 offset:4096\n\t" TR_RD "%7, %20 offset:6144\n\t" TR_RD "%8, %21 offset:4096\n\t" TR_RD "%9, %21 offset:6144\n\t"
                           TR_RD "%10, %22 offset:4096\n\t" TR_RD "%11, %22 offset:6144\n\t" TR_RD "%12, %23 offset:4096\n\t" TR_RD "%13, %23 offset:6144\n\t"
                           "ds_read_u16 %14, %25\n\tds_read_u16 %15, %25 offset:16\n\tds_read_u16 %16, %25 offset:32\n\tds_read_u16 %17, %25 offset:48\n\ts_waitcnt lgkmcnt(0)"
                           : "=&v"(kf[0][0]), "=&v"(kf[0][1]), "=&v"(kf[1][0]), "=&v"(kf[1][1]), "=&v"(kiw[0]), "=&v"(kiw[1]),
                             "=&v"(tv[0][0]), "=&v"(tv[0][1]), "=&v"(tv[1][0]), "=&v"(tv[1][1]), "=&v"(tv[2][0]), "=&v"(tv[2][1]), "=&v"(tv[3][0]), "=&v"(tv[3][1]),
                             "=&v"(nk[0]), "=&v"(nk[1]), "=&v"(nk[2]), "=&v"(nk[3])
                           : "v"(ka0), "v"(ka1), "v"(va0), "v"(va1), "v"(va2), "v"(va3), "v"(kwa), "v"(nka) : "memory"); }
            if (c + 2 < nch) { LAS unsigned char* nb = gbuf + (c & 1) * 8192;
#pragma unroll
                for (int i = 0; i < 4; ++i) { const unsigned ki_ = nk[i] < (unsigned)KROWS ? nk[i] : 0u;
                    __builtin_amdgcn_global_load_lds((const unsigned*)(kc + (size_t)ki_ * 64 + 8 * pcl), (LAS unsigned*)(nb + i * 1024), 16, 0, 0);
                    __builtin_amdgcn_global_load_lds((const unsigned*)(vc + (size_t)ki_ * 64 + 8 * pcl), (LAS unsigned*)(nb + 4096 + i * 1024), 16, 0, 0); } }
            f32x4 st[2];
#pragma unroll
            for (int u = 0; u < 2; ++u) { st[u] = MFMA16(__builtin_bit_cast(bf16x8, kf[u][0]), qf[0], ((f32x4){0.f, 0.f, 0.f, 0.f})); st[u] = MFMA16(__builtin_bit_cast(bf16x8, kf[u][1]), qf[1], st[u]); }
            float bv[8];
#pragma unroll
            for (int u = 0; u < 2; ++u)
#pragma unroll
                for (int r = 0; r < 4; ++r) { const int ki = (int)((r & 1) ? kiw[u][r >> 1] >> 16 : kiw[u][r >> 1] & 0xffffu); int dd = pq - ki; dd = dd < 0 ? 0 : (dd > 135 ? 135 : dd);
                    bv[4 * u + r] = BIAS[hv * 144 + 8 + dd]; }
            float pe[8];
#pragma unroll
            for (int u = 0; u < 2; ++u)
#pragma unroll
                for (int r = 0; r < 4; ++r) { const float lg = (32 * c + 16 * u + 4 * g4 + r) < nsel ? st[u][r] + bv[4 * u + r] : -30000.f; pe[4 * u + r] = __builtin_amdgcn_exp2f(lg); lsum += pe[4 * u + r]; }
            const v4u pw = (v4u){pkbf(pe[0], pe[1]), pkbf(pe[2], pe[3]), pkbf(pe[4], pe[5]), pkbf(pe[6], pe[7])};
            const bf16x8 pf = __builtin_bit_cast(bf16x8, pw);
#pragma unroll
            for (int dt = 0; dt < 4; ++dt) oacc[dt] = MFMA16(tr_pack(tv[dt][0], tv[dt][1]), pf, oacc[dt]);
        }
#undef DSA_GDMA
        lsum += __shfl_xor(lsum, 16); lsum += __shfl_xor(lsum, 32);
        if (h < 8) { const float il = 1.f / lsum; bf16* yp = y + (size_t)qq * D + 64 * h + 4 * g4;
#pragma unroll
            for (int dt = 0; dt < 4; ++dt) *(GAS u32x2v*)(yp + 16 * dt) = (u32x2v){pkbf(oacc[dt][0] * il, oacc[dt][1] * il), pkbf(oacc[dt][2] * il, oacc[dt][3] * il)}; }
    }
}
__device__ __forceinline__ float wave_sum(float v) {
#pragma unroll
    for (int o = 1; o < 64; o <<= 1) v += __shfl_xor(v, o);
    return v;
}
__device__ __forceinline__ void p0_transpose_item(const float* W, int K, int N, int NP, bf16* WT, LAS float* scr, int item, int lane, const float* kscale = nullptr) {
    const int nblk = NP / 32, kb = item / nblk, nb = item % nblk, k0 = 64 * kb, n0 = 32 * nb;
    const int nn = n0 + (lane & 31); const bool ok = nn < N;
#pragma unroll 8
    for (int i = 0; i < 32; ++i) { const int kk = 2 * i + (lane >> 5); scr[kk * 33 + (lane & 31)] = ok ? W[(size_t)(k0 + kk) * N + nn] * (kscale ? kscale[k0 + kk] : 1.f) : 0.f; }
    LDS_WAIT(); asm volatile("" ::: "memory");
    const int c = lane & 7;
#pragma unroll
    for (int j = 0; j < 4; ++j) { const int n = (lane >> 3) + 8 * j; const LAS float* s = scr + (8 * c) * 33 + n;
        v4u o; o.x = pk2(s[0 * 33], s[1 * 33]); o.y = pk2(s[2 * 33], s[3 * 33]); o.z = pk2(s[4 * 33], s[5 * 33]); o.w = pk2(s[6 * 33], s[7 * 33]);
        *(GAS v4u*)(WT + (size_t)(n0 + n) * K + k0 + 8 * c) = o; }
    LDS_WAIT(); asm volatile("" ::: "memory");
}
__device__ __forceinline__ void rms_row_to_bf16(const float* xrow, const float* w, bf16* orow, int lane) {
    const GAS f32x4* xr = (const GAS f32x4*)xrow + lane; const GAS f32x4* wr = (const GAS f32x4*)w + lane;
    f32x4 v[4]; float s = 0.f;
#pragma unroll
    for (int j = 0; j < 4; ++j) { v[j] = xr[64 * j]; s += (v[j].x * v[j].x + v[j].y * v[j].y) + (v[j].z * v[j].z + v[j].w * v[j].w); }
    const float r = 1.f / sqrtf(wave_sum(s) * (1.f / D) + EPS);
    GAS unsigned long long* o8 = (GAS unsigned long long*)orow + lane;
#pragma unroll
    for (int j = 0; j < 4; ++j) { const f32x4 g = wr[64 * j];
        o8[64 * j] = (unsigned long long)pk2(v[j].x * r * g.x, v[j].y * r * g.y) | ((unsigned long long)pk2(v[j].z * r * g.z, v[j].w * r * g.w) << 32); }
}

__device__ __forceinline__ void rms_row2_to_bf16(const float* xa, const float* xb, const float* w, bf16* oa, bf16* ob, float* xsa, float* xsb, int lane) {
    const GAS f32x4* pa = (const GAS f32x4*)xa + lane; const GAS f32x4* pb = (const GAS f32x4*)xb + lane; const GAS f32x4* wr = (const GAS f32x4*)w + lane;
    f32x4 va[4], vb[4]; float sa = 0.f, sb = 0.f;
#pragma unroll
    for (int j = 0; j < 4; ++j) { va[j] = __builtin_nontemporal_load(pa + 64 * j); vb[j] = __builtin_nontemporal_load(pb + 64 * j); }
#pragma unroll
    for (int j = 0; j < 4; ++j) { sa += (va[j].x * va[j].x + va[j].y * va[j].y) + (va[j].z * va[j].z + va[j].w * va[j].w); sb += (vb[j].x * vb[j].x + vb[j].y * vb[j].y) + (vb[j].z * vb[j].z + vb[j].w * vb[j].w); }
    const float qa_ = sqrtf(wave_sum(sa) * (1.f / D) + EPS), qb_ = sqrtf(wave_sum(sb) * (1.f / D) + EPS); const float ra = 1.f / qa_, rb = 1.f / qb_;
    if (lane == 0) { *xsa = qa_; *xsb = qb_; }
    GAS unsigned long long* qa = (GAS unsigned long long*)oa + lane; GAS unsigned long long* qb = (GAS unsigned long long*)ob + lane;
#pragma unroll
    for (int j = 0; j < 4; ++j) { const f32x4 g = wr[64 * j];
        qa[64 * j] = (unsigned long long)pk2(va[j].x * ra * g.x, va[j].y * ra * g.y) | ((unsigned long long)pk2(va[j].z * ra * g.z, va[j].w * ra * g.w) << 32);
        qb[64 * j] = (unsigned long long)pk2(vb[j].x * rb * g.x, vb[j].y * rb * g.y) | ((unsigned long long)pk2(vb[j].z * rb * g.z, vb[j].w * rb * g.w) << 32); }
}

struct Args { const float* in[12]; float* out; unsigned char* ws; int ph_lo, ph_hi; };
__global__ void __launch_bounds__(NWAVES * 64, 2) mk_fwd(Args args) {
    extern __shared__ __attribute__((aligned(16))) unsigned char lds_raw[];
    LAS unsigned char* lds = (LAS unsigned char*)lds_raw;
    volatile LAS unsigned* MISC = (volatile LAS unsigned*)(lds + MISC_OFF);
    const int tid = threadIdx.x, lane = tid & 63, wave = __builtin_amdgcn_readfirstlane(tid >> 6);
    const int G = gridDim.x; const int bx = blockIdx.x; const int vcu = (G % 8 == 0) ? (bx % 8) * (G / 8) + bx / 8 : bx;
    unsigned char* ws = args.ws;
    gu32* ctl = (gu32*)(ws + WS_CTL);
    const float* x = args.in[0]; const float* meta = args.in[1]; const float* norm1_w = args.in[2]; const float* w_in = args.in[3];
    const float* ret_norm_w = args.in[4]; const float* q_norm_w = args.in[5]; const float* k_norm_w = args.in[6]; const float* rel_bias = args.in[7];
    const float* w_out = args.in[8]; const float* norm2_w = args.in[9]; const float* w_ff1 = args.in[10]; const float* w_ff2 = args.in[11];
    float* out = args.out;
    bf16* WIN_T = (bf16*)(ws + WS_WIN); bf16* WOUT_T = (bf16*)(ws + WS_WOUT); bf16* W1_T = (bf16*)(ws + WS_W1); bf16* W2_T = (bf16*)(ws + WS_W2);
    bf16* U = (bf16*)(ws + WS_U); bf16* PROJ = (bf16*)(ws + WS_PROJ); bf16* Y = (bf16*)(ws + WS_Y); bf16* HB = (bf16*)(ws + WS_H);
    float* ROPE = (float*)(ws + WS_ROPE); float* PMETA = (float*)(ws + WS_PMETA); bf16* PM16 = (bf16*)(ws + WS_PMETA + 512 * 1024); bf16* SPT = (bf16*)(ws + WS_SPT);
    float* XS = (float*)(ws + WS_CTL + 768 * 1024);
    float* SSQ = (float*)(ws + WS_CTL + 512 * 1024);
    bf16* KC = (bf16*)(ws + WS_KC); bf16* IKC = (bf16*)(ws + WS_IKC); bf16* VT = (bf16*)(ws + WS_VT); bf16* VC = (bf16*)(ws + WS_QN + 32 * MiB); unsigned short* LISTG = (unsigned short*)(ws + WS_LIST); bf16* RET = (bf16*)(ws + WS_RET);
    for (int u = tid; u < (LDS_BYTES - LDSCTL_OFF) / 4; u += NWAVES * 64) ((LAS unsigned*)(lds + LDSCTL_OFF))[u] = 0u;
    __syncthreads();
    XcdBarrier bar; bar.bar = (unsigned*)(ctl + CW_BAR); bar.x = 0; bar.st = nullptr;
    if (ONE_LAUNCH) bar = xcd_barrier_post((unsigned*)(ctl + CW_BAR), MISC + 8);
#define GRID_BAR() do { if (ONE_LAUNCH) xcd_barrier(bar); } while (0)
    const int lo = args.ph_lo, hi = args.ph_hi;
#define IN(k) (lo <= (k) && (k) < hi)
#define BOTH(k) (IN(k) && IN((k) + 1 + ((k) == 4)))
    const int gw = vcu * NWAVES + wave, NGW = G * NWAVES;

    if (IN(0)) {
        LAS float* scr = (LAS float*)(lds + RING_OFF + wave * 16384);
        constexpr int I_IN = (D / 64) * (DINP / 32), I_O = (D / 64) * (D / 32), I_1 = (D / 64) * (FF / 32), I_2 = (FF / 64) * (D / 32);
        constexpr int NITEMS = I_IN + I_O + I_1 + I_2;
        for (int it = gw; it < NITEMS; it += NGW) {
            int r = it;
            if (r < I_IN) { p0_transpose_item(w_in, D, DIN, DINP, WIN_T, scr, r, lane); continue; } r -= I_IN;
            if (r < I_O) { p0_transpose_item(w_out, D, D, D, WOUT_T, scr, r, lane); continue; } r -= I_O;
            if (r < I_1) { p0_transpose_item(w_ff1, D, FF, FF, W1_T, scr, r, lane, norm2_w); continue; } r -= I_1;
            p0_transpose_item(w_ff2, FF, D, D, W2_T, scr, r, lane);
        }
        for (int m = gw; m < M; m += 2 * NGW) rms_row2_to_bf16(x + (size_t)m * D, x + (size_t)(m + NGW) * D, norm1_w, U + (size_t)m * D, U + (size_t)(m + NGW) * D, XS + m, XS + m + NGW, lane);

        for (int i = bx * 512 + tid; i < TK * 64; i += G * 512) {
            const int t = i >> 6, fi = i & 63;
            const double inv = exp2(-(double)fi * (13.287712379549449 / 64.0));
            const double ang = (double)t * inv;
            const double nrev = rint(ang * 0.15915494309189535);
            double r = fma(-nrev, 6.283185307179586, ang); r = fma(-nrev, 2.4492935982947064e-16, r);
            const double r2 = r * r; double sn = 1.0, cn = 1.0;
#pragma unroll
            for (int k = 12; k >= 1; --k) { sn = 1.0 - r2 / (double)((2 * k) * (2 * k + 1)) * sn; cn = 1.0 - r2 / (double)((2 * k - 1) * (2 * k)) * cn; }
            sn *= r;
            ((GAS f32x2v*)ROPE)[i] = (f32x2v){(float)cn, (float)sn};
        }
        for (int i = bx * 512 + tid; i < 112 * DINP * 2 / 16; i += G * 512) ((GAS v4u*)PM16)[i] = (v4u){0u, 0u, 0u, 0u};
        {
            __syncthreads();
            LAS float* un = (LAS float*)(lds + RING_OFF);
            LAS float* red = (LAS float*)(lds + RING_OFF + 16 * 1025 * 4);
#pragma unroll
            for (int rr = 0; rr < 2; ++rr) { const int r = 2 * wave + rr; const GAS f32x4* xr = (const GAS f32x4*)(meta + (size_t)r * D) + lane; const GAS f32x4* wr = (const GAS f32x4*)norm1_w + lane;
                f32x4 v[4]; float s = 0.f;
#pragma unroll
                for (int j = 0; j < 4; ++j) { v[j] = xr[64 * j]; s += (v[j].x * v[j].x + v[j].y * v[j].y) + (v[j].z * v[j].z + v[j].w * v[j].w); }
                const float ri = 1.f / sqrtf(wave_sum(s) * (1.f / D) + EPS);
#pragma unroll
                for (int j = 0; j < 4; ++j) { const f32x4 g = wr[64 * j]; const int k = 4 * lane + 256 * j;
                    un[r * 1025 + k] = v[j].x * ri * g.x; un[r * 1025 + k + 1] = v[j].y * ri * g.y; un[r * 1025 + k + 2] = v[j].z * ri * g.z; un[r * 1025 + k + 3] = v[j].w * ri * g.w; } }
            __syncthreads();
            const int c0 = 13 * vcu; float acc[13];
#pragma unroll
            for (int cc = 0; cc < 13; ++cc) acc[cc] = 0.f;
            for (int i = 0; i < 32; ++i) { const int k = 128 * wave + (lane >> 4) + 4 * i; const float uv = un[(lane & 15) * 1025 + k]; const float* wp = w_in + (size_t)k * DIN + c0;
#pragma unroll
                for (int cc = 0; cc < 13; ++cc) { const float wv = (c0 + cc < DIN) ? wp[cc] : 0.f; acc[cc] = fmaf(uv, wv, acc[cc]); } }
#pragma unroll
            for (int cc = 0; cc < 13; ++cc) { acc[cc] += __shfl_xor(acc[cc], 16); acc[cc] += __shfl_xor(acc[cc], 32); if (lane < 16) red[(wave * 16 + lane) * 13 + cc] = acc[cc]; }
            __syncthreads();
            if (tid < 208) { const int r = tid / 13, cc = tid % 13; float s = 0.f;
#pragma unroll
                for (int w8 = 0; w8 < 8; ++w8) s += red[(w8 * 16 + r) * 13 + cc];
                const int c = c0 + cc; if (c >= DIN) s = 0.f;
                PMETA[r * DINP + c] = s; PM16[(size_t)(112 + r) * DINP + c] = (bf16)f2bf(s); }
            __syncthreads();
        }
        if (BOTH(0)) GRID_BAR();
    }
    if (IN(1)) {
        pg8::Gemm g{U, WIN_T, M, DINP, D}; pg8::StaticOrder S; S.init(M, DINP, G, (int)blockIdx.x);
        pg8::EpiProj E{PROJ, DP2, RET, M};
        pg8::gemm_phase<pg8::EpiProj, pg8::StaticOrder, true, true>(lds + RING_OFF, g, S, E);
        if (BOTH(1)) GRID_BAR();
    }
    if (IN(2)) {
        {
            LAS unsigned char* vscr = lds + RING_OFF + 65536 + wave * 1024;
            const int r = lane >> 3, sub = lane & 7;
            const f32x4 kg0 = *(const GAS f32x4*)(k_norm_w + 8 * sub), kg1 = *(const GAS f32x4*)(k_norm_w + 8 * sub + 4);
            for (int unit = gw; unit < BATCH * 520; unit += NGW) {
                const int b = unit / 520, gidx = unit % 520; const bool isx = gidx >= 2 && gidx < 514, ismeta = gidx < 2;
                const bf16* src = ismeta ? PM16 + (size_t)(112 + 8 * gidx + r) * DINP + 2048 : PROJ + ((size_t)b * SEQ + (isx ? 8 * (gidx - 2) + r : 0)) * DP2;
                const size_t krow = ((size_t)b * KROWS + 8 * gidx + r) * 64 + 8 * sub;
                v4u kv = (v4u){0u, 0u, 0u, 0u}, iv = kv, vv = kv;
                if (isx || ismeta) { kv = *(const GAS v4u*)(src + C2_DK + 8 * sub); iv = *(const GAS v4u*)(src + C2_IK + 8 * sub); vv = *(const GAS v4u*)(src + C2_DV + 8 * sub); }
                float xk[8]; float sk = 0.f;
#pragma unroll
                for (int i = 0; i < 4; ++i) { xk[2 * i] = __uint_as_float(kv[i] << 16); xk[2 * i + 1] = __uint_as_float(kv[i] & 0xffff0000u); sk += xk[2 * i] * xk[2 * i] + xk[2 * i + 1] * xk[2 * i + 1]; }
                sk += __shfl_xor(sk, 1); sk += __shfl_xor(sk, 2); sk += __shfl_xor(sk, 4);
                const float sck = 1.f / sqrtf(sk * (1.f / 64.f) + EPS);
                *(GAS v4u*)(KC + krow) = (v4u){pkbf(xk[0] * sck * kg0[0], xk[1] * sck * kg0[1]), pkbf(xk[2] * sck * kg0[2], xk[3] * sck * kg0[3]), pkbf(xk[4] * sck * kg1[0], xk[5] * sck * kg1[1]), pkbf(xk[6] * sck * kg1[2], xk[7] * sck * kg1[3])};
                *(GAS v4u*)(IKC + krow) = iv;
                *(GAS v4u*)(VC + krow) = vv;
                *(LAS v4u*)(vscr + lane * 16) = vv;
                LDS_WAIT(); asm volatile("" ::: "memory");
                { const LAS unsigned short* vs = (const LAS unsigned short*)vscr + lane; v4u o;
#pragma unroll
                  for (int i = 0; i < 4; ++i) o[i] = (unsigned)vs[(2 * i) * 64] | ((unsigned)vs[(2 * i + 1) * 64] << 16);
                  *(GAS v4u*)(VT + ((size_t)b * 64 + lane) * KROWS + 8 * gidx) = o; }
                LDS_WAIT(); asm volatile("" ::: "memory");
            }
            __syncthreads();
        }
        if (vcu < 256) {
            const int b = vcu >> 4, h = (vcu >> 2) & 3, dq = vcu & 3;
            const float lg2 = log2f(1.f - exp2f(-5.f - (float)h));
            const float cdec = exp2f(lg2 * 128.f);
            LAS unsigned char* Kimg = lds + 3 * 40960;
            f32x4 acc[2]; acc[0] = (f32x4){0.f, 0.f, 0.f, 0.f}; acc[1] = acc[0];
            f32x4 rc[4], rc1[4], rstep[4];
            { const int c = (tid >> 1) & 127, jh = tid & 1; int t0 = c - 112; t0 = t0 < 0 ? 0 : t0; const int t1 = 16 + c;
              const GAS f32x4* r0 = (const GAS f32x4*)(ROPE + ((size_t)t0 * 64 + 16 * dq + 8 * jh) * 2); const GAS f32x4* r1 = (const GAS f32x4*)(ROPE + ((size_t)t1 * 64 + 16 * dq + 8 * jh) * 2);
              const GAS f32x4* rs = (const GAS f32x4*)(ROPE + ((size_t)128 * 64 + 16 * dq + 8 * jh) * 2);
#pragma unroll
              for (int i = 0; i < 4; ++i) { rc[i] = r0[i]; rc1[i] = r1[i]; rstep[i] = rs[i]; } }
            const float ksc0 = RET_KSCALE * exp2f(lg2 * (float)(127 - ((tid >> 1) & 127)));
#define R12_DMA(n, slot) do { const bool m0_ = (n) == 0; const size_t rs_ = m0_ ? (size_t)DINP : (size_t)128;     \
                const bf16* kb_ = m0_ ? PM16 + C_RK + 128 * h : RET + ((size_t)(4 + h) * M + (size_t)b * SEQ + 128 * ((n) - 1)) * 128; const bf16* vb_ = m0_ ? PM16 + C_RV + 128 * h : RET + ((size_t)(8 + h) * M + (size_t)b * SEQ + 128 * ((n) - 1)) * 128; \
                _Pragma("unroll") for (int i = 0; i < 4; ++i) __builtin_amdgcn_global_load_lds((const unsigned*)(vb_ + (size_t)(16 * wave + 4 * i + (lane >> 4)) * rs_ + 8 * ((lane & 15) ^ (2 * (lane >> 4)))), (LAS unsigned*)(lds + (slot) * 40960 + (4 * wave + i) * 1024), 16, 0, 0); \
                __builtin_amdgcn_global_load_lds((const unsigned*)(kb_ + (size_t)(16 * wave + (lane >> 2)) * rs_ + 64 * ((lane >> 1) & 1) + 16 * dq + 8 * (lane & 1)), (LAS unsigned*)(lds + (slot) * 40960 + 32768 + wave * 1024), 16, 0, 0); } while (0)
            R12_DMA(0, 0); R12_DMA(1, 1); R12_DMA(2, 2);
            asm volatile("s_waitcnt vmcnt(0)" ::: "memory"); __syncthreads();
            const unsigned kimg_a0 = DSA_LDS_ADDR(Kimg + ((tid >> 1) & 127) * 64 + 16 * (tid & 1));
            const unsigned trk_a = DSA_LDS_ADDR(Kimg + (8 * (lane >> 4) + ((lane >> 2) & 3)) * 64 + 8 * (lane & 3));
            const unsigned trv_off = (unsigned)((8 * (lane >> 4) + ((lane >> 2) & 3)) * 256 + 16 * ((2 * wave + ((lane & 3) >> 1)) ^ (2 * ((lane >> 2) & 3))) + 8 * (lane & 1));
#pragma unroll 1
            for (int n = 0; n < 32; ++n) {
                const LAS unsigned char* slot = lds + (n % 3) * 40960;
                const unsigned slot_a = DSA_LDS_ADDR(slot);
                if (tid < 256) {
                    if (n == 1) {
#pragma unroll
                        for (int i = 0; i < 4; ++i) rc[i] = rc1[i]; }
                    else if (n > 1) {
#pragma unroll
                        for (int i = 0; i < 4; ++i) { const f32x4 a = rc[i], st = rstep[i];
                            rc[i] = (f32x4){a[0] * st[0] - a[1] * st[1], a[1] * st[0] + a[0] * st[1], a[2] * st[2] - a[3] * st[3], a[3] * st[2] + a[2] * st[3]}; } }
                    const LAS unsigned char* rp = slot + 32768 + (tid >> 1) * 64 + 16 * (tid & 1); v4u o1, o2;
                    rot8(*(const LAS v4u*)rp, *(const LAS v4u*)(rp + 32), rc, ksc0, o1, o2);
                    asm volatile("ds_write_b128 %0, %1\n\tds_write_b128 %0, %2 offset:32" :: "v"(kimg_a0), "v"(o1), "v"(o2) : "memory"); }
                asm volatile("s_waitcnt lgkmcnt(0)\n\ts_barrier" ::: "memory");
                acc[0] = acc[0] * cdec; acc[1] = acc[1] * cdec;
                { const unsigned va_ = slot_a + trv_off;
#pragma unroll
                  for (int kp = 0; kp < 2; ++kp) { u32x2v t[12];
                      if (kp == 0) asm volatile(TR_RD "%0, %12\n\t" TR_RD "%1, %12 offset:256\n\t" TR_RD "%2, %12 offset:32\n\t" TR_RD "%3, %12 offset:288\n\t" TR_RD "%4, %13\n\t" TR_RD "%5, %13 offset:1024\n\t"
                                                TR_RD "%6, %12 offset:2048\n\t" TR_RD "%7, %12 offset:2304\n\t" TR_RD "%8, %12 offset:2080\n\t" TR_RD "%9, %12 offset:2336\n\t" TR_RD "%10, %13 offset:8192\n\t" TR_RD "%11, %13 offset:9216\n\ts_waitcnt lgkmcnt(0)"
                                                : "=&v"(t[0]), "=&v"(t[1]), "=&v"(t[2]), "=&v"(t[3]), "=&v"(t[4]), "=&v"(t[5]), "=&v"(t[6]), "=&v"(t[7]), "=&v"(t[8]), "=&v"(t[9]), "=&v"(t[10]), "=&v"(t[11]) : "v"(trk_a), "v"(va_) : "memory");
                      else asm volatile(TR_RD "%0, %12 offset:4096\n\t" TR_RD "%1, %12 offset:4352\n\t" TR_RD "%2, %12 offset:4128\n\t" TR_RD "%3, %12 offset:4384\n\t" TR_RD "%4, %13 offset:16384\n\t" TR_RD "%5, %13 offset:17408\n\t"
                                        TR_RD "%6, %12 offset:6144\n\t" TR_RD "%7, %12 offset:6400\n\t" TR_RD "%8, %12 offset:6176\n\t" TR_RD "%9, %12 offset:6432\n\t" TR_RD "%10, %13 offset:24576\n\t" TR_RD "%11, %13 offset:25600\n\ts_waitcnt lgkmcnt(0)"
                                        : "=&v"(t[0]), "=&v"(t[1]), "=&v"(t[2]), "=&v"(t[3]), "=&v"(t[4]), "=&v"(t[5]), "=&v"(t[6]), "=&v"(t[7]), "=&v"(t[8]), "=&v"(t[9]), "=&v"(t[10]), "=&v"(t[11]) : "v"(trk_a), "v"(va_) : "memory");
#pragma unroll
                      for (int kk = 0; kk < 2; ++kk) { const bf16x8 a0 = tr_pack(t[6 * kk], t[6 * kk + 1]), a1 = tr_pack(t[6 * kk + 2], t[6 * kk + 3]), bv = tr_pack(t[6 * kk + 4], t[6 * kk + 5]);
                          acc[0] = MFMA16(a0, bv, acc[0]); acc[1] = MFMA16(a1, bv, acc[1]); } } }
                bf16* sp = SPT + ((size_t)((b * 4 + h) * 32 + n)) * 16384;
#pragma unroll
                for (int dt = 0; dt < 2; ++dt) { const int e = 16 * wave + (lane & 15), d = 64 * dt + 16 * dq + 4 * (lane >> 4);
                    *(GAS u32x2v*)(sp + e * 128 + d) = (u32x2v){pkbf(acc[dt][0], acc[dt][1]), pkbf(acc[dt][2], acc[dt][3])}; }
                asm volatile("s_waitcnt vmcnt(9) lgkmcnt(0)\n\ts_barrier" ::: "memory");
                { const int nn = n + 3 < 32 ? n + 3 : 31; R12_DMA(nn, n % 3); }
            }
            asm volatile("s_waitcnt vmcnt(0)" ::: "memory"); __syncthreads();
#undef R12_DMA
        }
        if (BOTH(2)) GRID_BAR();
    }
    if (IN(3)) {
        {
            for (int i = tid; i < 8 * 144; i += 512) { const int h = i / 144, d = i % 144 - 8; float v = 0.f;
                if (d >= 0 && d < 113) { int bk = d; if (d >= 16) { bk = 16 + (int)(logf((float)d * (1.f / 16.f)) / logf(8.f) * 16.f); bk = bk > 31 ? 31 : bk; } v = (rel_bias[bk * 8 + h] - rel_bias[31 * 8 + h]) * LOG2E; }
                ((LAS float*)(lds + L_BIAS))[i] = v; }
            __syncthreads();
            LAS unsigned* HIST = (LAS unsigned*)(lds + L_HIST); LAS unsigned* MASK = (LAS unsigned*)(lds + L_MASK); LAS unsigned* QPAR = (LAS unsigned*)(lds + L_QPAR);
            LAS unsigned* CCNT = (LAS unsigned*)(lds + L_CCNT); const LAS float* BIAS = (const LAS float*)(lds + L_BIAS);
            LAS unsigned char* STG = lds + L_STAGE;
            LAS unsigned char* STG3 = lds + L_HIST;
            const int ql = lane & 15, g4 = lane >> 4;
            const int dk_row = 32 * (wave >> 2) + 8 * (ql >> 2) + 4 * ((wave >> 1) & 1) + (ql & 3), dk_col = 32 * (wave & 1) + 8 * g4;
            const int dv_row = 16 * (wave & 3) + ql, dv_col = 32 * (wave >> 2) + 8 * g4;
            const int xq = vcu >> 5;
            for (;;) {
                if (vcu >= 256) break;
                if (tid == 0) MISC[4] = __hip_atomic_fetch_add(ctl + 2048 + 64 * xq, 1u, __ATOMIC_RELAXED, __HIP_MEMORY_SCOPE_AGENT);
                __syncthreads();
                const int uq = (int)MISC[4];
                __syncthreads();
                if (uq >= 64) break;
                const int b = 2 * xq + (uq >> 5), j = 31 - (uq & 31);
                const int nt = 5 + 4 * j, ns = (nt + 1) >> 1;
                const int qloc = 16 * wave + ql;
                const size_t mrow = (size_t)b * SEQ + 128 * j + qloc;
                const int p = 16 + 128 * j + qloc;
                const int pmaxw = 16 + 128 * j + 16 * wave + 15;
                const bf16* ikb = IKC + (size_t)b * KROWS * 64; const bf16* kcb = KC + (size_t)b * KROWS * 64; const bf16* vtb = VT + (size_t)b * 64 * KROWS; const bf16* vcb = VC + (size_t)b * KROWS * 64;
                unsigned char* tqb = (b < 15 ? (unsigned char*)out + (size_t)b * (17u << 20) : ws + WS_QN) + (size_t)(j * j + 2 * j) * 16384 + wave * 1024 + lane * 16;
                LAS unsigned* hrow = HIST + qloc * 128;
                bf16x8 iq[8][2], cq[2]; float wh[8];
                { const bf16* rp = PROJ + mrow * DP2 + C2_IQ + 8 * g4;
#pragma unroll
                  for (int h = 0; h < 8; ++h) { iq[h][0] = *(const GAS bf16x8*)(rp + 64 * h); iq[h][1] = *(const GAS bf16x8*)(rp + 64 * h + 32); }
                  const v4u wv = *(const GAS v4u*)(PROJ + mrow * DP2 + C2_IW);
#pragma unroll
                  for (int i = 0; i < 4; ++i) { wh[2 * i] = __uint_as_float(wv[i] << 16) * (0.5f * 0.35355339059327373f * 0.125f); wh[2 * i + 1] = __uint_as_float(wv[i] & 0xffff0000u) * (0.5f * 0.35355339059327373f * 0.125f); }
#pragma unroll
                  for (int sx = 0; sx < 2; ++sx) { float ca[8];
#pragma unroll
                      for (int e = 0; e < 8; ++e) ca[e] = 0.f;
#pragma unroll
                      for (int h = 0; h < 8; ++h) { const v4u qv = __builtin_bit_cast(v4u, iq[h][sx]);
#pragma unroll
                          for (int e = 0; e < 4; ++e) { ca[2 * e] = __builtin_fmaf(wh[h], __uint_as_float(qv[e] << 16), ca[2 * e]); ca[2 * e + 1] = __builtin_fmaf(wh[h], __uint_as_float(qv[e] & 0xffff0000u), ca[2 * e + 1]); } }
                      const v4u cw = (v4u){pkbf(ca[0], ca[1]), pkbf(ca[2], ca[3]), pkbf(ca[4], ca[5]), pkbf(ca[6], ca[7])}; cq[sx] = __builtin_bit_cast(bf16x8, cw); } }
                float lo, invw, binc;
                { float s1 = 0.f, s2 = 0.f;
                  int lane_p0 = lane; DSA_OPAQUE(lane_p0);
                  for (int kt = 0; kt < 2; ++kt) { f32x4 sc[2]; idx_tile(ikb, kt, iq, cq, wh, lane_p0, sc);
#pragma unroll
                      for (int u = 0; u < 2; ++u)
#pragma unroll
                          for (int r = 0; r < 4; ++r) { s1 += sc[u][r]; s2 += sc[u][r] * sc[u][r]; } }
                  s1 += __shfl_xor(s1, 16); s1 += __shfl_xor(s1, 32); s2 += __shfl_xor(s2, 16); s2 += __shfl_xor(s2, 32);
                  const float mean = s1 * (1.f / 64.f); float var = s2 * (1.f / 64.f) - mean * mean; var = var > 1e-30f ? var : 1e-30f;
                  const float sd = sqrtf(var); lo = mean - 3.f * sd; invw = 256.f * (float)DSA_NB / (6.f * sd); binc = -lo * invw; }
                { LAS v4u* hz = (LAS v4u*)(HIST + 16 * wave * 128);
#pragma unroll
                  for (int i = 0; i < 8; ++i) hz[lane + 64 * i] = (v4u){0u, 0u, 0u, 0u}; }
                __syncthreads();
                DSA_DMA_K(ikb, 0, DSA_PB1(0)); DSA_DMA_K(ikb, ns > 1 ? 1 : ns - 1, DSA_PB1(1)); DSA_DMA_K(ikb, ns > 2 ? 2 : ns - 1, DSA_PB1(2));
                DSA_WAITBAR(2);
                { const unsigned hbase = DSA_LDS_ADDR(hrow); unsigned one_v = 1u; DSA_OPAQUE(one_v);
                for (int step = 0; step < ns; ++step) {
                    { const int sn = step + 3 < ns ? step + 3 : ns - 1; DSA_DMA_K(ikb, sn, DSA_PB1(step + 3)); }
                    const LAS unsigned char* tb = DSA_PB1(step);
#pragma unroll 1
                    for (int tt = 0; tt < 2; ++tt) { const int kt = 2 * step + tt; unsigned tqv[4]; if (32 * kt > pmaxw) continue;
                        if (32 * kt + 31 <= pmaxw - 15) {
#pragma unroll
                        for (int u = 0; u < 2; ++u) { const f32x4 scu = idx_sub_lds2(tb + tt * 4096, u, iq, cq, wh, lane);
#pragma unroll
                            for (int r = 0; r < 4; ++r) {
                                const unsigned tq = (unsigned)(int)__builtin_amdgcn_fmed3f(bin_t(scu[r], binc, invw), 0.f, 32767.f);
                                asm volatile("ds_add_u32 %0, %1" :: "v"(hbase | ((tq >> 6) & 0x1fcu)), "v"(one_v) : "memory");
                                tqv[r] = tq; }
                            *(GAS u32x2v*)(tqb + (size_t)kt * 8192 + 8 * u) = (u32x2v){tqv[0] | (tqv[1] << 16), tqv[2] | (tqv[3] << 16)};
                            __builtin_amdgcn_sched_barrier(0); }
                        } else {
#pragma unroll
                        for (int u = 0; u < 2; ++u) { const f32x4 scu = idx_sub_lds2(tb + tt * 4096, u, iq, cq, wh, lane);
#pragma unroll
                            for (int r = 0; r < 4; ++r) { const int kk = 32 * kt + 8 * g4 + 4 * u + r; const bool causal = kk <= p;
                                const unsigned tq = (unsigned)(int)__builtin_amdgcn_fmed3f(bin_t(scu[r], binc, invw), 0.f, 32767.f);
                                asm volatile("ds_add_u32 %0, %1" :: "v"(hbase | ((tq >> 6) & 0x1fcu)), "v"(causal ? 1u : 0u) : "memory");
                                tqv[r] = causal ? tq : 0xffffu; }
                            *(GAS u32x2v*)(tqb + (size_t)kt * 8192 + 8 * u) = (u32x2v){tqv[0] | (tqv[1] << 16), tqv[2] | (tqv[3] << 16)};
                            __builtin_amdgcn_sched_barrier(0); } } }
                    DSA_WAITBAR(2);
                } }
#pragma unroll 1
                for (int qq = 0; qq < 16; ++qq) { const int q = 16 * wave + qq; const int pq = 16 + 128 * j + q; const int kq = pq + 1 < 256 ? pq + 1 : 256;
                    const u32x2v wv = *(const LAS u32x2v*)(HIST + q * 128 + 2 * lane);
                    const int c0 = (int)wv[0], c1 = (int)wv[1]; const int sl = c0 + c1;
                    int pre = sl;
                    pre += __builtin_amdgcn_update_dpp(0, pre, 0x111, 0xf, 0xf, true); pre += __builtin_amdgcn_update_dpp(0, pre, 0x112, 0xf, 0xf, true);
                    pre += __builtin_amdgcn_update_dpp(0, pre, 0x114, 0xf, 0xf, true); pre += __builtin_amdgcn_update_dpp(0, pre, 0x118, 0xf, 0xf, true);
                    pre += __builtin_amdgcn_update_dpp(0, pre, 0x142, 0xa, 0xf, false); pre += __builtin_amdgcn_update_dpp(0, pre, 0x143, 0xc, 0xf, false);
                    int cum = __builtin_amdgcn_readlane(pre, 63) - pre; int bst = -1, ngt = 0;
                    if (cum < kq && cum + c1 >= kq) { bst = 2 * lane + 1; ngt = cum; } cum += c1;
                    if (cum < kq && cum + c0 >= kq) { bst = 2 * lane + 0; ngt = cum; }
                    if (bst >= 0) { QPAR[q * 4 + 0] = (unsigned)bst; QPAR[q * 4 + 1] = (unsigned)(kq - ngt); } }
                LDS_WAIT(); asm volatile("" ::: "memory");
                const int bstar = (int)QPAR[qloc * 4 + 0];
                int ccnt = 0;
                const unsigned cbase = DSA_LDS_ADDR(lds + L_HIST + qloc * 256), mbase = DSA_LDS_ADDR(MASK + qloc * DSA_MSTR);
                const int thi16 = (bstar + 1) << 8;
                __syncthreads();
                { v4u tw[4];
#pragma unroll
                  for (int i = 0; i < 4; ++i) tw[i] = *(const GAS v4u*)(tqb + (size_t)(i < 2 * ns ? i : 0) * 8192);
                  for (int kt0 = 0; kt0 < 2 * ns; kt0 += 4) {
#pragma unroll
                    for (int i = 0; i < 4; ++i) { const int kt = kt0 + i; if (kt < 2 * ns && 32 * kt <= pmaxw) {
                        const v4u cw = tw[i]; { const int kn = kt + 4 < 2 * ns ? kt + 4 : kt; tw[i] = *(const GAS v4u*)(tqb + (size_t)kn * 8192); }
                        unsigned bits = 0u;
#pragma unroll
                        for (int e = 0; e < 8; ++e) { const unsigned tq = (e & 1) ? cw[e >> 1] >> 16 : cw[e >> 1] & 0xffffu; const int kk = 32 * kt + 8 * g4 + e;
                            bits |= (int)(short)tq >= thi16 ? 1u << (8 * g4 + e) : 0u;
                            const bool cand = (int)(tq >> 8) == bstar; const unsigned long long m = __ballot(cand);
                            if (m) {
                                const unsigned long long mq = (m >> ql) & 0x0001000100010001ull;
                                const int rank = __popcll(mq & ((1ull << (16 * g4)) - 1ull)), tot = __popcll(mq);
                                if (cand) { const int slot = ccnt + rank; if (slot < DSA_CAP) asm volatile("ds_write_b32 %0, %1" :: "v"(cbase + 4u * (unsigned)slot), "v"((tq << 16) | (0xffffu - (unsigned)kk)) : "memory"); }
                                ccnt += tot; } }
                        bits |= __shfl_xor(bits, 16); bits |= __shfl_xor(bits, 32);
                        if (g4 == 0) asm volatile("ds_write_b32 %0, %1" :: "v"(mbase + 4u * (unsigned)kt), "v"(bits) : "memory"); } }
                  } }
                if (g4 == 0) CCNT[qloc] = (unsigned)ccnt;
                LDS_WAIT(); asm volatile("" ::: "memory");
#pragma unroll 1
                for (int qq = 0; qq < 16; ++qq) { const int q = 16 * wave + qq;
                    int cnt = (int)CCNT[q]; cnt = cnt < DSA_CAP ? cnt : DSA_CAP; cnt = __builtin_amdgcn_readfirstlane(cnt);
                    const int need = (int)QPAR[q * 4 + 1];
                    const LAS unsigned* cc_ = (const LAS unsigned*)(lds + L_HIST + q * 256);
                    const unsigned cme = lane < cnt ? cc_[lane] : 0u; const unsigned kme = 0xffffu - (cme & 0xffffu); int rank = 0;
                    for (int t = 0; t < cnt; ++t) rank += (unsigned)__builtin_amdgcn_readlane((int)cme, t) > cme ? 1 : 0;
                    if (lane < cnt && rank < need) __hip_atomic_fetch_or(MASK + q * DSA_MSTR + (kme >> 5), 1u << (kme & 31u), __ATOMIC_RELAXED, __HIP_MEMORY_SCOPE_WORKGROUP); }
                if (j >= 17) {
                    unsigned short* lstg = LISTG + ((size_t)((b * 32 + j) * 128 + 16 * wave)) * 256;
                    if (lane < 16) QPAR[(16 * wave + lane) * 4 + 2] = 0u;
#pragma unroll 1
                    for (int qq = 0; qq < 16; ++qq) { const int q = 16 * wave + qq; const int pq = 16 + 128 * j + q;
#pragma unroll 1
                        for (int rr = 0; rr < 3; ++rr) { const int kt = 64 * rr + lane;
                            unsigned w = (kt <= (pq >> 5)) ? MASK[q * DSA_MSTR + (kt < DSA_MSTR ? kt : 0)] : 0u;
                            const int cw = __popc(w);
                            int pos = cw ? (int)__hip_atomic_fetch_add(QPAR + q * 4 + 2, (unsigned)cw, __ATOMIC_RELAXED, __HIP_MEMORY_SCOPE_WORKGROUP) : 0;
                            while (w) { const int bpos = __builtin_ctz(w); w &= w - 1u; if (pos < 256) lstg[qq * 256 + pos] = (unsigned short)(32 * kt + bpos); ++pos; } } }
                    asm volatile("s_waitcnt vmcnt(0)" ::: "memory");
                    __syncthreads();
                    { int mrow_s = (int)((size_t)b * SEQ + 128 * j + 16 * wave); asm volatile("" : "+s"(mrow_s));
                      dsa_gather(lds + wave * 16384, lds + L_STAGE + wave * 1024, BIAS, kcb, vcb, lstg, QPAR + 16 * wave * 4 + 2, PROJ + (size_t)mrow_s * DP2 + C2_DQ, q_norm_w, Y + (size_t)mrow_s * D + 512, 16 + 128 * j + 16 * wave, lane); }
                    __syncthreads();
                } else {
                    __syncthreads();
                    int mrow_s = (int)mrow; asm volatile("" : "+v"(mrow_s));
                    dsa_sweep<4>(lds, 0, kcb, vtb, PROJ + (size_t)mrow_s * DP2 + C2_DQ, q_norm_w, Y + (size_t)mrow_s * D + 512, ns, p, 16 + 128 * j + 16 * wave, qloc, wave, lane);
                    dsa_sweep<4>(lds, 4, kcb, vtb, PROJ + (size_t)mrow_s * DP2 + C2_DQ, q_norm_w, Y + (size_t)mrow_s * D + 512, ns, p, 16 + 128 * j + 16 * wave, qloc, wave, lane);
                }
            }
            __syncthreads();
        }
        {
            LAS unsigned char* Kimg = lds + RING_OFF; LAS unsigned char* Vimg = Kimg + 128 * IMG_STRIDE; LAS unsigned char* Simg = Vimg + 128 * IMG_STRIDE;
            for (;;) {
                if (tid == 0) MISC[5] = __hip_atomic_fetch_add(ctl + 2048 + 64 * 16, 1u, __ATOMIC_RELAXED, __HIP_MEMORY_SCOPE_AGENT);
                __syncthreads();
                const int unit = (int)MISC[5];
                __syncthreads();
                if (unit >= BATCH * 4 * 32) break;
                const int b = unit >> 7, h = (unit >> 5) & 3, n = (unit & 31) + 1;
                const float lg2 = log2f(1.f - exp2f(-5.f - (float)h));
                const size_t row0 = (size_t)b * SEQ + 128 * (n - 1);
#pragma unroll
                for (int i_ = 0; i_ < 2; ++i_) { const int item = tid + 512 * i_, c = item >> 3, j = item & 7;
                    const bf16* rp = RET + ((size_t)(4 + h) * M + row0 + c) * 128 + 8 * j; const v4u a = *(const GAS v4u*)rp, bq = *(const GAS v4u*)(rp + 64);
                    const int t = 128 * n - 112 + c; const GAS f32x4* rq = (const GAS f32x4*)(ROPE + ((size_t)t * 64 + 8 * j) * 2); f32x4 cs[4]; cs[0] = rq[0]; cs[1] = rq[1]; cs[2] = rq[2]; cs[3] = rq[3];
                    v4u o1, o2; rot8(a, bq, cs, RET_KSCALE, o1, o2);
                    *(LAS v4u*)(Kimg + c * IMG_STRIDE + 16 * j) = o1; *(LAS v4u*)(Kimg + c * IMG_STRIDE + 128 + 16 * j) = o2; }
                const bf16* sp = SPT + ((size_t)((b * 4 + h) * 32 + (n - 1))) * 16384;
#pragma unroll
                for (int i_ = 0; i_ < 4; ++i_) { const int item = tid + 512 * i_, c = item >> 4, part = item & 15;
                    *(LAS v4u*)(Vimg + c * IMG_STRIDE + 16 * part) = *(const GAS v4u*)(RET + ((size_t)(8 + h) * M + row0 + c) * 128 + 8 * part);
                    *(LAS v4u*)(Simg + c * IMG_STRIDE + 16 * part) = *(const GAS v4u*)(sp + c * 128 + 8 * part); }
                const int cq = 16 * wave + (lane & 15), g4 = lane >> 4;
                bf16x8 qf[4];
                { const bf16* rp = RET + ((size_t)h * M + row0 + cq) * 128 + 8 * g4; const int t = 128 * n - 112 + cq;
                  const v4u q0 = *(const GAS v4u*)rp, q1 = *(const GAS v4u*)(rp + 32), q2 = *(const GAS v4u*)(rp + 64), q3 = *(const GAS v4u*)(rp + 96);
                  const GAS f32x4* ra = (const GAS f32x4*)(ROPE + ((size_t)t * 64 + 8 * g4) * 2); f32x4 c0[4], c1[4];
#pragma unroll
                  for (int i_ = 0; i_ < 4; ++i_) { c0[i_] = ra[i_]; c1[i_] = ra[16 + i_]; }
                  v4u o0, o1, o2, o3; rot8(q0, q2, c0, 1.f, o0, o2); rot8(q1, q3, c1, 1.f, o1, o3);
                  qf[0] = __builtin_bit_cast(bf16x8, o0); qf[1] = __builtin_bit_cast(bf16x8, o1); qf[2] = __builtin_bit_cast(bf16x8, o2); qf[3] = __builtin_bit_cast(bf16x8, o3); }
                u32x2v gpre[8];
                { const bf16* gp0 = RET + ((size_t)(12 + h) * M + row0 + cq) * 128 + 4 * g4;
#pragma unroll
                  for (int et = 0; et < 8; ++et) gpre[et] = *(const GAS u32x2v*)(gp0 + 16 * et); }
                __syncthreads();
                f32x4 oin[8], ocr[8];
#pragma unroll
                for (int et = 0; et < 8; ++et) { oin[et] = (f32x4){0.f, 0.f, 0.f, 0.f}; ocr[et] = oin[et]; }
#pragma unroll
                for (int et = 0; et < 8; ++et)
#pragma unroll
                    for (int ks = 0; ks < 4; ++ks) ocr[et] = MFMA16(frag_n(Simg, IMG_STRIDE, 16 * et + (lane & 15), 32 * ks, lane), qf[ks], ocr[et]);
                const int kgmax = wave >> 1;
                for (int kg = 0; kg <= kgmax; ++kg) {
                    f32x4 st[2];
#pragma unroll
                    for (int u = 0; u < 2; ++u) { st[u] = (f32x4){0.f, 0.f, 0.f, 0.f};
                        const int mrow = 32 * kg + 8 * ((lane & 15) >> 2) + 4 * u + (lane & 3);
#pragma unroll
                        for (int ks = 0; ks < 4; ++ks) st[u] = MFMA16(frag_n(Kimg, IMG_STRIDE, mrow, 32 * ks, lane), qf[ks], st[u]); }
                    float pv[8];
#pragma unroll
                    for (int u = 0; u < 2; ++u)
#pragma unroll
                        for (int r = 0; r < 4; ++r) { const int m = 32 * kg + 8 * g4 + 4 * u + r; const int dd = cq - m; pv[4 * u + r] = dd >= 0 ? st[u][r] * exp2f(lg2 * (float)dd) : 0.f; }
                    const v4u pw = (v4u){pkbf(pv[0], pv[1]), pkbf(pv[2], pv[3]), pkbf(pv[4], pv[5]), pkbf(pv[6], pv[7])};
                    const bf16x8 pf = __builtin_bit_cast(bf16x8, pw);
#pragma unroll
                    for (int et = 0; et < 8; ++et) oin[et] = MFMA16(frag_t(Vimg, IMG_STRIDE, 16 * et, 32 * kg, lane), pf, oin[et]);
                }
                const float xi = exp2f(lg2 * (float)(cq + 1)); float ss = 0.f;
#pragma unroll
                for (int et = 0; et < 8; ++et) { oin[et] = oin[et] + ocr[et] * xi; ss += (oin[et][0] * oin[et][0] + oin[et][1] * oin[et][1]) + (oin[et][2] * oin[et][2] + oin[et][3] * oin[et][3]); }
                ss += __shfl_xor(ss, 16); ss += __shfl_xor(ss, 32);
                const float rinv = 1.f / sqrtf(ss * (1.f / 128.f) + EPS);
                bf16* yp = Y + (row0 + cq) * D + 128 * h + 4 * g4; const float* wn = ret_norm_w + 128 * h + 4 * g4;
#pragma unroll
                for (int et = 0; et < 8; ++et) { const u32x2v gw2 = gpre[et]; const f32x4 gn = *(const GAS f32x4*)(wn + 16 * et);
                    float gt[4] = {__uint_as_float(gw2[0] << 16), __uint_as_float(gw2[0] & 0xffff0000u), __uint_as_float(gw2[1] << 16), __uint_as_float(gw2[1] & 0xffff0000u)}; float o[4];
#pragma unroll
                    for (int r = 0; r < 4; ++r) { const float sg = gt[r] / (1.f + __expf(-gt[r])); o[r] = oin[et][r] * rinv * gn[r] * sg; }
                    *(GAS u32x2v*)(yp + 16 * et) = (u32x2v){pkbf(o[0], o[1]), pkbf(o[2], o[3])}; }
                __syncthreads();
            }
        }
        if (BOTH(3)) GRID_BAR();
    }
    if (IN(4)) {
        pg8::Gemm g{Y, WOUT_T, M, D, D}; pg8::StaticOrder S; S.init(M, D, G, (int)blockIdx.x);
        pg8::EpiResBf16Stats E{U, XS, norm1_w, SSQ, D};
        pg8::gemm_phase<pg8::EpiResBf16Stats, pg8::StaticOrder, true, true>(lds + RING_OFF, g, S, E);
        if (BOTH(4)) GRID_BAR();
    }
    if (IN(6)) {
        pg8::Gemm g{U, W1_T, M, FF, D}; pg8::StaticOrder S; S.init(M, FF, G, (int)blockIdx.x);
        pg8::EpiBf16RowScaleRelu2 E{HB, FF, SSQ, 1.f / D, EPS};
        pg8::gemm_phase<pg8::EpiBf16RowScaleRelu2, pg8::StaticOrder, true, true>(lds + RING_OFF, g, S, E);
        if (BOTH(6)) GRID_BAR();
    }
    if (IN(7)) {
        pg8::Gemm g{HB, W2_T, M, D, FF}; pg8::StaticOrder S; S.init(M, D, G, (int)blockIdx.x);
        pg8::EpiResFromBf16 E{U, out, D};
        pg8::gemm_phase<pg8::EpiResFromBf16, pg8::StaticOrder, true, true>(lds + RING_OFF, g, S, E);
    }
#undef IN
#undef BOTH
}

extern "C" void kernel_launch(void* const* d_in, const int* in_sizes, int n_in, void* d_out, int out_size, void* d_ws, size_t ws_size, hipStream_t stream) {
    static int grid = 0;
    if (grid == 0) {
        if (n_in != 12 || in_sizes[0] != M * D || out_size != M * D || ws_size < WS_END) { fprintf(stderr, "kernel_launch: unexpected shapes (n_in %d, in0 %d, out %d, ws %zu); nothing launched\n", n_in, n_in > 0 ? in_sizes[0] : -1, out_size, ws_size); grid = -1; return; }
        int dev = 0, cus = 0, per_cu = 0;
        if (hipGetDevice(&dev) != hipSuccess || hipDeviceGetAttribute(&cus, hipDeviceAttributeMultiprocessorCount, dev) != hipSuccess) { grid = -1; return; }
        if (hipFuncSetAttribute((const void*)mk_fwd, hipFuncAttributeMaxDynamicSharedMemorySize, LDS_BYTES) != hipSuccess) { fprintf(stderr, "kernel_launch: hipFuncSetAttribute failed\n"); grid = -1; return; }
        if (hipOccupancyMaxActiveBlocksPerMultiprocessor(&per_cu, (const void*)mk_fwd, NWAVES * 64, LDS_BYTES) != hipSuccess || per_cu < 1)
            fprintf(stderr, "kernel_launch: note: occupancy query reports %d workgroups per CU\n", per_cu);
        (void)hipGetLastError();
        grid = cus;
    }
    if (grid < 0) return;
    if (hipMemsetAsync((char*)d_ws + WS_CTL, 0, CTL_ZERO_BYTES, stream) != hipSuccess) return;
    Args a{};
    for (int i = 0; i < 12; ++i) a.in[i] = (const float*)d_in[i];
    a.out = (float*)d_out; a.ws = (unsigned char*)d_ws;
    if (ONE_LAUNCH) { a.ph_lo = 0; a.ph_hi = N_PHASES; hipLaunchKernelGGL(mk_fwd, dim3(grid), dim3(NWAVES * 64), LDS_BYTES, stream, a); }
    else for (int p = 0; p < N_PHASES; ++p) { a.ph_lo = p; a.ph_hi = p + 1; hipLaunchKernelGGL(mk_fwd, dim3(grid), dim3(NWAVES * 64), LDS_BYTES, stream, a); }
    const hipError_t le = hipPeekAtLastError();
    if (le != hipSuccess) fprintf(stderr, "kernel_launch: launch failed: %s\n", hipGetErrorName(le));
}
```

```cpp
#include <hip/hip_runtime.h>
#include <cstdio>
#include <cstdint>
namespace pg8 {
#define PG8_LAS __attribute__((address_space(3)))
typedef unsigned short bf16_t;
typedef short bf16x8 __attribute__((ext_vector_type(8)));
typedef float f32x4 __attribute__((ext_vector_type(4)));
typedef unsigned u32x4 __attribute__((ext_vector_type(4)));
constexpr int BM = 256, BK = 64, HALF = 128, HTB = HALF * BK * 2  , STAGE_BYTES = 8 * HTB, NXCD = 8, WGM = 8;

__host__ __device__ __forceinline__ int lds_byte(int r, int c) { const int st = (r >> 4) * 2 + (c >> 5), rr = r & 15, cc = c & 31, ob = rr * 64 + cc * 2; return st * 1024 + (ob ^ (((ob >> 9) & 1) << 5)); }
__host__ __device__ __forceinline__ void stage_rc(int b, int& R, int& C) { const int st = b / 1024, sb = b % 1024, swz = sb ^ (((sb >> 9) & 1) << 5); R = (st >> 1) * 16 + swz / 64; C = (st & 1) * 32 + (swz % 64) / 2; }
__host__ __device__ __forceinline__ int perm32(int rho) { const int n = rho >> 4, i = rho & 15; return 8 * (i >> 2) + 4 * n + (i & 3); }

struct Unit { int pm, pn; };
struct Gemm { const bf16_t* A; const bf16_t* Bt; int M, N, K; };

struct StaticOrder {
    int nM, nN, nwg, G, c;
    __host__ __device__ void init(int M, int N, int G_, int c_) { nM = M / BM; nN = N / BM; nwg = nM * nN; G = G_; c = c_; }
    __host__ __device__ bool next(int i, Unit& u) const {
        const long L = (long)i * G + c; if (L >= nwg) return false;
        int wgid = (int)L; { const int q = nwg / NXCD, r = nwg % NXCD, xcd = wgid % NXCD, off = wgid / NXCD; wgid = (xcd < r ? xcd * (q + 1) : r * (q + 1) + (xcd - r) * q) + off; }
        const int nig = WGM * nN, gid = wgid / nig, fm = gid * WGM, gsz = (nM - fm) < WGM ? (nM - fm) : WGM;
        u.pm = fm + ((wgid % nig) % gsz); u.pn = (wgid % nig) / gsz; return true;
    }
    __device__ __forceinline__ void a_ready(const Unit&) const {}
    __device__ __forceinline__ void done(const Unit&) const {}
};

typedef float f32x2c __attribute__((ext_vector_type(2))); typedef __bf16 bf16x2c __attribute__((ext_vector_type(2)));
__device__ __forceinline__ unsigned cvt_pk_bf16(float lo, float hi) { const f32x2c v = {lo, hi}; const bf16x2c b = __builtin_convertvector(v, bf16x2c); return __builtin_bit_cast(unsigned, b); }

template <int ACT  > struct EpiBf16 {
    static constexpr bool PERM = true, AFTER_DRAIN = false;
    bf16_t* O; int ldc;
    __device__ __forceinline__ void operator()(const f32x4 (&acc)[2][2][4][2], const Unit& u, int wr, int wc, int fr, int fq) const {
        const int row0 = u.pm * BM + wr * 64 + fr; const int col0 = u.pn * BM + wc * 32 + 8 * fq;
#pragma unroll
        for (int ai = 0; ai < 2; ++ai)
#pragma unroll
            for (int m = 0; m < 4; ++m) { bf16_t* rowp = O + (size_t)(row0 + ai * HALF + m * 16) * ldc + col0;
#pragma unroll
                for (int bj = 0; bj < 2; ++bj) { f32x4 v0 = acc[ai][bj][m][0], v1 = acc[ai][bj][m][1];
                    if (ACT == 2) {
#pragma unroll
                        for (int e = 0; e < 4; ++e) { const float a = fmaxf(v0[e], 0.f), b = fmaxf(v1[e], 0.f); v0[e] = a * a; v1[e] = b * b; } }
                    u32x4 w; w.x = cvt_pk_bf16(v0[0], v0[1]); w.y = cvt_pk_bf16(v0[2], v0[3]); w.z = cvt_pk_bf16(v1[0], v1[1]); w.w = cvt_pk_bf16(v1[2], v1[3]);
                    __builtin_nontemporal_store(w, (u32x4*)(rowp + bj * HALF)); } }
    }
};

struct EpiProj {
    static constexpr bool PERM = true, AFTER_DRAIN = false;
    bf16_t* O; int ldc; bf16_t* R; int mrows;
    __device__ __forceinline__ void operator()(const f32x4 (&acc)[2][2][4][2], const Unit& u, int wr, int wc, int fr, int fq) const {
        const int row0 = u.pm * BM + wr * 64 + fr; const int col0 = (u.pn - 8) * BM + wc * 32 + 8 * fq; const bool hm = u.pn < 8;
#pragma unroll
        for (int ai = 0; ai < 2; ++ai)
#pragma unroll
            for (int m = 0; m < 4; ++m) { const int row = row0 + ai * HALF + m * 16;
#pragma unroll
                for (int bj = 0; bj < 2; ++bj) { const f32x4 v0 = acc[ai][bj][m][0], v1 = acc[ai][bj][m][1];
                    u32x4 w; w.x = cvt_pk_bf16(v0[0], v0[1]); w.y = cvt_pk_bf16(v0[2], v0[3]); w.z = cvt_pk_bf16(v1[0], v1[1]); w.w = cvt_pk_bf16(v1[2], v1[3]);
                    bf16_t* p = hm ? R + ((size_t)(u.pn * 2 + bj) * mrows + row) * 128 + wc * 32 + 8 * fq : O + (size_t)row * ldc + col0 + bj * HALF;
                    __builtin_nontemporal_store(w, (u32x4*)p); } }
    }
};

struct EpiResF32 {
    static constexpr bool PERM = true, AFTER_DRAIN = false;
    const float* base; float* out; int ldc;
    __device__ __forceinline__ void operator()(const f32x4 (&acc)[2][2][4][2], const Unit& u, int wr, int wc, int fr, int fq) const {
        const int col0 = u.pn * BM + wc * 32 + 8 * fq;
#pragma unroll
        for (int ai = 0; ai < 2; ++ai)
#pragma unroll
            for (int m = 0; m < 4; ++m) { const size_t off = (size_t)(u.pm * BM + ai * HALF + wr * 64 + m * 16 + fr) * ldc + col0;
#pragma unroll
                for (int bj = 0; bj < 2; ++bj)
#pragma unroll
                    for (int n = 0; n < 2; ++n) { const f32x4 bs = *(const f32x4*)(base + off + bj * HALF + n * 4); *(f32x4*)(out + off + bj * HALF + n * 4) = bs + acc[ai][bj][m][n]; }
                if (m & 1) asm volatile("" ::: "memory"); }
    }
};
struct EpiResF32Stats {
    static constexpr bool PERM = true, AFTER_DRAIN = false;
    const float* base; float* out; bf16_t* xn; const float* w; float* ss; int ldc;
    __device__ __forceinline__ void operator()(const f32x4 (&acc)[2][2][4][2], const Unit& u, int wr, int wc, int fr, int fq) const {
        const int col0 = u.pn * BM + wc * 32 + 8 * fq;
        f32x4 wv[2][2];
#pragma unroll
        for (int bj = 0; bj < 2; ++bj)
#pragma unroll
            for (int n = 0; n < 2; ++n) wv[bj][n] = *(const f32x4*)(w + col0 + bj * HALF + n * 4);
#pragma unroll
        for (int ai = 0; ai < 2; ++ai)
#pragma unroll
            for (int m = 0; m < 4; ++m) { const int row = u.pm * BM + ai * HALF + wr * 64 + m * 16 + fr; const size_t off = (size_t)row * ldc + col0; float s = 0.f;
#pragma unroll
                for (int bj = 0; bj < 2; ++bj) { f32x4 a[2];
#pragma unroll
                    for (int n = 0; n < 2; ++n) { const f32x4 h = *(const f32x4*)(base + off + bj * HALF + n * 4) + acc[ai][bj][m][n]; *(f32x4*)(out + off + bj * HALF + n * 4) = h;
                        s += (h[0] * h[0] + h[1] * h[1]) + (h[2] * h[2] + h[3] * h[3]); a[n] = h * wv[bj][n]; }
                    u32x4 o; o.x = cvt_pk_bf16(a[0][0], a[0][1]); o.y = cvt_pk_bf16(a[0][2], a[0][3]); o.z = cvt_pk_bf16(a[1][0], a[1][1]); o.w = cvt_pk_bf16(a[1][2], a[1][3]);
                    *(u32x4*)(xn + off + bj * HALF) = o; }
                s += __shfl_xor(s, 16); s += __shfl_xor(s, 32);
                if (fq == 0) __hip_atomic_fetch_add(ss + row, s, __ATOMIC_RELAXED, __HIP_MEMORY_SCOPE_AGENT);
                if (m & 1) asm volatile("" ::: "memory"); }
    }
};
struct EpiBf16RowScaleRelu2 {
    static constexpr bool PERM = true, AFTER_DRAIN = false;
    bf16_t* O; int ldc; const float* ss; float inv_n, eps;
    __device__ __forceinline__ void operator()(const f32x4 (&acc)[2][2][4][2], const Unit& u, int wr, int wc, int fr, int fq) const {
        const int row0 = u.pm * BM + wr * 64 + fr; const int col0 = u.pn * BM + wc * 32 + 8 * fq;
#pragma unroll
        for (int ai = 0; ai < 2; ++ai)
#pragma unroll
            for (int m = 0; m < 4; ++m) { const int row = row0 + ai * HALF + m * 16; bf16_t* rowp = O + (size_t)row * ldc + col0; const float ri = 1.f / sqrtf(ss[row] * inv_n + eps);
#pragma unroll
                for (int bj = 0; bj < 2; ++bj) { f32x4 v0 = acc[ai][bj][m][0], v1 = acc[ai][bj][m][1];
#pragma unroll
                    for (int e = 0; e < 4; ++e) { const float a = fmaxf(v0[e] * ri, 0.f), b = fmaxf(v1[e] * ri, 0.f); v0[e] = a * a; v1[e] = b * b; }
                    u32x4 w; w.x = cvt_pk_bf16(v0[0], v0[1]); w.y = cvt_pk_bf16(v0[2], v0[3]); w.z = cvt_pk_bf16(v1[0], v1[1]); w.w = cvt_pk_bf16(v1[2], v1[3]);
                    __builtin_nontemporal_store(w, (u32x4*)(rowp + bj * HALF)); } }
    }
};

struct EpiResBf16Stats {
    static constexpr bool PERM = true, AFTER_DRAIN = false;
    bf16_t* xn; const float* xs; const float* w1; float* ss; int ldc;
    __device__ __forceinline__ void operator()(const f32x4 (&acc)[2][2][4][2], const Unit& u, int wr, int wc, int fr, int fq) const {
        const int col0 = u.pn * BM + wc * 32 + 8 * fq;
        f32x4 iw[2][2];
#pragma unroll
        for (int bj = 0; bj < 2; ++bj)
#pragma unroll
            for (int n = 0; n < 2; ++n) { const f32x4 g = *(const f32x4*)(w1 + col0 + bj * HALF + n * 4); iw[bj][n] = (f32x4){1.f / g[0], 1.f / g[1], 1.f / g[2], 1.f / g[3]}; }
#pragma unroll
        for (int ai = 0; ai < 2; ++ai)
#pragma unroll
            for (int m = 0; m < 4; ++m) { const int row = u.pm * BM + ai * HALF + wr * 64 + m * 16 + fr; const size_t off = (size_t)row * ldc + col0; float s = 0.f; const float xr = xs[row];
#pragma unroll
                for (int bj = 0; bj < 2; ++bj) { const u32x4 b = *(const u32x4*)(xn + off + bj * HALF); f32x4 h[2];
                    h[0] = (f32x4){__uint_as_float(b.x << 16), __uint_as_float(b.x & 0xffff0000u), __uint_as_float(b.y << 16), __uint_as_float(b.y & 0xffff0000u)} * iw[bj][0] * xr + acc[ai][bj][m][0];
                    h[1] = (f32x4){__uint_as_float(b.z << 16), __uint_as_float(b.z & 0xffff0000u), __uint_as_float(b.w << 16), __uint_as_float(b.w & 0xffff0000u)} * iw[bj][1] * xr + acc[ai][bj][m][1];
#pragma unroll
                    for (int n = 0; n < 2; ++n) s += (h[n][0] * h[n][0] + h[n][1] * h[n][1]) + (h[n][2] * h[n][2] + h[n][3] * h[n][3]);
                    u32x4 o; o.x = cvt_pk_bf16(h[0][0], h[0][1]); o.y = cvt_pk_bf16(h[0][2], h[0][3]); o.z = cvt_pk_bf16(h[1][0], h[1][1]); o.w = cvt_pk_bf16(h[1][2], h[1][3]);
                    *(u32x4*)(xn + off + bj * HALF) = o; }
                s += __shfl_xor(s, 16); s += __shfl_xor(s, 32);
                if (fq == 0) __hip_atomic_fetch_add(ss + row, s, __ATOMIC_RELAXED, __HIP_MEMORY_SCOPE_AGENT);
                if (m & 1) asm volatile("" ::: "memory"); }
    }
};
struct EpiResFromBf16 {
    static constexpr bool PERM = true, AFTER_DRAIN = false;
    const bf16_t* base; float* out; int ldc;
    __device__ __forceinline__ void operator()(const f32x4 (&acc)[2][2][4][2], const Unit& u, int wr, int wc, int fr, int fq) const {
        const int col0 = u.pn * BM + wc * 32 + 8 * fq;
#pragma unroll
        for (int ai = 0; ai < 2; ++ai)
#pragma unroll
            for (int m = 0; m < 4; ++m) { const size_t off = (size_t)(u.pm * BM + ai * HALF + wr * 64 + m * 16 + fr) * ldc + col0;
#pragma unroll
                for (int bj = 0; bj < 2; ++bj) { const u32x4 b = *(const u32x4*)(base + off + bj * HALF);
                    const f32x4 b0 = (f32x4){__uint_as_float(b.x << 16), __uint_as_float(b.x & 0xffff0000u), __uint_as_float(b.y << 16), __uint_as_float(b.y & 0xffff0000u)};
                    const f32x4 b1 = (f32x4){__uint_as_float(b.z << 16), __uint_as_float(b.z & 0xffff0000u), __uint_as_float(b.w << 16), __uint_as_float(b.w & 0xffff0000u)};
                    __builtin_nontemporal_store(b0 + acc[ai][bj][m][0], (f32x4*)(out + off + bj * HALF)); __builtin_nontemporal_store(b1 + acc[ai][bj][m][1], (f32x4*)(out + off + bj * HALF + 4)); }
                if (m & 1) asm volatile("" ::: "memory"); }
    }
};
template <class Epi, class Sched, bool ALIGN_EPI = false, bool SP2 = false>
__device__ __forceinline__ void gemm_phase(PG8_LAS unsigned char* lds, const Gemm g, const Sched& S, const Epi& E) {
    const int tid = threadIdx.x, wid = __builtin_amdgcn_readfirstlane(tid >> 6), lane = tid & 63, wr = wid >> 2, wc = wid & 3, fr = lane & 15, fq = lane >> 4;
    const int K = g.K, nt = K / BK;
    unsigned voffA[2], voffB[2];
#pragma unroll
    for (int i = 0; i < 2; ++i) { int R, C; stage_rc(tid * 16 + i * 8192, R, C); const int Rb = Epi::PERM ? ((R & ~31) + perm32(R & 31)) : R;
        voffA[i] = (unsigned)(R * K + C) * 2u; voffB[i] = (unsigned)(Rb * K + C) * 2u; }
    const size_t kstep = (size_t)(BK * 2);
    const size_t hstep = (size_t)HALF * K * 2;
    const size_t tstep = 2 * hstep;
    const unsigned ldsw = (unsigned)wid * 1024u;
    const int aoff = lds_byte(wr * 64 + fr, fq * 8), boff = lds_byte(wc * 32 + fr, fq * 8);
#define PG8_SA(b, h) (((b) * 2 + (h)) * HTB)
#define PG8_SB(b, h) ((4 + (b) * 2 + (h)) * HTB)
#define PG8_STAGE(bufoff, gbase, voff) do { _Pragma("unroll") for (int _i = 0; _i < 2; ++_i) \
        __builtin_amdgcn_global_load_lds((const unsigned*)((const char*)(gbase) + (voff)[_i]), (PG8_LAS unsigned*)(lds + (bufoff) + ldsw + _i * 8192), 16, 0, 0); } while (0)
#define PG8_LDA(dst, b, h) do { _Pragma("unroll") for (int m = 0; m < 4; ++m) _Pragma("unroll") for (int k = 0; k < 2; ++k) dst[m][k] = *(const PG8_LAS bf16x8*)(lds + PG8_SA(b, h) + aoff + m * 2048 + k * 1024); } while (0)
#define PG8_LDB(dst, b, h) do { _Pragma("unroll") for (int n = 0; n < 2; ++n) _Pragma("unroll") for (int k = 0; k < 2; ++k) dst[n][k] = *(const PG8_LAS bf16x8*)(lds + PG8_SB(b, h) + boff + n * 2048 + k * 1024); } while (0)
#define PG8_MMA(ai, bj, At, Bt) do { __builtin_amdgcn_s_setprio(1); _Pragma("unroll") for (int m = 0; m < 4; ++m) _Pragma("unroll") for (int n = 0; n < 2; ++n) _Pragma("unroll") for (int k = 0; k < 2; ++k) \
        acc[ai][bj][m][n] = __builtin_amdgcn_mfma_f32_16x16x32_bf16(Bt[n][k], At[m][k], acc[ai][bj][m][n], 0, 0, 0); __builtin_amdgcn_s_setprio(0); } while (0)
#define PG8_WAIT_V(n) asm volatile("s_waitcnt vmcnt(" #n ")" ::: "memory")
#define PG8_WAIT_L(n) asm volatile("s_waitcnt lgkmcnt(" #n ")" ::: "memory")
#define PG8_BAR __builtin_amdgcn_s_barrier()
#define PG8_SCHED __builtin_amdgcn_sched_barrier(0)
    Unit cur, nxt; int ui = 0;
    if (!S.next(0, cur)) return;
    f32x4 acc[2][2][4][2];
#pragma unroll
    for (int a = 0; a < 2; ++a)
#pragma unroll
        for (int b = 0; b < 2; ++b)
#pragma unroll
            for (int m = 0; m < 4; ++m)
#pragma unroll
                for (int n = 0; n < 2; ++n) acc[a][b][m][n] = (f32x4){0.f, 0.f, 0.f, 0.f};
    bf16x8 At[4][2], B0[2][2], B1[2][2];
    const char* cA = (const char*)g.A + (size_t)cur.pm * tstep; const char* cB = (const char*)g.Bt + (size_t)cur.pn * tstep;
    S.a_ready(cur);
    if constexpr (SP2) {
        PG8_STAGE(PG8_SB(0, 0), cB, voffB); PG8_STAGE(PG8_SB(0, 1), cB + hstep, voffB); PG8_STAGE(PG8_SA(0, 0), cA, voffA); PG8_STAGE(PG8_SA(0, 1), cA + hstep, voffA);
        if (wr == 1) PG8_BAR;
        PG8_WAIT_V(2); PG8_BAR;
        PG8_STAGE(PG8_SB(1, 0), cB + kstep, voffB); PG8_STAGE(PG8_SA(1, 0), cA + kstep, voffA); PG8_STAGE(PG8_SB(1, 1), cB + hstep + kstep, voffB);
        PG8_WAIT_V(6); PG8_BAR;
    } else {
        PG8_STAGE(PG8_SB(0, 0), cB, voffB); PG8_STAGE(PG8_SA(0, 0), cA, voffA); PG8_STAGE(PG8_SB(0, 1), cB + hstep, voffB); PG8_STAGE(PG8_SA(0, 1), cA + hstep, voffA);
        if (wr == 1) PG8_BAR;
        PG8_WAIT_V(4); PG8_BAR;
        PG8_STAGE(PG8_SB(1, 0), cB + kstep, voffB); PG8_STAGE(PG8_SA(1, 0), cA + kstep, voffA); PG8_STAGE(PG8_SB(1, 1), cB + hstep + kstep, voffB);
        PG8_WAIT_V(6); PG8_BAR;
    }
    for (;;) {
        const bool has_next = S.next(ui + 1, nxt);
        const char* nA = has_next ? (const char*)g.A + (size_t)nxt.pm * tstep : cA; const char* nB = has_next ? (const char*)g.Bt + (size_t)nxt.pn * tstep : cB;
        for (int t = 0; t < nt; t += 2) {
            const bool last = (t == nt - 2);
            const char* a1 = cA + (size_t)(t + 1) * kstep;
            const char* a2 = last ? nA : cA + (size_t)(t + 2) * kstep; const char* b2 = last ? nB : cB + (size_t)(t + 2) * kstep;
            const char* a3 = a2 + kstep; const char* b3 = b2 + kstep;
            if (last && has_next) S.a_ready(nxt);
            if constexpr (SP2) {
            PG8_LDB(B0, 0, 0); PG8_LDB(B1, 0, 1); PG8_SCHED; PG8_LDA(At, 0, 0); PG8_STAGE(PG8_SA(1, 1), a1 + hstep, voffA);
            PG8_WAIT_V(8); PG8_WAIT_L(0); PG8_BAR; PG8_MMA(0, 0, At, B0); PG8_MMA(0, 1, At, B1); PG8_BAR; PG8_SCHED;
            PG8_LDA(At, 0, 1); PG8_STAGE(PG8_SB(0, 0), b2, voffB); PG8_STAGE(PG8_SB(0, 1), b2 + hstep, voffB); PG8_STAGE(PG8_SA(0, 0), a2, voffA);
            PG8_WAIT_V(8); PG8_WAIT_L(0); PG8_BAR; PG8_MMA(1, 0, At, B0); PG8_MMA(1, 1, At, B1); PG8_BAR; PG8_SCHED;
            PG8_LDB(B0, 1, 0); PG8_LDB(B1, 1, 1); PG8_SCHED; PG8_LDA(At, 1, 0); PG8_STAGE(PG8_SA(0, 1), a2 + hstep, voffA);
            PG8_WAIT_V(8); PG8_WAIT_L(0); PG8_BAR; PG8_MMA(0, 0, At, B0); PG8_MMA(0, 1, At, B1); PG8_BAR; PG8_SCHED;
            PG8_LDA(At, 1, 1); PG8_STAGE(PG8_SB(1, 0), b3, voffB); PG8_STAGE(PG8_SB(1, 1), b3 + hstep, voffB); PG8_STAGE(PG8_SA(1, 0), a3, voffA);
            PG8_WAIT_V(8); PG8_WAIT_L(0); PG8_BAR; PG8_MMA(1, 0, At, B0); PG8_MMA(1, 1, At, B1); PG8_BAR; PG8_SCHED;
            } else {
            PG8_LDB(B0, 0, 0); PG8_SCHED; PG8_LDA(At, 0, 0); PG8_STAGE(PG8_SA(1, 1), a1 + hstep, voffA);
            PG8_WAIT_L(8); PG8_BAR; PG8_WAIT_L(0); PG8_MMA(0, 0, At, B0); PG8_BAR; PG8_SCHED;
            PG8_LDB(B1, 0, 1); PG8_STAGE(PG8_SB(0, 0), b2, voffB);
            PG8_BAR; PG8_WAIT_L(0); PG8_MMA(0, 1, At, B1); PG8_BAR;
            PG8_LDA(At, 0, 1); PG8_STAGE(PG8_SA(0, 0), a2, voffA);
            PG8_BAR; PG8_WAIT_L(0); PG8_MMA(1, 0, At, B0); PG8_BAR; PG8_SCHED;
            PG8_STAGE(PG8_SB(0, 1), b2 + hstep, voffB);
            PG8_WAIT_V(6); PG8_BAR; PG8_MMA(1, 1, At, B1); PG8_BAR;
            PG8_LDB(B0, 1, 0); PG8_SCHED; PG8_LDA(At, 1, 0); PG8_STAGE(PG8_SA(0, 1), a2 + hstep, voffA);
            PG8_WAIT_L(8); PG8_BAR; PG8_WAIT_L(0); PG8_MMA(0, 0, At, B0); PG8_BAR; PG8_SCHED;
            PG8_LDB(B1, 1, 1); PG8_STAGE(PG8_SB(1, 0), b3, voffB);
            PG8_BAR; PG8_WAIT_L(0); PG8_MMA(0, 1, At, B1); PG8_BAR;
            PG8_LDA(At, 1, 1); PG8_STAGE(PG8_SA(1, 0), a3, voffA);
            PG8_BAR; PG8_WAIT_L(0); PG8_MMA(1, 0, At, B0); PG8_BAR; PG8_SCHED;
            PG8_STAGE(PG8_SB(1, 1), b3 + hstep, voffB);
            PG8_WAIT_V(6); PG8_BAR; PG8_MMA(1, 1, At, B1); PG8_BAR;
            }
        }
        if constexpr (ALIGN_EPI) { if (wr == 0) PG8_BAR; }
        if constexpr (!Epi::AFTER_DRAIN) { E(acc, cur, wr, wc, fr, fq); S.done(cur); }
        if (!has_next) break;
#pragma unroll
        for (int a = 0; a < 2; ++a)
#pragma unroll
            for (int b = 0; b < 2; ++b)
#pragma unroll
                for (int m = 0; m < 4; ++m)
#pragma unroll
                    for (int n = 0; n < 2; ++n) acc[a][b][m][n] = (f32x4){0.f, 0.f, 0.f, 0.f};
        cur = nxt; cA = nA; cB = nB; ++ui;
        if constexpr (ALIGN_EPI) { if (wr == 1) PG8_BAR; }
    }
    PG8_WAIT_V(0);
    if constexpr (!ALIGN_EPI) { if (wr == 0) PG8_BAR; }
    PG8_BAR;
    if constexpr (Epi::AFTER_DRAIN) { E.fused(acc, cur, wr, wc, fr, fq, lds, wid, lane); S.done(cur); }
#undef PG8_SA
#undef PG8_SB
#undef PG8_STAGE
#undef PG8_LDA
#undef PG8_LDB
#undef PG8_MMA
#undef PG8_WAIT_V
#undef PG8_WAIT_L
#undef PG8_BAR
#undef PG8_SCHED
}
}
constexpr int NWAVES = 8;
#ifndef MK_N_LAUNCHES
#define MK_N_LAUNCHES 1
#endif
constexpr int N_PHASES = 8;
constexpr bool ONE_LAUNCH = (MK_N_LAUNCHES == 1);

constexpr int BATCH = 16, SEQ = 4096, D = 1024, NMETA = 16, TK = SEQ + NMETA, FF = 4096;
constexpr int M = BATCH * SEQ;
constexpr int DIN = 3272, DINP = 3328;
constexpr int C_RQ = 0, C_RK = 512, C_RV = 1024, C_RG = 1536, C_DQ = 2048, C_DK = 2560, C_DV = 2624, C_IQ = 2688, C_IK = 3200, C_IW = 3264;
constexpr int DP2 = 1280;
constexpr int C2_DQ = C_DQ - 2048, C2_DK = C_DK - 2048, C2_DV = C_DV - 2048, C2_IQ = C_IQ - 2048, C2_IK = C_IK - 2048, C2_IW = C_IW - 2048;
constexpr float EPS = 1e-6f;
constexpr int KROWS = 4160;

constexpr size_t MiB = 1u << 20;
constexpr size_t WS_CTL = 0, CTL_ZERO_BYTES = 1 * MiB;
constexpr size_t WS_WIN = 2 * MiB;
constexpr size_t WS_WOUT = 9 * MiB;
constexpr size_t WS_W1 = 11 * MiB;
constexpr size_t WS_W2 = 19 * MiB;
constexpr size_t WS_ROPE = 27 * MiB;
constexpr size_t WS_PMETA = 30 * MiB;
constexpr size_t WS_KC = 32 * MiB;
constexpr size_t WS_IKC = 41 * MiB;
constexpr size_t WS_VT = 50 * MiB;
constexpr size_t WS_U = 64 * MiB;
constexpr size_t WS_PROJ = 192 * MiB;
constexpr size_t WS_RET = 352 * MiB;
constexpr size_t WS_QN = 608 * MiB;
constexpr size_t WS_SPT = 672 * MiB;
constexpr size_t WS_Y = 736 * MiB;
constexpr size_t WS_H = 192 * MiB;
constexpr size_t WS_TQ2 = 864 * MiB;
constexpr size_t WS_LIST = 864 * MiB;
constexpr size_t WS_END = 1024 * MiB;
static_assert(WS_H + (size_t)M * FF * 2 <= WS_Y && WS_Y + (size_t)M * D * 2 <= WS_END, "d_ws map");
constexpr int CW_TMO = 0, CW_CODE = 1;
constexpr int CW_BAR = 4096;

constexpr int RING_OFF = 0, RING_BYTES = 131072;
constexpr int LDS_BYTES = 163840;
constexpr int LDSCTL_OFF = LDS_BYTES - 512, MISC_OFF = LDSCTL_OFF + 320;
static_assert(MISC_OFF + 128 <= LDS_BYTES, "LDS map");
#define GAS __attribute__((address_space(1)))
#define LAS __attribute__((address_space(3)))
typedef unsigned short bf16;
typedef unsigned v4u __attribute__((ext_vector_type(4)));
typedef float f32x4 __attribute__((ext_vector_type(4)));
typedef short bf16x8 __attribute__((ext_vector_type(8)));
typedef GAS unsigned gu32;
typedef GAS unsigned long long gu64;
#define RLX_AGENT __ATOMIC_RELAXED, __HIP_MEMORY_SCOPE_AGENT
#define LDS_WAIT() asm volatile("s_waitcnt lgkmcnt(0)" ::: "memory")
#define VM_WAIT() asm volatile("s_waitcnt vmcnt(0)" ::: "memory")
__device__ __forceinline__ unsigned long long rt() { return __builtin_amdgcn_s_memrealtime(); }
__device__ __forceinline__ unsigned f2bf(float f) { unsigned u = __builtin_bit_cast(unsigned, f); return (u + 0x7fffu + ((u >> 16) & 1u)) >> 16; }
__device__ __forceinline__ unsigned pk2(float lo, float hi) { return f2bf(lo) | (f2bf(hi) << 16); }

#define XB_TMO      128
#define XB_XCNT(j)  (256  + 64 * (j))
#define XB_XSUB(j)  (1280 + 64 * (j))
#define XB_XGEN(j)  (2304 + 64 * (j))
#define XB_TOP      3328
#define XB_TOPGEN   3392
#define XCD_BAR_WORDS 3456
#define XB_SPIN_CAP (1u << 22)

__device__ __forceinline__ unsigned xb_ld(unsigned* p)              { return __hip_atomic_load(p, __ATOMIC_RELAXED, __HIP_MEMORY_SCOPE_AGENT); }
__device__ __forceinline__ unsigned xb_add(unsigned* p, unsigned v) { return __hip_atomic_fetch_add(p, v, __ATOMIC_RELAXED, __HIP_MEMORY_SCOPE_AGENT); }
__device__ __forceinline__ unsigned xb_xcc_id() { return (unsigned)__builtin_amdgcn_s_getreg((3 << 11) | 20) & 0xFu; }
#define XB_SPIN(cond, bar) do { unsigned _sp = 0; while (cond) { __builtin_amdgcn_s_sleep(1); \
    if ((++_sp & 255u) == 0u) { if (xb_ld(&(bar)[XB_TMO])) break; if (_sp > XB_SPIN_CAP) { atomicAdd(&(bar)[XB_TMO], 1u); break; } } } } while (0)

struct XcdBarrier {
    unsigned* bar; unsigned x;
    volatile LAS unsigned* st;
};

__device__ __forceinline__ XcdBarrier xcd_barrier_post(unsigned* bar, volatile LAS unsigned* st) {
    XcdBarrier b; b.bar = bar; b.x = xb_xcc_id(); b.st = st;
    if (threadIdx.x == 0) (void)xb_add(&bar[XB_XCNT(b.x)], 1u);
    return b;
}
__device__ __forceinline__ void xcd_barrier_complete(unsigned* bar, unsigned x, unsigned& nloc, unsigned& nx) {
    const unsigned G = gridDim.x * gridDim.y * gridDim.z;
    unsigned sum, cnt, mine, sp = 0u;
    for (;;) {
        sum = 0u; cnt = 0u; mine = 0u;
#pragma unroll
        for (unsigned j = 0; j < 16; ++j) { const unsigned c = xb_ld(&bar[XB_XCNT(j)]); sum += c; cnt += (c > 0u) ? 1u : 0u; mine = (j == x) ? c : mine; }
        if (sum == G) break;
        __builtin_amdgcn_s_sleep(1);
        if ((++sp & 255u) == 0u) { if (xb_ld(&bar[XB_TMO])) break; if (sp > XB_SPIN_CAP) { atomicAdd(&bar[XB_TMO], 1u); break; } }
    }
    nloc = mine > 0u ? mine : 1u; nx = cnt > 0u ? cnt : 1u;
}

__device__ __forceinline__ void xcd_barrier(const XcdBarrier& b) {
    asm volatile("s_waitcnt vmcnt(0)" ::: "memory");
    __syncthreads();
    if (threadIdx.x == 0) {
        unsigned* bar = b.bar;
        __builtin_amdgcn_s_waitcnt(0);
        unsigned nloc = b.st[0], nx = b.st[1];
        if (nloc == 0u) { xcd_barrier_complete(bar, b.x, nloc, nx); b.st[0] = nloc; b.st[1] = nx; }
        const unsigned old = xb_add(&bar[XB_XSUB(b.x)], 1u);
        const unsigned gen = old / nloc;
        if (old + 1u == (gen + 1u) * nloc) {
            __builtin_amdgcn_fence(__ATOMIC_RELEASE, "agent");
            asm volatile("s_waitcnt vmcnt(0)" ::: "memory");
            const unsigned og = xb_add(&bar[XB_TOP], 1u);
            const unsigned tg = og / nx;
            if (og + 1u == (tg + 1u) * nx) xb_add(&bar[XB_TOPGEN], 1u);
            else XB_SPIN(xb_ld(&bar[XB_TOPGEN]) == tg, bar);
            __builtin_amdgcn_fence(__ATOMIC_ACQUIRE, "agent");
            xb_add(&bar[XB_XGEN(b.x)], 1u);
            asm volatile("s_waitcnt vmcnt(0)" ::: "memory");
        } else {
            XB_SPIN(xb_ld(&bar[XB_XGEN(b.x)]) == gen, bar);
            __builtin_amdgcn_fence(__ATOMIC_ACQUIRE, "agent");
            asm volatile("s_waitcnt vmcnt(0)" ::: "memory");
        }
    }
    __syncthreads();
}

typedef short v4i16_t __attribute__((ext_vector_type(4)));
typedef float f32x2v __attribute__((ext_vector_type(2)));
typedef unsigned u32x2v __attribute__((ext_vector_type(2)));
#define MFMA16(a, b, c) __builtin_amdgcn_mfma_f32_16x16x32_bf16((a), (b), (c), 0, 0, 0)
__device__ __forceinline__ float bf2f(unsigned short u) { return __uint_as_float((unsigned)u << 16); }
__device__ __forceinline__ bf16x8 frag_n(const LAS unsigned char* img, int stride, int rowsel, int k0, int lane) {
    return *(const LAS bf16x8*)(img + rowsel * stride + (k0 + 8 * (lane >> 4)) * 2);
}
__device__ __forceinline__ bf16x8 frag_t(const LAS unsigned char* img, int stride, int row0, int k0, int lane) {
    const int g = lane >> 4, q = (lane >> 2) & 3, p = lane & 3;
    const LAS unsigned char* a = img + (k0 + 8 * g + q) * stride + (row0 + 4 * p) * 2;
    const v4i16_t lo = __builtin_amdgcn_ds_read_tr16_b64_v4i16((LAS v4i16_t*)a);
    const v4i16_t hi = __builtin_amdgcn_ds_read_tr16_b64_v4i16((LAS v4i16_t*)(a + 4 * stride));
    return (bf16x8){lo[0], lo[1], lo[2], lo[3], hi[0], hi[1], hi[2], hi[3]};
}
__device__ __forceinline__ unsigned pkbf(float lo, float hi) { return pg8::cvt_pk_bf16(lo, hi); }
#define TR_RD "ds_read_b64_tr_b16 "
__device__ __forceinline__ bf16x8 tr_pack(u32x2v lo, u32x2v hi) { const v4u w = (v4u){lo[0], lo[1], hi[0], hi[1]}; return __builtin_bit_cast(bf16x8, w); }

constexpr int IMG_STRIDE = 288;
constexpr float RET_KSCALE = 0.08838834764831845f;

__device__ __forceinline__ void rot8(const v4u a, const v4u b, const f32x4 (&cs)[4], float sc, v4u& o1, v4u& o2) {
    float x1[8], x2[8], c[8], s[8];
#pragma unroll
    for (int i = 0; i < 4; ++i) { x1[2 * i] = __uint_as_float(a[i] << 16); x1[2 * i + 1] = __uint_as_float(a[i] & 0xffff0000u); x2[2 * i] = __uint_as_float(b[i] << 16); x2[2 * i + 1] = __uint_as_float(b[i] & 0xffff0000u);
        c[2 * i] = cs[i][0]; s[2 * i] = cs[i][1]; c[2 * i + 1] = cs[i][2]; s[2 * i + 1] = cs[i][3]; }
    float r1[8], r2[8];
#pragma unroll
    for (int i = 0; i < 8; ++i) { r1[i] = (x1[i] * c[i] - x2[i] * s[i]) * sc; r2[i] = (x1[i] * s[i] + x2[i] * c[i]) * sc; }
#pragma unroll
    for (int i = 0; i < 4; ++i) { o1[i] = pkbf(r1[2 * i], r1[2 * i + 1]); o2[i] = pkbf(r2[2 * i], r2[2 * i + 1]); }
}
#define DSA_OPAQUE(x) asm volatile("" : "+v"(x))
constexpr int DSA_CAP = 64;
constexpr int DSA_MSTR = 132;
constexpr int L_HIST = 0, L_MASK = 65536, L_QPAR = L_MASK + 128 * DSA_MSTR * 4, L_CCNT = L_QPAR + 128 * 16, L_BIAS = L_CCNT + 512, L_STAGE = L_BIAS + 8 * 144 * 4, L_DSA_END = L_STAGE + 2 * 8192;
static_assert(L_DSA_END <= LDSCTL_OFF, "DSA LDS map");
constexpr float LOG2E = 1.4426950408889634f;

constexpr int DSA_NB = 128;
#define DSA_SCORE_BODY \
        f32x4 acc = MFMA16(a0, cq[0], ((f32x4){0.f, 0.f, 0.f, 0.f})); acc = MFMA16(a1, cq[1], acc); \
        _Pragma("unroll") for (int h = 0; h < 8; ++h) { \
            f32x4 s = MFMA16(a0, iq[h][0], ((f32x4){0.f, 0.f, 0.f, 0.f})); s = MFMA16(a1, iq[h][1], s); \
            _Pragma("unroll") for (int r = 0; r < 4; ++r) acc[r] = __builtin_fmaf(wh[h], __builtin_fabsf(s[r]), acc[r]); } \
        sc[u] = acc;
__device__ __forceinline__ void idx_tile(const bf16* ikb, int kt, const bf16x8 (&iq)[8][2], const bf16x8 (&cq)[2], const float (&wh)[8], int lane, f32x4 (&sc)[2]) {
    const int i = lane & 15, g = lane >> 4;
#pragma unroll
    for (int u = 0; u < 2; ++u) {
        const bf16* rp = ikb + (size_t)(32 * kt + 8 * (i >> 2) + 4 * u + (i & 3)) * 64 + 8 * g;
        const bf16x8 a0 = *(const GAS bf16x8*)rp, a1 = *(const GAS bf16x8*)(rp + 32);
        DSA_SCORE_BODY
    }
}
__device__ __forceinline__ void idx_tile_lds(const LAS unsigned char* tb, const bf16x8 (&iq)[8][2], const bf16x8 (&cq)[2], const float (&wh)[8], int lane, f32x4 (&sc)[2]) {
#pragma unroll
    for (int u = 0; u < 2; ++u) {
        const bf16x8 a0 = *(const LAS bf16x8*)(tb + (u * 2 + 0) * 1024 + lane * 16), a1 = *(const LAS bf16x8*)(tb + (u * 2 + 1) * 1024 + lane * 16);
        DSA_SCORE_BODY
    }
}
__device__ __forceinline__ float bin_t(float s, float binc, float invw) { return __builtin_fmaf(s, invw, binc); }
__device__ __forceinline__ int bin_of_t(float t) { return (int)__builtin_amdgcn_fmed3f(t, 0.f, (float)(DSA_NB - 1)); }

__device__ __forceinline__ f32x4 idx_sub_lds2(const LAS unsigned char* tb, int u, const bf16x8 (&iq)[8][2], const bf16x8 (&cq)[2], const float (&wh)[8], int lane) {
    const bf16x8 a0 = *(const LAS bf16x8*)(tb + (u * 2 + 0) * 1024 + lane * 16), a1 = *(const LAS bf16x8*)(tb + (u * 2 + 1) * 1024 + lane * 16);
    f32x4 s[9];
#pragma unroll
    for (int h = 0; h < 8; ++h) s[h] = MFMA16(a0, iq[h][0], ((f32x4){0.f, 0.f, 0.f, 0.f}));
    s[8] = MFMA16(a0, cq[0], ((f32x4){0.f, 0.f, 0.f, 0.f}));
#pragma unroll
    for (int h = 0; h < 8; ++h) s[h] = MFMA16(a1, iq[h][1], s[h]);
    s[8] = MFMA16(a1, cq[1], s[8]);
    f32x4 acc = s[8];
#pragma unroll
    for (int h = 0; h < 8; ++h)
#pragma unroll
        for (int r = 0; r < 4; ++r) acc[r] = __builtin_fmaf(wh[h], __builtin_fabsf(s[h][r]), acc[r]);
    __builtin_amdgcn_sched_group_barrier(0x100, 2, 0);
    __builtin_amdgcn_sched_group_barrier(0x008, 18, 0);
    __builtin_amdgcn_sched_group_barrier(0x002, 32, 0);
    return acc;
}
struct IdxAcc { f32x4 s[9]; };
__device__ __forceinline__ IdxAcc idx_mfma_group(const LAS unsigned char* tb, int sub, const bf16x8 (&iq)[8][2], const bf16x8 (&cq)[2], int lane) {
    const LAS unsigned char* ab = tb + (sub >> 1) * 4096 + (sub & 1) * 2048 + lane * 16;
    const bf16x8 a0 = *(const LAS bf16x8*)ab, a1 = *(const LAS bf16x8*)(ab + 1024);
    IdxAcc r;
#pragma unroll
    for (int h = 0; h < 8; ++h) r.s[h] = MFMA16(a0, iq[h][0], ((f32x4){0.f, 0.f, 0.f, 0.f}));
    r.s[8] = MFMA16(a0, cq[0], ((f32x4){0.f, 0.f, 0.f, 0.f}));
#pragma unroll
    for (int h = 0; h < 8; ++h) r.s[h] = MFMA16(a1, iq[h][1], r.s[h]);
    r.s[8] = MFMA16(a1, cq[1], r.s[8]);
    return r;
}
__device__ __forceinline__ f32x4 idx_combine(const IdxAcc& a, const float (&wh)[8]) {
    f32x4 acc = a.s[8];
#pragma unroll
    for (int h = 0; h < 8; ++h)
#pragma unroll
        for (int r = 0; r < 4; ++r) acc[r] = __builtin_fmaf(wh[h], __builtin_fabsf(a.s[h][r]), acc[r]);
    return acc;
}
#define DSA_DMA_K(base, step, buf) __builtin_amdgcn_global_load_lds((const unsigned*)((base) + (size_t)(64 * (step) + dk_row) * 64 + dk_col), (LAS unsigned*)((buf) + wave * 1024), 16, 0, 0)
#define DSA_WAITBAR(N) asm volatile("s_waitcnt vmcnt(" #N ") lgkmcnt(0)\n\ts_barrier" ::: "memory")
#define DSA_LDS_ADDR(p) ((unsigned)(unsigned long long)(p))
#define DSA_PB1(i) (lds + L_MASK + ((i) & 3) * 8192)
#define DSA_PB2(i) (lds + (((i) & 2) ? L_STAGE : 49152) + ((i) & 1) * 8192)
#define DSA_PB3(i) (lds + L_HIST + ((i) & 3) * 16384)
#define DSA_DMA_V(base, step, buf) __builtin_amdgcn_global_load_lds((const unsigned*)((base) + (size_t)dv_row * KROWS + 64 * (step) + dv_col), (LAS unsigned*)((buf) + 8192 + wave * 1024), 16, 0, 0)

template <int NH>
__device__ __forceinline__ void dsa_sweep(LAS unsigned char* lds, int h0, const bf16* kcb, const bf16* vtb, const bf16* qrow, const float* qgain, bf16* yrow, int ns, int p, int pmin, int qloc, int wave, int lane) {
    DSA_OPAQUE(lane);
    const int ql = lane & 15, g4 = lane >> 4;
    const int dk_row = 32 * (wave >> 2) + 8 * (ql >> 2) + 4 * ((wave >> 1) & 1) + (ql & 3), dk_col = 32 * (wave & 1) + 8 * g4;
    const int dv_row = 16 * (wave & 3) + ql, dv_col = 32 * (wave >> 2) + 8 * g4;
    const LAS unsigned* MASK = (const LAS unsigned*)(lds + L_MASK); const LAS float* BIAS = (const LAS float*)(lds + L_BIAS);
    bf16x8 qf[NH][2];
#pragma unroll 1
    for (int pass_ = 0; pass_ < 1; ++pass_) {
#pragma unroll
      for (int hh = 0; hh < NH; ++hh) { v4u qv[2]; float ss = 0.f;
#pragma unroll
          for (int sx = 0; sx < 2; ++sx) { qv[sx] = *(const GAS v4u*)(qrow + 64 * (h0 + hh) + 32 * sx + 8 * g4);
#pragma unroll
              for (int e = 0; e < 4; ++e) { const float a = __uint_as_float(qv[sx][e] << 16), c = __uint_as_float(qv[sx][e] & 0xffff0000u); ss += a * a + c * c; } }
          ss += __shfl_xor(ss, 16); ss += __shfl_xor(ss, 32);
          const float scq = (1.f / sqrtf(ss * (1.f / 64.f) + 1e-6f)) * (0.125f * LOG2E);
#pragma unroll
          for (int sx = 0; sx < 2; ++sx) { const f32x4 g0 = *(const GAS f32x4*)(qgain + 32 * sx + 8 * g4), g1 = *(const GAS f32x4*)(qgain + 32 * sx + 8 * g4 + 4); v4u o;
#pragma unroll
              for (int e = 0; e < 4; ++e) { const float a = __uint_as_float(qv[sx][e] << 16), c = __uint_as_float(qv[sx][e] & 0xffff0000u);
                  const float ga = e < 2 ? g0[2 * e] : g1[2 * e - 4], gc = e < 2 ? g0[2 * e + 1] : g1[2 * e - 3]; o[e] = pkbf(a * scq * ga, c * scq * gc); }
              qf[hh][sx] = __builtin_bit_cast(bf16x8, o); } } }
    f32x4 oacc[NH][4]; float lsum[NH];
#pragma unroll
    for (int hh = 0; hh < NH; ++hh) { lsum[hh] = 0.f;
#pragma unroll
        for (int dt = 0; dt < 4; ++dt) oacc[hh][dt] = (f32x4){0.f, 0.f, 0.f, 0.f}; }
    DSA_DMA_K(kcb, 0, DSA_PB3(0)); DSA_DMA_V(vtb, 0, DSA_PB3(0));
    { const int s1 = ns > 1 ? 1 : ns - 1, s2 = ns > 2 ? 2 : ns - 1; DSA_DMA_K(kcb, s1, DSA_PB3(1)); DSA_DMA_V(vtb, s1, DSA_PB3(1)); DSA_DMA_K(kcb, s2, DSA_PB3(2)); DSA_DMA_V(vtb, s2, DSA_PB3(2)); }
    DSA_WAITBAR(4);
    for (int step = 0; step < ns; ++step) {
        { const int sn = step + 3 < ns ? step + 3 : ns - 1; DSA_DMA_K(kcb, sn, DSA_PB3(step + 3)); DSA_DMA_V(vtb, sn, DSA_PB3(step + 3)); }
        const LAS unsigned char* tb = DSA_PB3(step);
#pragma unroll 1
        for (int tt = 0; tt < 2; ++tt) { const int kt = 2 * step + tt; if (32 * kt > pmin + 15) continue;
            const unsigned mw = (MASK[qloc * DSA_MSTR + kt] >> (8 * g4)) & 0xffu;
            bf16x8 ka[2][2], vt[4];
#pragma unroll
            for (int u = 0; u < 2; ++u) { ka[u][0] = *(const LAS bf16x8*)(tb + tt * 4096 + (u * 2 + 0) * 1024 + lane * 16); ka[u][1] = *(const LAS bf16x8*)(tb + tt * 4096 + (u * 2 + 1) * 1024 + lane * 16); }
#pragma unroll
            for (int dt = 0; dt < 4; ++dt) vt[dt] = *(const LAS bf16x8*)(tb + 8192 + tt * 4096 + dt * 1024 + lane * 16);
            f32x4 cm[2];
#pragma unroll
            for (int u = 0; u < 2; ++u)
#pragma unroll
                for (int r = 0; r < 4; ++r) cm[u][r] = ((mw >> (4 * u + r)) & 1u) ? 0.f : -30000.f;
            const bool near = 32 * kt + 31 + 112 >= pmin;
#pragma unroll
            for (int hh = 0; hh < NH; ++hh) {
                f32x4 st[2]; st[0] = cm[0]; st[1] = cm[1];
                if (near) {
                    int d0 = p - (32 * kt + 8 * g4); d0 = d0 < 0 ? 0 : (d0 > 135 ? 135 : d0);
                    const LAS float* bt = BIAS + (h0 + hh) * 144 + 8 + d0 - 7;
#pragma unroll
                    for (int u = 0; u < 2; ++u)
#pragma unroll
                        for (int r = 0; r < 4; ++r) st[u][r] += bt[7 - (4 * u + r)]; }
#pragma unroll
                for (int u = 0; u < 2; ++u) { st[u] = MFMA16(ka[u][0], qf[hh][0], st[u]); st[u] = MFMA16(ka[u][1], qf[hh][1], st[u]); }
                float pe[8];
#pragma unroll
                for (int u = 0; u < 2; ++u)
#pragma unroll
                    for (int r = 0; r < 4; ++r) { pe[4 * u + r] = __builtin_amdgcn_exp2f(st[u][r]); lsum[hh] += pe[4 * u + r]; }
                const v4u pw = (v4u){pkbf(pe[0], pe[1]), pkbf(pe[2], pe[3]), pkbf(pe[4], pe[5]), pkbf(pe[6], pe[7])};
                const bf16x8 pf = __builtin_bit_cast(bf16x8, pw);
#pragma unroll
                for (int dt = 0; dt < 4; ++dt) oacc[hh][dt] = MFMA16(vt[dt], pf, oacc[hh][dt]);
            }
        }
        DSA_WAITBAR(4);
    }
#pragma unroll
    for (int hh = 0; hh < NH; ++hh) { float l = lsum[hh]; l += __shfl_xor(l, 16); l += __shfl_xor(l, 32); const float il = 1.f / l;
        bf16* yp = yrow + 64 * (h0 + hh) + 4 * g4;
#pragma unroll
        for (int dt = 0; dt < 4; ++dt) *(GAS u32x2v*)(yp + 16 * dt) = (u32x2v){pkbf(oacc[hh][dt][0] * il, oacc[hh][dt][1] * il), pkbf(oacc[hh][dt][2] * il, oacc[hh][dt][3] * il)}; }
}

__device__ __forceinline__ void dsa_gather(LAS unsigned char* gbuf, LAS unsigned char* lstb, const LAS float* BIAS, const bf16* kc, const bf16* vc, const unsigned short* lst,
                                           const LAS unsigned* qcnt  , const bf16* projq  , const float* qgain, bf16* y  , int p0  , int lane) {
    DSA_OPAQUE(lane);
    const int h = lane & 15, g4 = lane >> 4, hv = h & 7;
    f32x4 gq[2][2];
#pragma unroll
    for (int sx = 0; sx < 2; ++sx) { gq[sx][0] = *(const GAS f32x4*)(qgain + 32 * sx + 8 * g4); gq[sx][1] = *(const GAS f32x4*)(qgain + 32 * sx + 8 * g4 + 4); }
    u32x2v lwn = *(const GAS u32x2v*)(lst + 4 * lane); v4u qvn[2];
    { const bf16* qp = projq + 64 * hv + 8 * g4; qvn[0] = *(const GAS v4u*)qp; qvn[1] = *(const GAS v4u*)(qp + 32); }
#pragma unroll 1
    for (int qq = 0; qq < 16; ++qq) {
        const int pq = p0 + qq; int nsel = pq + 1 < 256 ? pq + 1 : 256; { const int nl = (int)qcnt[4 * qq]; nsel = nl < nsel ? nl : nsel; }
        nsel = __builtin_amdgcn_readfirstlane(nsel); const int nch = (nsel + 31) >> 5;
        { u32x2v lw = lwn;
          if (4 * lane + 0 >= nsel) lw[0] &= 0xffff0000u; if (4 * lane + 1 >= nsel) lw[0] &= 0x0000ffffu; if (4 * lane + 2 >= nsel) lw[1] &= 0xffff0000u; if (4 * lane + 3 >= nsel) lw[1] &= 0x0000ffffu;
          *(LAS u32x2v*)(lstb + 8 * lane) = lw; }
        bf16x8 qf[2];
        { v4u qv[2]; qv[0] = qvn[0]; qv[1] = qvn[1]; float ss = 0.f;
#pragma unroll
          for (int sx = 0; sx < 2; ++sx) {
#pragma unroll
              for (int e = 0; e < 4; ++e) { const float a = __uint_as_float(qv[sx][e] << 16), c = __uint_as_float(qv[sx][e] & 0xffff0000u); ss += a * a + c * c; } }
          ss += __shfl_xor(ss, 16); ss += __shfl_xor(ss, 32);
          const float scq = (1.f / sqrtf(ss * (1.f / 64.f) + 1e-6f)) * (0.125f * LOG2E);
#pragma unroll
          for (int sx = 0; sx < 2; ++sx) { const f32x4 g0 = gq[sx][0], g1 = gq[sx][1]; v4u o;
#pragma unroll
              for (int e = 0; e < 4; ++e) { const float a = __uint_as_float(qv[sx][e] << 16), c = __uint_as_float(qv[sx][e] & 0xffff0000u);
                  const float ga = e < 2 ? g0[2 * e] : g1[2 * e - 4], gc = e < 2 ? g0[2 * e + 1] : g1[2 * e - 3]; o[e] = pkbf(a * scq * ga, c * scq * gc); }
              qf[sx] = __builtin_bit_cast(bf16x8, o); } }
        LDS_WAIT(); asm volatile("" ::: "memory");
        f32x4 oacc[4]; float lsum = 0.f;
#pragma unroll
        for (int dt = 0; dt < 4; ++dt) oacc[dt] = (f32x4){0.f, 0.f, 0.f, 0.f};
#define DSA_GDMA(c, buf) do { _Pragma("unroll") for (int i = 0; i < 4; ++i) { const int r_ = 8 * i + (lane >> 3); unsigned ki_ = *(const LAS unsigned short*)(lstb + 2 * (32 * (c) + r_)); ki_ = ki_ < (unsigned)KROWS ? ki_ : 0u; \
            const int pc_ = (lane & 7) ^ (r_ & 7); \
            __builtin_amdgcn_global_load_lds((const unsigned*)(kc + (size_t)ki_ * 64 + 8 * pc_), (LAS unsigned*)((buf) + i * 1024), 16, 0, 0); \
            __builtin_amdgcn_global_load_lds((const unsigned*)(vc + (size_t)ki_ * 64 + 8 * pc_), (LAS unsigned*)((buf) + 4096 + i * 1024), 16, 0, 0); } } while (0)
        DSA_GDMA(0, gbuf); if (nch > 1) DSA_GDMA(1, gbuf + 8192);
        __builtin_amdgcn_sched_barrier(0);
        { const int qn = qq < 15 ? qq + 1 : 15; lwn = *(const GAS u32x2v*)(lst + qn * 256 + 4 * lane); const bf16* qp = projq + (size_t)qn * DP2 + 64 * hv + 8 * g4; qvn[0] = *(const GAS v4u*)qp; qvn[1] = *(const GAS v4u*)(qp + 32); }
        __builtin_amdgcn_sched_barrier(0);
        const int qd = (lane >> 2) & 3, pp = lane & 3, R0 = 4 * g4 + qd, pcl = (lane & 7) ^ (lane >> 3);
        const unsigned gb0 = DSA_LDS_ADDR(gbuf), kof0 = (unsigned)(h * 128 + 16 * (g4 ^ (h & 7))), kof1 = (unsigned)(h * 128 + 16 * ((4 + g4) ^ (h & 7)));
        const unsigned vofb = (unsigned)(R0 * 128 + 8 * (pp & 1)), vsw = (unsigned)((pp >> 1) ^ (R0 & 7));
        const unsigned lsa = DSA_LDS_ADDR(lstb);
#pragma unroll 1
        for (int c = 0; c < nch; ++c) {
            if (c < 2) { if (c + 1 < nch) asm volatile("s_waitcnt vmcnt(11)" ::: "memory"); else asm volatile("s_waitcnt vmcnt(3)" ::: "memory"); }
            else { if (c + 1 < nch) asm volatile("s_waitcnt vmcnt(8)" ::: "memory"); else asm volatile("s_waitcnt vmcnt(0)" ::: "memory"); }
            const unsigned gb = gb0 + (unsigned)(c & 1) * 8192u;
            v4u kf[2][2]; u32x2v kiw[2], tv[4][2]; unsigned nk[4];
            { const unsigned ka0 = gb + kof0, ka1 = gb + kof1, va0 = gb + vofb + 16u * (vsw ^ 0u), va1 = gb + vofb + 16u * (vsw ^ 2u), va2 = gb + vofb + 16u * (vsw ^ 4u), va3 = gb + vofb + 16u * (vsw ^ 6u);
              const unsigned kwa = lsa + 2u * (unsigned)(32 * c + 4 * g4), nka = lsa + 2u * (unsigned)(32 * (c + 2) + (lane >> 3));
              asm volatile("ds_read_b128 %0, %18\n\tds_read_b128 %1, %19\n\tds_read_b128 %2, %18 offset:2048\n\tds_read_b128 %3, %19 offset:2048\n\tds_read_b64 %4, %24\n\tds_read_b64 %5, %24 offset:32\n\t"
                           TR_RD "%6, %20 offset:4096\n\t" TR_RD "%7, %20 offset:6144\n\t" TR_RD "%8, %21 offset:4096\n\t" TR_RD "%9, %21 offset:6144\n\t"
                           TR_RD "%10, %22 offset:4096\n\t" TR_RD "%11, %22 offset:6144\n\t" TR_RD "%12, %23 offset:4096\n\t" TR_RD "%13, %23 offset:6144\n\t"
                           "ds_read_u16 %14, %25\n\tds_read_u16 %15, %25 offset:16\n\tds_read_u16 %16, %25 offset:32\n\tds_read_u16 %17, %25 offset:48\n\ts_waitcnt lgkmcnt(0)"
                           : "=&v"(kf[0][0]), "=&v"(kf[0][1]), "=&v"(kf[1][0]), "=&v"(kf[1][1]), "=&v"(kiw[0]), "=&v"(kiw[1]),
                             "=&v"(tv[0][0]), "=&v"(tv[0][1]), "=&v"(tv[1][0]), "=&v"(tv[1][1]), "=&v"(tv[2][0]), "=&v"(tv[2][1]), "=&v"(tv[3][0]), "=&v"(tv[3][1]),
                             "=&v"(nk[0]), "=&v"(nk[1]), "=&v"(nk[2]), "=&v"(nk[3])
                           : "v"(ka0), "v"(ka1), "v"(va0), "v"(va1), "v"(va2), "v"(va3), "v"(kwa), "v"(nka) : "memory"); }
            if (c + 2 < nch) { LAS unsigned char* nb = gbuf + (c & 1) * 8192;
#pragma unroll
                for (int i = 0; i < 4; ++i) { const unsigned ki_ = nk[i] < (unsigned)KROWS ? nk[i] : 0u;
                    __builtin_amdgcn_global_load_lds((const unsigned*)(kc + (size_t)ki_ * 64 + 8 * pcl), (LAS unsigned*)(nb + i * 1024), 16, 0, 0);
                    __builtin_amdgcn_global_load_lds((const unsigned*)(vc + (size_t)ki_ * 64 + 8 * pcl), (LAS unsigned*)(nb + 4096 + i * 1024), 16, 0, 0); } }
            f32x4 st[2];
#pragma unroll
            for (int u = 0; u < 2; ++u) { st[u] = MFMA16(__builtin_bit_cast(bf16x8, kf[u][0]), qf[0], ((f32x4){0.f, 0.f, 0.f, 0.f})); st[u] = MFMA16(__builtin_bit_cast(bf16x8, kf[u][1]), qf[1], st[u]); }
            float bv[8];
#pragma unroll
            for (int u = 0; u < 2; ++u)
#pragma unroll
                for (int r = 0; r < 4; ++r) { const int ki = (int)((r & 1) ? kiw[u][r >> 1] >> 16 : kiw[u][r >> 1] & 0xffffu); int dd = pq - ki; dd = dd < 0 ? 0 : (dd > 135 ? 135 : dd);
                    bv[4 * u + r] = BIAS[hv * 144 + 8 + dd]; }
            float pe[8];
#pragma unroll
            for (int u = 0; u < 2; ++u)
#pragma unroll
                for (int r = 0; r < 4; ++r) { const float lg = (32 * c + 16 * u + 4 * g4 + r) < nsel ? st[u][r] + bv[4 * u + r] : -30000.f; pe[4 * u + r] = __builtin_amdgcn_exp2f(lg); lsum += pe[4 * u + r]; }
            const v4u pw = (v4u){pkbf(pe[0], pe[1]), pkbf(pe[2], pe[3]), pkbf(pe[4], pe[5]), pkbf(pe[6], pe[7])};
            const bf16x8 pf = __builtin_bit_cast(bf16x8, pw);
#pragma unroll
            for (int dt = 0; dt < 4; ++dt) oacc[dt] = MFMA16(tr_pack(tv[dt][0], tv[dt][1]), pf, oacc[dt]);
        }
#undef DSA_GDMA
        lsum += __shfl_xor(lsum, 16); lsum += __shfl_xor(lsum, 32);
        if (h < 8) { const float il = 1.f / lsum; bf16* yp = y + (size_t)qq * D + 64 * h + 4 * g4;
#pragma unroll
            for (int dt = 0; dt < 4; ++dt) *(GAS u32x2v*)(yp + 16 * dt) = (u32x2v){pkbf(oacc[dt][0] * il, oacc[dt][1] * il), pkbf(oacc[dt][2] * il, oacc[dt][3] * il)}; }
    }
}
__device__ __forceinline__ float wave_sum(float v) {
#pragma unroll
    for (int o = 1; o < 64; o <<= 1) v += __shfl_xor(v, o);
    return v;
}
__device__ __forceinline__ void p0_transpose_item(const float* W, int K, int N, int NP, bf16* WT, LAS float* scr, int item, int lane, const float* kscale = nullptr) {
    const int nblk = NP / 32, kb = item / nblk, nb = item % nblk, k0 = 64 * kb, n0 = 32 * nb;
    const int nn = n0 + (lane & 31); const bool ok = nn < N;
#pragma unroll 8
    for (int i = 0; i < 32; ++i) { const int kk = 2 * i + (lane >> 5); scr[kk * 33 + (lane & 31)] = ok ? W[(size_t)(k0 + kk) * N + nn] * (kscale ? kscale[k0 + kk] : 1.f) : 0.f; }
    LDS_WAIT(); asm volatile("" ::: "memory");
    const int c = lane & 7;
#pragma unroll
    for (int j = 0; j < 4; ++j) { const int n = (lane >> 3) + 8 * j; const LAS float* s = scr + (8 * c) * 33 + n;
        v4u o; o.x = pk2(s[0 * 33], s[1 * 33]); o.y = pk2(s[2 * 33], s[3 * 33]); o.z = pk2(s[4 * 33], s[5 * 33]); o.w = pk2(s[6 * 33], s[7 * 33]);
        *(GAS v4u*)(WT + (size_t)(n0 + n) * K + k0 + 8 * c) = o; }
    LDS_WAIT(); asm volatile("" ::: "memory");
}
__device__ __forceinline__ void rms_row_to_bf16(const float* xrow, const float* w, bf16* orow, int lane) {
    const GAS f32x4* xr = (const GAS f32x4*)xrow + lane; const GAS f32x4* wr = (const GAS f32x4*)w + lane;
    f32x4 v[4]; float s = 0.f;
#pragma unroll
    for (int j = 0; j < 4; ++j) { v[j] = xr[64 * j]; s += (v[j].x * v[j].x + v[j].y * v[j].y) + (v[j].z * v[j].z + v[j].w * v[j].w); }
    const float r = 1.f / sqrtf(wave_sum(s) * (1.f / D) + EPS);
    GAS unsigned long long* o8 = (GAS unsigned long long*)orow + lane;
#pragma unroll
    for (int j = 0; j < 4; ++j) { const f32x4 g = wr[64 * j];
        o8[64 * j] = (unsigned long long)pk2(v[j].x * r * g.x, v[j].y * r * g.y) | ((unsigned long long)pk2(v[j].z * r * g.z, v[j].w * r * g.w) << 32); }
}

__device__ __forceinline__ void rms_row2_to_bf16(const float* xa, const float* xb, const float* w, bf16* oa, bf16* ob, float* xsa, float* xsb, int lane) {
    const GAS f32x4* pa = (const GAS f32x4*)xa + lane; const GAS f32x4* pb = (const GAS f32x4*)xb + lane; const GAS f32x4* wr = (const GAS f32x4*)w + lane;
    f32x4 va[4], vb[4]; float sa = 0.f, sb = 0.f;
#pragma unroll
    for (int j = 0; j < 4; ++j) { va[j] = __builtin_nontemporal_load(pa + 64 * j); vb[j] = __builtin_nontemporal_load(pb + 64 * j); }
#pragma unroll
    for (int j = 0; j < 4; ++j) { sa += (va[j].x * va[j].x + va[j].y * va[j].y) + (va[j].z * va[j].z + va[j].w * va[j].w); sb += (vb[j].x * vb[j].x + vb[j].y * vb[j].y) + (vb[j].z * vb[j].z + vb[j].w * vb[j].w); }
    const float qa_ = sqrtf(wave_sum(sa) * (1.f / D) + EPS), qb_ = sqrtf(wave_sum(sb) * (1.f / D) + EPS); const float ra = 1.f / qa_, rb = 1.f / qb_;
    if (lane == 0) { *xsa = qa_; *xsb = qb_; }
    GAS unsigned long long* qa = (GAS unsigned long long*)oa + lane; GAS unsigned long long* qb = (GAS unsigned long long*)ob + lane;
#pragma unroll
    for (int j = 0; j < 4; ++j) { const f32x4 g = wr[64 * j];
        qa[64 * j] = (unsigned long long)pk2(va[j].x * ra * g.x, va[j].y * ra * g.y) | ((unsigned long long)pk2(va[j].z * ra * g.z, va[j].w * ra * g.w) << 32);
        qb[64 * j] = (unsigned long long)pk2(vb[j].x * rb * g.x, vb[j].y * rb * g.y) | ((unsigned long long)pk2(vb[j].z * rb * g.z, vb[j].w * rb * g.w) << 32); }
}

struct Args { const float* in[12]; float* out; unsigned char* ws; int ph_lo, ph_hi; };
__global__ void __launch_bounds__(NWAVES * 64, 2) mk_fwd(Args args) {
    extern __shared__ __attribute__((aligned(16))) unsigned char lds_raw[];
    LAS unsigned char* lds = (LAS unsigned char*)lds_raw;
    volatile LAS unsigned* MISC = (volatile LAS unsigned*)(lds + MISC_OFF);
    const int tid = threadIdx.x, lane = tid & 63, wave = __builtin_amdgcn_readfirstlane(tid >> 6);
    const int G = gridDim.x; const int bx = blockIdx.x; const int vcu = (G % 8 == 0) ? (bx % 8) * (G / 8) + bx / 8 : bx;
    unsigned char* ws = args.ws;
    gu32* ctl = (gu32*)(ws + WS_CTL);
    const float* x = args.in[0]; const float* meta = args.in[1]; const float* norm1_w = args.in[2]; const float* w_in = args.in[3];
    const float* ret_norm_w = args.in[4]; const float* q_norm_w = args.in[5]; const float* k_norm_w = args.in[6]; const float* rel_bias = args.in[7];
    const float* w_out = args.in[8]; const float* norm2_w = args.in[9]; const float* w_ff1 = args.in[10]; const float* w_ff2 = args.in[11];
    float* out = args.out;
    bf16* WIN_T = (bf16*)(ws + WS_WIN); bf16* WOUT_T = (bf16*)(ws + WS_WOUT); bf16* W1_T = (bf16*)(ws + WS_W1); bf16* W2_T = (bf16*)(ws + WS_W2);
    bf16* U = (bf16*)(ws + WS_U); bf16* PROJ = (bf16*)(ws + WS_PROJ); bf16* Y = (bf16*)(ws + WS_Y); bf16* HB = (bf16*)(ws + WS_H);
    float* ROPE = (float*)(ws + WS_ROPE); float* PMETA = (float*)(ws + WS_PMETA); bf16* PM16 = (bf16*)(ws + WS_PMETA + 512 * 1024); bf16* SPT = (bf16*)(ws + WS_SPT);
    float* XS = (float*)(ws + WS_CTL + 768 * 1024);
    float* SSQ = (float*)(ws + WS_CTL + 512 * 1024);
    bf16* KC = (bf16*)(ws + WS_KC); bf16* IKC = (bf16*)(ws + WS_IKC); bf16* VT = (bf16*)(ws + WS_VT); bf16* VC = (bf16*)(ws + WS_QN + 32 * MiB); unsigned short* LISTG = (unsigned short*)(ws + WS_LIST); bf16* RET = (bf16*)(ws + WS_RET);
    for (int u = tid; u < (LDS_BYTES - LDSCTL_OFF) / 4; u += NWAVES * 64) ((LAS unsigned*)(lds + LDSCTL_OFF))[u] = 0u;
    __syncthreads();
    XcdBarrier bar; bar.bar = (unsigned*)(ctl + CW_BAR); bar.x = 0; bar.st = nullptr;
    if (ONE_LAUNCH) bar = xcd_barrier_post((unsigned*)(ctl + CW_BAR), MISC + 8);
#define GRID_BAR() do { if (ONE_LAUNCH) xcd_barrier(bar); } while (0)
    const int lo = args.ph_lo, hi = args.ph_hi;
#define IN(k) (lo <= (k) && (k) < hi)
#define BOTH(k) (IN(k) && IN((k) + 1 + ((k) == 4)))
    const int gw = vcu * NWAVES + wave, NGW = G * NWAVES;

    if (IN(0)) {
        LAS float* scr = (LAS float*)(lds + RING_OFF + wave * 16384);
        constexpr int I_IN = (D / 64) * (DINP / 32), I_O = (D / 64) * (D / 32), I_1 = (D / 64) * (FF / 32), I_2 = (FF / 64) * (D / 32);
        constexpr int NITEMS = I_IN + I_O + I_1 + I_2;
        for (int it = gw; it < NITEMS; it += NGW) {
            int r = it;
            if (r < I_IN) { p0_transpose_item(w_in, D, DIN, DINP, WIN_T, scr, r, lane); continue; } r -= I_IN;
            if (r < I_O) { p0_transpose_item(w_out, D, D, D, WOUT_T, scr, r, lane); continue; } r -= I_O;
            if (r < I_1) { p0_transpose_item(w_ff1, D, FF, FF, W1_T, scr, r, lane, norm2_w); continue; } r -= I_1;
            p0_transpose_item(w_ff2, FF, D, D, W2_T, scr, r, lane);
        }
        for (int m = gw; m < M; m += 2 * NGW) rms_row2_to_bf16(x + (size_t)m * D, x + (size_t)(m + NGW) * D, norm1_w, U + (size_t)m * D, U + (size_t)(m + NGW) * D, XS + m, XS + m + NGW, lane);

        for (int i = bx * 512 + tid; i < TK * 64; i += G * 512) {
            const int t = i >> 6, fi = i & 63;
            const double inv = exp2(-(double)fi * (13.287712379549449 / 64.0));
            const double ang = (double)t * inv;
            const double nrev = rint(ang * 0.15915494309189535);
            double r = fma(-nrev, 6.283185307179586, ang); r = fma(-nrev, 2.4492935982947064e-16, r);
            const double r2 = r * r; double sn = 1.0, cn = 1.0;
#pragma unroll
            for (int k = 12; k >= 1; --k) { sn = 1.0 - r2 / (double)((2 * k) * (2 * k + 1)) * sn; cn = 1.0 - r2 / (double)((2 * k - 1) * (2 * k)) * cn; }
            sn *= r;
            ((GAS f32x2v*)ROPE)[i] = (f32x2v){(float)cn, (float)sn};
        }
        for (int i = bx * 512 + tid; i < 112 * DINP * 2 / 16; i += G * 512) ((GAS v4u*)PM16)[i] = (v4u){0u, 0u, 0u, 0u};
        {
            __syncthreads();
            LAS float* un = (LAS float*)(lds + RING_OFF);
            LAS float* red = (LAS float*)(lds + RING_OFF + 16 * 1025 * 4);
#pragma unroll
            for (int rr = 0; rr < 2; ++rr) { const int r = 2 * wave + rr; const GAS f32x4* xr = (const GAS f32x4*)(meta + (size_t)r * D) + lane; const GAS f32x4* wr = (const GAS f32x4*)norm1_w + lane;
                f32x4 v[4]; float s = 0.f;
#pragma unroll
                for (int j = 0; j < 4; ++j) { v[j] = xr[64 * j]; s += (v[j].x * v[j].x + v[j].y * v[j].y) + (v[j].z * v[j].z + v[j].w * v[j].w); }
                const float ri = 1.f / sqrtf(wave_sum(s) * (1.f / D) + EPS);
#pragma unroll
                for (int j = 0; j < 4; ++j) { const f32x4 g = wr[64 * j]; const int k = 4 * lane + 256 * j;
                    un[r * 1025 + k] = v[j].x * ri * g.x; un[r * 1025 + k + 1] = v[j].y * ri * g.y; un[r * 1025 + k + 2] = v[j].z * ri * g.z; un[r * 1025 + k + 3] = v[j].w * ri * g.w; } }
            __syncthreads();
            const int c0 = 13 * vcu; float acc[13];
#pragma unroll
            for (int cc = 0; cc < 13; ++cc) acc[cc] = 0.f;
            for (int i = 0; i < 32; ++i) { const int k = 128 * wave + (lane >> 4) + 4 * i; const float uv = un[(lane & 15) * 1025 + k]; const float* wp = w_in + (size_t)k * DIN + c0;
#pragma unroll
                for (int cc = 0; cc < 13; ++cc) { const float wv = (c0 + cc < DIN) ? wp[cc] : 0.f; acc[cc] = fmaf(uv, wv, acc[cc]); } }
#pragma unroll
            for (int cc = 0; cc < 13; ++cc) { acc[cc] += __shfl_xor(acc[cc], 16); acc[cc] += __shfl_xor(acc[cc], 32); if (lane < 16) red[(wave * 16 + lane) * 13 + cc] = acc[cc]; }
            __syncthreads();
            if (tid < 208) { const int r = tid / 13, cc = tid % 13; float s = 0.f;
#pragma unroll
                for (int w8 = 0; w8 < 8; ++w8) s += red[(w8 * 16 + r) * 13 + cc];
                const int c = c0 + cc; if (c >= DIN) s = 0.f;
                PMETA[r * DINP + c] = s; PM16[(size_t)(112 + r) * DINP + c] = (bf16)f2bf(s); }
            __syncthreads();
        }
        if (BOTH(0)) GRID_BAR();
    }
    if (IN(1)) {
        pg8::Gemm g{U, WIN_T, M, DINP, D}; pg8::StaticOrder S; S.init(M, DINP, G, (int)blockIdx.x);
        pg8::EpiProj E{PROJ, DP2, RET, M};
        pg8::gemm_phase<pg8::EpiProj, pg8::StaticOrder, true, true>(lds + RING_OFF, g, S, E);
        if (BOTH(1)) GRID_BAR();
    }
    if (IN(2)) {
        {
            LAS unsigned char* vscr = lds + RING_OFF + 65536 + wave * 1024;
            const int r = lane >> 3, sub = lane & 7;
            const f32x4 kg0 = *(const GAS f32x4*)(k_norm_w + 8 * sub), kg1 = *(const GAS f32x4*)(k_norm_w + 8 * sub + 4);
            for (int unit = gw; unit < BATCH * 520; unit += NGW) {
                const int b = unit / 520, gidx = unit % 520; const bool isx = gidx >= 2 && gidx < 514, ismeta = gidx < 2;
                const bf16* src = ismeta ? PM16 + (size_t)(112 + 8 * gidx + r) * DINP + 2048 : PROJ + ((size_t)b * SEQ + (isx ? 8 * (gidx - 2) + r : 0)) * DP2;
                const size_t krow = ((size_t)b * KROWS + 8 * gidx + r) * 64 + 8 * sub;
                v4u kv = (v4u){0u, 0u, 0u, 0u}, iv = kv, vv = kv;
                if (isx || ismeta) { kv = *(const GAS v4u*)(src + C2_DK + 8 * sub); iv = *(const GAS v4u*)(src + C2_IK + 8 * sub); vv = *(const GAS v4u*)(src + C2_DV + 8 * sub); }
                float xk[8]; float sk = 0.f;
#pragma unroll
                for (int i = 0; i < 4; ++i) { xk[2 * i] = __uint_as_float(kv[i] << 16); xk[2 * i + 1] = __uint_as_float(kv[i] & 0xffff0000u); sk += xk[2 * i] * xk[2 * i] + xk[2 * i + 1] * xk[2 * i + 1]; }
                sk += __shfl_xor(sk, 1); sk += __shfl_xor(sk, 2); sk += __shfl_xor(sk, 4);
                const float sck = 1.f / sqrtf(sk * (1.f / 64.f) + EPS);
                *(GAS v4u*)(KC + krow) = (v4u){pkbf(xk[0] * sck * kg0[0], xk[1] * sck * kg0[1]), pkbf(xk[2] * sck * kg0[2], xk[3] * sck * kg0[3]), pkbf(xk[4] * sck * kg1[0], xk[5] * sck * kg1[1]), pkbf(xk[6] * sck * kg1[2], xk[7] * sck * kg1[3])};
                *(GAS v4u*)(IKC + krow) = iv;
                *(GAS v4u*)(VC + krow) = vv;
                *(LAS v4u*)(vscr + lane * 16) = vv;
                LDS_WAIT(); asm volatile("" ::: "memory");
                { const LAS unsigned short* vs = (const LAS unsigned short*)vscr + lane; v4u o;
#pragma unroll
                  for (int i = 0; i < 4; ++i) o[i] = (unsigned)vs[(2 * i) * 64] | ((unsigned)vs[(2 * i + 1) * 64] << 16);
                  *(GAS v4u*)(VT + ((size_t)b * 64 + lane) * KROWS + 8 * gidx) = o; }
                LDS_WAIT(); asm volatile("" ::: "memory");
            }
            __syncthreads();
        }
        if (vcu < 256) {
            const int b = vcu >> 4, h = (vcu >> 2) & 3, dq = vcu & 3;
            const float lg2 = log2f(1.f - exp2f(-5.f - (float)h));
            const float cdec = exp2f(lg2 * 128.f);
            LAS unsigned char* Kimg = lds + 3 * 40960;
            f32x4 acc[2]; acc[0] = (f32x4){0.f, 0.f, 0.f, 0.f}; acc[1] = acc[0];
            f32x4 rc[4], rc1[4], rstep[4];
            { const int c = (tid >> 1) & 127, jh = tid & 1; int t0 = c - 112; t0 = t0 < 0 ? 0 : t0; const int t1 = 16 + c;
              const GAS f32x4* r0 = (const GAS f32x4*)(ROPE + ((size_t)t0 * 64 + 16 * dq + 8 * jh) * 2); const GAS f32x4* r1 = (const GAS f32x4*)(ROPE + ((size_t)t1 * 64 + 16 * dq + 8 * jh) * 2);
              const GAS f32x4* rs = (const GAS f32x4*)(ROPE + ((size_t)128 * 64 + 16 * dq + 8 * jh) * 2);
#pragma unroll
              for (int i = 0; i < 4; ++i) { rc[i] = r0[i]; rc1[i] = r1[i]; rstep[i] = rs[i]; } }
            const float ksc0 = RET_KSCALE * exp2f(lg2 * (float)(127 - ((tid >> 1) & 127)));
#define R12_DMA(n, slot) do { const bool m0_ = (n) == 0; const size_t rs_ = m0_ ? (size_t)DINP : (size_t)128;     \
                const bf16* kb_ = m0_ ? PM16 + C_RK + 128 * h : RET + ((size_t)(4 + h) * M + (size_t)b * SEQ + 128 * ((n) - 1)) * 128; const bf16* vb_ = m0_ ? PM16 + C_RV + 128 * h : RET + ((size_t)(8 + h) * M + (size_t)b * SEQ + 128 * ((n) - 1)) * 128; \
                _Pragma("unroll") for (int i = 0; i < 4; ++i) __builtin_amdgcn_global_load_lds((const unsigned*)(vb_ + (size_t)(16 * wave + 4 * i + (lane >> 4)) * rs_ + 8 * ((lane & 15) ^ (2 * (lane >> 4)))), (LAS unsigned*)(lds + (slot) * 40960 + (4 * wave + i) * 1024), 16, 0, 0); \
                __builtin_amdgcn_global_load_lds((const unsigned*)(kb_ + (size_t)(16 * wave + (lane >> 2)) * rs_ + 64 * ((lane >> 1) & 1) + 16 * dq + 8 * (lane & 1)), (LAS unsigned*)(lds + (slot) * 40960 + 32768 + wave * 1024), 16, 0, 0); } while (0)
            R12_DMA(0, 0); R12_DMA(1, 1); R12_DMA(2, 2);
            asm volatile("s_waitcnt vmcnt(0)" ::: "memory"); __syncthreads();
            const unsigned kimg_a0 = DSA_LDS_ADDR(Kimg + ((tid >> 1) & 127) * 64 + 16 * (tid & 1));
            const unsigned trk_a = DSA_LDS_ADDR(Kimg + (8 * (lane >> 4) + ((lane >> 2) & 3)) * 64 + 8 * (lane & 3));
            const unsigned trv_off = (unsigned)((8 * (lane >> 4) + ((lane >> 2) & 3)) * 256 + 16 * ((2 * wave + ((lane & 3) >> 1)) ^ (2 * ((lane >> 2) & 3))) + 8 * (lane & 1));
#pragma unroll 1
            for (int n = 0; n < 32; ++n) {
                const LAS unsigned char* slot = lds + (n % 3) * 40960;
                const unsigned slot_a = DSA_LDS_ADDR(slot);
                if (tid < 256) {
                    if (n == 1) {
#pragma unroll
                        for (int i = 0; i < 4; ++i) rc[i] = rc1[i]; }
                    else if (n > 1) {
#pragma unroll
                        for (int i = 0; i < 4; ++i) { const f32x4 a = rc[i], st = rstep[i];
                            rc[i] = (f32x4){a[0] * st[0] - a[1] * st[1], a[1] * st[0] + a[0] * st[1], a[2] * st[2] - a[3] * st[3], a[3] * st[2] + a[2] * st[3]}; } }
                    const LAS unsigned char* rp = slot + 32768 + (tid >> 1) * 64 + 16 * (tid & 1); v4u o1, o2;
                    rot8(*(const LAS v4u*)rp, *(const LAS v4u*)(rp + 32), rc, ksc0, o1, o2);
                    asm volatile("ds_write_b128 %0, %1\n\tds_write_b128 %0, %2 offset:32" :: "v"(kimg_a0), "v"(o1), "v"(o2) : "memory"); }
                asm volatile("s_waitcnt lgkmcnt(0)\n\ts_barrier" ::: "memory");
                acc[0] = acc[0] * cdec; acc[1] = acc[1] * cdec;
                { const unsigned va_ = slot_a + trv_off;
#pragma unroll
                  for (int kp = 0; kp < 2; ++kp) { u32x2v t[12];
                      if (kp == 0) asm volatile(TR_RD "%0, %12\n\t" TR_RD "%1, %12 offset:256\n\t" TR_RD "%2, %12 offset:32\n\t" TR_RD "%3, %12 offset:288\n\t" TR_RD "%4, %13\n\t" TR_RD "%5, %13 offset:1024\n\t"
                                                TR_RD "%6, %12 offset:2048\n\t" TR_RD "%7, %12 offset:2304\n\t" TR_RD "%8, %12 offset:2080\n\t" TR_RD "%9, %12 offset:2336\n\t" TR_RD "%10, %13 offset:8192\n\t" TR_RD "%11, %13 offset:9216\n\ts_waitcnt lgkmcnt(0)"
                                                : "=&v"(t[0]), "=&v"(t[1]), "=&v"(t[2]), "=&v"(t[3]), "=&v"(t[4]), "=&v"(t[5]), "=&v"(t[6]), "=&v"(t[7]), "=&v"(t[8]), "=&v"(t[9]), "=&v"(t[10]), "=&v"(t[11]) : "v"(trk_a), "v"(va_) : "memory");
                      else asm volatile(TR_RD "%0, %12 offset:4096\n\t" TR_RD "%1, %12 offset:4352\n\t" TR_RD "%2, %12 offset:4128\n\t" TR_RD "%3, %12 offset:4384\n\t" TR_RD "%4, %13 offset:16384\n\t" TR_RD "%5, %13 offset:17408\n\t"
                                        TR_RD "%6, %12 offset:6144\n\t" TR_RD "%7, %12 offset:6400\n\t" TR_RD "%8, %12 offset:6176\n\t" TR_RD "%9, %12 offset:6432\n\t" TR_RD "%10, %13 offset:24576\n\t" TR_RD "%11, %13 offset:25600\n\ts_waitcnt lgkmcnt(0)"
                                        : "=&v"(t[0]), "=&v"(t[1]), "=&v"(t[2]), "=&v"(t[3]), "=&v"(t[4]), "=&v"(t[5]), "=&v"(t[6]), "=&v"(t[7]), "=&v"(t[8]), "=&v"(t[9]), "=&v"(t[10]), "=&v"(t[11]) : "v"(trk_a), "v"(va_) : "memory");
#pragma unroll
                      for (int kk = 0; kk < 2; ++kk) { const bf16x8 a0 = tr_pack(t[6 * kk], t[6 * kk + 1]), a1 = tr_pack(t[6 * kk + 2], t[6 * kk + 3]), bv = tr_pack(t[6 * kk + 4], t[6 * kk + 5]);
                          acc[0] = MFMA16(a0, bv, acc[0]); acc[1] = MFMA16(a1, bv, acc[1]); } } }
                bf16* sp = SPT + ((size_t)((b * 4 + h) * 32 + n)) * 16384;
#pragma unroll
                for (int dt = 0; dt < 2; ++dt) { const int e = 16 * wave + (lane & 15), d = 64 * dt + 16 * dq + 4 * (lane >> 4);
                    *(GAS u32x2v*)(sp + e * 128 + d) = (u32x2v){pkbf(acc[dt][0], acc[dt][1]), pkbf(acc[dt][2], acc[dt][3])}; }
                asm volatile("s_waitcnt vmcnt(9) lgkmcnt(0)\n\ts_barrier" ::: "memory");
                { const int nn = n + 3 < 32 ? n + 3 : 31; R12_DMA(nn, n % 3); }
            }
            asm volatile("s_waitcnt vmcnt(0)" ::: "memory"); __syncthreads();
#undef R12_DMA
        }
        if (BOTH(2)) GRID_BAR();
    }
    if (IN(3)) {
        {
            for (int i = tid; i < 8 * 144; i += 512) { const int h = i / 144, d = i % 144 - 8; float v = 0.f;
                if (d >= 0 && d < 113) { int bk = d; if (d >= 16) { bk = 16 + (int)(logf((float)d * (1.f / 16.f)) / logf(8.f) * 16.f); bk = bk > 31 ? 31 : bk; } v = (rel_bias[bk * 8 + h] - rel_bias[31 * 8 + h]) * LOG2E; }
                ((LAS float*)(lds + L_BIAS))[i] = v; }
            __syncthreads();
            LAS unsigned* HIST = (LAS unsigned*)(lds + L_HIST); LAS unsigned* MASK = (LAS unsigned*)(lds + L_MASK); LAS unsigned* QPAR = (LAS unsigned*)(lds + L_QPAR);
            LAS unsigned* CCNT = (LAS unsigned*)(lds + L_CCNT); const LAS float* BIAS = (const LAS float*)(lds + L_BIAS);
            LAS unsigned char* STG = lds + L_STAGE;
            LAS unsigned char* STG3 = lds + L_HIST;
            const int ql = lane & 15, g4 = lane >> 4;
            const int dk_row = 32 * (wave >> 2) + 8 * (ql >> 2) + 4 * ((wave >> 1) & 1) + (ql & 3), dk_col = 32 * (wave & 1) + 8 * g4;
            const int dv_row = 16 * (wave & 3) + ql, dv_col = 32 * (wave >> 2) + 8 * g4;
            const int xq = vcu >> 5;
            for (;;) {
                if (vcu >= 256) break;
                if (tid == 0) MISC[4] = __hip_atomic_fetch_add(ctl + 2048 + 64 * xq, 1u, __ATOMIC_RELAXED, __HIP_MEMORY_SCOPE_AGENT);
                __syncthreads();
                const int uq = (int)MISC[4];
                __syncthreads();
                if (uq >= 64) break;
                const int b = 2 * xq + (uq >> 5), j = 31 - (uq & 31);
                const int nt = 5 + 4 * j, ns = (nt + 1) >> 1;
                const int qloc = 16 * wave + ql;
                const size_t mrow = (size_t)b * SEQ + 128 * j + qloc;
                const int p = 16 + 128 * j + qloc;
                const int pmaxw = 16 + 128 * j + 16 * wave + 15;
                const bf16* ikb = IKC + (size_t)b * KROWS * 64; const bf16* kcb = KC + (size_t)b * KROWS * 64; const bf16* vtb = VT + (size_t)b * 64 * KROWS; const bf16* vcb = VC + (size_t)b * KROWS * 64;
                unsigned char* tqb = (b < 15 ? (unsigned char*)out + (size_t)b * (17u << 20) : ws + WS_QN) + (size_t)(j * j + 2 * j) * 16384 + wave * 1024 + lane * 16;
                LAS unsigned* hrow = HIST + qloc * 128;
                bf16x8 iq[8][2], cq[2]; float wh[8];
                { const bf16* rp = PROJ + mrow * DP2 + C2_IQ + 8 * g4;
#pragma unroll
                  for (int h = 0; h < 8; ++h) { iq[h][0] = *(const GAS bf16x8*)(rp + 64 * h); iq[h][1] = *(const GAS bf16x8*)(rp + 64 * h + 32); }
                  const v4u wv = *(const GAS v4u*)(PROJ + mrow * DP2 + C2_IW);
#pragma unroll
                  for (int i = 0; i < 4; ++i) { wh[2 * i] = __uint_as_float(wv[i] << 16) * (0.5f * 0.35355339059327373f * 0.125f); wh[2 * i + 1] = __uint_as_float(wv[i] & 0xffff0000u) * (0.5f * 0.35355339059327373f * 0.125f); }
#pragma unroll
                  for (int sx = 0; sx < 2; ++sx) { float ca[8];
#pragma unroll
                      for (int e = 0; e < 8; ++e) ca[e] = 0.f;
#pragma unroll
                      for (int h = 0; h < 8; ++h) { const v4u qv = __builtin_bit_cast(v4u, iq[h][sx]);
#pragma unroll
                          for (int e = 0; e < 4; ++e) { ca[2 * e] = __builtin_fmaf(wh[h], __uint_as_float(qv[e] << 16), ca[2 * e]); ca[2 * e + 1] = __builtin_fmaf(wh[h], __uint_as_float(qv[e] & 0xffff0000u), ca[2 * e + 1]); } }
                      const v4u cw = (v4u){pkbf(ca[0], ca[1]), pkbf(ca[2], ca[3]), pkbf(ca[4], ca[5]), pkbf(ca[6], ca[7])}; cq[sx] = __builtin_bit_cast(bf16x8, cw); } }
                float lo, invw, binc;
                { float s1 = 0.f, s2 = 0.f;
                  int lane_p0 = lane; DSA_OPAQUE(lane_p0);
                  for (int kt = 0; kt < 2; ++kt) { f32x4 sc[2]; idx_tile(ikb, kt, iq, cq, wh, lane_p0, sc);
#pragma unroll
                      for (int u = 0; u < 2; ++u)
#pragma unroll
                          for (int r = 0; r < 4; ++r) { s1 += sc[u][r]; s2 += sc[u][r] * sc[u][r]; } }
                  s1 += __shfl_xor(s1, 16); s1 += __shfl_xor(s1, 32); s2 += __shfl_xor(s2, 16); s2 += __shfl_xor(s2, 32);
                  const float mean = s1 * (1.f / 64.f); float var = s2 * (1.f / 64.f) - mean * mean; var = var > 1e-30f ? var : 1e-30f;
                  const float sd = sqrtf(var); lo = mean - 3.f * sd; invw = 256.f * (float)DSA_NB / (6.f * sd); binc = -lo * invw; }
                { LAS v4u* hz = (LAS v4u*)(HIST + 16 * wave * 128);
#pragma unroll
                  for (int i = 0; i < 8; ++i) hz[lane + 64 * i] = (v4u){0u, 0u, 0u, 0u}; }
                __syncthreads();
                DSA_DMA_K(ikb, 0, DSA_PB1(0)); DSA_DMA_K(ikb, ns > 1 ? 1 : ns - 1, DSA_PB1(1)); DSA_DMA_K(ikb, ns > 2 ? 2 : ns - 1, DSA_PB1(2));
                DSA_WAITBAR(2);
                { const unsigned hbase = DSA_LDS_ADDR(hrow); unsigned one_v = 1u; DSA_OPAQUE(one_v);
                for (int step = 0; step < ns; ++step) {
                    { const int sn = step + 3 < ns ? step + 3 : ns - 1; DSA_DMA_K(ikb, sn, DSA_PB1(step + 3)); }
                    const LAS unsigned char* tb = DSA_PB1(step);
#pragma unroll 1
                    for (int tt = 0; tt < 2; ++tt) { const int kt = 2 * step + tt; unsigned tqv[4]; if (32 * kt > pmaxw) continue;
                        if (32 * kt + 31 <= pmaxw - 15) {
#pragma unroll
                        for (int u = 0; u < 2; ++u) { const f32x4 scu = idx_sub_lds2(tb + tt * 4096, u, iq, cq, wh, lane);
#pragma unroll
                            for (int r = 0; r < 4; ++r) {
                                const unsigned tq = (unsigned)(int)__builtin_amdgcn_fmed3f(bin_t(scu[r], binc, invw), 0.f, 32767.f);
                                asm volatile("ds_add_u32 %0, %1" :: "v"(hbase | ((tq >> 6) & 0x1fcu)), "v"(one_v) : "memory");
                                tqv[r] = tq; }
                            *(GAS u32x2v*)(tqb + (size_t)kt * 8192 + 8 * u) = (u32x2v){tqv[0] | (tqv[1] << 16), tqv[2] | (tqv[3] << 16)};
                            __builtin_amdgcn_sched_barrier(0); }
                        } else {
#pragma unroll
                        for (int u = 0; u < 2; ++u) { const f32x4 scu = idx_sub_lds2(tb + tt * 4096, u, iq, cq, wh, lane);
#pragma unroll
                            for (int r = 0; r < 4; ++r) { const int kk = 32 * kt + 8 * g4 + 4 * u + r; const bool causal = kk <= p;
                                const unsigned tq = (unsigned)(int)__builtin_amdgcn_fmed3f(bin_t(scu[r], binc, invw), 0.f, 32767.f);
                                asm volatile("ds_add_u32 %0, %1" :: "v"(hbase | ((tq >> 6) & 0x1fcu)), "v"(causal ? 1u : 0u) : "memory");
                                tqv[r] = causal ? tq : 0xffffu; }
                            *(GAS u32x2v*)(tqb + (size_t)kt * 8192 + 8 * u) = (u32x2v){tqv[0] | (tqv[1] << 16), tqv[2] | (tqv[3] << 16)};
                            __builtin_amdgcn_sched_barrier(0); } } }
                    DSA_WAITBAR(2);
                } }
#pragma unroll 1
                for (int qq = 0; qq < 16; ++qq) { const int q = 16 * wave + qq; const int pq = 16 + 128 * j + q; const int kq = pq + 1 < 256 ? pq + 1 : 256;
                    const u32x2v wv = *(const LAS u32x2v*)(HIST + q * 128 + 2 * lane);
                    const int c0 = (int)wv[0], c1 = (int)wv[1]; const int sl = c0 + c1;
                    int pre = sl;
                    pre += __builtin_amdgcn_update_dpp(0, pre, 0x111, 0xf, 0xf, true); pre += __builtin_amdgcn_update_dpp(0, pre, 0x112, 0xf, 0xf, true);
                    pre += __builtin_amdgcn_update_dpp(0, pre, 0x114, 0xf, 0xf, true); pre += __builtin_amdgcn_update_dpp(0, pre, 0x118, 0xf, 0xf, true);
                    pre += __builtin_amdgcn_update_dpp(0, pre, 0x142, 0xa, 0xf, false); pre += __builtin_amdgcn_update_dpp(0, pre, 0x143, 0xc, 0xf, false);
                    int cum = __builtin_amdgcn_readlane(pre, 63) - pre; int bst = -1, ngt = 0;
                    if (cum < kq && cum + c1 >= kq) { bst = 2 * lane + 1; ngt = cum; } cum += c1;
                    if (cum < kq && cum + c0 >= kq) { bst = 2 * lane + 0; ngt = cum; }
                    if (bst >= 0) { QPAR[q * 4 + 0] = (unsigned)bst; QPAR[q * 4 + 1] = (unsigned)(kq - ngt); } }
                LDS_WAIT(); asm volatile("" ::: "memory");
                const int bstar = (int)QPAR[qloc * 4 + 0];
                int ccnt = 0;
                const unsigned cbase = DSA_LDS_ADDR(lds + L_HIST + qloc * 256), mbase = DSA_LDS_ADDR(MASK + qloc * DSA_MSTR);
                const int thi16 = (bstar + 1) << 8;
                __syncthreads();
                { v4u tw[4];
#pragma unroll
                  for (int i = 0; i < 4; ++i) tw[i] = *(const GAS v4u*)(tqb + (size_t)(i < 2 * ns ? i : 0) * 8192);
                  for (int kt0 = 0; kt0 < 2 * ns; kt0 += 4) {
#pragma unroll
                    for (int i = 0; i < 4; ++i) { const int kt = kt0 + i; if (kt < 2 * ns && 32 * kt <= pmaxw) {
                        const v4u cw = tw[i]; { const int kn = kt + 4 < 2 * ns ? kt + 4 : kt; tw[i] = *(const GAS v4u*)(tqb + (size_t)kn * 8192); }
                        unsigned bits = 0u;
#pragma unroll
                        for (int e = 0; e < 8; ++e) { const unsigned tq = (e & 1) ? cw[e >> 1] >> 16 : cw[e >> 1] & 0xffffu; const int kk = 32 * kt + 8 * g4 + e;
                            bits |= (int)(short)tq >= thi16 ? 1u << (8 * g4 + e) : 0u;
                            const bool cand = (int)(tq >> 8) == bstar; const unsigned long long m = __ballot(cand);
                            if (m) {
                                const unsigned long long mq = (m >> ql) & 0x0001000100010001ull;
                                const int rank = __popcll(mq & ((1ull << (16 * g4)) - 1ull)), tot = __popcll(mq);
                                if (cand) { const int slot = ccnt + rank; if (slot < DSA_CAP) asm volatile("ds_write_b32 %0, %1" :: "v"(cbase + 4u * (unsigned)slot), "v"((tq << 16) | (0xffffu - (unsigned)kk)) : "memory"); }
                                ccnt += tot; } }
                        bits |= __shfl_xor(bits, 16); bits |= __shfl_xor(bits, 32);
                        if (g4 == 0) asm volatile("ds_write_b32 %0, %1" :: "v"(mbase + 4u * (unsigned)kt), "v"(bits) : "memory"); } }
                  } }
                if (g4 == 0) CCNT[qloc] = (unsigned)ccnt;
                LDS_WAIT(); asm volatile("" ::: "memory");
#pragma unroll 1
                for (int qq = 0; qq < 16; ++qq) { const int q = 16 * wave + qq;
                    int cnt = (int)CCNT[q]; cnt = cnt < DSA_CAP ? cnt : DSA_CAP; cnt = __builtin_amdgcn_readfirstlane(cnt);
                    const int need = (int)QPAR[q * 4 + 1];
                    const LAS unsigned* cc_ = (const LAS unsigned*)(lds + L_HIST + q * 256);
                    const unsigned cme = lane < cnt ? cc_[lane] : 0u; const unsigned kme = 0xffffu - (cme & 0xffffu); int rank = 0;
                    for (int t = 0; t < cnt; ++t) rank += (unsigned)__builtin_amdgcn_readlane((int)cme, t) > cme ? 1 : 0;
                    if (lane < cnt && rank < need) __hip_atomic_fetch_or(MASK + q * DSA_MSTR + (kme >> 5), 1u << (kme & 31u), __ATOMIC_RELAXED, __HIP_MEMORY_SCOPE_WORKGROUP); }
                if (j >= 17) {
                    unsigned short* lstg = LISTG + ((size_t)((b * 32 + j) * 128 + 16 * wave)) * 256;
                    if (lane < 16) QPAR[(16 * wave + lane) * 4 + 2] = 0u;
#pragma unroll 1
                    for (int qq = 0; qq < 16; ++qq) { const int q = 16 * wave + qq; const int pq = 16 + 128 * j + q;
#pragma unroll 1
                        for (int rr = 0; rr < 3; ++rr) { const int kt = 64 * rr + lane;
                            unsigned w = (kt <= (pq >> 5)) ? MASK[q * DSA_MSTR + (kt < DSA_MSTR ? kt : 0)] : 0u;
                            const int cw = __popc(w);
                            int pos = cw ? (int)__hip_atomic_fetch_add(QPAR + q * 4 + 2, (unsigned)cw, __ATOMIC_RELAXED, __HIP_MEMORY_SCOPE_WORKGROUP) : 0;
                            while (w) { const int bpos = __builtin_ctz(w); w &= w - 1u; if (pos < 256) lstg[qq * 256 + pos] = (unsigned short)(32 * kt + bpos); ++pos; } } }
                    asm volatile("s_waitcnt vmcnt(0)" ::: "memory");
                    __syncthreads();
                    { int mrow_s = (int)((size_t)b * SEQ + 128 * j + 16 * wave); asm volatile("" : "+s"(mrow_s));
                      dsa_gather(lds + wave * 16384, lds + L_STAGE + wave * 1024, BIAS, kcb, vcb, lstg, QPAR + 16 * wave * 4 + 2, PROJ + (size_t)mrow_s * DP2 + C2_DQ, q_norm_w, Y + (size_t)mrow_s * D + 512, 16 + 128 * j + 16 * wave, lane); }
                    __syncthreads();
                } else {
                    __syncthreads();
                    int mrow_s = (int)mrow; asm volatile("" : "+v"(mrow_s));
                    dsa_sweep<4>(lds, 0, kcb, vtb, PROJ + (size_t)mrow_s * DP2 + C2_DQ, q_norm_w, Y + (size_t)mrow_s * D + 512, ns, p, 16 + 128 * j + 16 * wave, qloc, wave, lane);
                    dsa_sweep<4>(lds, 4, kcb, vtb, PROJ + (size_t)mrow_s * DP2 + C2_DQ, q_norm_w, Y + (size_t)mrow_s * D + 512, ns, p, 16 + 128 * j + 16 * wave, qloc, wave, lane);
                }
            }
            __syncthreads();
        }
        {
            LAS unsigned char* Kimg = lds + RING_OFF; LAS unsigned char* Vimg = Kimg + 128 * IMG_STRIDE; LAS unsigned char* Simg = Vimg + 128 * IMG_STRIDE;
            const int cq = 16 * wave + (lane & 15), g4 = lane >> 4;
            v4u pk[2][2], pv[4], ps[4], pq[4];
#define R3_GRAB(dst) do { if (tid == 0) MISC[5] = __hip_atomic_fetch_add(ctl + 2048 + 64 * 16, 1u, __ATOMIC_RELAXED, __HIP_MEMORY_SCOPE_AGENT); __syncthreads(); dst = (int)MISC[5]; __syncthreads(); } while (0)
#define R3_LOAD(U_) do { const int b_ = (U_) >> 7, h_ = ((U_) >> 5) & 3, n_ = ((U_) & 31) + 1; const size_t r0_ = (size_t)b_ * SEQ + 128 * (n_ - 1); \
                _Pragma("unroll") for (int i_ = 0; i_ < 2; ++i_) { const int item = tid + 512 * i_, c = item >> 3, j = item & 7; const bf16* rp = RET + ((size_t)(4 + h_) * M + r0_ + c) * 128 + 8 * j; pk[i_][0] = *(const GAS v4u*)rp; pk[i_][1] = *(const GAS v4u*)(rp + 64); } \
                const bf16* sp_ = SPT + ((size_t)((b_ * 4 + h_) * 32 + (n_ - 1))) * 16384; \
                _Pragma("unroll") for (int i_ = 0; i_ < 4; ++i_) { const int item = tid + 512 * i_, c = item >> 4, part = item & 15; pv[i_] = *(const GAS v4u*)(RET + ((size_t)(8 + h_) * M + r0_ + c) * 128 + 8 * part); ps[i_] = *(const GAS v4u*)(sp_ + c * 128 + 8 * part); } \
                { const bf16* rp = RET + ((size_t)h_ * M + r0_ + cq) * 128 + 8 * g4; pq[0] = *(const GAS v4u*)rp; pq[1] = *(const GAS v4u*)(rp + 32); pq[2] = *(const GAS v4u*)(rp + 64); pq[3] = *(const GAS v4u*)(rp + 96); } } while (0)
            int unit; R3_GRAB(unit);
            if (unit < BATCH * 4 * 32) R3_LOAD(unit);
            for (;;) {
                if (unit >= BATCH * 4 * 32) break;
                int unit_nx; R3_GRAB(unit_nx);
                const int b = unit >> 7, h = (unit >> 5) & 3, n = (unit & 31) + 1;
                const float lg2 = log2f(1.f - exp2f(-5.f - (float)h));
                const size_t row0 = (size_t)b * SEQ + 128 * (n - 1);
#pragma unroll
                for (int i_ = 0; i_ < 2; ++i_) { const int item = tid + 512 * i_, c = item >> 3, j = item & 7;
                    const int t = 128 * n - 112 + c; const GAS f32x4* rq = (const GAS f32x4*)(ROPE + ((size_t)t * 64 + 8 * j) * 2); f32x4 cs[4]; cs[0] = rq[0]; cs[1] = rq[1]; cs[2] = rq[2]; cs[3] = rq[3];
                    v4u o1, o2; rot8(pk[i_][0], pk[i_][1], cs, RET_KSCALE, o1, o2);
                    *(LAS v4u*)(Kimg + c * IMG_STRIDE + 16 * j) = o1; *(LAS v4u*)(Kimg + c * IMG_STRIDE + 128 + 16 * j) = o2; }
#pragma unroll
                for (int i_ = 0; i_ < 4; ++i_) { const int item = tid + 512 * i_, c = item >> 4, part = item & 15;
                    *(LAS v4u*)(Vimg + c * IMG_STRIDE + 16 * part) = pv[i_];
                    *(LAS v4u*)(Simg + c * IMG_STRIDE + 16 * part) = ps[i_]; }
                bf16x8 qf[4];
                { const int t = 128 * n - 112 + cq;
                  const GAS f32x4* ra = (const GAS f32x4*)(ROPE + ((size_t)t * 64 + 8 * g4) * 2); f32x4 c0[4], c1[4];
#pragma unroll
                  for (int i_ = 0; i_ < 4; ++i_) { c0[i_] = ra[i_]; c1[i_] = ra[16 + i_]; }
                  v4u o0, o1, o2, o3; rot8(pq[0], pq[2], c0, 1.f, o0, o2); rot8(pq[1], pq[3], c1, 1.f, o1, o3);
                  qf[0] = __builtin_bit_cast(bf16x8, o0); qf[1] = __builtin_bit_cast(bf16x8, o1); qf[2] = __builtin_bit_cast(bf16x8, o2); qf[3] = __builtin_bit_cast(bf16x8, o3); }
                __syncthreads();
                if (unit_nx < BATCH * 4 * 32) R3_LOAD(unit_nx);
                u32x2v gpre[8];
                { const bf16* gp0 = RET + ((size_t)(12 + h) * M + row0 + cq) * 128 + 4 * g4;
#pragma unroll
                  for (int et = 0; et < 8; ++et) gpre[et] = *(const GAS u32x2v*)(gp0 + 16 * et); }
                f32x4 oin[8], ocr[8];
#pragma unroll
                for (int et = 0; et < 8; ++et) { oin[et] = (f32x4){0.f, 0.f, 0.f, 0.f}; ocr[et] = oin[et]; }
#pragma unroll
                for (int et = 0; et < 8; ++et)
#pragma unroll
                    for (int ks = 0; ks < 4; ++ks) ocr[et] = MFMA16(frag_n(Simg, IMG_STRIDE, 16 * et + (lane & 15), 32 * ks, lane), qf[ks], ocr[et]);
                const int kgmax = wave >> 1;
                for (int kg = 0; kg <= kgmax; ++kg) {
                    f32x4 st[2];
#pragma unroll
                    for (int u = 0; u < 2; ++u) { st[u] = (f32x4){0.f, 0.f, 0.f, 0.f};
                        const int mrow = 32 * kg + 8 * ((lane & 15) >> 2) + 4 * u + (lane & 3);
#pragma unroll
                        for (int ks = 0; ks < 4; ++ks) st[u] = MFMA16(frag_n(Kimg, IMG_STRIDE, mrow, 32 * ks, lane), qf[ks], st[u]); }
                    float pv[8];
#pragma unroll
                    for (int u = 0; u < 2; ++u)
#pragma unroll
                        for (int r = 0; r < 4; ++r) { const int m = 32 * kg + 8 * g4 + 4 * u + r; const int dd = cq - m; pv[4 * u + r] = dd >= 0 ? st[u][r] * exp2f(lg2 * (float)dd) : 0.f; }
                    const v4u pw = (v4u){pkbf(pv[0], pv[1]), pkbf(pv[2], pv[3]), pkbf(pv[4], pv[5]), pkbf(pv[6], pv[7])};
                    const bf16x8 pf = __builtin_bit_cast(bf16x8, pw);
#pragma unroll
                    for (int et = 0; et < 8; ++et) oin[et] = MFMA16(frag_t(Vimg, IMG_STRIDE, 16 * et, 32 * kg, lane), pf, oin[et]);
                }
                const float xi = exp2f(lg2 * (float)(cq + 1)); float ss = 0.f;
#pragma unroll
                for (int et = 0; et < 8; ++et) { oin[et] = oin[et] + ocr[et] * xi; ss += (oin[et][0] * oin[et][0] + oin[et][1] * oin[et][1]) + (oin[et][2] * oin[et][2] + oin[et][3] * oin[et][3]); }
                ss += __shfl_xor(ss, 16); ss += __shfl_xor(ss, 32);
                const float rinv = 1.f / sqrtf(ss * (1.f / 128.f) + EPS);
                bf16* yp = Y + (row0 + cq) * D + 128 * h + 4 * g4; const float* wn = ret_norm_w + 128 * h + 4 * g4;
#pragma unroll
                for (int et = 0; et < 8; ++et) { const u32x2v gw2 = gpre[et]; const f32x4 gn = *(const GAS f32x4*)(wn + 16 * et);
                    float gt[4] = {__uint_as_float(gw2[0] << 16), __uint_as_float(gw2[0] & 0xffff0000u), __uint_as_float(gw2[1] << 16), __uint_as_float(gw2[1] & 0xffff0000u)}; float o[4];
#pragma unroll
                    for (int r = 0; r < 4; ++r) { const float sg = gt[r] / (1.f + __expf(-gt[r])); o[r] = oin[et][r] * rinv * gn[r] * sg; }
                    *(GAS u32x2v*)(yp + 16 * et) = (u32x2v){pkbf(o[0], o[1]), pkbf(o[2], o[3])}; }
                __syncthreads();
                unit = unit_nx;
            }
#undef R3_GRAB
#undef R3_LOAD
        }
        if (BOTH(3)) GRID_BAR();
    }
    if (IN(4)) {
        pg8::Gemm g{Y, WOUT_T, M, D, D}; pg8::StaticOrder S; S.init(M, D, G, (int)blockIdx.x);
        pg8::EpiResBf16Stats E{U, XS, norm1_w, SSQ, D};
        pg8::gemm_phase<pg8::EpiResBf16Stats, pg8::StaticOrder, true, true>(lds + RING_OFF, g, S, E);
        if (BOTH(4)) GRID_BAR();
    }
    if (IN(6)) {
        pg8::Gemm g{U, W1_T, M, FF, D}; pg8::StaticOrder S; S.init(M, FF, G, (int)blockIdx.x);
        pg8::EpiBf16RowScaleRelu2 E{HB, FF, SSQ, 1.f / D, EPS};
        pg8::gemm_phase<pg8::EpiBf16RowScaleRelu2, pg8::StaticOrder, true, true>(lds + RING_OFF, g, S, E);
        if (BOTH(6)) GRID_BAR();
    }
    if (IN(7)) {
        pg8::Gemm g{HB, W2_T, M, D, FF}; pg8::StaticOrder S; S.init(M, D, G, (int)blockIdx.x);
        pg8::EpiResFromBf16 E{U, out, D};
        pg8::gemm_phase<pg8::EpiResFromBf16, pg8::StaticOrder, true, true>(lds + RING_OFF, g, S, E);
    }
#undef IN
#undef BOTH
}

extern "C" void kernel_launch(void* const* d_in, const int* in_sizes, int n_in, void* d_out, int out_size, void* d_ws, size_t ws_size, hipStream_t stream) {
    static int grid = 0;
    if (grid == 0) {
        if (n_in != 12 || in_sizes[0] != M * D || out_size != M * D || ws_size < WS_END) { fprintf(stderr, "kernel_launch: unexpected shapes (n_in %d, in0 %d, out %d, ws %zu); nothing launched\n", n_in, n_in > 0 ? in_sizes[0] : -1, out_size, ws_size); grid = -1; return; }
        int dev = 0, cus = 0, per_cu = 0;
        if (hipGetDevice(&dev) != hipSuccess || hipDeviceGetAttribute(&cus, hipDeviceAttributeMultiprocessorCount, dev) != hipSuccess) { grid = -1; return; }
        if (hipFuncSetAttribute((const void*)mk_fwd, hipFuncAttributeMaxDynamicSharedMemorySize, LDS_BYTES) != hipSuccess) { fprintf(stderr, "kernel_launch: hipFuncSetAttribute failed\n"); grid = -1; return; }
        if (hipOccupancyMaxActiveBlocksPerMultiprocessor(&per_cu, (const void*)mk_fwd, NWAVES * 64, LDS_BYTES) != hipSuccess || per_cu < 1)
            fprintf(stderr, "kernel_launch: note: occupancy query reports %d workgroups per CU\n", per_cu);
        (void)hipGetLastError();
        grid = cus;
    }
    if (grid < 0) return;
    if (hipMemsetAsync((char*)d_ws + WS_CTL, 0, CTL_ZERO_BYTES, stream) != hipSuccess) return;
    Args a{};
    for (int i = 0; i < 12; ++i) a.in[i] = (const float*)d_in[i];
    a.out = (float*)d_out; a.ws = (unsigned char*)d_ws;
    if (ONE_LAUNCH) { a.ph_lo = 0; a.ph_hi = N_PHASES; hipLaunchKernelGGL(mk_fwd, dim3(grid), dim3(NWAVES * 64), LDS_BYTES, stream, a); }
    else for (int p = 0; p < N_PHASES; ++p) { a.ph_lo = p; a.ph_hi = p + 1; hipLaunchKernelGGL(mk_fwd, dim3(grid), dim3(NWAVES * 64), LDS_BYTES, stream, a); }
    const hipError_t le = hipPeekAtLastError();
    if (le != hipSuccess) fprintf(stderr, "kernel_launch: launch failed: %s\n", hipGetErrorName(le));
}
```

```cpp
#include <hip/hip_runtime.h>
#include <cstdio>
#include <cstdint>
namespace pg8 {
#define PG8_LAS __attribute__((address_space(3)))
typedef unsigned short bf16_t;
typedef short bf16x8 __attribute__((ext_vector_type(8)));
typedef float f32x4 __attribute__((ext_vector_type(4)));
typedef unsigned u32x4 __attribute__((ext_vector_type(4)));
constexpr int BM = 256, BK = 64, HALF = 128, HTB = HALF * BK * 2  , STAGE_BYTES = 8 * HTB, NXCD = 8, WGM = 8;

__host__ __device__ __forceinline__ int lds_byte(int r, int c) { const int st = (r >> 4) * 2 + (c >> 5), rr = r & 15, cc = c & 31, ob = rr * 64 + cc * 2; return st * 1024 + (ob ^ (((ob >> 9) & 1) << 5)); }
__host__ __device__ __forceinline__ void stage_rc(int b, int& R, int& C) { const int st = b / 1024, sb = b % 1024, swz = sb ^ (((sb >> 9) & 1) << 5); R = (st >> 1) * 16 + swz / 64; C = (st & 1) * 32 + (swz % 64) / 2; }
__host__ __device__ __forceinline__ int perm32(int rho) { const int n = rho >> 4, i = rho & 15; return 8 * (i >> 2) + 4 * n + (i & 3); }

struct Unit { int pm, pn; };
struct Gemm { const bf16_t* A; const bf16_t* Bt; int M, N, K; };

struct StaticOrder {
    int nM, nN, nwg, G, c;
    __host__ __device__ void init(int M, int N, int G_, int c_) { nM = M / BM; nN = N / BM; nwg = nM * nN; G = G_; c = c_; }
    __host__ __device__ bool next(int i, Unit& u) const {
        const long L = (long)i * G + c; if (L >= nwg) return false;
        int wgid = (int)L; { const int q = nwg / NXCD, r = nwg % NXCD, xcd = wgid % NXCD, off = wgid / NXCD; wgid = (xcd < r ? xcd * (q + 1) : r * (q + 1) + (xcd - r) * q) + off; }
        const int nig = WGM * nN, gid = wgid / nig, fm = gid * WGM, gsz = (nM - fm) < WGM ? (nM - fm) : WGM;
        u.pm = fm + ((wgid % nig) % gsz); u.pn = (wgid % nig) / gsz; return true;
    }
    __device__ __forceinline__ void a_ready(const Unit&) const {}
    __device__ __forceinline__ void done(const Unit&) const {}
};

typedef float f32x2c __attribute__((ext_vector_type(2))); typedef __bf16 bf16x2c __attribute__((ext_vector_type(2)));
__device__ __forceinline__ unsigned cvt_pk_bf16(float lo, float hi) { const f32x2c v = {lo, hi}; const bf16x2c b = __builtin_convertvector(v, bf16x2c); return __builtin_bit_cast(unsigned, b); }

template <int ACT  > struct EpiBf16 {
    static constexpr bool PERM = true, AFTER_DRAIN = false;
    bf16_t* O; int ldc;
    __device__ __forceinline__ void operator()(const f32x4 (&acc)[2][2][4][2], const Unit& u, int wr, int wc, int fr, int fq) const {
        const int row0 = u.pm * BM + wr * 64 + fr; const int col0 = u.pn * BM + wc * 32 + 8 * fq;
#pragma unroll
        for (int ai = 0; ai < 2; ++ai)
#pragma unroll
            for (int m = 0; m < 4; ++m) { bf16_t* rowp = O + (size_t)(row0 + ai * HALF + m * 16) * ldc + col0;
#pragma unroll
                for (int bj = 0; bj < 2; ++bj) { f32x4 v0 = acc[ai][bj][m][0], v1 = acc[ai][bj][m][1];
                    if (ACT == 2) {
#pragma unroll
                        for (int e = 0; e < 4; ++e) { const float a = fmaxf(v0[e], 0.f), b = fmaxf(v1[e], 0.f); v0[e] = a * a; v1[e] = b * b; } }
                    u32x4 w; w.x = cvt_pk_bf16(v0[0], v0[1]); w.y = cvt_pk_bf16(v0[2], v0[3]); w.z = cvt_pk_bf16(v1[0], v1[1]); w.w = cvt_pk_bf16(v1[2], v1[3]);
                    __builtin_nontemporal_store(w, (u32x4*)(rowp + bj * HALF)); } }
    }
};

struct EpiProj {
    static constexpr bool PERM = true, AFTER_DRAIN = false;
    bf16_t* O; int ldc; bf16_t* R; int mrows;
    __device__ __forceinline__ void operator()(const f32x4 (&acc)[2][2][4][2], const Unit& u, int wr, int wc, int fr, int fq) const {
        const int row0 = u.pm * BM + wr * 64 + fr; const int col0 = (u.pn - 8) * BM + wc * 32 + 8 * fq; const bool hm = u.pn < 8;
#pragma unroll
        for (int ai = 0; ai < 2; ++ai)
#pragma unroll
            for (int m = 0; m < 4; ++m) { const int row = row0 + ai * HALF + m * 16;
#pragma unroll
                for (int bj = 0; bj < 2; ++bj) { const f32x4 v0 = acc[ai][bj][m][0], v1 = acc[ai][bj][m][1];
                    u32x4 w; w.x = cvt_pk_bf16(v0[0], v0[1]); w.y = cvt_pk_bf16(v0[2], v0[3]); w.z = cvt_pk_bf16(v1[0], v1[1]); w.w = cvt_pk_bf16(v1[2], v1[3]);
                    bf16_t* p = hm ? R + ((size_t)(u.pn * 2 + bj) * mrows + row) * 128 + wc * 32 + 8 * fq : O + (size_t)row * ldc + col0 + bj * HALF;
                    __builtin_nontemporal_store(w, (u32x4*)p); } }
    }
};

struct EpiResF32 {
    static constexpr bool PERM = true, AFTER_DRAIN = false;
    const float* base; float* out; int ldc;
    __device__ __forceinline__ void operator()(const f32x4 (&acc)[2][2][4][2], const Unit& u, int wr, int wc, int fr, int fq) const {
        const int col0 = u.pn * BM + wc * 32 + 8 * fq;
#pragma unroll
        for (int ai = 0; ai < 2; ++ai)
#pragma unroll
            for (int m = 0; m < 4; ++m) { const size_t off = (size_t)(u.pm * BM + ai * HALF + wr * 64 + m * 16 + fr) * ldc + col0;
#pragma unroll
                for (int bj = 0; bj < 2; ++bj)
#pragma unroll
                    for (int n = 0; n < 2; ++n) { const f32x4 bs = *(const f32x4*)(base + off + bj * HALF + n * 4); *(f32x4*)(out + off + bj * HALF + n * 4) = bs + acc[ai][bj][m][n]; }
                if (m & 1) asm volatile("" ::: "memory"); }
    }
};
struct EpiResF32Stats {
    static constexpr bool PERM = true, AFTER_DRAIN = false;
    const float* base; float* out; bf16_t* xn; const float* w; float* ss; int ldc;
    __device__ __forceinline__ void operator()(const f32x4 (&acc)[2][2][4][2], const Unit& u, int wr, int wc, int fr, int fq) const {
        const int col0 = u.pn * BM + wc * 32 + 8 * fq;
        f32x4 wv[2][2];
#pragma unroll
        for (int bj = 0; bj < 2; ++bj)
#pragma unroll
            for (int n = 0; n < 2; ++n) wv[bj][n] = *(const f32x4*)(w + col0 + bj * HALF + n * 4);
#pragma unroll
        for (int ai = 0; ai < 2; ++ai)
#pragma unroll
            for (int m = 0; m < 4; ++m) { const int row = u.pm * BM + ai * HALF + wr * 64 + m * 16 + fr; const size_t off = (size_t)row * ldc + col0; float s = 0.f;
#pragma unroll
                for (int bj = 0; bj < 2; ++bj) { f32x4 a[2];
#pragma unroll
                    for (int n = 0; n < 2; ++n) { const f32x4 h = *(const f32x4*)(base + off + bj * HALF + n * 4) + acc[ai][bj][m][n]; *(f32x4*)(out + off + bj * HALF + n * 4) = h;
                        s += (h[0] * h[0] + h[1] * h[1]) + (h[2] * h[2] + h[3] * h[3]); a[n] = h * wv[bj][n]; }
                    u32x4 o; o.x = cvt_pk_bf16(a[0][0], a[0][1]); o.y = cvt_pk_bf16(a[0][2], a[0][3]); o.z = cvt_pk_bf16(a[1][0], a[1][1]); o.w = cvt_pk_bf16(a[1][2], a[1][3]);
                    *(u32x4*)(xn + off + bj * HALF) = o; }
                s += __shfl_xor(s, 16); s += __shfl_xor(s, 32);
                if (fq == 0) __hip_atomic_fetch_add(ss + row, s, __ATOMIC_RELAXED, __HIP_MEMORY_SCOPE_AGENT);
                if (m & 1) asm volatile("" ::: "memory"); }
    }
};
struct EpiBf16RowScaleRelu2 {
    static constexpr bool PERM = true, AFTER_DRAIN = false;
    bf16_t* O; int ldc; const float* ss; float inv_n, eps;
    __device__ __forceinline__ void operator()(const f32x4 (&acc)[2][2][4][2], const Unit& u, int wr, int wc, int fr, int fq) const {
        const int row0 = u.pm * BM + wr * 64 + fr; const int col0 = u.pn * BM + wc * 32 + 8 * fq;
#pragma unroll
        for (int ai = 0; ai < 2; ++ai)
#pragma unroll
            for (int m = 0; m < 4; ++m) { const int row = row0 + ai * HALF + m * 16; bf16_t* rowp = O + (size_t)row * ldc + col0; const float ri = 1.f / sqrtf(ss[row] * inv_n + eps);
#pragma unroll
                for (int bj = 0; bj < 2; ++bj) { f32x4 v0 = acc[ai][bj][m][0], v1 = acc[ai][bj][m][1];
#pragma unroll
                    for (int e = 0; e < 4; ++e) { const float a = fmaxf(v0[e] * ri, 0.f), b = fmaxf(v1[e] * ri, 0.f); v0[e] = a * a; v1[e] = b * b; }
                    u32x4 w; w.x = cvt_pk_bf16(v0[0], v0[1]); w.y = cvt_pk_bf16(v0[2], v0[3]); w.z = cvt_pk_bf16(v1[0], v1[1]); w.w = cvt_pk_bf16(v1[2], v1[3]);
                    __builtin_nontemporal_store(w, (u32x4*)(rowp + bj * HALF)); } }
    }
};

struct EpiResBf16Stats {
    static constexpr bool PERM = true, AFTER_DRAIN = false;
    bf16_t* xn; const float* xs; const float* w1; float* ss; int ldc;
    __device__ __forceinline__ void operator()(const f32x4 (&acc)[2][2][4][2], const Unit& u, int wr, int wc, int fr, int fq) const {
        const int col0 = u.pn * BM + wc * 32 + 8 * fq;
        f32x4 iw[2][2];
#pragma unroll
        for (int bj = 0; bj < 2; ++bj)
#pragma unroll
            for (int n = 0; n < 2; ++n) { const f32x4 g = *(const f32x4*)(w1 + col0 + bj * HALF + n * 4); iw[bj][n] = (f32x4){1.f / g[0], 1.f / g[1], 1.f / g[2], 1.f / g[3]}; }
#pragma unroll
        for (int ai = 0; ai < 2; ++ai)
#pragma unroll
            for (int m = 0; m < 4; ++m) { const int row = u.pm * BM + ai * HALF + wr * 64 + m * 16 + fr; const size_t off = (size_t)row * ldc + col0; float s = 0.f; const float xr = xs[row];
#pragma unroll
                for (int bj = 0; bj < 2; ++bj) { const u32x4 b = *(const u32x4*)(xn + off + bj * HALF); f32x4 h[2];
                    h[0] = (f32x4){__uint_as_float(b.x << 16), __uint_as_float(b.x & 0xffff0000u), __uint_as_float(b.y << 16), __uint_as_float(b.y & 0xffff0000u)} * iw[bj][0] * xr + acc[ai][bj][m][0];
                    h[1] = (f32x4){__uint_as_float(b.z << 16), __uint_as_float(b.z & 0xffff0000u), __uint_as_float(b.w << 16), __uint_as_float(b.w & 0xffff0000u)} * iw[bj][1] * xr + acc[ai][bj][m][1];
#pragma unroll
                    for (int n = 0; n < 2; ++n) s += (h[n][0] * h[n][0] + h[n][1] * h[n][1]) + (h[n][2] * h[n][2] + h[n][3] * h[n][3]);
                    u32x4 o; o.x = cvt_pk_bf16(h[0][0], h[0][1]); o.y = cvt_pk_bf16(h[0][2], h[0][3]); o.z = cvt_pk_bf16(h[1][0], h[1][1]); o.w = cvt_pk_bf16(h[1][2], h[1][3]);
                    *(u32x4*)(xn + off + bj * HALF) = o; }
                s += __shfl_xor(s, 16); s += __shfl_xor(s, 32);
                if (fq == 0) __hip_atomic_fetch_add(ss + row, s, __ATOMIC_RELAXED, __HIP_MEMORY_SCOPE_AGENT);
                if (m & 1) asm volatile("" ::: "memory"); }
    }
};
struct EpiResFromBf16 {
    static constexpr bool PERM = true, AFTER_DRAIN = false;
    const bf16_t* base; float* out; int ldc;
    __device__ __forceinline__ void operator()(const f32x4 (&acc)[2][2][4][2], const Unit& u, int wr, int wc, int fr, int fq) const {
        const int col0 = u.pn * BM + wc * 32 + 8 * fq;
#pragma unroll
        for (int ai = 0; ai < 2; ++ai)
#pragma unroll
            for (int m = 0; m < 4; ++m) { const size_t off = (size_t)(u.pm * BM + ai * HALF + wr * 64 + m * 16 + fr) * ldc + col0;
#pragma unroll
                for (int bj = 0; bj < 2; ++bj) { const u32x4 b = *(const u32x4*)(base + off + bj * HALF);
                    const f32x4 b0 = (f32x4){__uint_as_float(b.x << 16), __uint_as_float(b.x & 0xffff0000u), __uint_as_float(b.y << 16), __uint_as_float(b.y & 0xffff0000u)};
                    const f32x4 b1 = (f32x4){__uint_as_float(b.z << 16), __uint_as_float(b.z & 0xffff0000u), __uint_as_float(b.w << 16), __uint_as_float(b.w & 0xffff0000u)};
                    __builtin_nontemporal_store(b0 + acc[ai][bj][m][0], (f32x4*)(out + off + bj * HALF)); __builtin_nontemporal_store(b1 + acc[ai][bj][m][1], (f32x4*)(out + off + bj * HALF + 4)); }
                if (m & 1) asm volatile("" ::: "memory"); }
    }
};
template <class Epi, class Sched, bool ALIGN_EPI = false, bool SP2 = false>
__device__ __forceinline__ void gemm_phase(PG8_LAS unsigned char* lds, const Gemm g, const Sched& S, const Epi& E) {
    const int tid = threadIdx.x, wid = __builtin_amdgcn_readfirstlane(tid >> 6), lane = tid & 63, wr = wid >> 2, wc = wid & 3, fr = lane & 15, fq = lane >> 4;
    const int K = g.K, nt = K / BK;
    unsigned voffA[2], voffB[2];
#pragma unroll
    for (int i = 0; i < 2; ++i) { int R, C; stage_rc(tid * 16 + i * 8192, R, C); const int Rb = Epi::PERM ? ((R & ~31) + perm32(R & 31)) : R;
        voffA[i] = (unsigned)(R * K + C) * 2u; voffB[i] = (unsigned)(Rb * K + C) * 2u; }
    const size_t kstep = (size_t)(BK * 2);
    const size_t hstep = (size_t)HALF * K * 2;
    const size_t tstep = 2 * hstep;
    const unsigned ldsw = (unsigned)wid * 1024u;
    const int aoff = lds_byte(wr * 64 + fr, fq * 8), boff = lds_byte(wc * 32 + fr, fq * 8);
#define PG8_SA(b, h) (((b) * 2 + (h)) * HTB)
#define PG8_SB(b, h) ((4 + (b) * 2 + (h)) * HTB)
#define PG8_STAGE(bufoff, gbase, voff) do { _Pragma("unroll") for (int _i = 0; _i < 2; ++_i) \
        __builtin_amdgcn_global_load_lds((const unsigned*)((const char*)(gbase) + (voff)[_i]), (PG8_LAS unsigned*)(lds + (bufoff) + ldsw + _i * 8192), 16, 0, 0); } while (0)
#define PG8_LDA(dst, b, h) do { _Pragma("unroll") for (int m = 0; m < 4; ++m) _Pragma("unroll") for (int k = 0; k < 2; ++k) dst[m][k] = *(const PG8_LAS bf16x8*)(lds + PG8_SA(b, h) + aoff + m * 2048 + k * 1024); } while (0)
#define PG8_LDB(dst, b, h) do { _Pragma("unroll") for (int n = 0; n < 2; ++n) _Pragma("unroll") for (int k = 0; k < 2; ++k) dst[n][k] = *(const PG8_LAS bf16x8*)(lds + PG8_SB(b, h) + boff + n * 2048 + k * 1024); } while (0)
#define PG8_MMA(ai, bj, At, Bt) do { __builtin_amdgcn_s_setprio(1); _Pragma("unroll") for (int m = 0; m < 4; ++m) _Pragma("unroll") for (int n = 0; n < 2; ++n) _Pragma("unroll") for (int k = 0; k < 2; ++k) \
        acc[ai][bj][m][n] = __builtin_amdgcn_mfma_f32_16x16x32_bf16(Bt[n][k], At[m][k], acc[ai][bj][m][n], 0, 0, 0); __builtin_amdgcn_s_setprio(0); } while (0)
#define PG8_MMAZ(ai, bj, At, Bt) do { __builtin_amdgcn_s_setprio(1); _Pragma("unroll") for (int m = 0; m < 4; ++m) _Pragma("unroll") for (int n = 0; n < 2; ++n) { \
        const f32x4 c0_ = __builtin_amdgcn_mfma_f32_16x16x32_bf16(Bt[n][0], At[m][0], ((f32x4){0.f, 0.f, 0.f, 0.f}), 0, 0, 0); acc[ai][bj][m][n] = __builtin_amdgcn_mfma_f32_16x16x32_bf16(Bt[n][1], At[m][1], c0_, 0, 0, 0); } __builtin_amdgcn_s_setprio(0); } while (0)
#define PG8_WAIT_V(n) asm volatile("s_waitcnt vmcnt(" #n ")" ::: "memory")
#define PG8_WAIT_L(n) asm volatile("s_waitcnt lgkmcnt(" #n ")" ::: "memory")
#define PG8_BAR __builtin_amdgcn_s_barrier()
#define PG8_SCHED __builtin_amdgcn_sched_barrier(0)
    Unit cur, nxt; int ui = 0;
    if (!S.next(0, cur)) return;
    f32x4 acc[2][2][4][2];
    if constexpr (!SP2) {
#pragma unroll
    for (int a = 0; a < 2; ++a)
#pragma unroll
        for (int b = 0; b < 2; ++b)
#pragma unroll
            for (int m = 0; m < 4; ++m)
#pragma unroll
                for (int n = 0; n < 2; ++n) acc[a][b][m][n] = (f32x4){0.f, 0.f, 0.f, 0.f};
    }
    bf16x8 At[4][2], B0[2][2], B1[2][2];
    const char* cA = (const char*)g.A + (size_t)cur.pm * tstep; const char* cB = (const char*)g.Bt + (size_t)cur.pn * tstep;
    S.a_ready(cur);
    if constexpr (SP2) {
        PG8_STAGE(PG8_SB(0, 0), cB, voffB); PG8_STAGE(PG8_SB(0, 1), cB + hstep, voffB); PG8_STAGE(PG8_SA(0, 0), cA, voffA); PG8_STAGE(PG8_SA(0, 1), cA + hstep, voffA);
        if (wr == 1) PG8_BAR;
        PG8_WAIT_V(2); PG8_BAR;
        PG8_STAGE(PG8_SB(1, 0), cB + kstep, voffB); PG8_STAGE(PG8_SA(1, 0), cA + kstep, voffA); PG8_STAGE(PG8_SB(1, 1), cB + hstep + kstep, voffB);
        PG8_WAIT_V(6); PG8_BAR;
    } else {
        PG8_STAGE(PG8_SB(0, 0), cB, voffB); PG8_STAGE(PG8_SA(0, 0), cA, voffA); PG8_STAGE(PG8_SB(0, 1), cB + hstep, voffB); PG8_STAGE(PG8_SA(0, 1), cA + hstep, voffA);
        if (wr == 1) PG8_BAR;
        PG8_WAIT_V(4); PG8_BAR;
        PG8_STAGE(PG8_SB(1, 0), cB + kstep, voffB); PG8_STAGE(PG8_SA(1, 0), cA + kstep, voffA); PG8_STAGE(PG8_SB(1, 1), cB + hstep + kstep, voffB);
        PG8_WAIT_V(6); PG8_BAR;
    }
    for (;;) {
        const bool has_next = S.next(ui + 1, nxt);
        const char* nA = has_next ? (const char*)g.A + (size_t)nxt.pm * tstep : cA; const char* nB = has_next ? (const char*)g.Bt + (size_t)nxt.pn * tstep : cB;
#define PG8_KPTRS \
            const bool last = (t == nt - 2); \
            const char* a1 = cA + (size_t)(t + 1) * kstep;                                             \
            const char* a2 = last ? nA : cA + (size_t)(t + 2) * kstep; const char* b2 = last ? nB : cB + (size_t)(t + 2) * kstep;     \
            const char* a3 = a2 + kstep; const char* b3 = b2 + kstep;                                \
            if (last && has_next) S.a_ready(nxt);
#define PG8_KITER(MM0) \
            PG8_LDB(B0, 0, 0); PG8_LDB(B1, 0, 1); PG8_SCHED; PG8_LDA(At, 0, 0); PG8_STAGE(PG8_SA(1, 1), a1 + hstep, voffA); \
            PG8_WAIT_V(8); PG8_WAIT_L(0); PG8_BAR; MM0(0, 0, At, B0); MM0(0, 1, At, B1); PG8_BAR; PG8_SCHED; \
            PG8_LDA(At, 0, 1); PG8_STAGE(PG8_SB(0, 0), b2, voffB); PG8_STAGE(PG8_SB(0, 1), b2 + hstep, voffB); PG8_STAGE(PG8_SA(0, 0), a2, voffA); \
            PG8_WAIT_V(8); PG8_WAIT_L(0); PG8_BAR; MM0(1, 0, At, B0); MM0(1, 1, At, B1); PG8_BAR; PG8_SCHED; \
            PG8_LDB(B0, 1, 0); PG8_LDB(B1, 1, 1); PG8_SCHED; PG8_LDA(At, 1, 0); PG8_STAGE(PG8_SA(0, 1), a2 + hstep, voffA); \
            PG8_WAIT_V(8); PG8_WAIT_L(0); PG8_BAR; PG8_MMA(0, 0, At, B0); PG8_MMA(0, 1, At, B1); PG8_BAR; PG8_SCHED; \
            PG8_LDA(At, 1, 1); PG8_STAGE(PG8_SB(1, 0), b3, voffB); PG8_STAGE(PG8_SB(1, 1), b3 + hstep, voffB); PG8_STAGE(PG8_SA(1, 0), a3, voffA); \
            PG8_WAIT_V(8); PG8_WAIT_L(0); PG8_BAR; PG8_MMA(1, 0, At, B0); PG8_MMA(1, 1, At, B1); PG8_BAR; PG8_SCHED;
        int t0 = 0;
        if constexpr (SP2) { const int t = 0; PG8_KPTRS PG8_KITER(PG8_MMAZ) t0 = 2; }
        for (int t = t0; t < nt; t += 2) {
            PG8_KPTRS
            if constexpr (SP2) {
            PG8_KITER(PG8_MMA)
            } else {
            PG8_LDB(B0, 0, 0); PG8_SCHED; PG8_LDA(At, 0, 0); PG8_STAGE(PG8_SA(1, 1), a1 + hstep, voffA);
            PG8_WAIT_L(8); PG8_BAR; PG8_WAIT_L(0); PG8_MMA(0, 0, At, B0); PG8_BAR; PG8_SCHED;
            PG8_LDB(B1, 0, 1); PG8_STAGE(PG8_SB(0, 0), b2, voffB);
            PG8_BAR; PG8_WAIT_L(0); PG8_MMA(0, 1, At, B1); PG8_BAR;
            PG8_LDA(At, 0, 1); PG8_STAGE(PG8_SA(0, 0), a2, voffA);
            PG8_BAR; PG8_WAIT_L(0); PG8_MMA(1, 0, At, B0); PG8_BAR; PG8_SCHED;
            PG8_STAGE(PG8_SB(0, 1), b2 + hstep, voffB);
            PG8_WAIT_V(6); PG8_BAR; PG8_MMA(1, 1, At, B1); PG8_BAR;
            PG8_LDB(B0, 1, 0); PG8_SCHED; PG8_LDA(At, 1, 0); PG8_STAGE(PG8_SA(0, 1), a2 + hstep, voffA);
            PG8_WAIT_L(8); PG8_BAR; PG8_WAIT_L(0); PG8_MMA(0, 0, At, B0); PG8_BAR; PG8_SCHED;
            PG8_LDB(B1, 1, 1); PG8_STAGE(PG8_SB(1, 0), b3, voffB);
            PG8_BAR; PG8_WAIT_L(0); PG8_MMA(0, 1, At, B1); PG8_BAR;
            PG8_LDA(At, 1, 1); PG8_STAGE(PG8_SA(1, 0), a3, voffA);
            PG8_BAR; PG8_WAIT_L(0); PG8_MMA(1, 0, At, B0); PG8_BAR; PG8_SCHED;
            PG8_STAGE(PG8_SB(1, 1), b3 + hstep, voffB);
            PG8_WAIT_V(6); PG8_BAR; PG8_MMA(1, 1, At, B1); PG8_BAR;
            }
        }
        if constexpr (ALIGN_EPI) { if (wr == 0) PG8_BAR; }
        if constexpr (!Epi::AFTER_DRAIN) { int ln_ = lane; asm volatile("" : "+v"(ln_));
            E(acc, cur, wr, wc, ln_ & 15, ln_ >> 4); S.done(cur); }
        if (!has_next) break;
        if constexpr (!SP2) {
#pragma unroll
        for (int a = 0; a < 2; ++a)
#pragma unroll
            for (int b = 0; b < 2; ++b)
#pragma unroll
                for (int m = 0; m < 4; ++m)
#pragma unroll
                    for (int n = 0; n < 2; ++n) acc[a][b][m][n] = (f32x4){0.f, 0.f, 0.f, 0.f};
        }
        cur = nxt; cA = nA; cB = nB; ++ui;
        if constexpr (ALIGN_EPI) { if (wr == 1) PG8_BAR; }
    }
    PG8_WAIT_V(0);
    if constexpr (!ALIGN_EPI) { if (wr == 0) PG8_BAR; }
    PG8_BAR;
    if constexpr (Epi::AFTER_DRAIN) { E.fused(acc, cur, wr, wc, fr, fq, lds, wid, lane); S.done(cur); }
#undef PG8_SA
#undef PG8_SB
#undef PG8_STAGE
#undef PG8_LDA
#undef PG8_LDB
#undef PG8_MMA
#undef PG8_MMAZ
#undef PG8_KPTRS
#undef PG8_KITER
#undef PG8_WAIT_V
#undef PG8_WAIT_L
#undef PG8_BAR
#undef PG8_SCHED
}
}
constexpr int NWAVES = 8;
#ifndef MK_N_LAUNCHES
#define MK_N_LAUNCHES 1
#endif
constexpr int N_PHASES = 8;
constexpr bool ONE_LAUNCH = (MK_N_LAUNCHES == 1);

constexpr int BATCH = 16, SEQ = 4096, D = 1024, NMETA = 16, TK = SEQ + NMETA, FF = 4096;
constexpr int M = BATCH * SEQ;
constexpr int DIN = 3272, DINP = 3328;
constexpr int C_RQ = 0, C_RK = 512, C_RV = 1024, C_RG = 1536, C_DQ = 2048, C_DK = 2560, C_DV = 2624, C_IQ = 2688, C_IK = 3200, C_IW = 3264;
constexpr int DP2 = 1280;
constexpr int C2_DQ = C_DQ - 2048, C2_DK = C_DK - 2048, C2_DV = C_DV - 2048, C2_IQ = C_IQ - 2048, C2_IK = C_IK - 2048, C2_IW = C_IW - 2048;
constexpr float EPS = 1e-6f;
constexpr int KROWS = 4160;

constexpr size_t MiB = 1u << 20;
constexpr size_t WS_CTL = 0, CTL_ZERO_BYTES = 1 * MiB;
constexpr size_t WS_WIN = 2 * MiB;
constexpr size_t WS_WOUT = 9 * MiB;
constexpr size_t WS_W1 = 11 * MiB;
constexpr size_t WS_W2 = 19 * MiB;
constexpr size_t WS_ROPE = 27 * MiB;
constexpr size_t WS_PMETA = 30 * MiB;
constexpr size_t WS_KC = 32 * MiB;
constexpr size_t WS_IKC = 41 * MiB;
constexpr size_t WS_VT = 50 * MiB;
constexpr size_t WS_U = 64 * MiB;
constexpr size_t WS_PROJ = 192 * MiB;
constexpr size_t WS_RET = 352 * MiB;
constexpr size_t WS_QN = 608 * MiB;
constexpr size_t WS_SPT = 672 * MiB;
constexpr size_t WS_Y = 736 * MiB;
constexpr size_t WS_H = 192 * MiB;
constexpr size_t WS_TQ2 = 864 * MiB;
constexpr size_t WS_LIST = 864 * MiB;
constexpr size_t WS_END = 1024 * MiB;
static_assert(WS_H + (size_t)M * FF * 2 <= WS_Y && WS_Y + (size_t)M * D * 2 <= WS_END, "d_ws map");
constexpr int CW_TMO = 0, CW_CODE = 1;
constexpr int CW_BAR = 4096;

constexpr int RING_OFF = 0, RING_BYTES = 131072;
constexpr int LDS_BYTES = 163840;
constexpr int LDSCTL_OFF = LDS_BYTES - 512, MISC_OFF = LDSCTL_OFF + 320;
static_assert(MISC_OFF + 128 <= LDS_BYTES, "LDS map");
#define GAS __attribute__((address_space(1)))
#define LAS __attribute__((address_space(3)))
typedef unsigned short bf16;
typedef unsigned v4u __attribute__((ext_vector_type(4)));
typedef float f32x4 __attribute__((ext_vector_type(4)));
typedef short bf16x8 __attribute__((ext_vector_type(8)));
typedef GAS unsigned gu32;
typedef GAS unsigned long long gu64;
#define RLX_AGENT __ATOMIC_RELAXED, __HIP_MEMORY_SCOPE_AGENT
#define LDS_WAIT() asm volatile("s_waitcnt lgkmcnt(0)" ::: "memory")
#define VM_WAIT() asm volatile("s_waitcnt vmcnt(0)" ::: "memory")
__device__ __forceinline__ unsigned long long rt() { return __builtin_amdgcn_s_memrealtime(); }
__device__ __forceinline__ unsigned f2bf(float f) { unsigned u = __builtin_bit_cast(unsigned, f); return (u + 0x7fffu + ((u >> 16) & 1u)) >> 16; }
__device__ __forceinline__ unsigned pk2(float lo, float hi) { return f2bf(lo) | (f2bf(hi) << 16); }

#define XB_TMO      128
#define XB_XCNT(j)  (256  + 64 * (j))
#define XB_XSUB(j)  (1280 + 64 * (j))
#define XB_XGEN(j)  (2304 + 64 * (j))
#define XB_TOP      3328
#define XB_TOPGEN   3392
#define XCD_BAR_WORDS 3456
#define XB_SPIN_CAP (1u << 22)

__device__ __forceinline__ unsigned xb_ld(unsigned* p)              { return __hip_atomic_load(p, __ATOMIC_RELAXED, __HIP_MEMORY_SCOPE_AGENT); }
__device__ __forceinline__ unsigned xb_add(unsigned* p, unsigned v) { return __hip_atomic_fetch_add(p, v, __ATOMIC_RELAXED, __HIP_MEMORY_SCOPE_AGENT); }
__device__ __forceinline__ unsigned xb_xcc_id() { return (unsigned)__builtin_amdgcn_s_getreg((3 << 11) | 20) & 0xFu; }
#define XB_SPIN(cond, bar) do { unsigned _sp = 0; while (cond) { __builtin_amdgcn_s_sleep(1); \
    if ((++_sp & 255u) == 0u) { if (xb_ld(&(bar)[XB_TMO])) break; if (_sp > XB_SPIN_CAP) { atomicAdd(&(bar)[XB_TMO], 1u); break; } } } } while (0)

struct XcdBarrier {
    unsigned* bar; unsigned x;
    volatile LAS unsigned* st;
};

__device__ __forceinline__ XcdBarrier xcd_barrier_post(unsigned* bar, volatile LAS unsigned* st) {
    XcdBarrier b; b.bar = bar; b.x = xb_xcc_id(); b.st = st;
    if (threadIdx.x == 0) (void)xb_add(&bar[XB_XCNT(b.x)], 1u);
    return b;
}
__device__ __forceinline__ void xcd_barrier_complete(unsigned* bar, unsigned x, unsigned& nloc, unsigned& nx) {
    const unsigned G = gridDim.x * gridDim.y * gridDim.z;
    unsigned sum, cnt, mine, sp = 0u;
    for (;;) {
        sum = 0u; cnt = 0u; mine = 0u;
#pragma unroll
        for (unsigned j = 0; j < 16; ++j) { const unsigned c = xb_ld(&bar[XB_XCNT(j)]); sum += c; cnt += (c > 0u) ? 1u : 0u; mine = (j == x) ? c : mine; }
        if (sum == G) break;
        __builtin_amdgcn_s_sleep(1);
        if ((++sp & 255u) == 0u) { if (xb_ld(&bar[XB_TMO])) break; if (sp > XB_SPIN_CAP) { atomicAdd(&bar[XB_TMO], 1u); break; } }
    }
    nloc = mine > 0u ? mine : 1u; nx = cnt > 0u ? cnt : 1u;
}

__device__ __forceinline__ void xcd_barrier(const XcdBarrier& b) {
    asm volatile("s_waitcnt vmcnt(0)" ::: "memory");
    __syncthreads();
    if (threadIdx.x == 0) {
        unsigned* bar = b.bar;
        __builtin_amdgcn_s_waitcnt(0);
        unsigned nloc = b.st[0], nx = b.st[1];
        if (nloc == 0u) { xcd_barrier_complete(bar, b.x, nloc, nx); b.st[0] = nloc; b.st[1] = nx; }
        const unsigned old = xb_add(&bar[XB_XSUB(b.x)], 1u);
        const unsigned gen = old / nloc;
        if (old + 1u == (gen + 1u) * nloc) {
            __builtin_amdgcn_fence(__ATOMIC_RELEASE, "agent");
            asm volatile("s_waitcnt vmcnt(0)" ::: "memory");
            const unsigned og = xb_add(&bar[XB_TOP], 1u);
            const unsigned tg = og / nx;
            if (og + 1u == (tg + 1u) * nx) xb_add(&bar[XB_TOPGEN], 1u);
            else XB_SPIN(xb_ld(&bar[XB_TOPGEN]) == tg, bar);
            __builtin_amdgcn_fence(__ATOMIC_ACQUIRE, "agent");
            xb_add(&bar[XB_XGEN(b.x)], 1u);
            asm volatile("s_waitcnt vmcnt(0)" ::: "memory");
        } else {
            XB_SPIN(xb_ld(&bar[XB_XGEN(b.x)]) == gen, bar);
            __builtin_amdgcn_fence(__ATOMIC_ACQUIRE, "agent");
            asm volatile("s_waitcnt vmcnt(0)" ::: "memory");
        }
    }
    __syncthreads();
}

typedef short v4i16_t __attribute__((ext_vector_type(4)));
typedef float f32x2v __attribute__((ext_vector_type(2)));
typedef unsigned u32x2v __attribute__((ext_vector_type(2)));
#define MFMA16(a, b, c) __builtin_amdgcn_mfma_f32_16x16x32_bf16((a), (b), (c), 0, 0, 0)
__device__ __forceinline__ float bf2f(unsigned short u) { return __uint_as_float((unsigned)u << 16); }
__device__ __forceinline__ bf16x8 frag_n(const LAS unsigned char* img, int stride, int rowsel, int k0, int lane) {
    return *(const LAS bf16x8*)(img + rowsel * stride + (k0 + 8 * (lane >> 4)) * 2);
}
__device__ __forceinline__ bf16x8 frag_t(const LAS unsigned char* img, int stride, int row0, int k0, int lane) {
    const int g = lane >> 4, q = (lane >> 2) & 3, p = lane & 3;
    const LAS unsigned char* a = img + (k0 + 8 * g + q) * stride + (row0 + 4 * p) * 2;
    const v4i16_t lo = __builtin_amdgcn_ds_read_tr16_b64_v4i16((LAS v4i16_t*)a);
    const v4i16_t hi = __builtin_amdgcn_ds_read_tr16_b64_v4i16((LAS v4i16_t*)(a + 4 * stride));
    return (bf16x8){lo[0], lo[1], lo[2], lo[3], hi[0], hi[1], hi[2], hi[3]};
}
__device__ __forceinline__ unsigned pkbf(float lo, float hi) { return pg8::cvt_pk_bf16(lo, hi); }
#define TR_RD "ds_read_b64_tr_b16 "
__device__ __forceinline__ bf16x8 tr_pack(u32x2v lo, u32x2v hi) { const v4u w = (v4u){lo[0], lo[1], hi[0], hi[1]}; return __builtin_bit_cast(bf16x8, w); }

constexpr int IMG_STRIDE = 288;
constexpr float RET_KSCALE = 0.08838834764831845f;

__device__ __forceinline__ void rot8(const v4u a, const v4u b, const f32x4 (&cs)[4], float sc, v4u& o1, v4u& o2) {
    float x1[8], x2[8], c[8], s[8];
#pragma unroll
    for (int i = 0; i < 4; ++i) { x1[2 * i] = __uint_as_float(a[i] << 16); x1[2 * i + 1] = __uint_as_float(a[i] & 0xffff0000u); x2[2 * i] = __uint_as_float(b[i] << 16); x2[2 * i + 1] = __uint_as_float(b[i] & 0xffff0000u);
        c[2 * i] = cs[i][0]; s[2 * i] = cs[i][1]; c[2 * i + 1] = cs[i][2]; s[2 * i + 1] = cs[i][3]; }
    float r1[8], r2[8];
#pragma unroll
    for (int i = 0; i < 8; ++i) { r1[i] = (x1[i] * c[i] - x2[i] * s[i]) * sc; r2[i] = (x1[i] * s[i] + x2[i] * c[i]) * sc; }
#pragma unroll
    for (int i = 0; i < 4; ++i) { o1[i] = pkbf(r1[2 * i], r1[2 * i + 1]); o2[i] = pkbf(r2[2 * i], r2[2 * i + 1]); }
}
#define DSA_OPAQUE(x) asm volatile("" : "+v"(x))
constexpr int DSA_CAP = 64;
constexpr int DSA_MSTR = 132;
constexpr int L_HIST = 0, L_MASK = 65536, L_QPAR = L_MASK + 128 * DSA_MSTR * 4, L_CCNT = L_QPAR + 128 * 16, L_BIAS = L_CCNT + 512, L_STAGE = L_BIAS + 8 * 144 * 4, L_DSA_END = L_STAGE + 2 * 8192;
static_assert(L_DSA_END <= LDSCTL_OFF, "DSA LDS map");
constexpr float LOG2E = 1.4426950408889634f;

constexpr int DSA_NB = 128;
#define DSA_SCORE_BODY \
        f32x4 acc = MFMA16(a0, cq[0], ((f32x4){0.f, 0.f, 0.f, 0.f})); acc = MFMA16(a1, cq[1], acc); \
        _Pragma("unroll") for (int h = 0; h < 8; ++h) { \
            f32x4 s = MFMA16(a0, iq[h][0], ((f32x4){0.f, 0.f, 0.f, 0.f})); s = MFMA16(a1, iq[h][1], s); \
            _Pragma("unroll") for (int r = 0; r < 4; ++r) acc[r] = __builtin_fmaf(wh[h], __builtin_fabsf(s[r]), acc[r]); } \
        sc[u] = acc;
__device__ __forceinline__ void idx_tile(const bf16* ikb, int kt, const bf16x8 (&iq)[8][2], const bf16x8 (&cq)[2], const float (&wh)[8], int lane, f32x4 (&sc)[2]) {
    const int i = lane & 15, g = lane >> 4;
#pragma unroll
    for (int u = 0; u < 2; ++u) {
        const bf16* rp = ikb + (size_t)(32 * kt + 8 * (i >> 2) + 4 * u + (i & 3)) * 64 + 8 * g;
        const bf16x8 a0 = *(const GAS bf16x8*)rp, a1 = *(const GAS bf16x8*)(rp + 32);
        DSA_SCORE_BODY
    }
}
__device__ __forceinline__ void idx_tile_lds(const LAS unsigned char* tb, const bf16x8 (&iq)[8][2], const bf16x8 (&cq)[2], const float (&wh)[8], int lane, f32x4 (&sc)[2]) {
#pragma unroll
    for (int u = 0; u < 2; ++u) {
        const bf16x8 a0 = *(const LAS bf16x8*)(tb + (u * 2 + 0) * 1024 + lane * 16), a1 = *(const LAS bf16x8*)(tb + (u * 2 + 1) * 1024 + lane * 16);
        DSA_SCORE_BODY
    }
}
__device__ __forceinline__ float bin_t(float s, float binc, float invw) { return __builtin_fmaf(s, invw, binc); }
__device__ __forceinline__ int bin_of_t(float t) { return (int)__builtin_amdgcn_fmed3f(t, 0.f, (float)(DSA_NB - 1)); }

__device__ __forceinline__ f32x4 idx_sub_lds2(const LAS unsigned char* tb, int u, const bf16x8 (&iq)[8][2], const bf16x8 (&cq)[2], const float (&wh)[8], int lane) {
    const bf16x8 a0 = *(const LAS bf16x8*)(tb + (u * 2 + 0) * 1024 + lane * 16), a1 = *(const LAS bf16x8*)(tb + (u * 2 + 1) * 1024 + lane * 16);
    f32x4 s[9];
#pragma unroll
    for (int h = 0; h < 8; ++h) s[h] = MFMA16(a0, iq[h][0], ((f32x4){0.f, 0.f, 0.f, 0.f}));
    s[8] = MFMA16(a0, cq[0], ((f32x4){0.f, 0.f, 0.f, 0.f}));
#pragma unroll
    for (int h = 0; h < 8; ++h) s[h] = MFMA16(a1, iq[h][1], s[h]);
    s[8] = MFMA16(a1, cq[1], s[8]);
    f32x4 acc = s[8];
#pragma unroll
    for (int h = 0; h < 8; ++h)
#pragma unroll
        for (int r = 0; r < 4; ++r) acc[r] = __builtin_fmaf(wh[h], __builtin_fabsf(s[h][r]), acc[r]);
    __builtin_amdgcn_sched_group_barrier(0x100, 2, 0);
    __builtin_amdgcn_sched_group_barrier(0x008, 18, 0);
    __builtin_amdgcn_sched_group_barrier(0x002, 32, 0);
    return acc;
}
struct IdxAcc { f32x4 s[9]; };
__device__ __forceinline__ IdxAcc idx_mfma_group(const LAS unsigned char* tb, int sub, const bf16x8 (&iq)[8][2], const bf16x8 (&cq)[2], int lane) {
    const LAS unsigned char* ab = tb + (sub >> 1) * 4096 + (sub & 1) * 2048 + lane * 16;
    const bf16x8 a0 = *(const LAS bf16x8*)ab, a1 = *(const LAS bf16x8*)(ab + 1024);
    IdxAcc r;
#pragma unroll
    for (int h = 0; h < 8; ++h) r.s[h] = MFMA16(a0, iq[h][0], ((f32x4){0.f, 0.f, 0.f, 0.f}));
    r.s[8] = MFMA16(a0, cq[0], ((f32x4){0.f, 0.f, 0.f, 0.f}));
#pragma unroll
    for (int h = 0; h < 8; ++h) r.s[h] = MFMA16(a1, iq[h][1], r.s[h]);
    r.s[8] = MFMA16(a1, cq[1], r.s[8]);
    return r;
}
__device__ __forceinline__ f32x4 idx_combine(const IdxAcc& a, const float (&wh)[8]) {
    f32x4 acc = a.s[8];
#pragma unroll
    for (int h = 0; h < 8; ++h)
#pragma unroll
        for (int r = 0; r < 4; ++r) acc[r] = __builtin_fmaf(wh[h], __builtin_fabsf(a.s[h][r]), acc[r]);
    return acc;
}
#define DSA_DMA_K(base, step, buf) __builtin_amdgcn_global_load_lds((const unsigned*)((base) + (size_t)(64 * (step) + dk_row) * 64 + dk_col), (LAS unsigned*)((buf) + wave * 1024), 16, 0, 0)
#define DSA_WAITBAR(N) asm volatile("s_waitcnt vmcnt(" #N ") lgkmcnt(0)\n\ts_barrier" ::: "memory")
#define DSA_LDS_ADDR(p) ((unsigned)(unsigned long long)(p))
#define DSA_PB1(i) (lds + L_MASK + ((i) & 3) * 8192)
#define DSA_PB2(i) (lds + (((i) & 2) ? L_STAGE : 49152) + ((i) & 1) * 8192)
#define DSA_PB3(i) (lds + L_HIST + ((i) & 3) * 16384)
#define DSA_DMA_V(base, step, buf) __builtin_amdgcn_global_load_lds((const unsigned*)((base) + (size_t)dv_row * KROWS + 64 * (step) + dv_col), (LAS unsigned*)((buf) + 8192 + wave * 1024), 16, 0, 0)

template <int NH>
__device__ __forceinline__ void dsa_sweep(LAS unsigned char* lds, int h0, const bf16* kcb, const bf16* vtb, const bf16* qrow, const float* qgain, bf16* yrow, int ns, int p, int pmin, int qloc, int wave, int lane) {
    DSA_OPAQUE(lane);
    const int ql = lane & 15, g4 = lane >> 4;
    const int dk_row = 32 * (wave >> 2) + 8 * (ql >> 2) + 4 * ((wave >> 1) & 1) + (ql & 3), dk_col = 32 * (wave & 1) + 8 * g4;
    const int dv_row = 16 * (wave & 3) + ql, dv_col = 32 * (wave >> 2) + 8 * g4;
    const LAS unsigned* MASK = (const LAS unsigned*)(lds + L_MASK); const LAS float* BIAS = (const LAS float*)(lds + L_BIAS);
    bf16x8 qf[NH][2];
#pragma unroll 1
    for (int pass_ = 0; pass_ < 1; ++pass_) {
#pragma unroll
      for (int hh = 0; hh < NH; ++hh) { v4u qv[2]; float ss = 0.f;
#pragma unroll
          for (int sx = 0; sx < 2; ++sx) { qv[sx] = *(const GAS v4u*)(qrow + 64 * (h0 + hh) + 32 * sx + 8 * g4);
#pragma unroll
              for (int e = 0; e < 4; ++e) { const float a = __uint_as_float(qv[sx][e] << 16), c = __uint_as_float(qv[sx][e] & 0xffff0000u); ss += a * a + c * c; } }
          ss += __shfl_xor(ss, 16); ss += __shfl_xor(ss, 32);
          const float scq = (1.f / sqrtf(ss * (1.f / 64.f) + 1e-6f)) * (0.125f * LOG2E);
#pragma unroll
          for (int sx = 0; sx < 2; ++sx) { const f32x4 g0 = *(const GAS f32x4*)(qgain + 32 * sx + 8 * g4), g1 = *(const GAS f32x4*)(qgain + 32 * sx + 8 * g4 + 4); v4u o;
#pragma unroll
              for (int e = 0; e < 4; ++e) { const float a = __uint_as_float(qv[sx][e] << 16), c = __uint_as_float(qv[sx][e] & 0xffff0000u);
                  const float ga = e < 2 ? g0[2 * e] : g1[2 * e - 4], gc = e < 2 ? g0[2 * e + 1] : g1[2 * e - 3]; o[e] = pkbf(a * scq * ga, c * scq * gc); }
              qf[hh][sx] = __builtin_bit_cast(bf16x8, o); } } }
    f32x4 oacc[NH][4]; float lsum[NH];
#pragma unroll
    for (int hh = 0; hh < NH; ++hh) { lsum[hh] = 0.f;
#pragma unroll
        for (int dt = 0; dt < 4; ++dt) oacc[hh][dt] = (f32x4){0.f, 0.f, 0.f, 0.f}; }
    DSA_DMA_K(kcb, 0, DSA_PB3(0)); DSA_DMA_V(vtb, 0, DSA_PB3(0));
    { const int s1 = ns > 1 ? 1 : ns - 1, s2 = ns > 2 ? 2 : ns - 1; DSA_DMA_K(kcb, s1, DSA_PB3(1)); DSA_DMA_V(vtb, s1, DSA_PB3(1)); DSA_DMA_K(kcb, s2, DSA_PB3(2)); DSA_DMA_V(vtb, s2, DSA_PB3(2)); }
    DSA_WAITBAR(4);
    for (int step = 0; step < ns; ++step) {
        { const int sn = step + 3 < ns ? step + 3 : ns - 1; DSA_DMA_K(kcb, sn, DSA_PB3(step + 3)); DSA_DMA_V(vtb, sn, DSA_PB3(step + 3)); }
        const LAS unsigned char* tb = DSA_PB3(step);
#pragma unroll 1
        for (int tt = 0; tt < 2; ++tt) { const int kt = 2 * step + tt; if (32 * kt > pmin + 15) continue;
            const unsigned mw = (MASK[qloc * DSA_MSTR + kt] >> (8 * g4)) & 0xffu;
            bf16x8 ka[2][2], vt[4];
#pragma unroll
            for (int u = 0; u < 2; ++u) { ka[u][0] = *(const LAS bf16x8*)(tb + tt * 4096 + (u * 2 + 0) * 1024 + lane * 16); ka[u][1] = *(const LAS bf16x8*)(tb + tt * 4096 + (u * 2 + 1) * 1024 + lane * 16); }
#pragma unroll
            for (int dt = 0; dt < 4; ++dt) vt[dt] = *(const LAS bf16x8*)(tb + 8192 + tt * 4096 + dt * 1024 + lane * 16);
            f32x4 cm[2];
#pragma unroll
            for (int u = 0; u < 2; ++u)
#pragma unroll
                for (int r = 0; r < 4; ++r) cm[u][r] = ((mw >> (4 * u + r)) & 1u) ? 0.f : -30000.f;
            const bool near = 32 * kt + 31 + 112 >= pmin;
#pragma unroll
            for (int hh = 0; hh < NH; ++hh) {
                f32x4 st[2]; st[0] = cm[0]; st[1] = cm[1];
                if (near) {
                    int d0 = p - (32 * kt + 8 * g4); d0 = d0 < 0 ? 0 : (d0 > 135 ? 135 : d0);
                    const LAS float* bt = BIAS + (h0 + hh) * 144 + 8 + d0 - 7;
#pragma unroll
                    for (int u = 0; u < 2; ++u)
#pragma unroll
                        for (int r = 0; r < 4; ++r) st[u][r] += bt[7 - (4 * u + r)]; }
#pragma unroll
                for (int u = 0; u < 2; ++u) { st[u] = MFMA16(ka[u][0], qf[hh][0], st[u]); st[u] = MFMA16(ka[u][1], qf[hh][1], st[u]); }
                float pe[8];
#pragma unroll
                for (int u = 0; u < 2; ++u)
#pragma unroll
                    for (int r = 0; r < 4; ++r) { pe[4 * u + r] = __builtin_amdgcn_exp2f(st[u][r]); lsum[hh] += pe[4 * u + r]; }
                const v4u pw = (v4u){pkbf(pe[0], pe[1]), pkbf(pe[2], pe[3]), pkbf(pe[4], pe[5]), pkbf(pe[6], pe[7])};
                const bf16x8 pf = __builtin_bit_cast(bf16x8, pw);
#pragma unroll
                for (int dt = 0; dt < 4; ++dt) oacc[hh][dt] = MFMA16(vt[dt], pf, oacc[hh][dt]);
            }
        }
        DSA_WAITBAR(4);
    }
#pragma unroll
    for (int hh = 0; hh < NH; ++hh) { float l = lsum[hh]; l += __shfl_xor(l, 16); l += __shfl_xor(l, 32); const float il = 1.f / l;
        bf16* yp = yrow + 64 * (h0 + hh) + 4 * g4;
#pragma unroll
        for (int dt = 0; dt < 4; ++dt) *(GAS u32x2v*)(yp + 16 * dt) = (u32x2v){pkbf(oacc[hh][dt][0] * il, oacc[hh][dt][1] * il), pkbf(oacc[hh][dt][2] * il, oacc[hh][dt][3] * il)}; }
}

__device__ __forceinline__ void dsa_gather(LAS unsigned char* gbuf, LAS unsigned char* lstb, const LAS float* BIAS, const bf16* kc, const bf16* vc, const unsigned short* lst,
                                           const LAS unsigned* qcnt  , const bf16* projq  , const float* qgain, bf16* y  , int p0  , int lane) {
    DSA_OPAQUE(lane);
    const int h = lane & 15, g4 = lane >> 4, hv = h & 7;
    f32x4 gq[2][2];
#pragma unroll
    for (int sx = 0; sx < 2; ++sx) { gq[sx][0] = *(const GAS f32x4*)(qgain + 32 * sx + 8 * g4); gq[sx][1] = *(const GAS f32x4*)(qgain + 32 * sx + 8 * g4 + 4); }
    u32x2v lwn = *(const GAS u32x2v*)(lst + 4 * lane); v4u qvn[2];
    { const bf16* qp = projq + 64 * hv + 8 * g4; qvn[0] = *(const GAS v4u*)qp; qvn[1] = *(const GAS v4u*)(qp + 32); }
#pragma unroll 1
    for (int qq = 0; qq < 16; ++qq) {
        const int pq = p0 + qq; int nsel = pq + 1 < 256 ? pq + 1 : 256; { const int nl = (int)qcnt[4 * qq]; nsel = nl < nsel ? nl : nsel; }
        nsel = __builtin_amdgcn_readfirstlane(nsel); const int nch = (nsel + 31) >> 5;
        { u32x2v lw = lwn;
          if (4 * lane + 0 >= nsel) lw[0] &= 0xffff0000u; if (4 * lane + 1 >= nsel) lw[0] &= 0x0000ffffu; if (4 * lane + 2 >= nsel) lw[1] &= 0xffff0000u; if (4 * lane + 3 >= nsel) lw[1] &= 0x0000ffffu;
          *(LAS u32x2v*)(lstb + 8 * lane) = lw; }
        bf16x8 qf[2];
        { v4u qv[2]; qv[0] = qvn[0]; qv[1] = qvn[1]; float ss = 0.f;
#pragma unroll
          for (int sx = 0; sx < 2; ++sx) {
#pragma unroll
              for (int e = 0; e < 4; ++e) { const float a = __uint_as_float(qv[sx][e] << 16), c = __uint_as_float(qv[sx][e] & 0xffff0000u); ss += a * a + c * c; } }
          ss += __shfl_xor(ss, 16); ss += __shfl_xor(ss, 32);
          const float scq = (1.f / sqrtf(ss * (1.f / 64.f) + 1e-6f)) * (0.125f * LOG2E);
#pragma unroll
          for (int sx = 0; sx < 2; ++sx) { const f32x4 g0 = gq[sx][0], g1 = gq[sx][1]; v4u o;
#pragma unroll
              for (int e = 0; e < 4; ++e) { const float a = __uint_as_float(qv[sx][e] << 16), c = __uint_as_float(qv[sx][e] & 0xffff0000u);
                  const float ga = e < 2 ? g0[2 * e] : g1[2 * e - 4], gc = e < 2 ? g0[2 * e + 1] : g1[2 * e - 3]; o[e] = pkbf(a * scq * ga, c * scq * gc); }
              qf[sx] = __builtin_bit_cast(bf16x8, o); } }
        LDS_WAIT(); asm volatile("" ::: "memory");
        f32x4 oacc[4]; float lsum = 0.f;
#pragma unroll
        for (int dt = 0; dt < 4; ++dt) oacc[dt] = (f32x4){0.f, 0.f, 0.f, 0.f};
#define DSA_GDMA(c, buf) do { _Pragma("unroll") for (int i = 0; i < 4; ++i) { const int r_ = 8 * i + (lane >> 3); unsigned ki_ = *(const LAS unsigned short*)(lstb + 2 * (32 * (c) + r_)); ki_ = ki_ < (unsigned)KROWS ? ki_ : 0u; \
            const int pc_ = (lane & 7) ^ (r_ & 7); \
            __builtin_amdgcn_global_load_lds((const unsigned*)(kc + (size_t)ki_ * 64 + 8 * pc_), (LAS unsigned*)((buf) + i * 1024), 16, 0, 0); \
            __builtin_amdgcn_global_load_lds((const unsigned*)(vc + (size_t)ki_ * 64 + 8 * pc_), (LAS unsigned*)((buf) + 4096 + i * 1024), 16, 0, 0); } } while (0)
        DSA_GDMA(0, gbuf); if (nch > 1) DSA_GDMA(1, gbuf + 8192);
        __builtin_amdgcn_sched_barrier(0);
        { const int qn = qq < 15 ? qq + 1 : 15; lwn = *(const GAS u32x2v*)(lst + qn * 256 + 4 * lane); const bf16* qp = projq + (size_t)qn * DP2 + 64 * hv + 8 * g4; qvn[0] = *(const GAS v4u*)qp; qvn[1] = *(const GAS v4u*)(qp + 32); }
        __builtin_amdgcn_sched_barrier(0);
        const int qd = (lane >> 2) & 3, pp = lane & 3, R0 = 4 * g4 + qd, pcl = (lane & 7) ^ (lane >> 3);
        const unsigned gb0 = DSA_LDS_ADDR(gbuf), kof0 = (unsigned)(h * 128 + 16 * (g4 ^ (h & 7))), kof1 = (unsigned)(h * 128 + 16 * ((4 + g4) ^ (h & 7)));
        const unsigned vofb = (unsigned)(R0 * 128 + 8 * (pp & 1)), vsw = (unsigned)((pp >> 1) ^ (R0 & 7));
        const unsigned lsa = DSA_LDS_ADDR(lstb);
#pragma unroll 1
        for (int c = 0; c < nch; ++c) {
            if (c < 2) { if (c + 1 < nch) asm volatile("s_waitcnt vmcnt(11)" ::: "memory"); else asm volatile("s_waitcnt vmcnt(3)" ::: "memory"); }
            else { if (c + 1 < nch) asm volatile("s_waitcnt vmcnt(8)" ::: "memory"); else asm volatile("s_waitcnt vmcnt(0)" ::: "memory"); }
            const unsigned gb = gb0 + (unsigned)(c & 1) * 8192u;
            v4u kf[2][2]; u32x2v kiw[2], tv[4][2]; unsigned nk[4];
            { const unsigned ka0 = gb + kof0, ka1 = gb + kof1, va0 = gb + vofb + 16u * (vsw ^ 0u), va1 = gb + vofb + 16u * (vsw ^ 2u), va2 = gb + vofb + 16u * (vsw ^ 4u), va3 = gb + vofb + 16u * (vsw ^ 6u);
              const unsigned kwa = lsa + 2u * (unsigned)(32 * c + 4 * g4), nka = lsa + 2u * (unsigned)(32 * (c + 2) + (lane >> 3));
              asm volatile("ds_read_b128 %0, %18\n\tds_read_b128 %1, %19\n\tds_read_b128 %2, %18 offset:2048\n\tds_read_b128 %3, %19 offset:2048\n\tds_read_b64 %4, %24\n\tds_read_b64 %5, %24 offset:32\n\t"
                           TR_RD "%6, %20 offset:4096\n\t" TR_RD "%7, %20 offset:6144\n\t" TR_RD "%8, %21 offset:4096\n\t" TR_RD "%9, %21 offset:6144\n\t"
                           TR_RD "%10, %22 offset:4096\n\t" TR_RD "%11, %22 offset:6144\n\t" TR_RD "%12, %23 offset:4096\n\t" TR_RD "%13, %23 offset:6144\n\t"
                           "ds_read_u16 %14, %25\n\tds_read_u16 %15, %25 offset:16\n\tds_read_u16 %16, %25 offset:32\n\tds_read_u16 %17, %25 offset:48\n\ts_waitcnt lgkmcnt(0)"
                           : "=&v"(kf[0][0]), "=&v"(kf[0][1]), "=&v"(kf[1][0]), "=&v"(kf[1][1]), "=&v"(kiw[0]), "=&v"(kiw[1]),
                             "=&v"(tv[0][0]), "=&v"(tv[0][1]), "=&v"(tv[1][0]), "=&v"(tv[1][1]), "=&v"(tv[2][0]), "=&v"(tv[2][1]), "=&v"(tv[3][0]), "=&v"(tv[3][1]),
                             "=&v"(nk[0]), "=&v"(nk[1]), "=&v"(nk[2]), "=&v"(nk[3])
                           : "v"(ka0), "v"(ka1), "v"(va0), "v"(va1), "v"(va2), "v"(va3), "v"(kwa), "v"(nka) : "memory"); }
            if (c + 2 < nch) { LAS unsigned char* nb = gbuf + (c & 1) * 8192;
#pragma unroll
                for (int i = 0; i < 4; ++i) { const unsigned ki_ = nk[i] < (unsigned)KROWS ? nk[i] : 0u;
                    __builtin_amdgcn_global_load_lds((const unsigned*)(kc + (size_t)ki_ * 64 + 8 * pcl), (LAS unsigned*)(nb + i * 1024), 16, 0, 0);
                    __builtin_amdgcn_global_load_lds((const unsigned*)(vc + (size_t)ki_ * 64 + 8 * pcl), (LAS unsigned*)(nb + 4096 + i * 1024), 16, 0, 0); } }
            f32x4 st[2];
#pragma unroll
            for (int u = 0; u < 2; ++u) { st[u] = MFMA16(__builtin_bit_cast(bf16x8, kf[u][0]), qf[0], ((f32x4){0.f, 0.f, 0.f, 0.f})); st[u] = MFMA16(__builtin_bit_cast(bf16x8, kf[u][1]), qf[1], st[u]); }
            float bv[8];
#pragma unroll
            for (int u = 0; u < 2; ++u)
#pragma unroll
                for (int r = 0; r < 4; ++r) { const int ki = (int)((r & 1) ? kiw[u][r >> 1] >> 16 : kiw[u][r >> 1] & 0xffffu); int dd = pq - ki; dd = dd < 0 ? 0 : (dd > 135 ? 135 : dd);
                    bv[4 * u + r] = BIAS[hv * 144 + 8 + dd]; }
            float pe[8];
#pragma unroll
            for (int u = 0; u < 2; ++u)
#pragma unroll
                for (int r = 0; r < 4; ++r) { const float lg = (32 * c + 16 * u + 4 * g4 + r) < nsel ? st[u][r] + bv[4 * u + r] : -30000.f; pe[4 * u + r] = __builtin_amdgcn_exp2f(lg); lsum += pe[4 * u + r]; }
            const v4u pw = (v4u){pkbf(pe[0], pe[1]), pkbf(pe[2], pe[3]), pkbf(pe[4], pe[5]), pkbf(pe[6], pe[7])};
            const bf16x8 pf = __builtin_bit_cast(bf16x8, pw);
#pragma unroll
            for (int dt = 0; dt < 4; ++dt) oacc[dt] = MFMA16(tr_pack(tv[dt][0], tv[dt][1]), pf, oacc[dt]);
        }
#undef DSA_GDMA
        lsum += __shfl_xor(lsum, 16); lsum += __shfl_xor(lsum, 32);
        if (h < 8) { const float il = 1.f / lsum; bf16* yp = y + (size_t)qq * D + 64 * h + 4 * g4;
#pragma unroll
            for (int dt = 0; dt < 4; ++dt) *(GAS u32x2v*)(yp + 16 * dt) = (u32x2v){pkbf(oacc[dt][0] * il, oacc[dt][1] * il), pkbf(oacc[dt][2] * il, oacc[dt][3] * il)}; }
    }
}
__device__ __forceinline__ float wave_sum(float v) {
#pragma unroll
    for (int o = 1; o < 64; o <<= 1) v += __shfl_xor(v, o);
    return v;
}
__device__ __forceinline__ void p0_transpose_item(const float* W, int K, int N, int NP, bf16* WT, LAS float* scr, int item, int lane, const float* kscale = nullptr) {
    const int nblk = NP / 32, kb = item / nblk, nb = item % nblk, k0 = 64 * kb, n0 = 32 * nb;
    const int nn = n0 + (lane & 31); const bool ok = nn < N;
#pragma unroll 8
    for (int i = 0; i < 32; ++i) { const int kk = 2 * i + (lane >> 5); scr[kk * 33 + (lane & 31)] = ok ? W[(size_t)(k0 + kk) * N + nn] * (kscale ? kscale[k0 + kk] : 1.f) : 0.f; }
    LDS_WAIT(); asm volatile("" ::: "memory");
    const int c = lane & 7;
#pragma unroll
    for (int j = 0; j < 4; ++j) { const int n = (lane >> 3) + 8 * j; const LAS float* s = scr + (8 * c) * 33 + n;
        v4u o; o.x = pk2(s[0 * 33], s[1 * 33]); o.y = pk2(s[2 * 33], s[3 * 33]); o.z = pk2(s[4 * 33], s[5 * 33]); o.w = pk2(s[6 * 33], s[7 * 33]);
        *(GAS v4u*)(WT + (size_t)(n0 + n) * K + k0 + 8 * c) = o; }
    LDS_WAIT(); asm volatile("" ::: "memory");
}
__device__ __forceinline__ void rms_row_to_bf16(const float* xrow, const float* w, bf16* orow, int lane) {
    const GAS f32x4* xr = (const GAS f32x4*)xrow + lane; const GAS f32x4* wr = (const GAS f32x4*)w + lane;
    f32x4 v[4]; float s = 0.f;
#pragma unroll
    for (int j = 0; j < 4; ++j) { v[j] = xr[64 * j]; s += (v[j].x * v[j].x + v[j].y * v[j].y) + (v[j].z * v[j].z + v[j].w * v[j].w); }
    const float r = 1.f / sqrtf(wave_sum(s) * (1.f / D) + EPS);
    GAS unsigned long long* o8 = (GAS unsigned long long*)orow + lane;
#pragma unroll
    for (int j = 0; j < 4; ++j) { const f32x4 g = wr[64 * j];
        o8[64 * j] = (unsigned long long)pk2(v[j].x * r * g.x, v[j].y * r * g.y) | ((unsigned long long)pk2(v[j].z * r * g.z, v[j].w * r * g.w) << 32); }
}

__device__ __forceinline__ void rms_row2_to_bf16(const float* xa, const float* xb, const float* w, bf16* oa, bf16* ob, float* xsa, float* xsb, int lane) {
    const GAS f32x4* pa = (const GAS f32x4*)xa + lane; const GAS f32x4* pb = (const GAS f32x4*)xb + lane; const GAS f32x4* wr = (const GAS f32x4*)w + lane;
    f32x4 va[4], vb[4]; float sa = 0.f, sb = 0.f;
#pragma unroll
    for (int j = 0; j < 4; ++j) { va[j] = __builtin_nontemporal_load(pa + 64 * j); vb[j] = __builtin_nontemporal_load(pb + 64 * j); }
#pragma unroll
    for (int j = 0; j < 4; ++j) { sa += (va[j].x * va[j].x + va[j].y * va[j].y) + (va[j].z * va[j].z + va[j].w * va[j].w); sb += (vb[j].x * vb[j].x + vb[j].y * vb[j].y) + (vb[j].z * vb[j].z + vb[j].w * vb[j].w); }
    const float qa_ = sqrtf(wave_sum(sa) * (1.f / D) + EPS), qb_ = sqrtf(wave_sum(sb) * (1.f / D) + EPS); const float ra = 1.f / qa_, rb = 1.f / qb_;
    if (lane == 0) { *xsa = qa_; *xsb = qb_; }
    GAS unsigned long long* qa = (GAS unsigned long long*)oa + lane; GAS unsigned long long* qb = (GAS unsigned long long*)ob + lane;
#pragma unroll
    for (int j = 0; j < 4; ++j) { const f32x4 g = wr[64 * j];
        qa[64 * j] = (unsigned long long)pk2(va[j].x * ra * g.x, va[j].y * ra * g.y) | ((unsigned long long)pk2(va[j].z * ra * g.z, va[j].w * ra * g.w) << 32);
        qb[64 * j] = (unsigned long long)pk2(vb[j].x * rb * g.x, vb[j].y * rb * g.y) | ((unsigned long long)pk2(vb[j].z * rb * g.z, vb[j].w * rb * g.w) << 32); }
}

struct Args { const float* in[12]; float* out; unsigned char* ws; int ph_lo, ph_hi; };
__global__ void __launch_bounds__(NWAVES * 64, 2) mk_fwd(Args args) {
    extern __shared__ __attribute__((aligned(16))) unsigned char lds_raw[];
    LAS unsigned char* lds = (LAS unsigned char*)lds_raw;
    volatile LAS unsigned* MISC = (volatile LAS unsigned*)(lds + MISC_OFF);
    const int tid = threadIdx.x, lane = tid & 63, wave = __builtin_amdgcn_readfirstlane(tid >> 6);
    const int G = gridDim.x; const int bx = blockIdx.x; const int vcu = (G % 8 == 0) ? (bx % 8) * (G / 8) + bx / 8 : bx;
    unsigned char* ws = args.ws;
    gu32* ctl = (gu32*)(ws + WS_CTL);
    const float* x = args.in[0]; const float* meta = args.in[1]; const float* norm1_w = args.in[2]; const float* w_in = args.in[3];
    const float* ret_norm_w = args.in[4]; const float* q_norm_w = args.in[5]; const float* k_norm_w = args.in[6]; const float* rel_bias = args.in[7];
    const float* w_out = args.in[8]; const float* norm2_w = args.in[9]; const float* w_ff1 = args.in[10]; const float* w_ff2 = args.in[11];
    float* out = args.out;
    bf16* WIN_T = (bf16*)(ws + WS_WIN); bf16* WOUT_T = (bf16*)(ws + WS_WOUT); bf16* W1_T = (bf16*)(ws + WS_W1); bf16* W2_T = (bf16*)(ws + WS_W2);
    bf16* U = (bf16*)(ws + WS_U); bf16* PROJ = (bf16*)(ws + WS_PROJ); bf16* Y = (bf16*)(ws + WS_Y); bf16* HB = (bf16*)(ws + WS_H);
    float* ROPE = (float*)(ws + WS_ROPE); float* PMETA = (float*)(ws + WS_PMETA); bf16* PM16 = (bf16*)(ws + WS_PMETA + 512 * 1024); bf16* SPT = (bf16*)(ws + WS_SPT);
    float* XS = (float*)(ws + WS_CTL + 768 * 1024);
    float* SSQ = (float*)(ws + WS_CTL + 512 * 1024);
    bf16* KC = (bf16*)(ws + WS_KC); bf16* IKC = (bf16*)(ws + WS_IKC); bf16* VT = (bf16*)(ws + WS_VT); bf16* VC = (bf16*)(ws + WS_QN + 32 * MiB); unsigned short* LISTG = (unsigned short*)(ws + WS_LIST); bf16* RET = (bf16*)(ws + WS_RET);
    for (int u = tid; u < (LDS_BYTES - LDSCTL_OFF) / 4; u += NWAVES * 64) ((LAS unsigned*)(lds + LDSCTL_OFF))[u] = 0u;
    __syncthreads();
    XcdBarrier bar; bar.bar = (unsigned*)(ctl + CW_BAR); bar.x = 0; bar.st = nullptr;
    if (ONE_LAUNCH) bar = xcd_barrier_post((unsigned*)(ctl + CW_BAR), MISC + 8);
#define GRID_BAR() do { if (ONE_LAUNCH) xcd_barrier(bar); } while (0)
    const int lo = args.ph_lo, hi = args.ph_hi;
#define IN(k) (lo <= (k) && (k) < hi)
#define BOTH(k) (IN(k) && IN((k) + 1 + ((k) == 4)))
    const int gw = vcu * NWAVES + wave, NGW = G * NWAVES;

    if (IN(0)) {
        LAS float* scr = (LAS float*)(lds + RING_OFF + wave * 16384);
        constexpr int I_IN = (D / 64) * (DINP / 32), I_O = (D / 64) * (D / 32), I_1 = (D / 64) * (FF / 32), I_2 = (FF / 64) * (D / 32);
        constexpr int NITEMS = I_IN + I_O + I_1 + I_2;
        for (int it = gw; it < NITEMS; it += NGW) {
            int r = it;
            if (r < I_IN) { p0_transpose_item(w_in, D, DIN, DINP, WIN_T, scr, r, lane); continue; } r -= I_IN;
            if (r < I_O) { p0_transpose_item(w_out, D, D, D, WOUT_T, scr, r, lane); continue; } r -= I_O;
            if (r < I_1) { p0_transpose_item(w_ff1, D, FF, FF, W1_T, scr, r, lane, norm2_w); continue; } r -= I_1;
            p0_transpose_item(w_ff2, FF, D, D, W2_T, scr, r, lane);
        }
        for (int m = gw; m < M; m += 2 * NGW) rms_row2_to_bf16(x + (size_t)m * D, x + (size_t)(m + NGW) * D, norm1_w, U + (size_t)m * D, U + (size_t)(m + NGW) * D, XS + m, XS + m + NGW, lane);

        for (int i = bx * 512 + tid; i < TK * 64; i += G * 512) {
            const int t = i >> 6, fi = i & 63;
            const double inv = exp2(-(double)fi * (13.287712379549449 / 64.0));
            const double ang = (double)t * inv;
            const double nrev = rint(ang * 0.15915494309189535);
            double r = fma(-nrev, 6.283185307179586, ang); r = fma(-nrev, 2.4492935982947064e-16, r);
            const double r2 = r * r; double sn = 1.0, cn = 1.0;
#pragma unroll
            for (int k = 12; k >= 1; --k) { sn = 1.0 - r2 / (double)((2 * k) * (2 * k + 1)) * sn; cn = 1.0 - r2 / (double)((2 * k - 1) * (2 * k)) * cn; }
            sn *= r;
            ((GAS f32x2v*)ROPE)[i] = (f32x2v){(float)cn, (float)sn};
        }
        for (int i = bx * 512 + tid; i < 112 * DINP * 2 / 16; i += G * 512) ((GAS v4u*)PM16)[i] = (v4u){0u, 0u, 0u, 0u};
        {
            __syncthreads();
            LAS float* un = (LAS float*)(lds + RING_OFF);
            LAS float* red = (LAS float*)(lds + RING_OFF + 16 * 1025 * 4);
#pragma unroll
            for (int rr = 0; rr < 2; ++rr) { const int r = 2 * wave + rr; const GAS f32x4* xr = (const GAS f32x4*)(meta + (size_t)r * D) + lane; const GAS f32x4* wr = (const GAS f32x4*)norm1_w + lane;
                f32x4 v[4]; float s = 0.f;
#pragma unroll
                for (int j = 0; j < 4; ++j) { v[j] = xr[64 * j]; s += (v[j].x * v[j].x + v[j].y * v[j].y) + (v[j].z * v[j].z + v[j].w * v[j].w); }
                const float ri = 1.f / sqrtf(wave_sum(s) * (1.f / D) + EPS);
#pragma unroll
                for (int j = 0; j < 4; ++j) { const f32x4 g = wr[64 * j]; const int k = 4 * lane + 256 * j;
                    un[r * 1025 + k] = v[j].x * ri * g.x; un[r * 1025 + k + 1] = v[j].y * ri * g.y; un[r * 1025 + k + 2] = v[j].z * ri * g.z; un[r * 1025 + k + 3] = v[j].w * ri * g.w; } }
            __syncthreads();
            const int c0 = 13 * vcu; float acc[13];
#pragma unroll
            for (int cc = 0; cc < 13; ++cc) acc[cc] = 0.f;
            for (int i = 0; i < 32; ++i) { const int k = 128 * wave + (lane >> 4) + 4 * i; const float uv = un[(lane & 15) * 1025 + k]; const float* wp = w_in + (size_t)k * DIN + c0;
#pragma unroll
                for (int cc = 0; cc < 13; ++cc) { const float wv = (c0 + cc < DIN) ? wp[cc] : 0.f; acc[cc] = fmaf(uv, wv, acc[cc]); } }
#pragma unroll
            for (int cc = 0; cc < 13; ++cc) { acc[cc] += __shfl_xor(acc[cc], 16); acc[cc] += __shfl_xor(acc[cc], 32); if (lane < 16) red[(wave * 16 + lane) * 13 + cc] = acc[cc]; }
            __syncthreads();
            if (tid < 208) { const int r = tid / 13, cc = tid % 13; float s = 0.f;
#pragma unroll
                for (int w8 = 0; w8 < 8; ++w8) s += red[(w8 * 16 + r) * 13 + cc];
                const int c = c0 + cc; if (c >= DIN) s = 0.f;
                PMETA[r * DINP + c] = s; PM16[(size_t)(112 + r) * DINP + c] = (bf16)f2bf(s); }
            __syncthreads();
        }
        if (BOTH(0)) GRID_BAR();
    }
    if (IN(1)) {
        pg8::Gemm g{U, WIN_T, M, DINP, D}; pg8::StaticOrder S; S.init(M, DINP, G, (int)blockIdx.x);
        pg8::EpiProj E{PROJ, DP2, RET, M};
        pg8::gemm_phase<pg8::EpiProj, pg8::StaticOrder, true, true>(lds + RING_OFF, g, S, E);
        if (BOTH(1)) GRID_BAR();
    }
    if (IN(2)) {
        {
            LAS unsigned char* vscr = lds + RING_OFF + 65536 + wave * 1024;
            const int r = lane >> 3, sub = lane & 7;
            const f32x4 kg0 = *(const GAS f32x4*)(k_norm_w + 8 * sub), kg1 = *(const GAS f32x4*)(k_norm_w + 8 * sub + 4);
            for (int unit = gw; unit < BATCH * 520; unit += NGW) {
                const int b = unit / 520, gidx = unit % 520; const bool isx = gidx >= 2 && gidx < 514, ismeta = gidx < 2;
                const bf16* src = ismeta ? PM16 + (size_t)(112 + 8 * gidx + r) * DINP + 2048 : PROJ + ((size_t)b * SEQ + (isx ? 8 * (gidx - 2) + r : 0)) * DP2;
                const size_t krow = ((size_t)b * KROWS + 8 * gidx + r) * 64 + 8 * sub;
                v4u kv = (v4u){0u, 0u, 0u, 0u}, iv = kv, vv = kv;
                if (isx || ismeta) { kv = *(const GAS v4u*)(src + C2_DK + 8 * sub); iv = *(const GAS v4u*)(src + C2_IK + 8 * sub); vv = *(const GAS v4u*)(src + C2_DV + 8 * sub); }
                float xk[8]; float sk = 0.f;
#pragma unroll
                for (int i = 0; i < 4; ++i) { xk[2 * i] = __uint_as_float(kv[i] << 16); xk[2 * i + 1] = __uint_as_float(kv[i] & 0xffff0000u); sk += xk[2 * i] * xk[2 * i] + xk[2 * i + 1] * xk[2 * i + 1]; }
                sk += __shfl_xor(sk, 1); sk += __shfl_xor(sk, 2); sk += __shfl_xor(sk, 4);
                const float sck = 1.f / sqrtf(sk * (1.f / 64.f) + EPS);
                *(GAS v4u*)(KC + krow) = (v4u){pkbf(xk[0] * sck * kg0[0], xk[1] * sck * kg0[1]), pkbf(xk[2] * sck * kg0[2], xk[3] * sck * kg0[3]), pkbf(xk[4] * sck * kg1[0], xk[5] * sck * kg1[1]), pkbf(xk[6] * sck * kg1[2], xk[7] * sck * kg1[3])};
                *(GAS v4u*)(IKC + krow) = iv;
                *(GAS v4u*)(VC + krow) = vv;
                *(LAS v4u*)(vscr + lane * 16) = vv;
                LDS_WAIT(); asm volatile("" ::: "memory");
                { const LAS unsigned short* vs = (const LAS unsigned short*)vscr + lane; v4u o;
#pragma unroll
                  for (int i = 0; i < 4; ++i) o[i] = (unsigned)vs[(2 * i) * 64] | ((unsigned)vs[(2 * i + 1) * 64] << 16);
                  *(GAS v4u*)(VT + ((size_t)b * 64 + lane) * KROWS + 8 * gidx) = o; }
                LDS_WAIT(); asm volatile("" ::: "memory");
            }
            __syncthreads();
        }
        if (vcu < 256) {
            const int b = vcu >> 4, h = (vcu >> 2) & 3, dq = vcu & 3;
            const float lg2 = log2f(1.f - exp2f(-5.f - (float)h));
            const float cdec = exp2f(lg2 * 128.f);
            LAS unsigned char* Kimg = lds + 3 * 40960;
            f32x4 acc[2]; acc[0] = (f32x4){0.f, 0.f, 0.f, 0.f}; acc[1] = acc[0];
            f32x4 rc[4], rc1[4], rstep[4];
            { const int c = (tid >> 1) & 127, jh = tid & 1; int t0 = c - 112; t0 = t0 < 0 ? 0 : t0; const int t1 = 16 + c;
              const GAS f32x4* r0 = (const GAS f32x4*)(ROPE + ((size_t)t0 * 64 + 16 * dq + 8 * jh) * 2); const GAS f32x4* r1 = (const GAS f32x4*)(ROPE + ((size_t)t1 * 64 + 16 * dq + 8 * jh) * 2);
              const GAS f32x4* rs = (const GAS f32x4*)(ROPE + ((size_t)128 * 64 + 16 * dq + 8 * jh) * 2);
#pragma unroll
              for (int i = 0; i < 4; ++i) { rc[i] = r0[i]; rc1[i] = r1[i]; rstep[i] = rs[i]; } }
            const float ksc0 = RET_KSCALE * exp2f(lg2 * (float)(127 - ((tid >> 1) & 127)));
#define R12_DMA(n, slot) do { const bool m0_ = (n) == 0; const size_t rs_ = m0_ ? (size_t)DINP : (size_t)128;     \
                const bf16* kb_ = m0_ ? PM16 + C_RK + 128 * h : RET + ((size_t)(4 + h) * M + (size_t)b * SEQ + 128 * ((n) - 1)) * 128; const bf16* vb_ = m0_ ? PM16 + C_RV + 128 * h : RET + ((size_t)(8 + h) * M + (size_t)b * SEQ + 128 * ((n) - 1)) * 128; \
                _Pragma("unroll") for (int i = 0; i < 4; ++i) __builtin_amdgcn_global_load_lds((const unsigned*)(vb_ + (size_t)(16 * wave + 4 * i + (lane >> 4)) * rs_ + 8 * ((lane & 15) ^ (2 * (lane >> 4)))), (LAS unsigned*)(lds + (slot) * 40960 + (4 * wave + i) * 1024), 16, 0, 0); \
                __builtin_amdgcn_global_load_lds((const unsigned*)(kb_ + (size_t)(16 * wave + (lane >> 2)) * rs_ + 64 * ((lane >> 1) & 1) + 16 * dq + 8 * (lane & 1)), (LAS unsigned*)(lds + (slot) * 40960 + 32768 + wave * 1024), 16, 0, 0); } while (0)
            R12_DMA(0, 0); R12_DMA(1, 1); R12_DMA(2, 2);
            asm volatile("s_waitcnt vmcnt(0)" ::: "memory"); __syncthreads();
            const unsigned kimg_a0 = DSA_LDS_ADDR(Kimg + ((tid >> 1) & 127) * 64 + 16 * (tid & 1));
            const unsigned trk_a = DSA_LDS_ADDR(Kimg + (8 * (lane >> 4) + ((lane >> 2) & 3)) * 64 + 8 * (lane & 3));
            const unsigned trv_off = (unsigned)((8 * (lane >> 4) + ((lane >> 2) & 3)) * 256 + 16 * ((2 * wave + ((lane & 3) >> 1)) ^ (2 * ((lane >> 2) & 3))) + 8 * (lane & 1));
#pragma unroll 1
            for (int n = 0; n < 32; ++n) {
                const LAS unsigned char* slot = lds + (n % 3) * 40960;
                const unsigned slot_a = DSA_LDS_ADDR(slot);
                if (tid < 256) {
                    if (n == 1) {
#pragma unroll
                        for (int i = 0; i < 4; ++i) rc[i] = rc1[i]; }
                    else if (n > 1) {
#pragma unroll
                        for (int i = 0; i < 4; ++i) { const f32x4 a = rc[i], st = rstep[i];
                            rc[i] = (f32x4){a[0] * st[0] - a[1] * st[1], a[1] * st[0] + a[0] * st[1], a[2] * st[2] - a[3] * st[3], a[3] * st[2] + a[2] * st[3]}; } }
                    const LAS unsigned char* rp = slot + 32768 + (tid >> 1) * 64 + 16 * (tid & 1); v4u o1, o2;
                    rot8(*(const LAS v4u*)rp, *(const LAS v4u*)(rp + 32), rc, ksc0, o1, o2);
                    asm volatile("ds_write_b128 %0, %1\n\tds_write_b128 %0, %2 offset:32" :: "v"(kimg_a0), "v"(o1), "v"(o2) : "memory"); }
                asm volatile("s_waitcnt lgkmcnt(0)\n\ts_barrier" ::: "memory");
                acc[0] = acc[0] * cdec; acc[1] = acc[1] * cdec;
                { const unsigned va_ = slot_a + trv_off;
#pragma unroll
                  for (int kp = 0; kp < 2; ++kp) { u32x2v t[12];
                      if (kp == 0) asm volatile(TR_RD "%0, %12\n\t" TR_RD "%1, %12 offset:256\n\t" TR_RD "%2, %12 offset:32\n\t" TR_RD "%3, %12 offset:288\n\t" TR_RD "%4, %13\n\t" TR_RD "%5, %13 offset:1024\n\t"
                                                TR_RD "%6, %12 offset:2048\n\t" TR_RD "%7, %12 offset:2304\n\t" TR_RD "%8, %12 offset:2080\n\t" TR_RD "%9, %12 offset:2336\n\t" TR_RD "%10, %13 offset:8192\n\t" TR_RD "%11, %13 offset:9216\n\ts_waitcnt lgkmcnt(0)"
                                                : "=&v"(t[0]), "=&v"(t[1]), "=&v"(t[2]), "=&v"(t[3]), "=&v"(t[4]), "=&v"(t[5]), "=&v"(t[6]), "=&v"(t[7]), "=&v"(t[8]), "=&v"(t[9]), "=&v"(t[10]), "=&v"(t[11]) : "v"(trk_a), "v"(va_) : "memory");
                      else asm volatile(TR_RD "%0, %12 offset:4096\n\t" TR_RD "%1, %12 offset:4352\n\t" TR_RD "%2, %12 offset:4128\n\t" TR_RD "%3, %12 offset:4384\n\t" TR_RD "%4, %13 offset:16384\n\t" TR_RD "%5, %13 offset:17408\n\t"
                                        TR_RD "%6, %12 offset:6144\n\t" TR_RD "%7, %12 offset:6400\n\t" TR_RD "%8, %12 offset:6176\n\t" TR_RD "%9, %12 offset:6432\n\t" TR_RD "%10, %13 offset:24576\n\t" TR_RD "%11, %13 offset:25600\n\ts_waitcnt lgkmcnt(0)"
                                        : "=&v"(t[0]), "=&v"(t[1]), "=&v"(t[2]), "=&v"(t[3]), "=&v"(t[4]), "=&v"(t[5]), "=&v"(t[6]), "=&v"(t[7]), "=&v"(t[8]), "=&v"(t[9]), "=&v"(t[10]), "=&v"(t[11]) : "v"(trk_a), "v"(va_) : "memory");
#pragma unroll
                      for (int kk = 0; kk < 2; ++kk) { const bf16x8 a0 = tr_pack(t[6 * kk], t[6 * kk + 1]), a1 = tr_pack(t[6 * kk + 2], t[6 * kk + 3]), bv = tr_pack(t[6 * kk + 4], t[6 * kk + 5]);
                          acc[0] = MFMA16(a0, bv, acc[0]); acc[1] = MFMA16(a1, bv, acc[1]); } } }
                bf16* sp = SPT + ((size_t)((b * 4 + h) * 32 + n)) * 16384;
#pragma unroll
                for (int dt = 0; dt < 2; ++dt) { const int e = 16 * wave + (lane & 15), d = 64 * dt + 16 * dq + 4 * (lane >> 4);
                    *(GAS u32x2v*)(sp + e * 128 + d) = (u32x2v){pkbf(acc[dt][0], acc[dt][1]), pkbf(acc[dt][2], acc[dt][3])}; }
                asm volatile("s_waitcnt vmcnt(9) lgkmcnt(0)\n\ts_barrier" ::: "memory");
                { const int nn = n + 3 < 32 ? n + 3 : 31; R12_DMA(nn, n % 3); }
            }
            asm volatile("s_waitcnt vmcnt(0)" ::: "memory"); __syncthreads();
#undef R12_DMA
        }
        if (BOTH(2)) GRID_BAR();
    }
    if (IN(3)) {
        {
            for (int i = tid; i < 8 * 144; i += 512) { const int h = i / 144, d = i % 144 - 8; float v = 0.f;
                if (d >= 0 && d < 113) { int bk = d; if (d >= 16) { bk = 16 + (int)(logf((float)d * (1.f / 16.f)) / logf(8.f) * 16.f); bk = bk > 31 ? 31 : bk; } v = (rel_bias[bk * 8 + h] - rel_bias[31 * 8 + h]) * LOG2E; }
                ((LAS float*)(lds + L_BIAS))[i] = v; }
            __syncthreads();
            LAS unsigned* HIST = (LAS unsigned*)(lds + L_HIST); LAS unsigned* MASK = (LAS unsigned*)(lds + L_MASK); LAS unsigned* QPAR = (LAS unsigned*)(lds + L_QPAR);
            LAS unsigned* CCNT = (LAS unsigned*)(lds + L_CCNT); const LAS float* BIAS = (const LAS float*)(lds + L_BIAS);
            LAS unsigned char* STG = lds + L_STAGE;
            LAS unsigned char* STG3 = lds + L_HIST;
            const int ql = lane & 15, g4 = lane >> 4;
            const int dk_row = 32 * (wave >> 2) + 8 * (ql >> 2) + 4 * ((wave >> 1) & 1) + (ql & 3), dk_col = 32 * (wave & 1) + 8 * g4;
            const int dv_row = 16 * (wave & 3) + ql, dv_col = 32 * (wave >> 2) + 8 * g4;
            const int xq = vcu >> 5;
            for (;;) {
                if (vcu >= 256) break;
                if (tid == 0) MISC[4] = __hip_atomic_fetch_add(ctl + 2048 + 64 * xq, 1u, __ATOMIC_RELAXED, __HIP_MEMORY_SCOPE_AGENT);
                __syncthreads();
                const int uq = (int)MISC[4];
                __syncthreads();
                if (uq >= 64) break;
                const int b = 2 * xq + (uq >> 5), j = 31 - (uq & 31);
                const int nt = 5 + 4 * j, ns = (nt + 1) >> 1;
                const int qloc = 16 * wave + ql;
                const size_t mrow = (size_t)b * SEQ + 128 * j + qloc;
                const int p = 16 + 128 * j + qloc;
                const int pmaxw = 16 + 128 * j + 16 * wave + 15;
                const bf16* ikb = IKC + (size_t)b * KROWS * 64; const bf16* kcb = KC + (size_t)b * KROWS * 64; const bf16* vtb = VT + (size_t)b * 64 * KROWS; const bf16* vcb = VC + (size_t)b * KROWS * 64;
                unsigned char* tqb = (b < 15 ? (unsigned char*)out + (size_t)b * (17u << 20) : ws + WS_QN) + (size_t)(j * j + 2 * j) * 16384 + wave * 1024 + lane * 16;
                LAS unsigned* hrow = HIST + qloc * 128;
                bf16x8 iq[8][2], cq[2]; float wh[8];
                { const bf16* rp = PROJ + mrow * DP2 + C2_IQ + 8 * g4;
#pragma unroll
                  for (int h = 0; h < 8; ++h) { iq[h][0] = *(const GAS bf16x8*)(rp + 64 * h); iq[h][1] = *(const GAS bf16x8*)(rp + 64 * h + 32); }
                  const v4u wv = *(const GAS v4u*)(PROJ + mrow * DP2 + C2_IW);
#pragma unroll
                  for (int i = 0; i < 4; ++i) { wh[2 * i] = __uint_as_float(wv[i] << 16) * (0.5f * 0.35355339059327373f * 0.125f); wh[2 * i + 1] = __uint_as_float(wv[i] & 0xffff0000u) * (0.5f * 0.35355339059327373f * 0.125f); }
#pragma unroll
                  for (int sx = 0; sx < 2; ++sx) { float ca[8];
#pragma unroll
                      for (int e = 0; e < 8; ++e) ca[e] = 0.f;
#pragma unroll
                      for (int h = 0; h < 8; ++h) { const v4u qv = __builtin_bit_cast(v4u, iq[h][sx]);
#pragma unroll
                          for (int e = 0; e < 4; ++e) { ca[2 * e] = __builtin_fmaf(wh[h], __uint_as_float(qv[e] << 16), ca[2 * e]); ca[2 * e + 1] = __builtin_fmaf(wh[h], __uint_as_float(qv[e] & 0xffff0000u), ca[2 * e + 1]); } }
                      const v4u cw = (v4u){pkbf(ca[0], ca[1]), pkbf(ca[2], ca[3]), pkbf(ca[4], ca[5]), pkbf(ca[6], ca[7])}; cq[sx] = __builtin_bit_cast(bf16x8, cw); } }
                float lo, invw, binc;
                { float s1 = 0.f, s2 = 0.f;
                  int lane_p0 = lane; DSA_OPAQUE(lane_p0);
                  for (int kt = 0; kt < 2; ++kt) { f32x4 sc[2]; idx_tile(ikb, kt, iq, cq, wh, lane_p0, sc);
#pragma unroll
                      for (int u = 0; u < 2; ++u)
#pragma unroll
                          for (int r = 0; r < 4; ++r) { s1 += sc[u][r]; s2 += sc[u][r] * sc[u][r]; } }
                  s1 += __shfl_xor(s1, 16); s1 += __shfl_xor(s1, 32); s2 += __shfl_xor(s2, 16); s2 += __shfl_xor(s2, 32);
                  const float mean = s1 * (1.f / 64.f); float var = s2 * (1.f / 64.f) - mean * mean; var = var > 1e-30f ? var : 1e-30f;
                  const float sd = sqrtf(var); lo = mean - 3.f * sd; invw = 256.f * (float)DSA_NB / (6.f * sd); binc = -lo * invw; }
                { LAS v4u* hz = (LAS v4u*)(HIST + 16 * wave * 128);
#pragma unroll
                  for (int i = 0; i < 8; ++i) hz[lane + 64 * i] = (v4u){0u, 0u, 0u, 0u}; }
                __syncthreads();
                DSA_DMA_K(ikb, 0, DSA_PB1(0)); DSA_DMA_K(ikb, ns > 1 ? 1 : ns - 1, DSA_PB1(1)); DSA_DMA_K(ikb, ns > 2 ? 2 : ns - 1, DSA_PB1(2));
                DSA_WAITBAR(2);
                { const unsigned hbase = DSA_LDS_ADDR(hrow); unsigned one_v = 1u; DSA_OPAQUE(one_v);
                for (int step = 0; step < ns; ++step) {
                    { const int sn = step + 3 < ns ? step + 3 : ns - 1; DSA_DMA_K(ikb, sn, DSA_PB1(step + 3)); }
                    const LAS unsigned char* tb = DSA_PB1(step);
#pragma unroll 1
                    for (int tt = 0; tt < 2; ++tt) { const int kt = 2 * step + tt; unsigned tqv[4]; if (32 * kt > pmaxw) continue;
                        if (32 * kt + 31 <= pmaxw - 15) {
#pragma unroll
                        for (int u = 0; u < 2; ++u) { const f32x4 scu = idx_sub_lds2(tb + tt * 4096, u, iq, cq, wh, lane);
#pragma unroll
                            for (int r = 0; r < 4; ++r) {
                                const unsigned tq = (unsigned)(int)__builtin_amdgcn_fmed3f(bin_t(scu[r], binc, invw), 0.f, 32767.f);
                                asm volatile("ds_add_u32 %0, %1" :: "v"(hbase | ((tq >> 6) & 0x1fcu)), "v"(one_v) : "memory");
                                tqv[r] = tq; }
                            *(GAS u32x2v*)(tqb + (size_t)kt * 8192 + 8 * u) = (u32x2v){tqv[0] | (tqv[1] << 16), tqv[2] | (tqv[3] << 16)};
                            __builtin_amdgcn_sched_barrier(0); }
                        } else {
#pragma unroll
                        for (int u = 0; u < 2; ++u) { const f32x4 scu = idx_sub_lds2(tb + tt * 4096, u, iq, cq, wh, lane);
#pragma unroll
                            for (int r = 0; r < 4; ++r) { const int kk = 32 * kt + 8 * g4 + 4 * u + r; const bool causal = kk <= p;
                                const unsigned tq = (unsigned)(int)__builtin_amdgcn_fmed3f(bin_t(scu[r], binc, invw), 0.f, 32767.f);
                                asm volatile("ds_add_u32 %0, %1" :: "v"(hbase | ((tq >> 6) & 0x1fcu)), "v"(causal ? 1u : 0u) : "memory");
                                tqv[r] = causal ? tq : 0xffffu; }
                            *(GAS u32x2v*)(tqb + (size_t)kt * 8192 + 8 * u) = (u32x2v){tqv[0] | (tqv[1] << 16), tqv[2] | (tqv[3] << 16)};
                            __builtin_amdgcn_sched_barrier(0); } } }
                    DSA_WAITBAR(2);
                } }
#pragma unroll 1
                for (int qq = 0; qq < 16; ++qq) { const int q = 16 * wave + qq; const int pq = 16 + 128 * j + q; const int kq = pq + 1 < 256 ? pq + 1 : 256;
                    const u32x2v wv = *(const LAS u32x2v*)(HIST + q * 128 + 2 * lane);
                    const int c0 = (int)wv[0], c1 = (int)wv[1]; const int sl = c0 + c1;
                    int pre = sl;
                    pre += __builtin_amdgcn_update_dpp(0, pre, 0x111, 0xf, 0xf, true); pre += __builtin_amdgcn_update_dpp(0, pre, 0x112, 0xf, 0xf, true);
                    pre += __builtin_amdgcn_update_dpp(0, pre, 0x114, 0xf, 0xf, true); pre += __builtin_amdgcn_update_dpp(0, pre, 0x118, 0xf, 0xf, true);
                    pre += __builtin_amdgcn_update_dpp(0, pre, 0x142, 0xa, 0xf, false); pre += __builtin_amdgcn_update_dpp(0, pre, 0x143, 0xc, 0xf, false);
                    int cum = __builtin_amdgcn_readlane(pre, 63) - pre; int bst = -1, ngt = 0;
                    if (cum < kq && cum + c1 >= kq) { bst = 2 * lane + 1; ngt = cum; } cum += c1;
                    if (cum < kq && cum + c0 >= kq) { bst = 2 * lane + 0; ngt = cum; }
                    if (bst >= 0) { QPAR[q * 4 + 0] = (unsigned)bst; QPAR[q * 4 + 1] = (unsigned)(kq - ngt); } }
                LDS_WAIT(); asm volatile("" ::: "memory");
                const int bstar = (int)QPAR[qloc * 4 + 0];
                int ccnt = 0;
                const unsigned cbase = DSA_LDS_ADDR(lds + L_HIST + qloc * 256), mbase = DSA_LDS_ADDR(MASK + qloc * DSA_MSTR);
                const int thi16 = (bstar + 1) << 8;
                __syncthreads();
                { v4u tw[4];
#pragma unroll
                  for (int i = 0; i < 4; ++i) tw[i] = *(const GAS v4u*)(tqb + (size_t)(i < 2 * ns ? i : 0) * 8192);
                  for (int kt0 = 0; kt0 < 2 * ns; kt0 += 4) {
#pragma unroll
                    for (int i = 0; i < 4; ++i) { const int kt = kt0 + i; if (kt < 2 * ns && 32 * kt <= pmaxw) {
                        const v4u cw = tw[i]; { const int kn = kt + 4 < 2 * ns ? kt + 4 : kt; tw[i] = *(const GAS v4u*)(tqb + (size_t)kn * 8192); }
                        unsigned bits = 0u;
#pragma unroll
                        for (int e = 0; e < 8; ++e) { const unsigned tq = (e & 1) ? cw[e >> 1] >> 16 : cw[e >> 1] & 0xffffu; const int kk = 32 * kt + 8 * g4 + e;
                            bits |= (int)(short)tq >= thi16 ? 1u << (8 * g4 + e) : 0u;
                            const bool cand = (int)(tq >> 8) == bstar; const unsigned long long m = __ballot(cand);
                            if (m) {
                                const unsigned long long mq = (m >> ql) & 0x0001000100010001ull;
                                const int rank = __popcll(mq & ((1ull << (16 * g4)) - 1ull)), tot = __popcll(mq);
                                if (cand) { const int slot = ccnt + rank; if (slot < DSA_CAP) asm volatile("ds_write_b32 %0, %1" :: "v"(cbase + 4u * (unsigned)slot), "v"((tq << 16) | (0xffffu - (unsigned)kk)) : "memory"); }
                                ccnt += tot; } }
                        bits |= __shfl_xor(bits, 16); bits |= __shfl_xor(bits, 32);
                        if (g4 == 0) asm volatile("ds_write_b32 %0, %1" :: "v"(mbase + 4u * (unsigned)kt), "v"(bits) : "memory"); } }
                  } }
                if (g4 == 0) CCNT[qloc] = (unsigned)ccnt;
                LDS_WAIT(); asm volatile("" ::: "memory");
#pragma unroll 1
                for (int qq = 0; qq < 16; ++qq) { const int q = 16 * wave + qq;
                    int cnt = (int)CCNT[q]; cnt = cnt < DSA_CAP ? cnt : DSA_CAP; cnt = __builtin_amdgcn_readfirstlane(cnt);
                    const int need = (int)QPAR[q * 4 + 1];
                    const LAS unsigned* cc_ = (const LAS unsigned*)(lds + L_HIST + q * 256);
                    const unsigned cme = lane < cnt ? cc_[lane] : 0u; const unsigned kme = 0xffffu - (cme & 0xffffu); int rank = 0;
                    for (int t = 0; t < cnt; ++t) rank += (unsigned)__builtin_amdgcn_readlane((int)cme, t) > cme ? 1 : 0;
                    if (lane < cnt && rank < need) __hip_atomic_fetch_or(MASK + q * DSA_MSTR + (kme >> 5), 1u << (kme & 31u), __ATOMIC_RELAXED, __HIP_MEMORY_SCOPE_WORKGROUP); }
                if (j >= 17) {
                    unsigned short* lstg = LISTG + ((size_t)((b * 32 + j) * 128 + 16 * wave)) * 256;
                    if (lane < 16) QPAR[(16 * wave + lane) * 4 + 2] = 0u;
#pragma unroll 1
                    for (int qq = 0; qq < 16; ++qq) { const int q = 16 * wave + qq; const int pq = 16 + 128 * j + q;
#pragma unroll 1
                        for (int rr = 0; rr < 3; ++rr) { const int kt = 64 * rr + lane;
                            unsigned w = (kt <= (pq >> 5)) ? MASK[q * DSA_MSTR + (kt < DSA_MSTR ? kt : 0)] : 0u;
                            const int cw = __popc(w);
                            int pos = cw ? (int)__hip_atomic_fetch_add(QPAR + q * 4 + 2, (unsigned)cw, __ATOMIC_RELAXED, __HIP_MEMORY_SCOPE_WORKGROUP) : 0;
                            while (w) { const int bpos = __builtin_ctz(w); w &= w - 1u; if (pos < 256) lstg[qq * 256 + pos] = (unsigned short)(32 * kt + bpos); ++pos; } } }
                    asm volatile("s_waitcnt vmcnt(0)" ::: "memory");
                    __syncthreads();
                    { int mrow_s = (int)((size_t)b * SEQ + 128 * j + 16 * wave); asm volatile("" : "+s"(mrow_s));
                      dsa_gather(lds + wave * 16384, lds + L_STAGE + wave * 1024, BIAS, kcb, vcb, lstg, QPAR + 16 * wave * 4 + 2, PROJ + (size_t)mrow_s * DP2 + C2_DQ, q_norm_w, Y + (size_t)mrow_s * D + 512, 16 + 128 * j + 16 * wave, lane); }
                    __syncthreads();
                } else {
                    __syncthreads();
                    int mrow_s = (int)mrow; asm volatile("" : "+v"(mrow_s));
                    dsa_sweep<4>(lds, 0, kcb, vtb, PROJ + (size_t)mrow_s * DP2 + C2_DQ, q_norm_w, Y + (size_t)mrow_s * D + 512, ns, p, 16 + 128 * j + 16 * wave, qloc, wave, lane);
                    dsa_sweep<4>(lds, 4, kcb, vtb, PROJ + (size_t)mrow_s * DP2 + C2_DQ, q_norm_w, Y + (size_t)mrow_s * D + 512, ns, p, 16 + 128 * j + 16 * wave, qloc, wave, lane);
                }
            }
            __syncthreads();
        }
        {
            LAS unsigned char* Kimg = lds + RING_OFF; LAS unsigned char* Vimg = Kimg + 128 * IMG_STRIDE; LAS unsigned char* Simg = Vimg + 128 * IMG_STRIDE;
            const int cq = 16 * wave + (lane & 15), g4 = lane >> 4;
            v4u pk[2][2], pv[4], ps[4], pq[4];
#define R3_GRAB(dst) do { if (tid == 0) MISC[5] = __hip_atomic_fetch_add(ctl + 2048 + 64 * 16, 1u, __ATOMIC_RELAXED, __HIP_MEMORY_SCOPE_AGENT); __syncthreads(); dst = (int)MISC[5]; __syncthreads(); } while (0)
#define R3_LOAD(U_) do { const int b_ = (U_) >> 7, h_ = ((U_) >> 5) & 3, n_ = ((U_) & 31) + 1; const size_t r0_ = (size_t)b_ * SEQ + 128 * (n_ - 1); \
                _Pragma("unroll") for (int i_ = 0; i_ < 2; ++i_) { const int item = tid + 512 * i_, c = item >> 3, j = item & 7; const bf16* rp = RET + ((size_t)(4 + h_) * M + r0_ + c) * 128 + 8 * j; pk[i_][0] = *(const GAS v4u*)rp; pk[i_][1] = *(const GAS v4u*)(rp + 64); } \
                const bf16* sp_ = SPT + ((size_t)((b_ * 4 + h_) * 32 + (n_ - 1))) * 16384; \
                _Pragma("unroll") for (int i_ = 0; i_ < 4; ++i_) { const int item = tid + 512 * i_, c = item >> 4, part = item & 15; pv[i_] = *(const GAS v4u*)(RET + ((size_t)(8 + h_) * M + r0_ + c) * 128 + 8 * part); ps[i_] = *(const GAS v4u*)(sp_ + c * 128 + 8 * part); } \
                { const bf16* rp = RET + ((size_t)h_ * M + r0_ + cq) * 128 + 8 * g4; pq[0] = *(const GAS v4u*)rp; pq[1] = *(const GAS v4u*)(rp + 32); pq[2] = *(const GAS v4u*)(rp + 64); pq[3] = *(const GAS v4u*)(rp + 96); } } while (0)
            int unit; R3_GRAB(unit);
            if (unit < BATCH * 4 * 32) R3_LOAD(unit);
            for (;;) {
                if (unit >= BATCH * 4 * 32) break;
                int unit_nx; R3_GRAB(unit_nx);
                const int b = unit >> 7, h = (unit >> 5) & 3, n = (unit & 31) + 1;
                const float lg2 = log2f(1.f - exp2f(-5.f - (float)h));
                const size_t row0 = (size_t)b * SEQ + 128 * (n - 1);
#pragma unroll
                for (int i_ = 0; i_ < 2; ++i_) { const int item = tid + 512 * i_, c = item >> 3, j = item & 7;
                    const int t = 128 * n - 112 + c; const GAS f32x4* rq = (const GAS f32x4*)(ROPE + ((size_t)t * 64 + 8 * j) * 2); f32x4 cs[4]; cs[0] = rq[0]; cs[1] = rq[1]; cs[2] = rq[2]; cs[3] = rq[3];
                    v4u o1, o2; rot8(pk[i_][0], pk[i_][1], cs, RET_KSCALE, o1, o2);
                    *(LAS v4u*)(Kimg + c * IMG_STRIDE + 16 * j) = o1; *(LAS v4u*)(Kimg + c * IMG_STRIDE + 128 + 16 * j) = o2; }
#pragma unroll
                for (int i_ = 0; i_ < 4; ++i_) { const int item = tid + 512 * i_, c = item >> 4, part = item & 15;
                    *(LAS v4u*)(Vimg + c * IMG_STRIDE + 16 * part) = pv[i_];
                    *(LAS v4u*)(Simg + c * IMG_STRIDE + 16 * part) = ps[i_]; }
                bf16x8 qf[4];
                { const int t = 128 * n - 112 + cq;
                  const GAS f32x4* ra = (const GAS f32x4*)(ROPE + ((size_t)t * 64 + 8 * g4) * 2); f32x4 c0[4], c1[4];
#pragma unroll
                  for (int i_ = 0; i_ < 4; ++i_) { c0[i_] = ra[i_]; c1[i_] = ra[16 + i_]; }
                  v4u o0, o1, o2, o3; rot8(pq[0], pq[2], c0, 1.f, o0, o2); rot8(pq[1], pq[3], c1, 1.f, o1, o3);
                  qf[0] = __builtin_bit_cast(bf16x8, o0); qf[1] = __builtin_bit_cast(bf16x8, o1); qf[2] = __builtin_bit_cast(bf16x8, o2); qf[3] = __builtin_bit_cast(bf16x8, o3); }
                __syncthreads();
                if (unit_nx < BATCH * 4 * 32) R3_LOAD(unit_nx);
                u32x2v gpre[8];
                { const bf16* gp0 = RET + ((size_t)(12 + h) * M + row0 + cq) * 128 + 4 * g4;
#pragma unroll
                  for (int et = 0; et < 8; ++et) gpre[et] = *(const GAS u32x2v*)(gp0 + 16 * et); }
                f32x4 oin[8], ocr[8];
#pragma unroll
                for (int et = 0; et < 8; ++et) { oin[et] = (f32x4){0.f, 0.f, 0.f, 0.f}; ocr[et] = oin[et]; }
#pragma unroll
                for (int et = 0; et < 8; ++et)
#pragma unroll
                    for (int ks = 0; ks < 4; ++ks) ocr[et] = MFMA16(frag_n(Simg, IMG_STRIDE, 16 * et + (lane & 15), 32 * ks, lane), qf[ks], ocr[et]);
                const int kgmax = wave >> 1;
                for (int kg = 0; kg <= kgmax; ++kg) {
                    f32x4 st[2];
#pragma unroll
                    for (int u = 0; u < 2; ++u) { st[u] = (f32x4){0.f, 0.f, 0.f, 0.f};
                        const int mrow = 32 * kg + 8 * ((lane & 15) >> 2) + 4 * u + (lane & 3);
#pragma unroll
                        for (int ks = 0; ks < 4; ++ks) st[u] = MFMA16(frag_n(Kimg, IMG_STRIDE, mrow, 32 * ks, lane), qf[ks], st[u]); }
                    float pv[8];
#pragma unroll
                    for (int u = 0; u < 2; ++u)
#pragma unroll
                        for (int r = 0; r < 4; ++r) { const int m = 32 * kg + 8 * g4 + 4 * u + r; const int dd = cq - m; pv[4 * u + r] = dd >= 0 ? st[u][r] * exp2f(lg2 * (float)dd) : 0.f; }
                    const v4u pw = (v4u){pkbf(pv[0], pv[1]), pkbf(pv[2], pv[3]), pkbf(pv[4], pv[5]), pkbf(pv[6], pv[7])};
                    const bf16x8 pf = __builtin_bit_cast(bf16x8, pw);
#pragma unroll
                    for (int et = 0; et < 8; ++et) oin[et] = MFMA16(frag_t(Vimg, IMG_STRIDE, 16 * et, 32 * kg, lane), pf, oin[et]);
                }
                const float xi = exp2f(lg2 * (float)(cq + 1)); float ss = 0.f;
#pragma unroll
                for (int et = 0; et < 8; ++et) { oin[et] = oin[et] + ocr[et] * xi; ss += (oin[et][0] * oin[et][0] + oin[et][1] * oin[et][1]) + (oin[et][2] * oin[et][2] + oin[et][3] * oin[et][3]); }
                ss += __shfl_xor(ss, 16); ss += __shfl_xor(ss, 32);
                const float rinv = 1.f / sqrtf(ss * (1.f / 128.f) + EPS);
                bf16* yp = Y + (row0 + cq) * D + 128 * h + 4 * g4; const float* wn = ret_norm_w + 128 * h + 4 * g4;
#pragma unroll
                for (int et = 0; et < 8; ++et) { const u32x2v gw2 = gpre[et]; const f32x4 gn = *(const GAS f32x4*)(wn + 16 * et);
                    float gt[4] = {__uint_as_float(gw2[0] << 16), __uint_as_float(gw2[0] & 0xffff0000u), __uint_as_float(gw2[1] << 16), __uint_as_float(gw2[1] & 0xffff0000u)}; float o[4];
#pragma unroll
                    for (int r = 0; r < 4; ++r) { const float sg = gt[r] / (1.f + __expf(-gt[r])); o[r] = oin[et][r] * rinv * gn[r] * sg; }
                    *(GAS u32x2v*)(yp + 16 * et) = (u32x2v){pkbf(o[0], o[1]), pkbf(o[2], o[3])}; }
                __syncthreads();
                unit = unit_nx;
            }
#undef R3_GRAB
#undef R3_LOAD
        }
        if (BOTH(3)) GRID_BAR();
    }
    if (IN(4)) {
        pg8::Gemm g{Y, WOUT_T, M, D, D}; pg8::StaticOrder S; S.init(M, D, G, (int)blockIdx.x);
        pg8::EpiResBf16Stats E{U, XS, norm1_w, SSQ, D};
        pg8::gemm_phase<pg8::EpiResBf16Stats, pg8::StaticOrder, true, true>(lds + RING_OFF, g, S, E);
        if (BOTH(4)) GRID_BAR();
    }
    if (IN(6)) {
        pg8::Gemm g{U, W1_T, M, FF, D}; pg8::StaticOrder S; S.init(M, FF, G, (int)blockIdx.x);
        pg8::EpiBf16RowScaleRelu2 E{HB, FF, SSQ, 1.f / D, EPS};
        pg8::gemm_phase<pg8::EpiBf16RowScaleRelu2, pg8::StaticOrder, true, true>(lds + RING_OFF, g, S, E);
        if (BOTH(6)) GRID_BAR();
    }
    if (IN(7)) {
        pg8::Gemm g{HB, W2_T, M, D, FF}; pg8::StaticOrder S; S.init(M, D, G, (int)blockIdx.x);
        pg8::EpiResFromBf16 E{U, out, D};
        pg8::gemm_phase<pg8::EpiResFromBf16, pg8::StaticOrder, true, true>(lds + RING_OFF, g, S, E);
    }
#undef IN
#undef BOTH
}

extern "C" void kernel_launch(void* const* d_in, const int* in_sizes, int n_in, void* d_out, int out_size, void* d_ws, size_t ws_size, hipStream_t stream) {
    static int grid = 0;
    if (grid == 0) {
        if (n_in != 12 || in_sizes[0] != M * D || out_size != M * D || ws_size < WS_END) { fprintf(stderr, "kernel_launch: unexpected shapes (n_in %d, in0 %d, out %d, ws %zu); nothing launched\n", n_in, n_in > 0 ? in_sizes[0] : -1, out_size, ws_size); grid = -1; return; }
        int dev = 0, cus = 0, per_cu = 0;
        if (hipGetDevice(&dev) != hipSuccess || hipDeviceGetAttribute(&cus, hipDeviceAttributeMultiprocessorCount, dev) != hipSuccess) { grid = -1; return; }
        if (hipFuncSetAttribute((const void*)mk_fwd, hipFuncAttributeMaxDynamicSharedMemorySize, LDS_BYTES) != hipSuccess) { fprintf(stderr, "kernel_launch: hipFuncSetAttribute failed\n"); grid = -1; return; }
        if (hipOccupancyMaxActiveBlocksPerMultiprocessor(&per_cu, (const void*)mk_fwd, NWAVES * 64, LDS_BYTES) != hipSuccess || per_cu < 1)
            fprintf(stderr, "kernel_launch: note: occupancy query reports %d workgroups per CU\n", per_cu);
        (void)hipGetLastError();
        grid = cus;
    }
    if (grid < 0) return;
    if (hipMemsetAsync((char*)d_ws + WS_CTL, 0, CTL_ZERO_BYTES, stream) != hipSuccess) return;
    Args a{};
    for (int i = 0; i < 12; ++i) a.in[i] = (const float*)d_in[i];
    a.out = (float*)d_out; a.ws = (unsigned char*)d_ws;
    if (ONE_LAUNCH) { a.ph_lo = 0; a.ph_hi = N_PHASES; hipLaunchKernelGGL(mk_fwd, dim3(grid), dim3(NWAVES * 64), LDS_BYTES, stream, a); }
    else for (int p = 0; p < N_PHASES; ++p) { a.ph_lo = p; a.ph_hi = p + 1; hipLaunchKernelGGL(mk_fwd, dim3(grid), dim3(NWAVES * 64), LDS_BYTES, stream, a); }
    const hipError_t le = hipPeekAtLastError();
    if (le != hipSuccess) fprintf(stderr, "kernel_launch: launch failed: %s\n", hipGetErrorName(le));
}
```

```cpp
#include <hip/hip_runtime.h>
#include <cstdio>
#include <cstdint>
namespace pg8 {
#define PG8_LAS __attribute__((address_space(3)))
typedef unsigned short bf16_t;
typedef short bf16x8 __attribute__((ext_vector_type(8)));
typedef float f32x4 __attribute__((ext_vector_type(4)));
typedef unsigned u32x4 __attribute__((ext_vector_type(4)));
constexpr int BM = 256, BK = 64, HALF = 128, HTB = HALF * BK * 2  , STAGE_BYTES = 8 * HTB, NXCD = 8, WGM = 8;

__host__ __device__ __forceinline__ int lds_byte(int r, int c) { const int st = (r >> 4) * 2 + (c >> 5), rr = r & 15, cc = c & 31, ob = rr * 64 + cc * 2; return st * 1024 + (ob ^ (((ob >> 9) & 1) << 5)); }
__host__ __device__ __forceinline__ void stage_rc(int b, int& R, int& C) { const int st = b / 1024, sb = b % 1024, swz = sb ^ (((sb >> 9) & 1) << 5); R = (st >> 1) * 16 + swz / 64; C = (st & 1) * 32 + (swz % 64) / 2; }
__host__ __device__ __forceinline__ int perm32(int rho) { const int n = rho >> 4, i = rho & 15; return 8 * (i >> 2) + 4 * n + (i & 3); }

struct Unit { int pm, pn; };
struct Gemm { const bf16_t* A; const bf16_t* Bt; int M, N, K; };

struct StaticOrder {
    int nM, nN, nwg, G, c;
    __host__ __device__ void init(int M, int N, int G_, int c_) { nM = M / BM; nN = N / BM; nwg = nM * nN; G = G_; c = c_; }
    __host__ __device__ bool next(int i, Unit& u) const {
        const long L = (long)i * G + c; if (L >= nwg) return false;
        int wgid = (int)L; { const int q = nwg / NXCD, r = nwg % NXCD, xcd = wgid % NXCD, off = wgid / NXCD; wgid = (xcd < r ? xcd * (q + 1) : r * (q + 1) + (xcd - r) * q) + off; }
        const int nig = WGM * nN, gid = wgid / nig, fm = gid * WGM, gsz = (nM - fm) < WGM ? (nM - fm) : WGM;
        u.pm = fm + ((wgid % nig) % gsz); u.pn = (wgid % nig) / gsz; return true;
    }
    __device__ __forceinline__ void a_ready(const Unit&) const {}
    __device__ __forceinline__ void done(const Unit&) const {}
};

typedef float f32x2c __attribute__((ext_vector_type(2))); typedef __bf16 bf16x2c __attribute__((ext_vector_type(2)));
__device__ __forceinline__ unsigned cvt_pk_bf16(float lo, float hi) { const f32x2c v = {lo, hi}; const bf16x2c b = __builtin_convertvector(v, bf16x2c); return __builtin_bit_cast(unsigned, b); }

template <int ACT  > struct EpiBf16 {
    static constexpr bool PERM = true, AFTER_DRAIN = false;
    bf16_t* O; int ldc;
    __device__ __forceinline__ void operator()(const f32x4 (&acc)[2][2][4][2], const Unit& u, int wr, int wc, int fr, int fq) const {
        const int row0 = u.pm * BM + wr * 64 + fr; const int col0 = u.pn * BM + wc * 32 + 8 * fq;
#pragma unroll
        for (int ai = 0; ai < 2; ++ai)
#pragma unroll
            for (int m = 0; m < 4; ++m) { bf16_t* rowp = O + (size_t)(row0 + ai * HALF + m * 16) * ldc + col0;
#pragma unroll
                for (int bj = 0; bj < 2; ++bj) { f32x4 v0 = acc[ai][bj][m][0], v1 = acc[ai][bj][m][1];
                    if (ACT == 2) {
#pragma unroll
                        for (int e = 0; e < 4; ++e) { const float a = fmaxf(v0[e], 0.f), b = fmaxf(v1[e], 0.f); v0[e] = a * a; v1[e] = b * b; } }
                    u32x4 w; w.x = cvt_pk_bf16(v0[0], v0[1]); w.y = cvt_pk_bf16(v0[2], v0[3]); w.z = cvt_pk_bf16(v1[0], v1[1]); w.w = cvt_pk_bf16(v1[2], v1[3]);
                    __builtin_nontemporal_store(w, (u32x4*)(rowp + bj * HALF)); } }
    }
};

struct EpiProj {
    static constexpr bool PERM = true, AFTER_DRAIN = false;
    bf16_t* O; int ldc; bf16_t* R; int mrows;
    __device__ __forceinline__ void operator()(const f32x4 (&acc)[2][2][4][2], const Unit& u, int wr, int wc, int fr, int fq) const {
        const int row0 = u.pm * BM + wr * 64 + fr; const int col0 = (u.pn - 8) * BM + wc * 32 + 8 * fq; const bool hm = u.pn < 8;
#pragma unroll
        for (int ai = 0; ai < 2; ++ai)
#pragma unroll
            for (int m = 0; m < 4; ++m) { const int row = row0 + ai * HALF + m * 16;
#pragma unroll
                for (int bj = 0; bj < 2; ++bj) { const f32x4 v0 = acc[ai][bj][m][0], v1 = acc[ai][bj][m][1];
                    u32x4 w; w.x = cvt_pk_bf16(v0[0], v0[1]); w.y = cvt_pk_bf16(v0[2], v0[3]); w.z = cvt_pk_bf16(v1[0], v1[1]); w.w = cvt_pk_bf16(v1[2], v1[3]);
                    bf16_t* p = hm ? R + ((size_t)(u.pn * 2 + bj) * mrows + row) * 128 + wc * 32 + 8 * fq : O + (size_t)row * ldc + col0 + bj * HALF;
                    __builtin_nontemporal_store(w, (u32x4*)p); } }
    }
};

struct EpiResF32 {
    static constexpr bool PERM = true, AFTER_DRAIN = false;
    const float* base; float* out; int ldc;
    __device__ __forceinline__ void operator()(const f32x4 (&acc)[2][2][4][2], const Unit& u, int wr, int wc, int fr, int fq) const {
        const int col0 = u.pn * BM + wc * 32 + 8 * fq;
#pragma unroll
        for (int ai = 0; ai < 2; ++ai)
#pragma unroll
            for (int m = 0; m < 4; ++m) { const size_t off = (size_t)(u.pm * BM + ai * HALF + wr * 64 + m * 16 + fr) * ldc + col0;
#pragma unroll
                for (int bj = 0; bj < 2; ++bj)
#pragma unroll
                    for (int n = 0; n < 2; ++n) { const f32x4 bs = *(const f32x4*)(base + off + bj * HALF + n * 4); *(f32x4*)(out + off + bj * HALF + n * 4) = bs + acc[ai][bj][m][n]; }
                if (m & 1) asm volatile("" ::: "memory"); }
    }
};
struct EpiResF32Stats {
    static constexpr bool PERM = true, AFTER_DRAIN = false;
    const float* base; float* out; bf16_t* xn; const float* w; float* ss; int ldc;
    __device__ __forceinline__ void operator()(const f32x4 (&acc)[2][2][4][2], const Unit& u, int wr, int wc, int fr, int fq) const {
        const int col0 = u.pn * BM + wc * 32 + 8 * fq;
        f32x4 wv[2][2];
#pragma unroll
        for (int bj = 0; bj < 2; ++bj)
#pragma unroll
            for (int n = 0; n < 2; ++n) wv[bj][n] = *(const f32x4*)(w + col0 + bj * HALF + n * 4);
#pragma unroll
        for (int ai = 0; ai < 2; ++ai)
#pragma unroll
            for (int m = 0; m < 4; ++m) { const int row = u.pm * BM + ai * HALF + wr * 64 + m * 16 + fr; const size_t off = (size_t)row * ldc + col0; float s = 0.f;
#pragma unroll
                for (int bj = 0; bj < 2; ++bj) { f32x4 a[2];
#pragma unroll
                    for (int n = 0; n < 2; ++n) { const f32x4 h = *(const f32x4*)(base + off + bj * HALF + n * 4) + acc[ai][bj][m][n]; *(f32x4*)(out + off + bj * HALF + n * 4) = h;
                        s += (h[0] * h[0] + h[1] * h[1]) + (h[2] * h[2] + h[3] * h[3]); a[n] = h * wv[bj][n]; }
                    u32x4 o; o.x = cvt_pk_bf16(a[0][0], a[0][1]); o.y = cvt_pk_bf16(a[0][2], a[0][3]); o.z = cvt_pk_bf16(a[1][0], a[1][1]); o.w = cvt_pk_bf16(a[1][2], a[1][3]);
                    *(u32x4*)(xn + off + bj * HALF) = o; }
                s += __shfl_xor(s, 16); s += __shfl_xor(s, 32);
                if (fq == 0) __hip_atomic_fetch_add(ss + row, s, __ATOMIC_RELAXED, __HIP_MEMORY_SCOPE_AGENT);
                if (m & 1) asm volatile("" ::: "memory"); }
    }
};
struct EpiBf16RowScaleRelu2 {
    static constexpr bool PERM = true, AFTER_DRAIN = false;
    bf16_t* O; int ldc; const float* ss; float inv_n, eps;
    __device__ __forceinline__ void operator()(const f32x4 (&acc)[2][2][4][2], const Unit& u, int wr, int wc, int fr, int fq) const {
        const int row0 = u.pm * BM + wr * 64 + fr; const int col0 = u.pn * BM + wc * 32 + 8 * fq;
#pragma unroll
        for (int ai = 0; ai < 2; ++ai)
#pragma unroll
            for (int m = 0; m < 4; ++m) { const int row = row0 + ai * HALF + m * 16; bf16_t* rowp = O + (size_t)row * ldc + col0; const float ri = 1.f / sqrtf(ss[row] * inv_n + eps);
#pragma unroll
                for (int bj = 0; bj < 2; ++bj) { f32x4 v0 = acc[ai][bj][m][0], v1 = acc[ai][bj][m][1];
#pragma unroll
                    for (int e = 0; e < 4; ++e) { const float a = fmaxf(v0[e] * ri, 0.f), b = fmaxf(v1[e] * ri, 0.f); v0[e] = a * a; v1[e] = b * b; }
                    u32x4 w; w.x = cvt_pk_bf16(v0[0], v0[1]); w.y = cvt_pk_bf16(v0[2], v0[3]); w.z = cvt_pk_bf16(v1[0], v1[1]); w.w = cvt_pk_bf16(v1[2], v1[3]);
                    __builtin_nontemporal_store(w, (u32x4*)(rowp + bj * HALF)); } }
    }
};

struct EpiResBf16Stats {
    static constexpr bool PERM = true, AFTER_DRAIN = false;
    bf16_t* xn; const float* xs; const float* w1; float* ss; int ldc;
    __device__ __forceinline__ void operator()(const f32x4 (&acc)[2][2][4][2], const Unit& u, int wr, int wc, int fr, int fq) const {
        const int col0 = u.pn * BM + wc * 32 + 8 * fq;
        f32x4 iw[2][2];
#pragma unroll
        for (int bj = 0; bj < 2; ++bj)
#pragma unroll
            for (int n = 0; n < 2; ++n) { const f32x4 g = *(const f32x4*)(w1 + col0 + bj * HALF + n * 4); iw[bj][n] = (f32x4){1.f / g[0], 1.f / g[1], 1.f / g[2], 1.f / g[3]}; }
#pragma unroll
        for (int ai = 0; ai < 2; ++ai)
#pragma unroll
            for (int m = 0; m < 4; ++m) { const int row = u.pm * BM + ai * HALF + wr * 64 + m * 16 + fr; const size_t off = (size_t)row * ldc + col0; float s = 0.f; const float xr = xs[row];
#pragma unroll
                for (int bj = 0; bj < 2; ++bj) { const u32x4 b = *(const u32x4*)(xn + off + bj * HALF); f32x4 h[2];
                    h[0] = (f32x4){__uint_as_float(b.x << 16), __uint_as_float(b.x & 0xffff0000u), __uint_as_float(b.y << 16), __uint_as_float(b.y & 0xffff0000u)} * iw[bj][0] * xr + acc[ai][bj][m][0];
                    h[1] = (f32x4){__uint_as_float(b.z << 16), __uint_as_float(b.z & 0xffff0000u), __uint_as_float(b.w << 16), __uint_as_float(b.w & 0xffff0000u)} * iw[bj][1] * xr + acc[ai][bj][m][1];
#pragma unroll
                    for (int n = 0; n < 2; ++n) s += (h[n][0] * h[n][0] + h[n][1] * h[n][1]) + (h[n][2] * h[n][2] + h[n][3] * h[n][3]);
                    u32x4 o; o.x = cvt_pk_bf16(h[0][0], h[0][1]); o.y = cvt_pk_bf16(h[0][2], h[0][3]); o.z = cvt_pk_bf16(h[1][0], h[1][1]); o.w = cvt_pk_bf16(h[1][2], h[1][3]);
                    *(u32x4*)(xn + off + bj * HALF) = o; }
                s += __shfl_xor(s, 16); s += __shfl_xor(s, 32);
                if (fq == 0) __hip_atomic_fetch_add(ss + row, s, __ATOMIC_RELAXED, __HIP_MEMORY_SCOPE_AGENT);
                if (m & 1) asm volatile("" ::: "memory"); }
    }
};
struct EpiResFromBf16 {
    static constexpr bool PERM = true, AFTER_DRAIN = false;
    const bf16_t* base; float* out; int ldc;
    __device__ __forceinline__ void operator()(const f32x4 (&acc)[2][2][4][2], const Unit& u, int wr, int wc, int fr, int fq) const {
        const int col0 = u.pn * BM + wc * 32 + 8 * fq;
#pragma unroll
        for (int ai = 0; ai < 2; ++ai)
#pragma unroll
            for (int m = 0; m < 4; ++m) { const size_t off = (size_t)(u.pm * BM + ai * HALF + wr * 64 + m * 16 + fr) * ldc + col0;
#pragma unroll
                for (int bj = 0; bj < 2; ++bj) { const u32x4 b = *(const u32x4*)(base + off + bj * HALF);
                    const f32x4 b0 = (f32x4){__uint_as_float(b.x << 16), __uint_as_float(b.x & 0xffff0000u), __uint_as_float(b.y << 16), __uint_as_float(b.y & 0xffff0000u)};
                    const f32x4 b1 = (f32x4){__uint_as_float(b.z << 16), __uint_as_float(b.z & 0xffff0000u), __uint_as_float(b.w << 16), __uint_as_float(b.w & 0xffff0000u)};
                    __builtin_nontemporal_store(b0 + acc[ai][bj][m][0], (f32x4*)(out + off + bj * HALF)); __builtin_nontemporal_store(b1 + acc[ai][bj][m][1], (f32x4*)(out + off + bj * HALF + 4)); }
                if (m & 1) asm volatile("" ::: "memory"); }
    }
};
template <class Epi, class Sched, bool ALIGN_EPI = false, bool SP2 = false>
__device__ __forceinline__ void gemm_phase(PG8_LAS unsigned char* lds, const Gemm g, const Sched& S, const Epi& E) {
    const int tid = threadIdx.x, wid = __builtin_amdgcn_readfirstlane(tid >> 6), lane = tid & 63, wr = wid >> 2, wc = wid & 3, fr = lane & 15, fq = lane >> 4;
    const int K = g.K, nt = K / BK;
    unsigned voffA[2], voffB[2];
#pragma unroll
    for (int i = 0; i < 2; ++i) { int R, C; stage_rc(tid * 16 + i * 8192, R, C); const int Rb = Epi::PERM ? ((R & ~31) + perm32(R & 31)) : R;
        voffA[i] = (unsigned)(R * K + C) * 2u; voffB[i] = (unsigned)(Rb * K + C) * 2u; }
    const size_t kstep = (size_t)(BK * 2);
    const size_t hstep = (size_t)HALF * K * 2;
    const size_t tstep = 2 * hstep;
    const unsigned ldsw = (unsigned)wid * 1024u;
    const int aoff = lds_byte(wr * 64 + fr, fq * 8), boff = lds_byte(wc * 32 + fr, fq * 8);
#define PG8_SA(b, h) (((b) * 2 + (h)) * HTB)
#define PG8_SB(b, h) ((4 + (b) * 2 + (h)) * HTB)
#define PG8_STAGE(bufoff, gbase, voff) do { _Pragma("unroll") for (int _i = 0; _i < 2; ++_i) \
        __builtin_amdgcn_global_load_lds((const unsigned*)((const char*)(gbase) + (voff)[_i]), (PG8_LAS unsigned*)(lds + (bufoff) + ldsw + _i * 8192), 16, 0, 0); } while (0)
#define PG8_LDA(dst, b, h) do { _Pragma("unroll") for (int m = 0; m < 4; ++m) _Pragma("unroll") for (int k = 0; k < 2; ++k) dst[m][k] = *(const PG8_LAS bf16x8*)(lds + PG8_SA(b, h) + aoff + m * 2048 + k * 1024); } while (0)
#define PG8_LDB(dst, b, h) do { _Pragma("unroll") for (int n = 0; n < 2; ++n) _Pragma("unroll") for (int k = 0; k < 2; ++k) dst[n][k] = *(const PG8_LAS bf16x8*)(lds + PG8_SB(b, h) + boff + n * 2048 + k * 1024); } while (0)
#define PG8_MMA(ai, bj, At, Bt) do { __builtin_amdgcn_s_setprio(1); _Pragma("unroll") for (int m = 0; m < 4; ++m) _Pragma("unroll") for (int n = 0; n < 2; ++n) _Pragma("unroll") for (int k = 0; k < 2; ++k) \
        acc[ai][bj][m][n] = __builtin_amdgcn_mfma_f32_16x16x32_bf16(Bt[n][k], At[m][k], acc[ai][bj][m][n], 0, 0, 0); __builtin_amdgcn_s_setprio(0); } while (0)
#define PG8_MMAZ(ai, bj, At, Bt) do { __builtin_amdgcn_s_setprio(1); _Pragma("unroll") for (int m = 0; m < 4; ++m) _Pragma("unroll") for (int n = 0; n < 2; ++n) { \
        const f32x4 c0_ = __builtin_amdgcn_mfma_f32_16x16x32_bf16(Bt[n][0], At[m][0], ((f32x4){0.f, 0.f, 0.f, 0.f}), 0, 0, 0); acc[ai][bj][m][n] = __builtin_amdgcn_mfma_f32_16x16x32_bf16(Bt[n][1], At[m][1], c0_, 0, 0, 0); } __builtin_amdgcn_s_setprio(0); } while (0)
#define PG8_WAIT_V(n) asm volatile("s_waitcnt vmcnt(" #n ")" ::: "memory")
#define PG8_WAIT_L(n) asm volatile("s_waitcnt lgkmcnt(" #n ")" ::: "memory")
#define PG8_BAR __builtin_amdgcn_s_barrier()
#define PG8_SCHED __builtin_amdgcn_sched_barrier(0)
    Unit cur, nxt; int ui = 0;
    if (!S.next(0, cur)) return;
    f32x4 acc[2][2][4][2];
    if constexpr (!SP2) {
#pragma unroll
    for (int a = 0; a < 2; ++a)
#pragma unroll
        for (int b = 0; b < 2; ++b)
#pragma unroll
            for (int m = 0; m < 4; ++m)
#pragma unroll
                for (int n = 0; n < 2; ++n) acc[a][b][m][n] = (f32x4){0.f, 0.f, 0.f, 0.f};
    }
    bf16x8 At[4][2], B0[2][2], B1[2][2];
    const char* cA = (const char*)g.A + (size_t)cur.pm * tstep; const char* cB = (const char*)g.Bt + (size_t)cur.pn * tstep;
    S.a_ready(cur);
    if constexpr (SP2) {
        PG8_STAGE(PG8_SB(0, 0), cB, voffB); PG8_STAGE(PG8_SB(0, 1), cB + hstep, voffB); PG8_STAGE(PG8_SA(0, 0), cA, voffA); PG8_STAGE(PG8_SA(0, 1), cA + hstep, voffA);
        if (wr == 1) PG8_BAR;
        PG8_WAIT_V(2); PG8_BAR;
        PG8_STAGE(PG8_SB(1, 0), cB + kstep, voffB); PG8_STAGE(PG8_SA(1, 0), cA + kstep, voffA); PG8_STAGE(PG8_SB(1, 1), cB + hstep + kstep, voffB);
        PG8_WAIT_V(6); PG8_BAR;
    } else {
        PG8_STAGE(PG8_SB(0, 0), cB, voffB); PG8_STAGE(PG8_SA(0, 0), cA, voffA); PG8_STAGE(PG8_SB(0, 1), cB + hstep, voffB); PG8_STAGE(PG8_SA(0, 1), cA + hstep, voffA);
        if (wr == 1) PG8_BAR;
        PG8_WAIT_V(4); PG8_BAR;
        PG8_STAGE(PG8_SB(1, 0), cB + kstep, voffB); PG8_STAGE(PG8_SA(1, 0), cA + kstep, voffA); PG8_STAGE(PG8_SB(1, 1), cB + hstep + kstep, voffB);
        PG8_WAIT_V(6); PG8_BAR;
    }
    for (;;) {
        const bool has_next = S.next(ui + 1, nxt);
        const char* nA = has_next ? (const char*)g.A + (size_t)nxt.pm * tstep : cA; const char* nB = has_next ? (const char*)g.Bt + (size_t)nxt.pn * tstep : cB;
#define PG8_KPTRS \
            const bool last = (t == nt - 2); \
            const char* a1 = cA + (size_t)(t + 1) * kstep;                                             \
            const char* a2 = last ? nA : cA + (size_t)(t + 2) * kstep; const char* b2 = last ? nB : cB + (size_t)(t + 2) * kstep;     \
            const char* a3 = a2 + kstep; const char* b3 = b2 + kstep;                                \
            if (last && has_next) S.a_ready(nxt);
#define PG8_KITER(MM0) \
            PG8_LDB(B0, 0, 0); PG8_LDB(B1, 0, 1); PG8_SCHED; PG8_LDA(At, 0, 0); PG8_STAGE(PG8_SA(1, 1), a1 + hstep, voffA); \
            PG8_WAIT_V(8); PG8_WAIT_L(0); PG8_BAR; MM0(0, 0, At, B0); MM0(0, 1, At, B1); PG8_BAR; PG8_SCHED; \
            PG8_LDA(At, 0, 1); PG8_STAGE(PG8_SB(0, 0), b2, voffB); PG8_STAGE(PG8_SB(0, 1), b2 + hstep, voffB); PG8_STAGE(PG8_SA(0, 0), a2, voffA); \
            PG8_WAIT_V(8); PG8_WAIT_L(0); PG8_BAR; MM0(1, 0, At, B0); MM0(1, 1, At, B1); PG8_BAR; PG8_SCHED; \
            PG8_LDB(B0, 1, 0); PG8_LDB(B1, 1, 1); PG8_SCHED; PG8_LDA(At, 1, 0); PG8_STAGE(PG8_SA(0, 1), a2 + hstep, voffA); \
            PG8_WAIT_V(8); PG8_WAIT_L(0); PG8_BAR; PG8_MMA(0, 0, At, B0); PG8_MMA(0, 1, At, B1); PG8_BAR; PG8_SCHED; \
            PG8_LDA(At, 1, 1); PG8_STAGE(PG8_SB(1, 0), b3, voffB); PG8_STAGE(PG8_SB(1, 1), b3 + hstep, voffB); PG8_STAGE(PG8_SA(1, 0), a3, voffA); \
            PG8_WAIT_V(8); PG8_WAIT_L(0); PG8_BAR; PG8_MMA(1, 0, At, B0); PG8_MMA(1, 1, At, B1); PG8_BAR; PG8_SCHED;
        int t0 = 0;
        if constexpr (SP2) { const int t = 0; PG8_KPTRS PG8_KITER(PG8_MMAZ) t0 = 2; }
        for (int t = t0; t < nt; t += 2) {
            PG8_KPTRS
            if constexpr (SP2) {
            PG8_KITER(PG8_MMA)
            } else {
            PG8_LDB(B0, 0, 0); PG8_SCHED; PG8_LDA(At, 0, 0); PG8_STAGE(PG8_SA(1, 1), a1 + hstep, voffA);
            PG8_WAIT_L(8); PG8_BAR; PG8_WAIT_L(0); PG8_MMA(0, 0, At, B0); PG8_BAR; PG8_SCHED;
            PG8_LDB(B1, 0, 1); PG8_STAGE(PG8_SB(0, 0), b2, voffB);
            PG8_BAR; PG8_WAIT_L(0); PG8_MMA(0, 1, At, B1); PG8_BAR;
            PG8_LDA(At, 0, 1); PG8_STAGE(PG8_SA(0, 0), a2, voffA);
            PG8_BAR; PG8_WAIT_L(0); PG8_MMA(1, 0, At, B0); PG8_BAR; PG8_SCHED;
            PG8_STAGE(PG8_SB(0, 1), b2 + hstep, voffB);
            PG8_WAIT_V(6); PG8_BAR; PG8_MMA(1, 1, At, B1); PG8_BAR;
            PG8_LDB(B0, 1, 0); PG8_SCHED; PG8_LDA(At, 1, 0); PG8_STAGE(PG8_SA(0, 1), a2 + hstep, voffA);
            PG8_WAIT_L(8); PG8_BAR; PG8_WAIT_L(0); PG8_MMA(0, 0, At, B0); PG8_BAR; PG8_SCHED;
            PG8_LDB(B1, 1, 1); PG8_STAGE(PG8_SB(1, 0), b3, voffB);
            PG8_BAR; PG8_WAIT_L(0); PG8_MMA(0, 1, At, B1); PG8_BAR;
            PG8_LDA(At, 1, 1); PG8_STAGE(PG8_SA(1, 0), a3, voffA);
            PG8_BAR; PG8_WAIT_L(0); PG8_MMA(1, 0, At, B0); PG8_BAR; PG8_SCHED;
            PG8_STAGE(PG8_SB(1, 1), b3 + hstep, voffB);
            PG8_WAIT_V(6); PG8_BAR; PG8_MMA(1, 1, At, B1); PG8_BAR;
            }
        }
        if constexpr (ALIGN_EPI) { if (wr == 0) PG8_BAR; }
        if constexpr (!Epi::AFTER_DRAIN) { int ln_ = lane; asm volatile("" : "+v"(ln_));
            E(acc, cur, wr, wc, ln_ & 15, ln_ >> 4); S.done(cur); }
        if (!has_next) break;
        if constexpr (!SP2) {
#pragma unroll
        for (int a = 0; a < 2; ++a)
#pragma unroll
            for (int b = 0; b < 2; ++b)
#pragma unroll
                for (int m = 0; m < 4; ++m)
#pragma unroll
                    for (int n = 0; n < 2; ++n) acc[a][b][m][n] = (f32x4){0.f, 0.f, 0.f, 0.f};
        }
        cur = nxt; cA = nA; cB = nB; ++ui;
        if constexpr (ALIGN_EPI) { if (wr == 1) PG8_BAR; }
    }
    PG8_WAIT_V(0);
    if constexpr (!ALIGN_EPI) { if (wr == 0) PG8_BAR; }
    PG8_BAR;
    if constexpr (Epi::AFTER_DRAIN) { E.fused(acc, cur, wr, wc, fr, fq, lds, wid, lane); S.done(cur); }
#undef PG8_SA
#undef PG8_SB
#undef PG8_STAGE
#undef PG8_LDA
#undef PG8_LDB
#undef PG8_MMA
#undef PG8_MMAZ
#undef PG8_KPTRS
#undef PG8_KITER
#undef PG8_WAIT_V
#undef PG8_WAIT_L
#undef PG8_BAR
#undef PG8_SCHED
}
}
constexpr int NWAVES = 8;
#ifndef MK_N_LAUNCHES
#define MK_N_LAUNCHES 1
#endif
constexpr int N_PHASES = 8;
constexpr bool ONE_LAUNCH = (MK_N_LAUNCHES == 1);

constexpr int BATCH = 16, SEQ = 4096, D = 1024, NMETA = 16, TK = SEQ + NMETA, FF = 4096;
constexpr int M = BATCH * SEQ;
constexpr int DIN = 3272, DINP = 3328;
constexpr int C_RQ = 0, C_RK = 512, C_RV = 1024, C_RG = 1536, C_DQ = 2048, C_DK = 2560, C_DV = 2624, C_IQ = 2688, C_IK = 3200, C_IW = 3264;
constexpr int DP2 = 1280;
constexpr int C2_DQ = C_DQ - 2048, C2_DK = C_DK - 2048, C2_DV = C_DV - 2048, C2_IQ = C_IQ - 2048, C2_IK = C_IK - 2048, C2_IW = C_IW - 2048;
constexpr float EPS = 1e-6f;
constexpr int KROWS = 4160;

constexpr size_t MiB = 1u << 20;
constexpr size_t WS_CTL = 0, CTL_ZERO_BYTES = 1 * MiB;
constexpr size_t WS_WIN = 2 * MiB;
constexpr size_t WS_WOUT = 9 * MiB;
constexpr size_t WS_W1 = 11 * MiB;
constexpr size_t WS_W2 = 19 * MiB;
constexpr size_t WS_ROPE = 27 * MiB;
constexpr size_t WS_PMETA = 30 * MiB;
constexpr size_t WS_KC = 32 * MiB;
constexpr size_t WS_IKC = 41 * MiB;
constexpr size_t WS_VT = 50 * MiB;
constexpr size_t WS_U = 64 * MiB;
constexpr size_t WS_PROJ = 192 * MiB;
constexpr size_t WS_RET = 352 * MiB;
constexpr size_t WS_QN = 608 * MiB;
constexpr size_t WS_SPT = 672 * MiB;
constexpr size_t WS_Y = 736 * MiB;
constexpr size_t WS_H = 192 * MiB;
constexpr size_t WS_TQ2 = 864 * MiB;
constexpr size_t WS_LIST = 864 * MiB;
constexpr size_t WS_END = 1024 * MiB;
static_assert(WS_H + (size_t)M * FF * 2 <= WS_Y && WS_Y + (size_t)M * D * 2 <= WS_END, "d_ws map");
constexpr int CW_TMO = 0, CW_CODE = 1;
constexpr int CW_BAR = 4096;

constexpr int RING_OFF = 0, RING_BYTES = 131072;
constexpr int LDS_BYTES = 163840;
constexpr int LDSCTL_OFF = LDS_BYTES - 512, MISC_OFF = LDSCTL_OFF + 320;
static_assert(MISC_OFF + 128 <= LDS_BYTES, "LDS map");
#define GAS __attribute__((address_space(1)))
#define LAS __attribute__((address_space(3)))
typedef unsigned short bf16;
typedef unsigned v4u __attribute__((ext_vector_type(4)));
typedef float f32x4 __attribute__((ext_vector_type(4)));
typedef short bf16x8 __attribute__((ext_vector_type(8)));
typedef GAS unsigned gu32;
typedef GAS unsigned long long gu64;
#define RLX_AGENT __ATOMIC_RELAXED, __HIP_MEMORY_SCOPE_AGENT
#define LDS_WAIT() asm volatile("s_waitcnt lgkmcnt(0)" ::: "memory")
#define VM_WAIT() asm volatile("s_waitcnt vmcnt(0)" ::: "memory")
__device__ __forceinline__ unsigned long long rt() { return __builtin_amdgcn_s_memrealtime(); }
__device__ __forceinline__ unsigned f2bf(float f) { unsigned u = __builtin_bit_cast(unsigned, f); return (u + 0x7fffu + ((u >> 16) & 1u)) >> 16; }
__device__ __forceinline__ unsigned pk2(float lo, float hi) { return f2bf(lo) | (f2bf(hi) << 16); }

#define XB_TMO      128
#define XB_XCNT(j)  (256  + 64 * (j))
#define XB_XSUB(j)  (1280 + 64 * (j))
#define XB_XGEN(j)  (2304 + 64 * (j))
#define XB_TOP      3328
#define XB_TOPGEN   3392
#define XCD_BAR_WORDS 3456
#define XB_SPIN_CAP (1u << 22)

__device__ __forceinline__ unsigned xb_ld(unsigned* p)              { return __hip_atomic_load(p, __ATOMIC_RELAXED, __HIP_MEMORY_SCOPE_AGENT); }
__device__ __forceinline__ unsigned xb_add(unsigned* p, unsigned v) { return __hip_atomic_fetch_add(p, v, __ATOMIC_RELAXED, __HIP_MEMORY_SCOPE_AGENT); }
__device__ __forceinline__ unsigned xb_xcc_id() { return (unsigned)__builtin_amdgcn_s_getreg((3 << 11) | 20) & 0xFu; }
#define XB_SPIN(cond, bar) do { unsigned _sp = 0; while (cond) { __builtin_amdgcn_s_sleep(1); \
    if ((++_sp & 255u) == 0u) { if (xb_ld(&(bar)[XB_TMO])) break; if (_sp > XB_SPIN_CAP) { atomicAdd(&(bar)[XB_TMO], 1u); break; } } } } while (0)

struct XcdBarrier {
    unsigned* bar; unsigned x;
    volatile LAS unsigned* st;
};

__device__ __forceinline__ XcdBarrier xcd_barrier_post(unsigned* bar, volatile LAS unsigned* st) {
    XcdBarrier b; b.bar = bar; b.x = xb_xcc_id(); b.st = st;
    if (threadIdx.x == 0) (void)xb_add(&bar[XB_XCNT(b.x)], 1u);
    return b;
}
__device__ __forceinline__ void xcd_barrier_complete(unsigned* bar, unsigned x, unsigned& nloc, unsigned& nx) {
    const unsigned G = gridDim.x * gridDim.y * gridDim.z;
    unsigned sum, cnt, mine, sp = 0u;
    for (;;) {
        sum = 0u; cnt = 0u; mine = 0u;
#pragma unroll
        for (unsigned j = 0; j < 16; ++j) { const unsigned c = xb_ld(&bar[XB_XCNT(j)]); sum += c; cnt += (c > 0u) ? 1u : 0u; mine = (j == x) ? c : mine; }
        if (sum == G) break;
        __builtin_amdgcn_s_sleep(1);
        if ((++sp & 255u) == 0u) { if (xb_ld(&bar[XB_TMO])) break; if (sp > XB_SPIN_CAP) { atomicAdd(&bar[XB_TMO], 1u); break; } }
    }
    nloc = mine > 0u ? mine : 1u; nx = cnt > 0u ? cnt : 1u;
}

__device__ __forceinline__ void xcd_barrier(const XcdBarrier& b) {
    asm volatile("s_waitcnt vmcnt(0)" ::: "memory");
    __syncthreads();
    if (threadIdx.x == 0) {
        unsigned* bar = b.bar;
        __builtin_amdgcn_s_waitcnt(0);
        unsigned nloc = b.st[0], nx = b.st[1];
        if (nloc == 0u) { xcd_barrier_complete(bar, b.x, nloc, nx); b.st[0] = nloc; b.st[1] = nx; }
        const unsigned old = xb_add(&bar[XB_XSUB(b.x)], 1u);
        const unsigned gen = old / nloc;
        if (old + 1u == (gen + 1u) * nloc) {
            __builtin_amdgcn_fence(__ATOMIC_RELEASE, "agent");
            asm volatile("s_waitcnt vmcnt(0)" ::: "memory");
            const unsigned og = xb_add(&bar[XB_TOP], 1u);
            const unsigned tg = og / nx;
            if (og + 1u == (tg + 1u) * nx) xb_add(&bar[XB_TOPGEN], 1u);
            else XB_SPIN(xb_ld(&bar[XB_TOPGEN]) == tg, bar);
            __builtin_amdgcn_fence(__ATOMIC_ACQUIRE, "agent");
            xb_add(&bar[XB_XGEN(b.x)], 1u);
            asm volatile("s_waitcnt vmcnt(0)" ::: "memory");
        } else {
            XB_SPIN(xb_ld(&bar[XB_XGEN(b.x)]) == gen, bar);
            __builtin_amdgcn_fence(__ATOMIC_ACQUIRE, "agent");
            asm volatile("s_waitcnt vmcnt(0)" ::: "memory");
        }
    }
    __syncthreads();
}

typedef short v4i16_t __attribute__((ext_vector_type(4)));
typedef float f32x2v __attribute__((ext_vector_type(2)));
typedef unsigned u32x2v __attribute__((ext_vector_type(2)));
#define MFMA16(a, b, c) __builtin_amdgcn_mfma_f32_16x16x32_bf16((a), (b), (c), 0, 0, 0)
__device__ __forceinline__ float bf2f(unsigned short u) { return __uint_as_float((unsigned)u << 16); }
__device__ __forceinline__ bf16x8 frag_n(const LAS unsigned char* img, int stride, int rowsel, int k0, int lane) {
    return *(const LAS bf16x8*)(img + rowsel * stride + (k0 + 8 * (lane >> 4)) * 2);
}
__device__ __forceinline__ bf16x8 frag_t(const LAS unsigned char* img, int stride, int row0, int k0, int lane) {
    const int g = lane >> 4, q = (lane >> 2) & 3, p = lane & 3;
    const LAS unsigned char* a = img + (k0 + 8 * g + q) * stride + (row0 + 4 * p) * 2;
    const v4i16_t lo = __builtin_amdgcn_ds_read_tr16_b64_v4i16((LAS v4i16_t*)a);
    const v4i16_t hi = __builtin_amdgcn_ds_read_tr16_b64_v4i16((LAS v4i16_t*)(a + 4 * stride));
    return (bf16x8){lo[0], lo[1], lo[2], lo[3], hi[0], hi[1], hi[2], hi[3]};
}
__device__ __forceinline__ unsigned pkbf(float lo, float hi) { return pg8::cvt_pk_bf16(lo, hi); }
#define TR_RD "ds_read_b64_tr_b16 "
__device__ __forceinline__ bf16x8 tr_pack(u32x2v lo, u32x2v hi) { const v4u w = (v4u){lo[0], lo[1], hi[0], hi[1]}; return __builtin_bit_cast(bf16x8, w); }

constexpr int IMG_STRIDE = 288;
constexpr float RET_KSCALE = 0.08838834764831845f;

__device__ __forceinline__ void rot8(const v4u a, const v4u b, const f32x4 (&cs)[4], float sc, v4u& o1, v4u& o2) {
    float x1[8], x2[8], c[8], s[8];
#pragma unroll
    for (int i = 0; i < 4; ++i) { x1[2 * i] = __uint_as_float(a[i] << 16); x1[2 * i + 1] = __uint_as_float(a[i] & 0xffff0000u); x2[2 * i] = __uint_as_float(b[i] << 16); x2[2 * i + 1] = __uint_as_float(b[i] & 0xffff0000u);
        c[2 * i] = cs[i][0]; s[2 * i] = cs[i][1]; c[2 * i + 1] = cs[i][2]; s[2 * i + 1] = cs[i][3]; }
    float r1[8], r2[8];
#pragma unroll
    for (int i = 0; i < 8; ++i) { r1[i] = (x1[i] * c[i] - x2[i] * s[i]) * sc; r2[i] = (x1[i] * s[i] + x2[i] * c[i]) * sc; }
#pragma unroll
    for (int i = 0; i < 4; ++i) { o1[i] = pkbf(r1[2 * i], r1[2 * i + 1]); o2[i] = pkbf(r2[2 * i], r2[2 * i + 1]); }
}
#define DSA_OPAQUE(x) asm volatile("" : "+v"(x))
constexpr int DSA_CAP = 64;
constexpr int DSA_MSTR = 132;
constexpr int L_HIST = 0, L_MASK = 65536, L_QPAR = L_MASK + 128 * DSA_MSTR * 4, L_CCNT = L_QPAR + 128 * 16, L_BIAS = L_CCNT + 512, L_STAGE = L_BIAS + 8 * 144 * 4, L_DSA_END = L_STAGE + 2 * 8192;
static_assert(L_DSA_END <= LDSCTL_OFF, "DSA LDS map");
constexpr float LOG2E = 1.4426950408889634f;

constexpr int DSA_NB = 128;
#define DSA_SCORE_BODY \
        f32x4 acc = MFMA16(a0, cq[0], ((f32x4){0.f, 0.f, 0.f, 0.f})); acc = MFMA16(a1, cq[1], acc); \
        _Pragma("unroll") for (int h = 0; h < 8; ++h) { \
            f32x4 s = MFMA16(a0, iq[h][0], ((f32x4){0.f, 0.f, 0.f, 0.f})); s = MFMA16(a1, iq[h][1], s); \
            _Pragma("unroll") for (int r = 0; r < 4; ++r) acc[r] = __builtin_fmaf(wh[h], __builtin_fabsf(s[r]), acc[r]); } \
        sc[u] = acc;
__device__ __forceinline__ void idx_tile(const bf16* ikb, int kt, const bf16x8 (&iq)[8][2], const bf16x8 (&cq)[2], const float (&wh)[8], int lane, f32x4 (&sc)[2]) {
    const int i = lane & 15, g = lane >> 4;
#pragma unroll
    for (int u = 0; u < 2; ++u) {
        const bf16* rp = ikb + (size_t)(32 * kt + 8 * (i >> 2) + 4 * u + (i & 3)) * 64 + 8 * g;
        const bf16x8 a0 = *(const GAS bf16x8*)rp, a1 = *(const GAS bf16x8*)(rp + 32);
        DSA_SCORE_BODY
    }
}
__device__ __forceinline__ void idx_tile_lds(const LAS unsigned char* tb, const bf16x8 (&iq)[8][2], const bf16x8 (&cq)[2], const float (&wh)[8], int lane, f32x4 (&sc)[2]) {
#pragma unroll
    for (int u = 0; u < 2; ++u) {
        const bf16x8 a0 = *(const LAS bf16x8*)(tb + (u * 2 + 0) * 1024 + lane * 16), a1 = *(const LAS bf16x8*)(tb + (u * 2 + 1) * 1024 + lane * 16);
        DSA_SCORE_BODY
    }
}
__device__ __forceinline__ float bin_t(float s, float binc, float invw) { return __builtin_fmaf(s, invw, binc); }
__device__ __forceinline__ int bin_of_t(float t) { return (int)__builtin_amdgcn_fmed3f(t, 0.f, (float)(DSA_NB - 1)); }

__device__ __forceinline__ f32x4 idx_sub_lds2(const LAS unsigned char* tb, int u, const bf16x8 (&iq)[8][2], const bf16x8 (&cq)[2], const float (&wh)[8], int lane) {
    const bf16x8 a0 = *(const LAS bf16x8*)(tb + (u * 2 + 0) * 1024 + lane * 16), a1 = *(const LAS bf16x8*)(tb + (u * 2 + 1) * 1024 + lane * 16);
    f32x4 s[9];
#pragma unroll
    for (int h = 0; h < 8; ++h) s[h] = MFMA16(a0, iq[h][0], ((f32x4){0.f, 0.f, 0.f, 0.f}));
    s[8] = MFMA16(a0, cq[0], ((f32x4){0.f, 0.f, 0.f, 0.f}));
#pragma unroll
    for (int h = 0; h < 8; ++h) s[h] = MFMA16(a1, iq[h][1], s[h]);
    s[8] = MFMA16(a1, cq[1], s[8]);
    f32x4 acc = s[8];
#pragma unroll
    for (int h = 0; h < 8; ++h)
#pragma unroll
        for (int r = 0; r < 4; ++r) acc[r] = __builtin_fmaf(wh[h], __builtin_fabsf(s[h][r]), acc[r]);
    __builtin_amdgcn_sched_group_barrier(0x100, 2, 0);
    __builtin_amdgcn_sched_group_barrier(0x008, 18, 0);
    __builtin_amdgcn_sched_group_barrier(0x002, 32, 0);
    return acc;
}
struct IdxAcc { f32x4 s[9]; };
__device__ __forceinline__ IdxAcc idx_mfma_group(const LAS unsigned char* tb, int sub, const bf16x8 (&iq)[8][2], const bf16x8 (&cq)[2], int lane) {
    const LAS unsigned char* ab = tb + (sub >> 1) * 4096 + (sub & 1) * 2048 + lane * 16;
    const bf16x8 a0 = *(const LAS bf16x8*)ab, a1 = *(const LAS bf16x8*)(ab + 1024);
    IdxAcc r;
#pragma unroll
    for (int h = 0; h < 8; ++h) r.s[h] = MFMA16(a0, iq[h][0], ((f32x4){0.f, 0.f, 0.f, 0.f}));
    r.s[8] = MFMA16(a0, cq[0], ((f32x4){0.f, 0.f, 0.f, 0.f}));
#pragma unroll
    for (int h = 0; h < 8; ++h) r.s[h] = MFMA16(a1, iq[h][1], r.s[h]);
    r.s[8] = MFMA16(a1, cq[1], r.s[8]);
    return r;
}
__device__ __forceinline__ f32x4 idx_combine(const IdxAcc& a, const float (&wh)[8]) {
    f32x4 acc = a.s[8];
#pragma unroll
    for (int h = 0; h < 8; ++h)
#pragma unroll
        for (int r = 0; r < 4; ++r) acc[r] = __builtin_fmaf(wh[h], __builtin_fabsf(a.s[h][r]), acc[r]);
    return acc;
}
#define DSA_DMA_K(base, step, buf) __builtin_amdgcn_global_load_lds((const unsigned*)((base) + (size_t)(64 * (step) + dk_row) * 64 + dk_col), (LAS unsigned*)((buf) + wave * 1024), 16, 0, 0)
#define DSA_WAITBAR(N) asm volatile("s_waitcnt vmcnt(" #N ") lgkmcnt(0)\n\ts_barrier" ::: "memory")
#define DSA_LDS_ADDR(p) ((unsigned)(unsigned long long)(p))
#define DSA_PB1(i) (lds + L_MASK + ((i) & 3) * 8192)
#define DSA_PB2(i) (lds + (((i) & 2) ? L_STAGE : 49152) + ((i) & 1) * 8192)
#define DSA_PB3(i) (lds + L_HIST + ((i) & 3) * 16384)
#define DSA_DMA_V(base, step, buf) __builtin_amdgcn_global_load_lds((const unsigned*)((base) + (size_t)dv_row * KROWS + 64 * (step) + dv_col), (LAS unsigned*)((buf) + 8192 + wave * 1024), 16, 0, 0)

template <int NH>
__device__ __forceinline__ void dsa_sweep(LAS unsigned char* lds, int h0, const bf16* kcb, const bf16* vtb, const bf16* qrow, const float* qgain, bf16* yrow, int ns, int p, int pmin, int qloc, int wave, int lane) {
    DSA_OPAQUE(lane);
    const int ql = lane & 15, g4 = lane >> 4;
    const int dk_row = 32 * (wave >> 2) + 8 * (ql >> 2) + 4 * ((wave >> 1) & 1) + (ql & 3), dk_col = 32 * (wave & 1) + 8 * g4;
    const int dv_row = 16 * (wave & 3) + ql, dv_col = 32 * (wave >> 2) + 8 * g4;
    const LAS unsigned* MASK = (const LAS unsigned*)(lds + L_MASK); const LAS float* BIAS = (const LAS float*)(lds + L_BIAS);
    bf16x8 qf[NH][2];
#pragma unroll 1
    for (int pass_ = 0; pass_ < 1; ++pass_) {
#pragma unroll
      for (int hh = 0; hh < NH; ++hh) { v4u qv[2]; float ss = 0.f;
#pragma unroll
          for (int sx = 0; sx < 2; ++sx) { qv[sx] = *(const GAS v4u*)(qrow + 64 * (h0 + hh) + 32 * sx + 8 * g4);
#pragma unroll
              for (int e = 0; e < 4; ++e) { const float a = __uint_as_float(qv[sx][e] << 16), c = __uint_as_float(qv[sx][e] & 0xffff0000u); ss += a * a + c * c; } }
          ss += __shfl_xor(ss, 16); ss += __shfl_xor(ss, 32);
          const float scq = (1.f / sqrtf(ss * (1.f / 64.f) + 1e-6f)) * (0.125f * LOG2E);
#pragma unroll
          for (int sx = 0; sx < 2; ++sx) { const f32x4 g0 = *(const GAS f32x4*)(qgain + 32 * sx + 8 * g4), g1 = *(const GAS f32x4*)(qgain + 32 * sx + 8 * g4 + 4); v4u o;
#pragma unroll
              for (int e = 0; e < 4; ++e) { const float a = __uint_as_float(qv[sx][e] << 16), c = __uint_as_float(qv[sx][e] & 0xffff0000u);
                  const float ga = e < 2 ? g0[2 * e] : g1[2 * e - 4], gc = e < 2 ? g0[2 * e + 1] : g1[2 * e - 3]; o[e] = pkbf(a * scq * ga, c * scq * gc); }
              qf[hh][sx] = __builtin_bit_cast(bf16x8, o); } } }
    f32x4 oacc[NH][4]; float lsum[NH];
#pragma unroll
    for (int hh = 0; hh < NH; ++hh) { lsum[hh] = 0.f;
#pragma unroll
        for (int dt = 0; dt < 4; ++dt) oacc[hh][dt] = (f32x4){0.f, 0.f, 0.f, 0.f}; }
    DSA_DMA_K(kcb, 0, DSA_PB3(0)); DSA_DMA_V(vtb, 0, DSA_PB3(0));
    { const int s1 = ns > 1 ? 1 : ns - 1, s2 = ns > 2 ? 2 : ns - 1; DSA_DMA_K(kcb, s1, DSA_PB3(1)); DSA_DMA_V(vtb, s1, DSA_PB3(1)); DSA_DMA_K(kcb, s2, DSA_PB3(2)); DSA_DMA_V(vtb, s2, DSA_PB3(2)); }
    DSA_WAITBAR(4);
    for (int step = 0; step < ns; ++step) {
        { const int sn = step + 3 < ns ? step + 3 : ns - 1; DSA_DMA_K(kcb, sn, DSA_PB3(step + 3)); DSA_DMA_V(vtb, sn, DSA_PB3(step + 3)); }
        const LAS unsigned char* tb = DSA_PB3(step);
#pragma unroll 1
        for (int tt = 0; tt < 2; ++tt) { const int kt = 2 * step + tt; if (32 * kt > pmin + 15) continue;
            const unsigned mw = (MASK[qloc * DSA_MSTR + kt] >> (8 * g4)) & 0xffu;
            bf16x8 ka[2][2], vt[4];
#pragma unroll
            for (int u = 0; u < 2; ++u) { ka[u][0] = *(const LAS bf16x8*)(tb + tt * 4096 + (u * 2 + 0) * 1024 + lane * 16); ka[u][1] = *(const LAS bf16x8*)(tb + tt * 4096 + (u * 2 + 1) * 1024 + lane * 16); }
#pragma unroll
            for (int dt = 0; dt < 4; ++dt) vt[dt] = *(const LAS bf16x8*)(tb + 8192 + tt * 4096 + dt * 1024 + lane * 16);
            f32x4 cm[2];
#pragma unroll
            for (int u = 0; u < 2; ++u)
#pragma unroll
                for (int r = 0; r < 4; ++r) cm[u][r] = ((mw >> (4 * u + r)) & 1u) ? 0.f : -30000.f;
            const bool near = 32 * kt + 31 + 112 >= pmin;
#pragma unroll
            for (int hh = 0; hh < NH; ++hh) {
                f32x4 st[2]; st[0] = cm[0]; st[1] = cm[1];
                if (near) {
                    int d0 = p - (32 * kt + 8 * g4); d0 = d0 < 0 ? 0 : (d0 > 135 ? 135 : d0);
                    const LAS float* bt = BIAS + (h0 + hh) * 144 + 8 + d0 - 7;
#pragma unroll
                    for (int u = 0; u < 2; ++u)
#pragma unroll
                        for (int r = 0; r < 4; ++r) st[u][r] += bt[7 - (4 * u + r)]; }
#pragma unroll
                for (int u = 0; u < 2; ++u) { st[u] = MFMA16(ka[u][0], qf[hh][0], st[u]); st[u] = MFMA16(ka[u][1], qf[hh][1], st[u]); }
                float pe[8];
#pragma unroll
                for (int u = 0; u < 2; ++u)
#pragma unroll
                    for (int r = 0; r < 4; ++r) { pe[4 * u + r] = __builtin_amdgcn_exp2f(st[u][r]); lsum[hh] += pe[4 * u + r]; }
                const v4u pw = (v4u){pkbf(pe[0], pe[1]), pkbf(pe[2], pe[3]), pkbf(pe[4], pe[5]), pkbf(pe[6], pe[7])};
                const bf16x8 pf = __builtin_bit_cast(bf16x8, pw);
#pragma unroll
                for (int dt = 0; dt < 4; ++dt) oacc[hh][dt] = MFMA16(vt[dt], pf, oacc[hh][dt]);
            }
        }
        DSA_WAITBAR(4);
    }
#pragma unroll
    for (int hh = 0; hh < NH; ++hh) { float l = lsum[hh]; l += __shfl_xor(l, 16); l += __shfl_xor(l, 32); const float il = 1.f / l;
        bf16* yp = yrow + 64 * (h0 + hh) + 4 * g4;
#pragma unroll
        for (int dt = 0; dt < 4; ++dt) *(GAS u32x2v*)(yp + 16 * dt) = (u32x2v){pkbf(oacc[hh][dt][0] * il, oacc[hh][dt][1] * il), pkbf(oacc[hh][dt][2] * il, oacc[hh][dt][3] * il)}; }
}

__device__ __forceinline__ void dsa_gather(LAS unsigned char* gbuf, LAS unsigned char* lstb, const LAS float* BIAS, const bf16* kc, const bf16* vc, const unsigned short* lst,
                                           const LAS unsigned* qcnt  , const bf16* projq  , const float* qgain, bf16* y  , int p0  , int lane) {
    DSA_OPAQUE(lane);
    const int h = lane & 15, g4 = lane >> 4, hv = h & 7;
    f32x4 gq[2][2];
#pragma unroll
    for (int sx = 0; sx < 2; ++sx) { gq[sx][0] = *(const GAS f32x4*)(qgain + 32 * sx + 8 * g4); gq[sx][1] = *(const GAS f32x4*)(qgain + 32 * sx + 8 * g4 + 4); }
    u32x2v lwn = *(const GAS u32x2v*)(lst + 4 * lane); v4u qvn[2];
    { const bf16* qp = projq + 64 * hv + 8 * g4; qvn[0] = *(const GAS v4u*)qp; qvn[1] = *(const GAS v4u*)(qp + 32); }
#pragma unroll 1
    for (int qq = 0; qq < 16; ++qq) {
        const int pq = p0 + qq; int nsel = pq + 1 < 256 ? pq + 1 : 256; { const int nl = (int)qcnt[4 * qq]; nsel = nl < nsel ? nl : nsel; }
        nsel = __builtin_amdgcn_readfirstlane(nsel); const int nch = (nsel + 31) >> 5;
        { u32x2v lw = lwn;
          if (4 * lane + 0 >= nsel) lw[0] &= 0xffff0000u; if (4 * lane + 1 >= nsel) lw[0] &= 0x0000ffffu; if (4 * lane + 2 >= nsel) lw[1] &= 0xffff0000u; if (4 * lane + 3 >= nsel) lw[1] &= 0x0000ffffu;
          *(LAS u32x2v*)(lstb + 8 * lane) = lw; }
        bf16x8 qf[2];
        { v4u qv[2]; qv[0] = qvn[0]; qv[1] = qvn[1]; float ss = 0.f;
#pragma unroll
          for (int sx = 0; sx < 2; ++sx) {
#pragma unroll
              for (int e = 0; e < 4; ++e) { const float a = __uint_as_float(qv[sx][e] << 16), c = __uint_as_float(qv[sx][e] & 0xffff0000u); ss += a * a + c * c; } }
          ss += __shfl_xor(ss, 16); ss += __shfl_xor(ss, 32);
          const float scq = (1.f / sqrtf(ss * (1.f / 64.f) + 1e-6f)) * (0.125f * LOG2E);
#pragma unroll
          for (int sx = 0; sx < 2; ++sx) { const f32x4 g0 = gq[sx][0], g1 = gq[sx][1]; v4u o;
#pragma unroll
              for (int e = 0; e < 4; ++e) { const float a = __uint_as_float(qv[sx][e] << 16), c = __uint_as_float(qv[sx][e] & 0xffff0000u);
                  const float ga = e < 2 ? g0[2 * e] : g1[2 * e - 4], gc = e < 2 ? g0[2 * e + 1] : g1[2 * e - 3]; o[e] = pkbf(a * scq * ga, c * scq * gc); }
              qf[sx] = __builtin_bit_cast(bf16x8, o); } }
        LDS_WAIT(); asm volatile("" ::: "memory");
        f32x4 oacc[4]; float lsum = 0.f;
#pragma unroll
        for (int dt = 0; dt < 4; ++dt) oacc[dt] = (f32x4){0.f, 0.f, 0.f, 0.f};
#define DSA_GDMA(c, buf) do { _Pragma("unroll") for (int i = 0; i < 4; ++i) { const int r_ = 8 * i + (lane >> 3); unsigned ki_ = *(const LAS unsigned short*)(lstb + 2 * (32 * (c) + r_)); ki_ = ki_ < (unsigned)KROWS ? ki_ : 0u; \
            const int pc_ = (lane & 7) ^ (r_ & 7); \
            __builtin_amdgcn_global_load_lds((const unsigned*)(kc + (size_t)ki_ * 64 + 8 * pc_), (LAS unsigned*)((buf) + i * 1024), 16, 0, 0); \
            __builtin_amdgcn_global_load_lds((const unsigned*)(vc + (size_t)ki_ * 64 + 8 * pc_), (LAS unsigned*)((buf) + 4096 + i * 1024), 16, 0, 0); } } while (0)
        DSA_GDMA(0, gbuf); if (nch > 1) DSA_GDMA(1, gbuf + 8192);
        __builtin_amdgcn_sched_barrier(0);
        { const int qn = qq < 15 ? qq + 1 : 15; lwn = *(const GAS u32x2v*)(lst + qn * 256 + 4 * lane); const bf16* qp = projq + (size_t)qn * DP2 + 64 * hv + 8 * g4; qvn[0] = *(const GAS v4u*)qp; qvn[1] = *(const GAS v4u*)(qp + 32); }
        __builtin_amdgcn_sched_barrier(0);
        const int qd = (lane >> 2) & 3, pp = lane & 3, R0 = 4 * g4 + qd, pcl = (lane & 7) ^ (lane >> 3);
        const unsigned gb0 = DSA_LDS_ADDR(gbuf), kof0 = (unsigned)(h * 128 + 16 * (g4 ^ (h & 7))), kof1 = (unsigned)(h * 128 + 16 * ((4 + g4) ^ (h & 7)));
        const unsigned vofb = (unsigned)(R0 * 128 + 8 * (pp & 1)), vsw = (unsigned)((pp >> 1) ^ (R0 & 7));
        const unsigned lsa = DSA_LDS_ADDR(lstb);
#pragma unroll 1
        for (int c = 0; c < nch; ++c) {
            if (c < 2) { if (c + 1 < nch) asm volatile("s_waitcnt vmcnt(11)" ::: "memory"); else asm volatile("s_waitcnt vmcnt(3)" ::: "memory"); }
            else { if (c + 1 < nch) asm volatile("s_waitcnt vmcnt(8)" ::: "memory"); else asm volatile("s_waitcnt vmcnt(0)" ::: "memory"); }
            const unsigned gb = gb0 + (unsigned)(c & 1) * 8192u;
            v4u kf[2][2]; u32x2v kiw[2], tv[4][2]; unsigned nk[4];
            { const unsigned ka0 = gb + kof0, ka1 = gb + kof1, va0 = gb + vofb + 16u * (vsw ^ 0u), va1 = gb + vofb + 16u * (vsw ^ 2u), va2 = gb + vofb + 16u * (vsw ^ 4u), va3 = gb + vofb + 16u * (vsw ^ 6u);
              const unsigned kwa = lsa + 2u * (unsigned)(32 * c + 4 * g4), nka = lsa + 2u * (unsigned)(32 * (c + 2) + (lane >> 3));
              asm volatile("ds_read_b128 %0, %18\n\tds_read_b128 %1, %19\n\tds_read_b128 %2, %18 offset:2048\n\tds_read_b128 %3, %19 offset:2048\n\tds_read_b64 %4, %24\n\tds_read_b64 %5, %24 offset:32\n\t"
                           TR_RD "%6, %20 offset:4096\n\t" TR_RD "%7, %20 offset:6144\n\t" TR_RD "%8, %21 offset:4096\n\t" TR_RD "%9, %21 offset:6144\n\t"
                           TR_RD "%10, %22 offset:4096\n\t" TR_RD "%11, %22 offset:6144\n\t" TR_RD "%12, %23 offset:4096\n\t" TR_RD "%13, %23 offset:6144\n\t"
                           "ds_read_u16 %14, %25\n\tds_read_u16 %15, %25 offset:16\n\tds_read_u16 %16, %25 offset:32\n\tds_read_u16 %17, %25 offset:48\n\ts_waitcnt lgkmcnt(0)"
                           : "=&v"(kf[0][0]), "=&v"(kf[0][1]), "=&v"(kf[1][0]), "=&v"(kf[1][1]), "=&v"(kiw[0]), "=&v"(kiw[1]),
                             "=&v"(tv[0][0]), "=&v"(tv[0][1]), "=&v"(tv[1][0]), "=&v"(tv[1][1]), "=&v"(tv[2][0]), "=&v"(tv[2][1]), "=&v"(tv[3][0]), "=&v"(tv[3][1]),
                             "=&v"(nk[0]), "=&v"(nk[1]), "=&v"(nk[2]), "=&v"(nk[3])
                           : "v"(ka0), "v"(ka1), "v"(va0), "v"(va1), "v"(va2), "v"(va3), "v"(kwa), "v"(nka) : "memory"); }
            if (c + 2 < nch) { LAS unsigned char* nb = gbuf + (c & 1) * 8192;
#pragma unroll
                for (int i = 0; i < 4; ++i) { const unsigned ki_ = nk[i] < (unsigned)KROWS ? nk[i] : 0u;
                    __builtin_amdgcn_global_load_lds((const unsigned*)(kc + (size_t)ki_ * 64 + 8 * pcl), (LAS unsigned*)(nb + i * 1024), 16, 0, 0);
                    __builtin_amdgcn_global_load_lds((const unsigned*)(vc + (size_t)ki_ * 64 + 8 * pcl), (LAS unsigned*)(nb + 4096 + i * 1024), 16, 0, 0); } }
            f32x4 st[2];
#pragma unroll
            for (int u = 0; u < 2; ++u) { st[u] = MFMA16(__builtin_bit_cast(bf16x8, kf[u][0]), qf[0], ((f32x4){0.f, 0.f, 0.f, 0.f})); st[u] = MFMA16(__builtin_bit_cast(bf16x8, kf[u][1]), qf[1], st[u]); }
            float bv[8];
#pragma unroll
            for (int u = 0; u < 2; ++u)
#pragma unroll
                for (int r = 0; r < 4; ++r) { const int ki = (int)((r & 1) ? kiw[u][r >> 1] >> 16 : kiw[u][r >> 1] & 0xffffu); int dd = pq - ki; dd = dd < 0 ? 0 : (dd > 135 ? 135 : dd);
                    bv[4 * u + r] = BIAS[hv * 144 + 8 + dd]; }
            float pe[8];
#pragma unroll
            for (int u = 0; u < 2; ++u)
#pragma unroll
                for (int r = 0; r < 4; ++r) { const float lg = (32 * c + 16 * u + 4 * g4 + r) < nsel ? st[u][r] + bv[4 * u + r] : -30000.f; pe[4 * u + r] = __builtin_amdgcn_exp2f(lg); lsum += pe[4 * u + r]; }
            const v4u pw = (v4u){pkbf(pe[0], pe[1]), pkbf(pe[2], pe[3]), pkbf(pe[4], pe[5]), pkbf(pe[6], pe[7])};
            const bf16x8 pf = __builtin_bit_cast(bf16x8, pw);
#pragma unroll
            for (int dt = 0; dt < 4; ++dt) oacc[dt] = MFMA16(tr_pack(tv[dt][0], tv[dt][1]), pf, oacc[dt]);
        }
#undef DSA_GDMA
        lsum += __shfl_xor(lsum, 16); lsum += __shfl_xor(lsum, 32);
        if (h < 8) { const float il = 1.f / lsum; bf16* yp = y + (size_t)qq * D + 64 * h + 4 * g4;
#pragma unroll
            for (int dt = 0; dt < 4; ++dt) *(GAS u32x2v*)(yp + 16 * dt) = (u32x2v){pkbf(oacc[dt][0] * il, oacc[dt][1] * il), pkbf(oacc[dt][2] * il, oacc[dt][3] * il)}; }
    }
}
__device__ __forceinline__ float wave_sum(float v) {
#pragma unroll
    for (int o = 1; o < 64; o <<= 1) v += __shfl_xor(v, o);
    return v;
}
__device__ __forceinline__ void p0_transpose_item(const float* W, int K, int N, int NP, bf16* WT, LAS float* scr, int item, int lane, const float* kscale = nullptr) {
    const int nblk = NP / 32, kb = item / nblk, nb = item % nblk, k0 = 64 * kb, n0 = 32 * nb;
    const int nn = n0 + (lane & 31); const bool ok = nn < N;
#pragma unroll 8
    for (int i = 0; i < 32; ++i) { const int kk = 2 * i + (lane >> 5); scr[kk * 33 + (lane & 31)] = ok ? W[(size_t)(k0 + kk) * N + nn] * (kscale ? kscale[k0 + kk] : 1.f) : 0.f; }
    LDS_WAIT(); asm volatile("" ::: "memory");
    const int c = lane & 7;
#pragma unroll
    for (int j = 0; j < 4; ++j) { const int n = (lane >> 3) + 8 * j; const LAS float* s = scr + (8 * c) * 33 + n;
        v4u o; o.x = pk2(s[0 * 33], s[1 * 33]); o.y = pk2(s[2 * 33], s[3 * 33]); o.z = pk2(s[4 * 33], s[5 * 33]); o.w = pk2(s[6 * 33], s[7 * 33]);
        *(GAS v4u*)(WT + (size_t)(n0 + n) * K + k0 + 8 * c) = o; }
    LDS_WAIT(); asm volatile("" ::: "memory");
}
__device__ __forceinline__ void rms_row_to_bf16(const float* xrow, const float* w, bf16* orow, int lane) {
    const GAS f32x4* xr = (const GAS f32x4*)xrow + lane; const GAS f32x4* wr = (const GAS f32x4*)w + lane;
    f32x4 v[4]; float s = 0.f;
#pragma unroll
    for (int j = 0; j < 4; ++j) { v[j] = xr[64 * j]; s += (v[j].x * v[j].x + v[j].y * v[j].y) + (v[j].z * v[j].z + v[j].w * v[j].w); }
    const float r = 1.f / sqrtf(wave_sum(s) * (1.f / D) + EPS);
    GAS unsigned long long* o8 = (GAS unsigned long long*)orow + lane;
#pragma unroll
    for (int j = 0; j < 4; ++j) { const f32x4 g = wr[64 * j];
        o8[64 * j] = (unsigned long long)pk2(v[j].x * r * g.x, v[j].y * r * g.y) | ((unsigned long long)pk2(v[j].z * r * g.z, v[j].w * r * g.w) << 32); }
}

__device__ __forceinline__ void rms_row2_to_bf16(const float* xa, const float* xb, const float* w, bf16* oa, bf16* ob, float* xsa, float* xsb, int lane) {
    const GAS f32x4* pa = (const GAS f32x4*)xa + lane; const GAS f32x4* pb = (const GAS f32x4*)xb + lane; const GAS f32x4* wr = (const GAS f32x4*)w + lane;
    f32x4 va[4], vb[4]; float sa = 0.f, sb = 0.f;
#pragma unroll
    for (int j = 0; j < 4; ++j) { va[j] = __builtin_nontemporal_load(pa + 64 * j); vb[j] = __builtin_nontemporal_load(pb + 64 * j); }
#pragma unroll
    for (int j = 0; j < 4; ++j) { sa += (va[j].x * va[j].x + va[j].y * va[j].y) + (va[j].z * va[j].z + va[j].w * va[j].w); sb += (vb[j].x * vb[j].x + vb[j].y * vb[j].y) + (vb[j].z * vb[j].z + vb[j].w * vb[j].w); }
    const float qa_ = sqrtf(wave_sum(sa) * (1.f / D) + EPS), qb_ = sqrtf(wave_sum(sb) * (1.f / D) + EPS); const float ra = 1.f / qa_, rb = 1.f / qb_;
    if (lane == 0) { *xsa = qa_; *xsb = qb_; }
    GAS unsigned long long* qa = (GAS unsigned long long*)oa + lane; GAS unsigned long long* qb = (GAS unsigned long long*)ob + lane;
#pragma unroll
    for (int j = 0; j < 4; ++j) { const f32x4 g = wr[64 * j];
        qa[64 * j] = (unsigned long long)pk2(va[j].x * ra * g.x, va[j].y * ra * g.y) | ((unsigned long long)pk2(va[j].z * ra * g.z, va[j].w * ra * g.w) << 32);
        qb[64 * j] = (unsigned long long)pk2(vb[j].x * rb * g.x, vb[j].y * rb * g.y) | ((unsigned long long)pk2(vb[j].z * rb * g.z, vb[j].w * rb * g.w) << 32); }
}

struct Args { const float* in[12]; float* out; unsigned char* ws; int ph_lo, ph_hi; };
__global__ void __launch_bounds__(NWAVES * 64, 2) mk_fwd(Args args) {
    extern __shared__ __attribute__((aligned(16))) unsigned char lds_raw[];
    LAS unsigned char* lds = (LAS unsigned char*)lds_raw;
    volatile LAS unsigned* MISC = (volatile LAS unsigned*)(lds + MISC_OFF);
    const int tid = threadIdx.x, lane = tid & 63, wave = __builtin_amdgcn_readfirstlane(tid >> 6);
    const int G = gridDim.x; const int bx = blockIdx.x; const int vcu = (G % 8 == 0) ? (bx % 8) * (G / 8) + bx / 8 : bx;
    unsigned char* ws = args.ws;
    gu32* ctl = (gu32*)(ws + WS_CTL);
    const float* x = args.in[0]; const float* meta = args.in[1]; const float* norm1_w = args.in[2]; const float* w_in = args.in[3];
    const float* ret_norm_w = args.in[4]; const float* q_norm_w = args.in[5]; const float* k_norm_w = args.in[6]; const float* rel_bias = args.in[7];
    const float* w_out = args.in[8]; const float* norm2_w = args.in[9]; const float* w_ff1 = args.in[10]; const float* w_ff2 = args.in[11];
    float* out = args.out;
    bf16* WIN_T = (bf16*)(ws + WS_WIN); bf16* WOUT_T = (bf16*)(ws + WS_WOUT); bf16* W1_T = (bf16*)(ws + WS_W1); bf16* W2_T = (bf16*)(ws + WS_W2);
    bf16* U = (bf16*)(ws + WS_U); bf16* PROJ = (bf16*)(ws + WS_PROJ); bf16* Y = (bf16*)(ws + WS_Y); bf16* HB = (bf16*)(ws + WS_H);
    float* ROPE = (float*)(ws + WS_ROPE); float* PMETA = (float*)(ws + WS_PMETA); bf16* PM16 = (bf16*)(ws + WS_PMETA + 512 * 1024); bf16* SPT = (bf16*)(ws + WS_SPT);
    float* XS = (float*)(ws + WS_CTL + 768 * 1024);
    float* SSQ = (float*)(ws + WS_CTL + 512 * 1024);
    bf16* KC = (bf16*)(ws + WS_KC); bf16* IKC = (bf16*)(ws + WS_IKC); bf16* VT = (bf16*)(ws + WS_VT); bf16* VC = (bf16*)(ws + WS_QN + 32 * MiB); unsigned short* LISTG = (unsigned short*)(ws + WS_LIST); bf16* RET = (bf16*)(ws + WS_RET);
    for (int u = tid; u < (LDS_BYTES - LDSCTL_OFF) / 4; u += NWAVES * 64) ((LAS unsigned*)(lds + LDSCTL_OFF))[u] = 0u;
    __syncthreads();
    XcdBarrier bar; bar.bar = (unsigned*)(ctl + CW_BAR); bar.x = 0; bar.st = nullptr;
    if (ONE_LAUNCH) bar = xcd_barrier_post((unsigned*)(ctl + CW_BAR), MISC + 8);
#define GRID_BAR() do { if (ONE_LAUNCH) xcd_barrier(bar); } while (0)
    const int lo = args.ph_lo, hi = args.ph_hi;
#define IN(k) (lo <= (k) && (k) < hi)
#define BOTH(k) (IN(k) && IN((k) + 1 + ((k) == 4)))
    const int gw = vcu * NWAVES + wave, NGW = G * NWAVES;

    if (IN(0)) {
        LAS float* scr = (LAS float*)(lds + RING_OFF + wave * 16384);
        constexpr int I_IN = (D / 64) * (DINP / 32), I_O = (D / 64) * (D / 32), I_1 = (D / 64) * (FF / 32), I_2 = (FF / 64) * (D / 32);
        constexpr int NITEMS = I_IN + I_O + I_1 + I_2;
        for (int it = gw; it < NITEMS; it += NGW) {
            int r = it;
            if (r < I_IN) { p0_transpose_item(w_in, D, DIN, DINP, WIN_T, scr, r, lane); continue; } r -= I_IN;
            if (r < I_O) { p0_transpose_item(w_out, D, D, D, WOUT_T, scr, r, lane); continue; } r -= I_O;
            if (r < I_1) { p0_transpose_item(w_ff1, D, FF, FF, W1_T, scr, r, lane, norm2_w); continue; } r -= I_1;
            p0_transpose_item(w_ff2, FF, D, D, W2_T, scr, r, lane);
        }
        for (int m = gw; m < M; m += 2 * NGW) rms_row2_to_bf16(x + (size_t)m * D, x + (size_t)(m + NGW) * D, norm1_w, U + (size_t)m * D, U + (size_t)(m + NGW) * D, XS + m, XS + m + NGW, lane);

        for (int i = bx * 512 + tid; i < TK * 64; i += G * 512) {
            const int t = i >> 6, fi = i & 63;
            const double inv = exp2(-(double)fi * (13.287712379549449 / 64.0));
            const double ang = (double)t * inv;
            const double nrev = rint(ang * 0.15915494309189535);
            double r = fma(-nrev, 6.283185307179586, ang); r = fma(-nrev, 2.4492935982947064e-16, r);
            const double r2 = r * r; double sn = 1.0, cn = 1.0;
#pragma unroll
            for (int k = 12; k >= 1; --k) { sn = 1.0 - r2 / (double)((2 * k) * (2 * k + 1)) * sn; cn = 1.0 - r2 / (double)((2 * k - 1) * (2 * k)) * cn; }
            sn *= r;
            ((GAS f32x2v*)ROPE)[i] = (f32x2v){(float)cn, (float)sn};
        }
        for (int i = bx * 512 + tid; i < 112 * DINP * 2 / 16; i += G * 512) ((GAS v4u*)PM16)[i] = (v4u){0u, 0u, 0u, 0u};
        {
            __syncthreads();
            LAS float* un = (LAS float*)(lds + RING_OFF);
            LAS float* red = (LAS float*)(lds + RING_OFF + 16 * 1025 * 4);
#pragma unroll
            for (int rr = 0; rr < 2; ++rr) { const int r = 2 * wave + rr; const GAS f32x4* xr = (const GAS f32x4*)(meta + (size_t)r * D) + lane; const GAS f32x4* wr = (const GAS f32x4*)norm1_w + lane;
                f32x4 v[4]; float s = 0.f;
#pragma unroll
                for (int j = 0; j < 4; ++j) { v[j] = xr[64 * j]; s += (v[j].x * v[j].x + v[j].y * v[j].y) + (v[j].z * v[j].z + v[j].w * v[j].w); }
                const float ri = 1.f / sqrtf(wave_sum(s) * (1.f / D) + EPS);
#pragma unroll
                for (int j = 0; j < 4; ++j) { const f32x4 g = wr[64 * j]; const int k = 4 * lane + 256 * j;
                    un[r * 1025 + k] = v[j].x * ri * g.x; un[r * 1025 + k + 1] = v[j].y * ri * g.y; un[r * 1025 + k + 2] = v[j].z * ri * g.z; un[r * 1025 + k + 3] = v[j].w * ri * g.w; } }
            __syncthreads();
            const int c0 = 13 * vcu; float acc[13];
#pragma unroll
            for (int cc = 0; cc < 13; ++cc) acc[cc] = 0.f;
            for (int i = 0; i < 32; ++i) { const int k = 128 * wave + (lane >> 4) + 4 * i; const float uv = un[(lane & 15) * 1025 + k]; const float* wp = w_in + (size_t)k * DIN + c0;
#pragma unroll
                for (int cc = 0; cc < 13; ++cc) { const float wv = (c0 + cc < DIN) ? wp[cc] : 0.f; acc[cc] = fmaf(uv, wv, acc[cc]); } }
#pragma unroll
            for (int cc = 0; cc < 13; ++cc) { acc[cc] += __shfl_xor(acc[cc], 16); acc[cc] += __shfl_xor(acc[cc], 32); if (lane < 16) red[(wave * 16 + lane) * 13 + cc] = acc[cc]; }
            __syncthreads();
            if (tid < 208) { const int r = tid / 13, cc = tid % 13; float s = 0.f;
#pragma unroll
                for (int w8 = 0; w8 < 8; ++w8) s += red[(w8 * 16 + r) * 13 + cc];
                const int c = c0 + cc; if (c >= DIN) s = 0.f;
                PMETA[r * DINP + c] = s; PM16[(size_t)(112 + r) * DINP + c] = (bf16)f2bf(s); }
            __syncthreads();
        }
        if (BOTH(0)) GRID_BAR();
    }
    if (IN(1)) {
        pg8::Gemm g{U, WIN_T, M, DINP, D}; pg8::StaticOrder S; S.init(M, DINP, G, (int)blockIdx.x);
        pg8::EpiProj E{PROJ, DP2, RET, M};
        pg8::gemm_phase<pg8::EpiProj, pg8::StaticOrder, true, true>(lds + RING_OFF, g, S, E);
        if (BOTH(1)) GRID_BAR();
    }
    if (IN(2)) {
        {
            LAS unsigned char* vscr = lds + RING_OFF + 65536 + wave * 1024;
            const int r = lane >> 3, sub = lane & 7;
            const f32x4 kg0 = *(const GAS f32x4*)(k_norm_w + 8 * sub), kg1 = *(const GAS f32x4*)(k_norm_w + 8 * sub + 4);
            for (int unit = gw; unit < BATCH * 520; unit += NGW) {
                const int b = unit / 520, gidx = unit % 520; const bool isx = gidx >= 2 && gidx < 514, ismeta = gidx < 2;
                const bf16* src = ismeta ? PM16 + (size_t)(112 + 8 * gidx + r) * DINP + 2048 : PROJ + ((size_t)b * SEQ + (isx ? 8 * (gidx - 2) + r : 0)) * DP2;
                const size_t krow = ((size_t)b * KROWS + 8 * gidx + r) * 64 + 8 * sub;
                v4u kv = (v4u){0u, 0u, 0u, 0u}, iv = kv, vv = kv;
                if (isx || ismeta) { kv = *(const GAS v4u*)(src + C2_DK + 8 * sub); iv = *(const GAS v4u*)(src + C2_IK + 8 * sub); vv = *(const GAS v4u*)(src + C2_DV + 8 * sub); }
                float xk[8]; float sk = 0.f;
#pragma unroll
                for (int i = 0; i < 4; ++i) { xk[2 * i] = __uint_as_float(kv[i] << 16); xk[2 * i + 1] = __uint_as_float(kv[i] & 0xffff0000u); sk += xk[2 * i] * xk[2 * i] + xk[2 * i + 1] * xk[2 * i + 1]; }
                sk += __shfl_xor(sk, 1); sk += __shfl_xor(sk, 2); sk += __shfl_xor(sk, 4);
                const float sck = 1.f / sqrtf(sk * (1.f / 64.f) + EPS);
                *(GAS v4u*)(KC + krow) = (v4u){pkbf(xk[0] * sck * kg0[0], xk[1] * sck * kg0[1]), pkbf(xk[2] * sck * kg0[2], xk[3] * sck * kg0[3]), pkbf(xk[4] * sck * kg1[0], xk[5] * sck * kg1[1]), pkbf(xk[6] * sck * kg1[2], xk[7] * sck * kg1[3])};
                *(GAS v4u*)(IKC + krow) = iv;
                *(GAS v4u*)(VC + krow) = vv;
                *(LAS v4u*)(vscr + lane * 16) = vv;
                LDS_WAIT(); asm volatile("" ::: "memory");
                { const LAS unsigned short* vs = (const LAS unsigned short*)vscr + lane; v4u o;
#pragma unroll
                  for (int i = 0; i < 4; ++i) o[i] = (unsigned)vs[(2 * i) * 64] | ((unsigned)vs[(2 * i + 1) * 64] << 16);
                  *(GAS v4u*)(VT + ((size_t)b * 64 + lane) * KROWS + 8 * gidx) = o; }
                LDS_WAIT(); asm volatile("" ::: "memory");
            }
            __syncthreads();
        }
        if (vcu < 256) {
            const int b = vcu >> 4, h = (vcu >> 2) & 3, dq = vcu & 3;
            const float lg2 = log2f(1.f - exp2f(-5.f - (float)h));
            const float cdec = exp2f(lg2 * 128.f);
            LAS unsigned char* Kimg = lds + 3 * 40960;
            f32x4 acc[2]; acc[0] = (f32x4){0.f, 0.f, 0.f, 0.f}; acc[1] = acc[0];
            f32x4 rc[4], rc1[4], rstep[4];
            { const int c = (tid >> 1) & 127, jh = tid & 1; int t0 = c - 112; t0 = t0 < 0 ? 0 : t0; const int t1 = 16 + c;
              const GAS f32x4* r0 = (const GAS f32x4*)(ROPE + ((size_t)t0 * 64 + 16 * dq + 8 * jh) * 2); const GAS f32x4* r1 = (const GAS f32x4*)(ROPE + ((size_t)t1 * 64 + 16 * dq + 8 * jh) * 2);
              const GAS f32x4* rs = (const GAS f32x4*)(ROPE + ((size_t)128 * 64 + 16 * dq + 8 * jh) * 2);
#pragma unroll
              for (int i = 0; i < 4; ++i) { rc[i] = r0[i]; rc1[i] = r1[i]; rstep[i] = rs[i]; } }
            const float ksc0 = RET_KSCALE * exp2f(lg2 * (float)(127 - ((tid >> 1) & 127)));
#define R12_DMA(n, slot) do { const bool m0_ = (n) == 0; const size_t rs_ = m0_ ? (size_t)DINP : (size_t)128;     \
                const bf16* kb_ = m0_ ? PM16 + C_RK + 128 * h : RET + ((size_t)(4 + h) * M + (size_t)b * SEQ + 128 * ((n) - 1)) * 128; const bf16* vb_ = m0_ ? PM16 + C_RV + 128 * h : RET + ((size_t)(8 + h) * M + (size_t)b * SEQ + 128 * ((n) - 1)) * 128; \
                _Pragma("unroll") for (int i = 0; i < 4; ++i) __builtin_amdgcn_global_load_lds((const unsigned*)(vb_ + (size_t)(16 * wave + 4 * i + (lane >> 4)) * rs_ + 8 * ((lane & 15) ^ (2 * (lane >> 4)))), (LAS unsigned*)(lds + (slot) * 40960 + (4 * wave + i) * 1024), 16, 0, 0); \
                __builtin_amdgcn_global_load_lds((const unsigned*)(kb_ + (size_t)(16 * wave + (lane >> 2)) * rs_ + 64 * ((lane >> 1) & 1) + 16 * dq + 8 * (lane & 1)), (LAS unsigned*)(lds + (slot) * 40960 + 32768 + wave * 1024), 16, 0, 0); } while (0)
            R12_DMA(0, 0); R12_DMA(1, 1); R12_DMA(2, 2);
            asm volatile("s_waitcnt vmcnt(0)" ::: "memory"); __syncthreads();
            const unsigned kimg_a0 = DSA_LDS_ADDR(Kimg + ((tid >> 1) & 127) * 64 + 16 * (tid & 1));
            const unsigned trk_a = DSA_LDS_ADDR(Kimg + (8 * (lane >> 4) + ((lane >> 2) & 3)) * 64 + 8 * (lane & 3));
            const unsigned trv_off = (unsigned)((8 * (lane >> 4) + ((lane >> 2) & 3)) * 256 + 16 * ((2 * wave + ((lane & 3) >> 1)) ^ (2 * ((lane >> 2) & 3))) + 8 * (lane & 1));
#pragma unroll 1
            for (int n = 0; n < 32; ++n) {
                const LAS unsigned char* slot = lds + (n % 3) * 40960;
                const unsigned slot_a = DSA_LDS_ADDR(slot);
                if (tid < 256) {
                    if (n == 1) {
#pragma unroll
                        for (int i = 0; i < 4; ++i) rc[i] = rc1[i]; }
                    else if (n > 1) {
#pragma unroll
                        for (int i = 0; i < 4; ++i) { const f32x4 a = rc[i], st = rstep[i];
                            rc[i] = (f32x4){a[0] * st[0] - a[1] * st[1], a[1] * st[0] + a[0] * st[1], a[2] * st[2] - a[3] * st[3], a[3] * st[2] + a[2] * st[3]}; } }
                    const LAS unsigned char* rp = slot + 32768 + (tid >> 1) * 64 + 16 * (tid & 1); v4u o1, o2;
                    rot8(*(const LAS v4u*)rp, *(const LAS v4u*)(rp + 32), rc, ksc0, o1, o2);
                    asm volatile("ds_write_b128 %0, %1\n\tds_write_b128 %0, %2 offset:32" :: "v"(kimg_a0), "v"(o1), "v"(o2) : "memory"); }
                asm volatile("s_waitcnt lgkmcnt(0)\n\ts_barrier" ::: "memory");
                acc[0] = acc[0] * cdec; acc[1] = acc[1] * cdec;
                { const unsigned va_ = slot_a + trv_off;
#pragma unroll
                  for (int kp = 0; kp < 2; ++kp) { u32x2v t[12];
                      if (kp == 0) asm volatile(TR_RD "%0, %12\n\t" TR_RD "%1, %12 offset:256\n\t" TR_RD "%2, %12 offset:32\n\t" TR_RD "%3, %12 offset:288\n\t" TR_RD "%4, %13\n\t" TR_RD "%5, %13 offset:1024\n\t"
                                                TR_RD "%6, %12 offset:2048\n\t" TR_RD "%7, %12 offset:2304\n\t" TR_RD "%8, %12 offset:2080\n\t" TR_RD "%9, %12 offset:2336\n\t" TR_RD "%10, %13 offset:8192\n\t" TR_RD "%11, %13 offset:9216\n\ts_waitcnt lgkmcnt(0)"
                                                : "=&v"(t[0]), "=&v"(t[1]), "=&v"(t[2]), "=&v"(t[3]), "=&v"(t[4]), "=&v"(t[5]), "=&v"(t[6]), "=&v"(t[7]), "=&v"(t[8]), "=&v"(t[9]), "=&v"(t[10]), "=&v"(t[11]) : "v"(trk_a), "v"(va_) : "memory");
                      else asm volatile(TR_RD "%0, %12 offset:4096\n\t" TR_RD "%1, %12 offset:4352\n\t" TR_RD "%2, %12 offset:4128\n\t" TR_RD "%3, %12 offset:4384\n\t" TR_RD "%4, %13 offset:16384\n\t" TR_RD "%5, %13 offset:17408\n\t"
                                        TR_RD "%6, %12 offset:6144\n\t" TR_RD "%7, %12 offset:6400\n\t" TR_RD "%8, %12 offset:6176\n\t" TR_RD "%9, %12 offset:6432\n\t" TR_RD "%10, %13 offset:24576\n\t" TR_RD "%11, %13 offset:25600\n\ts_waitcnt lgkmcnt(0)"
                                        : "=&v"(t[0]), "=&v"(t[1]), "=&v"(t[2]), "=&v"(t[3]), "=&v"(t[4]), "=&v"(t[5]), "=&v"(t[6]), "=&v"(t[7]), "=&v"(t[8]), "=&v"(t[9]), "=&v"(t[10]), "=&v"(t[11]) : "v"(trk_a), "v"(va_) : "memory");
#pragma unroll
                      for (int kk = 0; kk < 2; ++kk) { const bf16x8 a0 = tr_pack(t[6 * kk], t[6 * kk + 1]), a1 = tr_pack(t[6 * kk + 2], t[6 * kk + 3]), bv = tr_pack(t[6 * kk + 4], t[6 * kk + 5]);
                          acc[0] = MFMA16(a0, bv, acc[0]); acc[1] = MFMA16(a1, bv, acc[1]); } } }
                bf16* sp = SPT + ((size_t)((b * 4 + h) * 32 + n)) * 16384;
#pragma unroll
                for (int dt = 0; dt < 2; ++dt) { const int e = 16 * wave + (lane & 15), d = 64 * dt + 16 * dq + 4 * (lane >> 4);
                    *(GAS u32x2v*)(sp + e * 128 + d) = (u32x2v){pkbf(acc[dt][0], acc[dt][1]), pkbf(acc[dt][2], acc[dt][3])}; }
                asm volatile("s_waitcnt vmcnt(9) lgkmcnt(0)\n\ts_barrier" ::: "memory");
                { const int nn = n + 3 < 32 ? n + 3 : 31; R12_DMA(nn, n % 3); }
            }
            asm volatile("s_waitcnt vmcnt(0)" ::: "memory"); __syncthreads();
#undef R12_DMA
        }
        if (BOTH(2)) GRID_BAR();
    }
    if (IN(3)) {
        {
            for (int i = tid; i < 8 * 144; i += 512) { const int h = i / 144, d = i % 144 - 8; float v = 0.f;
                if (d >= 0 && d < 113) { int bk = d; if (d >= 16) { bk = 16 + (int)(logf((float)d * (1.f / 16.f)) / logf(8.f) * 16.f); bk = bk > 31 ? 31 : bk; } v = (rel_bias[bk * 8 + h] - rel_bias[31 * 8 + h]) * LOG2E; }
                ((LAS float*)(lds + L_BIAS))[i] = v; }
            __syncthreads();
            LAS unsigned* HIST = (LAS unsigned*)(lds + L_HIST); LAS unsigned* MASK = (LAS unsigned*)(lds + L_MASK); LAS unsigned* QPAR = (LAS unsigned*)(lds + L_QPAR);
            LAS unsigned* CCNT = (LAS unsigned*)(lds + L_CCNT); const LAS float* BIAS = (const LAS float*)(lds + L_BIAS);
            LAS unsigned char* STG = lds + L_STAGE;
            LAS unsigned char* STG3 = lds + L_HIST;
            const int ql = lane & 15, g4 = lane >> 4;
            const int dk_row = 32 * (wave >> 2) + 8 * (ql >> 2) + 4 * ((wave >> 1) & 1) + (ql & 3), dk_col = 32 * (wave & 1) + 8 * g4;
            const int dv_row = 16 * (wave & 3) + ql, dv_col = 32 * (wave >> 2) + 8 * g4;
            const int xq = vcu >> 5;
            for (;;) {
                if (vcu >= 256) break;
                if (tid == 0) MISC[4] = __hip_atomic_fetch_add(ctl + 2048 + 64 * xq, 1u, __ATOMIC_RELAXED, __HIP_MEMORY_SCOPE_AGENT);
                __syncthreads();
                const int uq = (int)MISC[4];
                __syncthreads();
                if (uq >= 64) break;
                const int b = 2 * xq + (uq >> 5), j = 31 - (uq & 31);
                const int nt = 5 + 4 * j, ns = (nt + 1) >> 1;
                const int qloc = 16 * wave + ql;
                const size_t mrow = (size_t)b * SEQ + 128 * j + qloc;
                const int p = 16 + 128 * j + qloc;
                const int pmaxw = 16 + 128 * j + 16 * wave + 15;
                const bf16* ikb = IKC + (size_t)b * KROWS * 64; const bf16* kcb = KC + (size_t)b * KROWS * 64; const bf16* vtb = VT + (size_t)b * 64 * KROWS; const bf16* vcb = VC + (size_t)b * KROWS * 64;
                unsigned char* tqb = (b < 15 ? (unsigned char*)out + (size_t)b * (17u << 20) : ws + WS_QN) + (size_t)(j * j + 2 * j) * 16384 + wave * 1024 + lane * 16;
                LAS unsigned* hrow = HIST + qloc * 128;
                bf16x8 iq[8][2], cq[2]; float wh[8];
                { const bf16* rp = PROJ + mrow * DP2 + C2_IQ + 8 * g4;
#pragma unroll
                  for (int h = 0; h < 8; ++h) { iq[h][0] = *(const GAS bf16x8*)(rp + 64 * h); iq[h][1] = *(const GAS bf16x8*)(rp + 64 * h + 32); }
                  const v4u wv = *(const GAS v4u*)(PROJ + mrow * DP2 + C2_IW);
#pragma unroll
                  for (int i = 0; i < 4; ++i) { wh[2 * i] = __uint_as_float(wv[i] << 16) * (0.5f * 0.35355339059327373f * 0.125f); wh[2 * i + 1] = __uint_as_float(wv[i] & 0xffff0000u) * (0.5f * 0.35355339059327373f * 0.125f); }
#pragma unroll
                  for (int sx = 0; sx < 2; ++sx) { float ca[8];
#pragma unroll
                      for (int e = 0; e < 8; ++e) ca[e] = 0.f;
#pragma unroll
                      for (int h = 0; h < 8; ++h) { const v4u qv = __builtin_bit_cast(v4u, iq[h][sx]);
#pragma unroll
                          for (int e = 0; e < 4; ++e) { ca[2 * e] = __builtin_fmaf(wh[h], __uint_as_float(qv[e] << 16), ca[2 * e]); ca[2 * e + 1] = __builtin_fmaf(wh[h], __uint_as_float(qv[e] & 0xffff0000u), ca[2 * e + 1]); } }
                      const v4u cw = (v4u){pkbf(ca[0], ca[1]), pkbf(ca[2], ca[3]), pkbf(ca[4], ca[5]), pkbf(ca[6], ca[7])}; cq[sx] = __builtin_bit_cast(bf16x8, cw); } }
                float lo, invw, binc;
                { float s1 = 0.f, s2 = 0.f;
                  int lane_p0 = lane; DSA_OPAQUE(lane_p0);
                  for (int kt = 0; kt < 2; ++kt) { f32x4 sc[2]; idx_tile(ikb, kt, iq, cq, wh, lane_p0, sc);
#pragma unroll
                      for (int u = 0; u < 2; ++u)
#pragma unroll
                          for (int r = 0; r < 4; ++r) { s1 += sc[u][r]; s2 += sc[u][r] * sc[u][r]; } }
                  s1 += __shfl_xor(s1, 16); s1 += __shfl_xor(s1, 32); s2 += __shfl_xor(s2, 16); s2 += __shfl_xor(s2, 32);
                  const float mean = s1 * (1.f / 64.f); float var = s2 * (1.f / 64.f) - mean * mean; var = var > 1e-30f ? var : 1e-30f;
                  const float sd = sqrtf(var); lo = mean - 3.f * sd; invw = 256.f * (float)DSA_NB / (6.f * sd); binc = -lo * invw; }
                { LAS v4u* hz = (LAS v4u*)(HIST + 16 * wave * 128);
#pragma unroll
                  for (int i = 0; i < 8; ++i) hz[lane + 64 * i] = (v4u){0u, 0u, 0u, 0u}; }
                __syncthreads();
                DSA_DMA_K(ikb, 0, DSA_PB1(0)); DSA_DMA_K(ikb, ns > 1 ? 1 : ns - 1, DSA_PB1(1)); DSA_DMA_K(ikb, ns > 2 ? 2 : ns - 1, DSA_PB1(2));
                DSA_WAITBAR(2);
                { const unsigned hbase = DSA_LDS_ADDR(hrow); unsigned one_v = 1u; DSA_OPAQUE(one_v);
                for (int step = 0; step < ns; ++step) {
                    { const int sn = step + 3 < ns ? step + 3 : ns - 1; DSA_DMA_K(ikb, sn, DSA_PB1(step + 3)); }
                    const LAS unsigned char* tb = DSA_PB1(step);
#pragma unroll 1
                    for (int tt = 0; tt < 2; ++tt) { const int kt = 2 * step + tt; unsigned tqv[4], tqp[4]; if (32 * kt > pmaxw) continue;
                        if (32 * kt + 31 <= pmaxw - 15) {
#pragma unroll
                        for (int u = 0; u < 2; ++u) { const f32x4 scu = idx_sub_lds2(tb + tt * 4096, u, iq, cq, wh, lane);
#pragma unroll
                            for (int r = 0; r < 4; ++r) {
                                const unsigned tq = (unsigned)(int)__builtin_amdgcn_fmed3f(bin_t(scu[r], binc, invw), 0.f, 32767.f);
                                asm volatile("ds_add_u32 %0, %1" :: "v"(hbase | ((tq >> 6) & 0x1fcu)), "v"(one_v) : "memory");
                                tqv[r] = tq; }
                            tqp[2 * u] = tqv[0] | (tqv[1] << 16); tqp[2 * u + 1] = tqv[2] | (tqv[3] << 16);
                            __builtin_amdgcn_sched_barrier(0); }
                        *(GAS v4u*)(tqb + (size_t)kt * 8192) = (v4u){tqp[0], tqp[1], tqp[2], tqp[3]};
                        } else {
#pragma unroll
                        for (int u = 0; u < 2; ++u) { const f32x4 scu = idx_sub_lds2(tb + tt * 4096, u, iq, cq, wh, lane);
#pragma unroll
                            for (int r = 0; r < 4; ++r) { const int kk = 32 * kt + 8 * g4 + 4 * u + r; const bool causal = kk <= p;
                                const unsigned tq = (unsigned)(int)__builtin_amdgcn_fmed3f(bin_t(scu[r], binc, invw), 0.f, 32767.f);
                                asm volatile("ds_add_u32 %0, %1" :: "v"(hbase | ((tq >> 6) & 0x1fcu)), "v"(causal ? 1u : 0u) : "memory");
                                tqv[r] = causal ? tq : 0xffffu; }
                            tqp[2 * u] = tqv[0] | (tqv[1] << 16); tqp[2 * u + 1] = tqv[2] | (tqv[3] << 16);
                            __builtin_amdgcn_sched_barrier(0); }
                        *(GAS v4u*)(tqb + (size_t)kt * 8192) = (v4u){tqp[0], tqp[1], tqp[2], tqp[3]}; } }
                    DSA_WAITBAR(2);
                } }
#pragma unroll 1
                for (int qq = 0; qq < 16; ++qq) { const int q = 16 * wave + qq; const int pq = 16 + 128 * j + q; const int kq = pq + 1 < 256 ? pq + 1 : 256;
                    const u32x2v wv = *(const LAS u32x2v*)(HIST + q * 128 + 2 * lane);
                    const int c0 = (int)wv[0], c1 = (int)wv[1]; const int sl = c0 + c1;
                    int pre = sl;
                    pre += __builtin_amdgcn_update_dpp(0, pre, 0x111, 0xf, 0xf, true); pre += __builtin_amdgcn_update_dpp(0, pre, 0x112, 0xf, 0xf, true);
                    pre += __builtin_amdgcn_update_dpp(0, pre, 0x114, 0xf, 0xf, true); pre += __builtin_amdgcn_update_dpp(0, pre, 0x118, 0xf, 0xf, true);
                    pre += __builtin_amdgcn_update_dpp(0, pre, 0x142, 0xa, 0xf, false); pre += __builtin_amdgcn_update_dpp(0, pre, 0x143, 0xc, 0xf, false);
                    int cum = __builtin_amdgcn_readlane(pre, 63) - pre; int bst = -1, ngt = 0;
                    if (cum < kq && cum + c1 >= kq) { bst = 2 * lane + 1; ngt = cum; } cum += c1;
                    if (cum < kq && cum + c0 >= kq) { bst = 2 * lane + 0; ngt = cum; }
                    if (bst >= 0) { QPAR[q * 4 + 0] = (unsigned)bst; QPAR[q * 4 + 1] = (unsigned)(kq - ngt); } }
                LDS_WAIT(); asm volatile("" ::: "memory");
                const int bstar = (int)QPAR[qloc * 4 + 0];
                int ccnt = 0;
                const unsigned cbase = DSA_LDS_ADDR(lds + L_HIST + qloc * 256), mbase = DSA_LDS_ADDR(MASK + qloc * DSA_MSTR);
                const int thi16 = (bstar + 1) << 8;
                __syncthreads();
                { v4u tw[4];
#pragma unroll
                  for (int i = 0; i < 4; ++i) tw[i] = *(const GAS v4u*)(tqb + (size_t)(i < 2 * ns ? i : 0) * 8192);
                  for (int kt0 = 0; kt0 < 2 * ns; kt0 += 4) {
#pragma unroll
                    for (int i = 0; i < 4; ++i) { const int kt = kt0 + i; if (kt < 2 * ns && 32 * kt <= pmaxw) {
                        const v4u cw = tw[i]; { const int kn = kt + 4 < 2 * ns ? kt + 4 : kt; tw[i] = *(const GAS v4u*)(tqb + (size_t)kn * 8192); }
                        unsigned bits = 0u;
#pragma unroll
                        for (int e = 0; e < 8; ++e) { const unsigned tq = (e & 1) ? cw[e >> 1] >> 16 : cw[e >> 1] & 0xffffu; const int kk = 32 * kt + 8 * g4 + e;
                            bits |= (int)(short)tq >= thi16 ? 1u << (8 * g4 + e) : 0u;
                            const bool cand = (int)(tq >> 8) == bstar; const unsigned long long m = __ballot(cand);
                            if (m) {
                                const unsigned long long mq = (m >> ql) & 0x0001000100010001ull;
                                const int rank = __popcll(mq & ((1ull << (16 * g4)) - 1ull)), tot = __popcll(mq);
                                if (cand) { const int slot = ccnt + rank; if (slot < DSA_CAP) asm volatile("ds_write_b32 %0, %1" :: "v"(cbase + 4u * (unsigned)slot), "v"((tq << 16) | (0xffffu - (unsigned)kk)) : "memory"); }
                                ccnt += tot; } }
                        bits |= __shfl_xor(bits, 16); bits |= __shfl_xor(bits, 32);
                        if (g4 == 0) asm volatile("ds_write_b32 %0, %1" :: "v"(mbase + 4u * (unsigned)kt), "v"(bits) : "memory"); } }
                  } }
                if (g4 == 0) CCNT[qloc] = (unsigned)ccnt;
                LDS_WAIT(); asm volatile("" ::: "memory");
#pragma unroll 1
                for (int qq = 0; qq < 16; ++qq) { const int q = 16 * wave + qq;
                    int cnt = (int)CCNT[q]; cnt = cnt < DSA_CAP ? cnt : DSA_CAP; cnt = __builtin_amdgcn_readfirstlane(cnt);
                    const int need = (int)QPAR[q * 4 + 1];
                    const LAS unsigned* cc_ = (const LAS unsigned*)(lds + L_HIST + q * 256);
                    const unsigned cme = lane < cnt ? cc_[lane] : 0u; const unsigned kme = 0xffffu - (cme & 0xffffu); int rank = 0;
                    for (int t = 0; t < cnt; ++t) rank += (unsigned)__builtin_amdgcn_readlane((int)cme, t) > cme ? 1 : 0;
                    if (lane < cnt && rank < need) __hip_atomic_fetch_or(MASK + q * DSA_MSTR + (kme >> 5), 1u << (kme & 31u), __ATOMIC_RELAXED, __HIP_MEMORY_SCOPE_WORKGROUP); }
                if (j >= 17) {
                    unsigned short* lstg = LISTG + ((size_t)((b * 32 + j) * 128 + 16 * wave)) * 256;
                    if (lane < 16) QPAR[(16 * wave + lane) * 4 + 2] = 0u;
#pragma unroll 1
                    for (int qq = 0; qq < 16; ++qq) { const int q = 16 * wave + qq; const int pq = 16 + 128 * j + q;
#pragma unroll 1
                        for (int rr = 0; rr < 3; ++rr) { const int kt = 64 * rr + lane;
                            unsigned w = (kt <= (pq >> 5)) ? MASK[q * DSA_MSTR + (kt < DSA_MSTR ? kt : 0)] : 0u;
                            const int cw = __popc(w);
                            int pos = cw ? (int)__hip_atomic_fetch_add(QPAR + q * 4 + 2, (unsigned)cw, __ATOMIC_RELAXED, __HIP_MEMORY_SCOPE_WORKGROUP) : 0;
                            while (w) { const int bpos = __builtin_ctz(w); w &= w - 1u; if (pos < 256) lstg[qq * 256 + pos] = (unsigned short)(32 * kt + bpos); ++pos; } } }
                    asm volatile("s_waitcnt vmcnt(0)" ::: "memory");
                    __syncthreads();
                    { int mrow_s = (int)((size_t)b * SEQ + 128 * j + 16 * wave); asm volatile("" : "+s"(mrow_s));
                      dsa_gather(lds + wave * 16384, lds + L_STAGE + wave * 1024, BIAS, kcb, vcb, lstg, QPAR + 16 * wave * 4 + 2, PROJ + (size_t)mrow_s * DP2 + C2_DQ, q_norm_w, Y + (size_t)mrow_s * D + 512, 16 + 128 * j + 16 * wave, lane); }
                    __syncthreads();
                } else {
                    __syncthreads();
                    int mrow_s = (int)mrow; asm volatile("" : "+v"(mrow_s));
                    dsa_sweep<4>(lds, 0, kcb, vtb, PROJ + (size_t)mrow_s * DP2 + C2_DQ, q_norm_w, Y + (size_t)mrow_s * D + 512, ns, p, 16 + 128 * j + 16 * wave, qloc, wave, lane);
                    dsa_sweep<4>(lds, 4, kcb, vtb, PROJ + (size_t)mrow_s * DP2 + C2_DQ, q_norm_w, Y + (size_t)mrow_s * D + 512, ns, p, 16 + 128 * j + 16 * wave, qloc, wave, lane);
                }
            }
            __syncthreads();
        }
        {
            LAS unsigned char* Kimg = lds + RING_OFF; LAS unsigned char* Vimg = Kimg + 128 * IMG_STRIDE; LAS unsigned char* Simg = Vimg + 128 * IMG_STRIDE;
            const int cq = 16 * wave + (lane & 15), g4 = lane >> 4;
            v4u pk[2][2], pv[4], ps[4], pq[4];
#define R3_GRAB(dst) do { if (tid == 0) MISC[5] = __hip_atomic_fetch_add(ctl + 2048 + 64 * 16, 1u, __ATOMIC_RELAXED, __HIP_MEMORY_SCOPE_AGENT); __syncthreads(); dst = (int)MISC[5]; __syncthreads(); } while (0)
#define R3_LOAD(U_) do { const int b_ = (U_) >> 7, h_ = ((U_) >> 5) & 3, n_ = ((U_) & 31) + 1; const size_t r0_ = (size_t)b_ * SEQ + 128 * (n_ - 1); \
                _Pragma("unroll") for (int i_ = 0; i_ < 2; ++i_) { const int item = tid + 512 * i_, c = item >> 3, j = item & 7; const bf16* rp = RET + ((size_t)(4 + h_) * M + r0_ + c) * 128 + 8 * j; pk[i_][0] = *(const GAS v4u*)rp; pk[i_][1] = *(const GAS v4u*)(rp + 64); } \
                const bf16* sp_ = SPT + ((size_t)((b_ * 4 + h_) * 32 + (n_ - 1))) * 16384; \
                _Pragma("unroll") for (int i_ = 0; i_ < 4; ++i_) { const int item = tid + 512 * i_, c = item >> 4, part = item & 15; pv[i_] = *(const GAS v4u*)(RET + ((size_t)(8 + h_) * M + r0_ + c) * 128 + 8 * part); ps[i_] = *(const GAS v4u*)(sp_ + c * 128 + 8 * part); } \
                { const bf16* rp = RET + ((size_t)h_ * M + r0_ + cq) * 128 + 8 * g4; pq[0] = *(const GAS v4u*)rp; pq[1] = *(const GAS v4u*)(rp + 32); pq[2] = *(const GAS v4u*)(rp + 64); pq[3] = *(const GAS v4u*)(rp + 96); } } while (0)
            int unit; R3_GRAB(unit);
            if (unit < BATCH * 4 * 32) R3_LOAD(unit);
            for (;;) {
                if (unit >= BATCH * 4 * 32) break;
                int unit_nx; R3_GRAB(unit_nx);
                const int b = unit >> 7, h = (unit >> 5) & 3, n = (unit & 31) + 1;
                const float lg2 = log2f(1.f - exp2f(-5.f - (float)h));
                const size_t row0 = (size_t)b * SEQ + 128 * (n - 1);
#pragma unroll
                for (int i_ = 0; i_ < 2; ++i_) { const int item = tid + 512 * i_, c = item >> 3, j = item & 7;
                    const int t = 128 * n - 112 + c; const GAS f32x4* rq = (const GAS f32x4*)(ROPE + ((size_t)t * 64 + 8 * j) * 2); f32x4 cs[4]; cs[0] = rq[0]; cs[1] = rq[1]; cs[2] = rq[2]; cs[3] = rq[3];
                    v4u o1, o2; rot8(pk[i_][0], pk[i_][1], cs, RET_KSCALE, o1, o2);
                    *(LAS v4u*)(Kimg + c * IMG_STRIDE + 16 * j) = o1; *(LAS v4u*)(Kimg + c * IMG_STRIDE + 128 + 16 * j) = o2; }
#pragma unroll
                for (int i_ = 0; i_ < 4; ++i_) { const int item = tid + 512 * i_, c = item >> 4, part = item & 15;
                    *(LAS v4u*)(Vimg + c * IMG_STRIDE + 16 * part) = pv[i_];
                    *(LAS v4u*)(Simg + c * IMG_STRIDE + 16 * part) = ps[i_]; }
                bf16x8 qf[4];
                { const int t = 128 * n - 112 + cq;
                  const GAS f32x4* ra = (const GAS f32x4*)(ROPE + ((size_t)t * 64 + 8 * g4) * 2); f32x4 c0[4], c1[4];
#pragma unroll
                  for (int i_ = 0; i_ < 4; ++i_) { c0[i_] = ra[i_]; c1[i_] = ra[16 + i_]; }
                  v4u o0, o1, o2, o3; rot8(pq[0], pq[2], c0, 1.f, o0, o2); rot8(pq[1], pq[3], c1, 1.f, o1, o3);
                  qf[0] = __builtin_bit_cast(bf16x8, o0); qf[1] = __builtin_bit_cast(bf16x8, o1); qf[2] = __builtin_bit_cast(bf16x8, o2); qf[3] = __builtin_bit_cast(bf16x8, o3); }
                __syncthreads();
                if (unit_nx < BATCH * 4 * 32) R3_LOAD(unit_nx);
                u32x2v gpre[8];
                { const bf16* gp0 = RET + ((size_t)(12 + h) * M + row0 + cq) * 128 + 4 * g4;
#pragma unroll
                  for (int et = 0; et < 8; ++et) gpre[et] = *(const GAS u32x2v*)(gp0 + 16 * et); }
                f32x4 oin[8], ocr[8];
#pragma unroll
                for (int et = 0; et < 8; ++et) { oin[et] = (f32x4){0.f, 0.f, 0.f, 0.f}; ocr[et] = oin[et]; }
#pragma unroll
                for (int et = 0; et < 8; ++et)
#pragma unroll
                    for (int ks = 0; ks < 4; ++ks) ocr[et] = MFMA16(frag_n(Simg, IMG_STRIDE, 16 * et + (lane & 15), 32 * ks, lane), qf[ks], ocr[et]);
                const int kgmax = wave >> 1;
                for (int kg = 0; kg <= kgmax; ++kg) {
                    f32x4 st[2];
#pragma unroll
                    for (int u = 0; u < 2; ++u) { st[u] = (f32x4){0.f, 0.f, 0.f, 0.f};
                        const int mrow = 32 * kg + 8 * ((lane & 15) >> 2) + 4 * u + (lane & 3);
#pragma unroll
                        for (int ks = 0; ks < 4; ++ks) st[u] = MFMA16(frag_n(Kimg, IMG_STRIDE, mrow, 32 * ks, lane), qf[ks], st[u]); }
                    float pv[8];
#pragma unroll
                    for (int u = 0; u < 2; ++u)
#pragma unroll
                        for (int r = 0; r < 4; ++r) { const int m = 32 * kg + 8 * g4 + 4 * u + r; const int dd = cq - m; pv[4 * u + r] = dd >= 0 ? st[u][r] * exp2f(lg2 * (float)dd) : 0.f; }
                    const v4u pw = (v4u){pkbf(pv[0], pv[1]), pkbf(pv[2], pv[3]), pkbf(pv[4], pv[5]), pkbf(pv[6], pv[7])};
                    const bf16x8 pf = __builtin_bit_cast(bf16x8, pw);
#pragma unroll
                    for (int et = 0; et < 8; ++et) oin[et] = MFMA16(frag_t(Vimg, IMG_STRIDE, 16 * et, 32 * kg, lane), pf, oin[et]);
                }
                const float xi = exp2f(lg2 * (float)(cq + 1)); float ss = 0.f;
#pragma unroll
                for (int et = 0; et < 8; ++et) { oin[et] = oin[et] + ocr[et] * xi; ss += (oin[et][0] * oin[et][0] + oin[et][1] * oin[et][1]) + (oin[et][2] * oin[et][2] + oin[et][3] * oin[et][3]); }
                ss += __shfl_xor(ss, 16); ss += __shfl_xor(ss, 32);
                const float rinv = 1.f / sqrtf(ss * (1.f / 128.f) + EPS);
                bf16* yp = Y + (row0 + cq) * D + 128 * h + 4 * g4; const float* wn = ret_norm_w + 128 * h + 4 * g4;
#pragma unroll
                for (int et = 0; et < 8; ++et) { const u32x2v gw2 = gpre[et]; const f32x4 gn = *(const GAS f32x4*)(wn + 16 * et);
                    float gt[4] = {__uint_as_float(gw2[0] << 16), __uint_as_float(gw2[0] & 0xffff0000u), __uint_as_float(gw2[1] << 16), __uint_as_float(gw2[1] & 0xffff0000u)}; float o[4];
#pragma unroll
                    for (int r = 0; r < 4; ++r) { const float sg = gt[r] / (1.f + __expf(-gt[r])); o[r] = oin[et][r] * rinv * gn[r] * sg; }
                    *(GAS u32x2v*)(yp + 16 * et) = (u32x2v){pkbf(o[0], o[1]), pkbf(o[2], o[3])}; }
                __syncthreads();
                unit = unit_nx;
            }
#undef R3_GRAB
#undef R3_LOAD
        }
        if (BOTH(3)) GRID_BAR();
    }
    if (IN(4)) {
        pg8::Gemm g{Y, WOUT_T, M, D, D}; pg8::StaticOrder S; S.init(M, D, G, (int)blockIdx.x);
        pg8::EpiResBf16Stats E{U, XS, norm1_w, SSQ, D};
        pg8::gemm_phase<pg8::EpiResBf16Stats, pg8::StaticOrder, true, true>(lds + RING_OFF, g, S, E);
        if (BOTH(4)) GRID_BAR();
    }
    if (IN(6)) {
        pg8::Gemm g{U, W1_T, M, FF, D}; pg8::StaticOrder S; S.init(M, FF, G, (int)blockIdx.x);
        pg8::EpiBf16RowScaleRelu2 E{HB, FF, SSQ, 1.f / D, EPS};
        pg8::gemm_phase<pg8::EpiBf16RowScaleRelu2, pg8::StaticOrder, true, true>(lds + RING_OFF, g, S, E);
        if (BOTH(6)) GRID_BAR();
    }
    if (IN(7)) {
        pg8::Gemm g{HB, W2_T, M, D, FF}; pg8::StaticOrder S; S.init(M, D, G, (int)blockIdx.x);
        pg8::EpiResFromBf16 E{U, out, D};
        pg8::gemm_phase<pg8::EpiResFromBf16, pg8::StaticOrder, true, true>(lds + RING_OFF, g, S, E);
    }
#undef IN
#undef BOTH
}

extern "C" void kernel_launch(void* const* d_in, const int* in_sizes, int n_in, void* d_out, int out_size, void* d_ws, size_t ws_size, hipStream_t stream) {
    static int grid = 0;
    if (grid == 0) {
        if (n_in != 12 || in_sizes[0] != M * D || out_size != M * D || ws_size < WS_END) { fprintf(stderr, "kernel_launch: unexpected shapes (n_in %d, in0 %d, out %d, ws %zu); nothing launched\n", n_in, n_in > 0 ? in_sizes[0] : -1, out_size, ws_size); grid = -1; return; }
        int dev = 0, cus = 0, per_cu = 0;
        if (hipGetDevice(&dev) != hipSuccess || hipDeviceGetAttribute(&cus, hipDeviceAttributeMultiprocessorCount, dev) != hipSuccess) { grid = -1; return; }
        if (hipFuncSetAttribute((const void*)mk_fwd, hipFuncAttributeMaxDynamicSharedMemorySize, LDS_BYTES) != hipSuccess) { fprintf(stderr, "kernel_launch: hipFuncSetAttribute failed\n"); grid = -1; return; }
        if (hipOccupancyMaxActiveBlocksPerMultiprocessor(&per_cu, (const void*)mk_fwd, NWAVES * 64, LDS_BYTES) != hipSuccess || per_cu < 1)
            fprintf(stderr, "kernel_launch: note: occupancy query reports %d workgroups per CU\n", per_cu);
        (void)hipGetLastError();
        grid = cus;
    }
    if (grid < 0) return;
    if (hipMemsetAsync((char*)d_ws + WS_CTL, 0, CTL_ZERO_BYTES, stream) != hipSuccess) return;
    Args a{};
    for (int i = 0; i < 12; ++i) a.in[i] = (const float*)d_in[i];
    a.out = (float*)d_out; a.ws = (unsigned char*)d_ws;
    if (ONE_LAUNCH) { a.ph_lo = 0; a.ph_hi = N_PHASES; hipLaunchKernelGGL(mk_fwd, dim3(grid), dim3(NWAVES * 64), LDS_BYTES, stream, a); }
    else for (int p = 0; p < N_PHASES; ++p) { a.ph_lo = p; a.ph_hi = p + 1; hipLaunchKernelGGL(mk_fwd, dim3(grid), dim3(NWAVES * 64), LDS_BYTES, stream, a); }
    const hipError_t le = hipPeekAtLastError();
    if (le != hipSuccess) fprintf(stderr, "kernel_launch: launch failed: %s\n", hipGetErrorName(le));
}
```

```cpp
#include <hip/hip_runtime.h>
#include <cstdio>
#include <cstdint>
namespace pg8 {
#define PG8_LAS __attribute__((address_space(3)))
typedef unsigned short bf16_t;
typedef short bf16x8 __attribute__((ext_vector_type(8)));
typedef float f32x4 __attribute__((ext_vector_type(4)));
typedef unsigned u32x4 __attribute__((ext_vector_type(4)));
constexpr int BM = 256, BK = 64, HALF = 128, HTB = HALF * BK * 2  , STAGE_BYTES = 8 * HTB, NXCD = 8, WGM = 8;

__host__ __device__ __forceinline__ int lds_byte(int r, int c) { const int st = (r >> 4) * 2 + (c >> 5), rr = r & 15, cc = c & 31, ob = rr * 64 + cc * 2; return st * 1024 + (ob ^ (((ob >> 9) & 1) << 5)); }
__host__ __device__ __forceinline__ void stage_rc(int b, int& R, int& C) { const int st = b / 1024, sb = b % 1024, swz = sb ^ (((sb >> 9) & 1) << 5); R = (st >> 1) * 16 + swz / 64; C = (st & 1) * 32 + (swz % 64) / 2; }
__host__ __device__ __forceinline__ int perm32(int rho) { const int n = rho >> 4, i = rho & 15; return 8 * (i >> 2) + 4 * n + (i & 3); }

struct Unit { int pm, pn; };
struct Gemm { const bf16_t* A; const bf16_t* Bt; int M, N, K; };

struct StaticOrder {
    int nM, nN, nwg, G, c;
    __host__ __device__ void init(int M, int N, int G_, int c_) { nM = M / BM; nN = N / BM; nwg = nM * nN; G = G_; c = c_; }
    __host__ __device__ bool next(int i, Unit& u) const {
        const long L = (long)i * G + c; if (L >= nwg) return false;
        int wgid = (int)L; { const int q = nwg / NXCD, r = nwg % NXCD, xcd = wgid % NXCD, off = wgid / NXCD; wgid = (xcd < r ? xcd * (q + 1) : r * (q + 1) + (xcd - r) * q) + off; }
        const int nig = WGM * nN, gid = wgid / nig, fm = gid * WGM, gsz = (nM - fm) < WGM ? (nM - fm) : WGM;
        u.pm = fm + ((wgid % nig) % gsz); u.pn = (wgid % nig) / gsz; return true;
    }
    __device__ __forceinline__ void a_ready(const Unit&) const {}
    __device__ __forceinline__ void done(const Unit&) const {}
};

typedef float f32x2c __attribute__((ext_vector_type(2))); typedef __bf16 bf16x2c __attribute__((ext_vector_type(2)));
__device__ __forceinline__ unsigned cvt_pk_bf16(float lo, float hi) { const f32x2c v = {lo, hi}; const bf16x2c b = __builtin_convertvector(v, bf16x2c); return __builtin_bit_cast(unsigned, b); }

template <int ACT  > struct EpiBf16 {
    static constexpr bool PERM = true, AFTER_DRAIN = false;
    bf16_t* O; int ldc;
    __device__ __forceinline__ void operator()(const f32x4 (&acc)[2][2][4][2], const Unit& u, int wr, int wc, int fr, int fq) const {
        const int row0 = u.pm * BM + wr * 64 + fr; const int col0 = u.pn * BM + wc * 32 + 8 * fq;
#pragma unroll
        for (int ai = 0; ai < 2; ++ai)
#pragma unroll
            for (int m = 0; m < 4; ++m) { bf16_t* rowp = O + (size_t)(row0 + ai * HALF + m * 16) * ldc + col0;
#pragma unroll
                for (int bj = 0; bj < 2; ++bj) { f32x4 v0 = acc[ai][bj][m][0], v1 = acc[ai][bj][m][1];
                    if (ACT == 2) {
#pragma unroll
                        for (int e = 0; e < 4; ++e) { const float a = fmaxf(v0[e], 0.f), b = fmaxf(v1[e], 0.f); v0[e] = a * a; v1[e] = b * b; } }
                    u32x4 w; w.x = cvt_pk_bf16(v0[0], v0[1]); w.y = cvt_pk_bf16(v0[2], v0[3]); w.z = cvt_pk_bf16(v1[0], v1[1]); w.w = cvt_pk_bf16(v1[2], v1[3]);
                    __builtin_nontemporal_store(w, (u32x4*)(rowp + bj * HALF)); } }
    }
};

struct EpiProj {
    static constexpr bool PERM = true, AFTER_DRAIN = false;
    bf16_t* O; int ldc; bf16_t* R; int mrows;
    __device__ __forceinline__ void operator()(const f32x4 (&acc)[2][2][4][2], const Unit& u, int wr, int wc, int fr, int fq) const {
        const int row0 = u.pm * BM + wr * 64 + fr; const int col0 = (u.pn - 8) * BM + wc * 32 + 8 * fq; const bool hm = u.pn < 8;
#pragma unroll
        for (int ai = 0; ai < 2; ++ai)
#pragma unroll
            for (int m = 0; m < 4; ++m) { const int row = row0 + ai * HALF + m * 16;
#pragma unroll
                for (int bj = 0; bj < 2; ++bj) { const f32x4 v0 = acc[ai][bj][m][0], v1 = acc[ai][bj][m][1];
                    u32x4 w; w.x = cvt_pk_bf16(v0[0], v0[1]); w.y = cvt_pk_bf16(v0[2], v0[3]); w.z = cvt_pk_bf16(v1[0], v1[1]); w.w = cvt_pk_bf16(v1[2], v1[3]);
                    bf16_t* p = hm ? R + ((size_t)(u.pn * 2 + bj) * mrows + row) * 128 + wc * 32 + 8 * fq : O + (size_t)row * ldc + col0 + bj * HALF;
                    __builtin_nontemporal_store(w, (u32x4*)p); } }
    }
};

struct EpiResF32 {
    static constexpr bool PERM = true, AFTER_DRAIN = false;
    const float* base; float* out; int ldc;
    __device__ __forceinline__ void operator()(const f32x4 (&acc)[2][2][4][2], const Unit& u, int wr, int wc, int fr, int fq) const {
        const int col0 = u.pn * BM + wc * 32 + 8 * fq;
#pragma unroll
        for (int ai = 0; ai < 2; ++ai)
#pragma unroll
            for (int m = 0; m < 4; ++m) { const size_t off = (size_t)(u.pm * BM + ai * HALF + wr * 64 + m * 16 + fr) * ldc + col0;
#pragma unroll
                for (int bj = 0; bj < 2; ++bj)
#pragma unroll
                    for (int n = 0; n < 2; ++n) { const f32x4 bs = *(const f32x4*)(base + off + bj * HALF + n * 4); *(f32x4*)(out + off + bj * HALF + n * 4) = bs + acc[ai][bj][m][n]; }
                if (m & 1) asm volatile("" ::: "memory"); }
    }
};
struct EpiResF32Stats {
    static constexpr bool PERM = true, AFTER_DRAIN = false;
    const float* base; float* out; bf16_t* xn; const float* w; float* ss; int ldc;
    __device__ __forceinline__ void operator()(const f32x4 (&acc)[2][2][4][2], const Unit& u, int wr, int wc, int fr, int fq) const {
        const int col0 = u.pn * BM + wc * 32 + 8 * fq;
        f32x4 wv[2][2];
#pragma unroll
        for (int bj = 0; bj < 2; ++bj)
#pragma unroll
            for (int n = 0; n < 2; ++n) wv[bj][n] = *(const f32x4*)(w + col0 + bj * HALF + n * 4);
#pragma unroll
        for (int ai = 0; ai < 2; ++ai)
#pragma unroll
            for (int m = 0; m < 4; ++m) { const int row = u.pm * BM + ai * HALF + wr * 64 + m * 16 + fr; const size_t off = (size_t)row * ldc + col0; float s = 0.f;
#pragma unroll
                for (int bj = 0; bj < 2; ++bj) { f32x4 a[2];
#pragma unroll
                    for (int n = 0; n < 2; ++n) { const f32x4 h = *(const f32x4*)(base + off + bj * HALF + n * 4) + acc[ai][bj][m][n]; *(f32x4*)(out + off + bj * HALF + n * 4) = h;
                        s += (h[0] * h[0] + h[1] * h[1]) + (h[2] * h[2] + h[3] * h[3]); a[n] = h * wv[bj][n]; }
                    u32x4 o; o.x = cvt_pk_bf16(a[0][0], a[0][1]); o.y = cvt_pk_bf16(a[0][2], a[0][3]); o.z = cvt_pk_bf16(a[1][0], a[1][1]); o.w = cvt_pk_bf16(a[1][2], a[1][3]);
                    *(u32x4*)(xn + off + bj * HALF) = o; }
                s += __shfl_xor(s, 16); s += __shfl_xor(s, 32);
                if (fq == 0) __hip_atomic_fetch_add(ss + row, s, __ATOMIC_RELAXED, __HIP_MEMORY_SCOPE_AGENT);
                if (m & 1) asm volatile("" ::: "memory"); }
    }
};
struct EpiBf16RowScaleRelu2 {
    static constexpr bool PERM = true, AFTER_DRAIN = false;
    bf16_t* O; int ldc; const float* ss; float inv_n, eps;
    __device__ __forceinline__ void operator()(const f32x4 (&acc)[2][2][4][2], const Unit& u, int wr, int wc, int fr, int fq) const {
        const int row0 = u.pm * BM + wr * 64 + fr; const int col0 = u.pn * BM + wc * 32 + 8 * fq;
#pragma unroll
        for (int ai = 0; ai < 2; ++ai)
#pragma unroll
            for (int m = 0; m < 4; ++m) { const int row = row0 + ai * HALF + m * 16; bf16_t* rowp = O + (size_t)row * ldc + col0; const float ri = 1.f / sqrtf(ss[row] * inv_n + eps);
#pragma unroll
                for (int bj = 0; bj < 2; ++bj) { f32x4 v0 = acc[ai][bj][m][0], v1 = acc[ai][bj][m][1];
#pragma unroll
                    for (int e = 0; e < 4; ++e) { const float a = fmaxf(v0[e] * ri, 0.f), b = fmaxf(v1[e] * ri, 0.f); v0[e] = a * a; v1[e] = b * b; }
                    u32x4 w; w.x = cvt_pk_bf16(v0[0], v0[1]); w.y = cvt_pk_bf16(v0[2], v0[3]); w.z = cvt_pk_bf16(v1[0], v1[1]); w.w = cvt_pk_bf16(v1[2], v1[3]);
                    __builtin_nontemporal_store(w, (u32x4*)(rowp + bj * HALF)); } }
    }
};

struct EpiResBf16Stats {
    static constexpr bool PERM = true, AFTER_DRAIN = false;
    bf16_t* xn; const float* xs; const float* w1; float* ss; int ldc;
    __device__ __forceinline__ void operator()(const f32x4 (&acc)[2][2][4][2], const Unit& u, int wr, int wc, int fr, int fq) const {
        const int col0 = u.pn * BM + wc * 32 + 8 * fq;
        f32x4 iw[2][2];
#pragma unroll
        for (int bj = 0; bj < 2; ++bj)
#pragma unroll
            for (int n = 0; n < 2; ++n) { const f32x4 g = *(const f32x4*)(w1 + col0 + bj * HALF + n * 4); iw[bj][n] = (f32x4){1.f / g[0], 1.f / g[1], 1.f / g[2], 1.f / g[3]}; }
#pragma unroll
        for (int ai = 0; ai < 2; ++ai)
#pragma unroll
            for (int m = 0; m < 4; ++m) { const int row = u.pm * BM + ai * HALF + wr * 64 + m * 16 + fr; const size_t off = (size_t)row * ldc + col0; float s = 0.f; const float xr = xs[row];
#pragma unroll
                for (int bj = 0; bj < 2; ++bj) { const u32x4 b = *(const u32x4*)(xn + off + bj * HALF); f32x4 h[2];
                    h[0] = (f32x4){__uint_as_float(b.x << 16), __uint_as_float(b.x & 0xffff0000u), __uint_as_float(b.y << 16), __uint_as_float(b.y & 0xffff0000u)} * iw[bj][0] * xr + acc[ai][bj][m][0];
                    h[1] = (f32x4){__uint_as_float(b.z << 16), __uint_as_float(b.z & 0xffff0000u), __uint_as_float(b.w << 16), __uint_as_float(b.w & 0xffff0000u)} * iw[bj][1] * xr + acc[ai][bj][m][1];
#pragma unroll
                    for (int n = 0; n < 2; ++n) s += (h[n][0] * h[n][0] + h[n][1] * h[n][1]) + (h[n][2] * h[n][2] + h[n][3] * h[n][3]);
                    u32x4 o; o.x = cvt_pk_bf16(h[0][0], h[0][1]); o.y = cvt_pk_bf16(h[0][2], h[0][3]); o.z = cvt_pk_bf16(h[1][0], h[1][1]); o.w = cvt_pk_bf16(h[1][2], h[1][3]);
                    *(u32x4*)(xn + off + bj * HALF) = o; }
                s += __shfl_xor(s, 16); s += __shfl_xor(s, 32);
                if (fq == 0) __hip_atomic_fetch_add(ss + row, s, __ATOMIC_RELAXED, __HIP_MEMORY_SCOPE_AGENT);
                if (m & 1) asm volatile("" ::: "memory"); }
    }
};
struct EpiResFromBf16 {
    static constexpr bool PERM = true, AFTER_DRAIN = false;
    const bf16_t* base; float* out; int ldc;
    __device__ __forceinline__ void operator()(const f32x4 (&acc)[2][2][4][2], const Unit& u, int wr, int wc, int fr, int fq) const {
        const int col0 = u.pn * BM + wc * 32 + 8 * fq;
#pragma unroll
        for (int ai = 0; ai < 2; ++ai)
#pragma unroll
            for (int m = 0; m < 4; ++m) { const size_t off = (size_t)(u.pm * BM + ai * HALF + wr * 64 + m * 16 + fr) * ldc + col0;
#pragma unroll
                for (int bj = 0; bj < 2; ++bj) { const u32x4 b = *(const u32x4*)(base + off + bj * HALF);
                    const f32x4 b0 = (f32x4){__uint_as_float(b.x << 16), __uint_as_float(b.x & 0xffff0000u), __uint_as_float(b.y << 16), __uint_as_float(b.y & 0xffff0000u)};
                    const f32x4 b1 = (f32x4){__uint_as_float(b.z << 16), __uint_as_float(b.z & 0xffff0000u), __uint_as_float(b.w << 16), __uint_as_float(b.w & 0xffff0000u)};
                    __builtin_nontemporal_store(b0 + acc[ai][bj][m][0], (f32x4*)(out + off + bj * HALF)); __builtin_nontemporal_store(b1 + acc[ai][bj][m][1], (f32x4*)(out + off + bj * HALF + 4)); }
                if (m & 1) asm volatile("" ::: "memory"); }
    }
};
template <class Epi, class Sched, bool ALIGN_EPI = false, bool SP2 = false>
__device__ __forceinline__ void gemm_phase(PG8_LAS unsigned char* lds, const Gemm g, const Sched& S, const Epi& E) {
    const int tid = threadIdx.x, wid = __builtin_amdgcn_readfirstlane(tid >> 6), lane = tid & 63, wr = wid >> 2, wc = wid & 3, fr = lane & 15, fq = lane >> 4;
    const int K = g.K, nt = K / BK;
    unsigned voffA[2], voffB[2];
#pragma unroll
    for (int i = 0; i < 2; ++i) { int R, C; stage_rc(tid * 16 + i * 8192, R, C); const int Rb = Epi::PERM ? ((R & ~31) + perm32(R & 31)) : R;
        voffA[i] = (unsigned)(R * K + C) * 2u; voffB[i] = (unsigned)(Rb * K + C) * 2u; }
    const size_t kstep = (size_t)(BK * 2);
    const size_t hstep = (size_t)HALF * K * 2;
    const size_t tstep = 2 * hstep;
    const unsigned ldsw = (unsigned)wid * 1024u;
    const int aoff = lds_byte(wr * 64 + fr, fq * 8), boff = lds_byte(wc * 32 + fr, fq * 8);
#define PG8_SA(b, h) (((b) * 2 + (h)) * HTB)
#define PG8_SB(b, h) ((4 + (b) * 2 + (h)) * HTB)
#define PG8_STAGE(bufoff, gbase, voff) do { _Pragma("unroll") for (int _i = 0; _i < 2; ++_i) \
        __builtin_amdgcn_global_load_lds((const unsigned*)((const char*)(gbase) + (voff)[_i]), (PG8_LAS unsigned*)(lds + (bufoff) + ldsw + _i * 8192), 16, 0, 0); } while (0)
#define PG8_LDA(dst, b, h) do { _Pragma("unroll") for (int m = 0; m < 4; ++m) _Pragma("unroll") for (int k = 0; k < 2; ++k) dst[m][k] = *(const PG8_LAS bf16x8*)(lds + PG8_SA(b, h) + aoff + m * 2048 + k * 1024); } while (0)
#define PG8_LDB(dst, b, h) do { _Pragma("unroll") for (int n = 0; n < 2; ++n) _Pragma("unroll") for (int k = 0; k < 2; ++k) dst[n][k] = *(const PG8_LAS bf16x8*)(lds + PG8_SB(b, h) + boff + n * 2048 + k * 1024); } while (0)
#define PG8_MMA(ai, bj, At, Bt) do { __builtin_amdgcn_s_setprio(1); _Pragma("unroll") for (int m = 0; m < 4; ++m) _Pragma("unroll") for (int n = 0; n < 2; ++n) _Pragma("unroll") for (int k = 0; k < 2; ++k) \
        acc[ai][bj][m][n] = __builtin_amdgcn_mfma_f32_16x16x32_bf16(Bt[n][k], At[m][k], acc[ai][bj][m][n], 0, 0, 0); __builtin_amdgcn_s_setprio(0); } while (0)
#define PG8_MMAZ(ai, bj, At, Bt) do { __builtin_amdgcn_s_setprio(1); _Pragma("unroll") for (int m = 0; m < 4; ++m) _Pragma("unroll") for (int n = 0; n < 2; ++n) { \
        const f32x4 c0_ = __builtin_amdgcn_mfma_f32_16x16x32_bf16(Bt[n][0], At[m][0], ((f32x4){0.f, 0.f, 0.f, 0.f}), 0, 0, 0); acc[ai][bj][m][n] = __builtin_amdgcn_mfma_f32_16x16x32_bf16(Bt[n][1], At[m][1], c0_, 0, 0, 0); } __builtin_amdgcn_s_setprio(0); } while (0)
#define PG8_WAIT_V(n) asm volatile("s_waitcnt vmcnt(" #n ")" ::: "memory")
#define PG8_WAIT_L(n) asm volatile("s_waitcnt lgkmcnt(" #n ")" ::: "memory")
#define PG8_BAR __builtin_amdgcn_s_barrier()
#define PG8_SCHED __builtin_amdgcn_sched_barrier(0)
    Unit cur, nxt; int ui = 0;
    if (!S.next(0, cur)) return;
    f32x4 acc[2][2][4][2];
    if constexpr (!SP2) {
#pragma unroll
    for (int a = 0; a < 2; ++a)
#pragma unroll
        for (int b = 0; b < 2; ++b)
#pragma unroll
            for (int m = 0; m < 4; ++m)
#pragma unroll
                for (int n = 0; n < 2; ++n) acc[a][b][m][n] = (f32x4){0.f, 0.f, 0.f, 0.f};
    }
    bf16x8 At[4][2], B0[2][2], B1[2][2];
    const char* cA = (const char*)g.A + (size_t)cur.pm * tstep; const char* cB = (const char*)g.Bt + (size_t)cur.pn * tstep;
    S.a_ready(cur);
    if constexpr (SP2) {
        PG8_STAGE(PG8_SB(0, 0), cB, voffB); PG8_STAGE(PG8_SB(0, 1), cB + hstep, voffB); PG8_STAGE(PG8_SA(0, 0), cA, voffA); PG8_STAGE(PG8_SA(0, 1), cA + hstep, voffA);
        if (wr == 1) PG8_BAR;
        PG8_WAIT_V(2); PG8_BAR;
        PG8_STAGE(PG8_SB(1, 0), cB + kstep, voffB); PG8_STAGE(PG8_SA(1, 0), cA + kstep, voffA); PG8_STAGE(PG8_SB(1, 1), cB + hstep + kstep, voffB);
        PG8_WAIT_V(6); PG8_BAR;
    } else {
        PG8_STAGE(PG8_SB(0, 0), cB, voffB); PG8_STAGE(PG8_SA(0, 0), cA, voffA); PG8_STAGE(PG8_SB(0, 1), cB + hstep, voffB); PG8_STAGE(PG8_SA(0, 1), cA + hstep, voffA);
        if (wr == 1) PG8_BAR;
        PG8_WAIT_V(4); PG8_BAR;
        PG8_STAGE(PG8_SB(1, 0), cB + kstep, voffB); PG8_STAGE(PG8_SA(1, 0), cA + kstep, voffA); PG8_STAGE(PG8_SB(1, 1), cB + hstep + kstep, voffB);
        PG8_WAIT_V(6); PG8_BAR;
    }
    for (;;) {
        const bool has_next = S.next(ui + 1, nxt);
        const char* nA = has_next ? (const char*)g.A + (size_t)nxt.pm * tstep : cA; const char* nB = has_next ? (const char*)g.Bt + (size_t)nxt.pn * tstep : cB;
#define PG8_KPTRS \
            const bool last = (t == nt - 2); \
            const char* a1 = cA + (size_t)(t + 1) * kstep;                                             \
            const char* a2 = last ? nA : cA + (size_t)(t + 2) * kstep; const char* b2 = last ? nB : cB + (size_t)(t + 2) * kstep;     \
            const char* a3 = a2 + kstep; const char* b3 = b2 + kstep;                                \
            if (last && has_next) S.a_ready(nxt);
#define PG8_KITER(MM0) \
            PG8_LDB(B0, 0, 0); PG8_LDB(B1, 0, 1); PG8_SCHED; PG8_LDA(At, 0, 0); PG8_STAGE(PG8_SA(1, 1), a1 + hstep, voffA); \
            PG8_WAIT_V(8); PG8_WAIT_L(0); PG8_BAR; MM0(0, 0, At, B0); MM0(0, 1, At, B1); PG8_BAR; PG8_SCHED; \
            PG8_LDA(At, 0, 1); PG8_STAGE(PG8_SB(0, 0), b2, voffB); PG8_STAGE(PG8_SB(0, 1), b2 + hstep, voffB); PG8_STAGE(PG8_SA(0, 0), a2, voffA); \
            PG8_WAIT_V(8); PG8_WAIT_L(0); PG8_BAR; MM0(1, 0, At, B0); MM0(1, 1, At, B1); PG8_BAR; PG8_SCHED; \
            PG8_LDB(B0, 1, 0); PG8_LDB(B1, 1, 1); PG8_SCHED; PG8_LDA(At, 1, 0); PG8_STAGE(PG8_SA(0, 1), a2 + hstep, voffA); \
            PG8_WAIT_V(8); PG8_WAIT_L(0); PG8_BAR; PG8_MMA(0, 0, At, B0); PG8_MMA(0, 1, At, B1); PG8_BAR; PG8_SCHED; \
            PG8_LDA(At, 1, 1); PG8_STAGE(PG8_SB(1, 0), b3, voffB); PG8_STAGE(PG8_SB(1, 1), b3 + hstep, voffB); PG8_STAGE(PG8_SA(1, 0), a3, voffA); \
            PG8_WAIT_V(8); PG8_WAIT_L(0); PG8_BAR; PG8_MMA(1, 0, At, B0); PG8_MMA(1, 1, At, B1); PG8_BAR; PG8_SCHED;
        int t0 = 0;
        if constexpr (SP2) { const int t = 0; PG8_KPTRS PG8_KITER(PG8_MMAZ) t0 = 2; }
        for (int t = t0; t < nt; t += 2) {
            PG8_KPTRS
            if constexpr (SP2) {
            PG8_KITER(PG8_MMA)
            } else {
            PG8_LDB(B0, 0, 0); PG8_SCHED; PG8_LDA(At, 0, 0); PG8_STAGE(PG8_SA(1, 1), a1 + hstep, voffA);
            PG8_WAIT_L(8); PG8_BAR; PG8_WAIT_L(0); PG8_MMA(0, 0, At, B0); PG8_BAR; PG8_SCHED;
            PG8_LDB(B1, 0, 1); PG8_STAGE(PG8_SB(0, 0), b2, voffB);
            PG8_BAR; PG8_WAIT_L(0); PG8_MMA(0, 1, At, B1); PG8_BAR;
            PG8_LDA(At, 0, 1); PG8_STAGE(PG8_SA(0, 0), a2, voffA);
            PG8_BAR; PG8_WAIT_L(0); PG8_MMA(1, 0, At, B0); PG8_BAR; PG8_SCHED;
            PG8_STAGE(PG8_SB(0, 1), b2 + hstep, voffB);
            PG8_WAIT_V(6); PG8_BAR; PG8_MMA(1, 1, At, B1); PG8_BAR;
            PG8_LDB(B0, 1, 0); PG8_SCHED; PG8_LDA(At, 1, 0); PG8_STAGE(PG8_SA(0, 1), a2 + hstep, voffA);
            PG8_WAIT_L(8); PG8_BAR; PG8_WAIT_L(0); PG8_MMA(0, 0, At, B0); PG8_BAR; PG8_SCHED;
            PG8_LDB(B1, 1, 1); PG8_STAGE(PG8_SB(1, 0), b3, voffB);
            PG8_BAR; PG8_WAIT_L(0); PG8_MMA(0, 1, At, B1); PG8_BAR;
            PG8_LDA(At, 1, 1); PG8_STAGE(PG8_SA(1, 0), a3, voffA);
            PG8_BAR; PG8_WAIT_L(0); PG8_MMA(1, 0, At, B0); PG8_BAR; PG8_SCHED;
            PG8_STAGE(PG8_SB(1, 1), b3 + hstep, voffB);
            PG8_WAIT_V(6); PG8_BAR; PG8_MMA(1, 1, At, B1); PG8_BAR;
            }
        }
        if constexpr (ALIGN_EPI) { if (wr == 0) PG8_BAR; }
        if constexpr (!Epi::AFTER_DRAIN) { int ln_ = lane; asm volatile("" : "+v"(ln_));
            E(acc, cur, wr, wc, ln_ & 15, ln_ >> 4); S.done(cur); }
        if (!has_next) break;
        if constexpr (!SP2) {
#pragma unroll
        for (int a = 0; a < 2; ++a)
#pragma unroll
            for (int b = 0; b < 2; ++b)
#pragma unroll
                for (int m = 0; m < 4; ++m)
#pragma unroll
                    for (int n = 0; n < 2; ++n) acc[a][b][m][n] = (f32x4){0.f, 0.f, 0.f, 0.f};
        }
        cur = nxt; cA = nA; cB = nB; ++ui;
        if constexpr (ALIGN_EPI) { if (wr == 1) PG8_BAR; }
    }
    PG8_WAIT_V(0);
    if constexpr (!ALIGN_EPI) { if (wr == 0) PG8_BAR; }
    PG8_BAR;
    if constexpr (Epi::AFTER_DRAIN) { E.fused(acc, cur, wr, wc, fr, fq, lds, wid, lane); S.done(cur); }
#undef PG8_SA
#undef PG8_SB
#undef PG8_STAGE
#undef PG8_LDA
#undef PG8_LDB
#undef PG8_MMA
#undef PG8_MMAZ
#undef PG8_KPTRS
#undef PG8_KITER
#undef PG8_WAIT_V
#undef PG8_WAIT_L
#undef PG8_BAR
#undef PG8_SCHED
}
}
constexpr int NWAVES = 8;
#ifndef MK_N_LAUNCHES
#define MK_N_LAUNCHES 1
#endif
constexpr int N_PHASES = 8;
constexpr bool ONE_LAUNCH = (MK_N_LAUNCHES == 1);

constexpr int BATCH = 16, SEQ = 4096, D = 1024, NMETA = 16, TK = SEQ + NMETA, FF = 4096;
constexpr int M = BATCH * SEQ;
constexpr int DIN = 3272, DINP = 3328;
constexpr int C_RQ = 0, C_RK = 512, C_RV = 1024, C_RG = 1536, C_DQ = 2048, C_DK = 2560, C_DV = 2624, C_IQ = 2688, C_IK = 3200, C_IW = 3264;
constexpr int DP2 = 1280;
constexpr int C2_DQ = C_DQ - 2048, C2_DK = C_DK - 2048, C2_DV = C_DV - 2048, C2_IQ = C_IQ - 2048, C2_IK = C_IK - 2048, C2_IW = C_IW - 2048;
constexpr float EPS = 1e-6f;
constexpr int KROWS = 4160;

constexpr size_t MiB = 1u << 20;
constexpr size_t WS_CTL = 0, CTL_ZERO_BYTES = 1 * MiB;
constexpr size_t WS_WIN = 2 * MiB;
constexpr size_t WS_WOUT = 9 * MiB;
constexpr size_t WS_W1 = 11 * MiB;
constexpr size_t WS_W2 = 19 * MiB;
constexpr size_t WS_ROPE = 27 * MiB;
constexpr size_t WS_PMETA = 30 * MiB;
constexpr size_t WS_KC = 32 * MiB;
constexpr size_t WS_IKC = 41 * MiB;
constexpr size_t WS_VT = 50 * MiB;
constexpr size_t WS_U = 64 * MiB;
constexpr size_t WS_PROJ = 192 * MiB;
constexpr size_t WS_RET = 352 * MiB;
constexpr size_t WS_QN = 608 * MiB;
constexpr size_t WS_SPT = 672 * MiB;
constexpr size_t WS_Y = 736 * MiB;
constexpr size_t WS_H = 192 * MiB;
constexpr size_t WS_TQ2 = 864 * MiB;
constexpr size_t WS_LIST = 864 * MiB;
constexpr size_t WS_END = 1024 * MiB;
static_assert(WS_H + (size_t)M * FF * 2 <= WS_Y && WS_Y + (size_t)M * D * 2 <= WS_END, "d_ws map");
constexpr int CW_TMO = 0, CW_CODE = 1;
constexpr int CW_BAR = 4096;

constexpr int RING_OFF = 0, RING_BYTES = 131072;
constexpr int LDS_BYTES = 163840;
constexpr int LDSCTL_OFF = LDS_BYTES - 512, MISC_OFF = LDSCTL_OFF + 320;
static_assert(MISC_OFF + 128 <= LDS_BYTES, "LDS map");
#define GAS __attribute__((address_space(1)))
#define LAS __attribute__((address_space(3)))
typedef unsigned short bf16;
typedef unsigned v4u __attribute__((ext_vector_type(4)));
typedef float f32x4 __attribute__((ext_vector_type(4)));
typedef short bf16x8 __attribute__((ext_vector_type(8)));
typedef GAS unsigned gu32;
typedef GAS unsigned long long gu64;
#define RLX_AGENT __ATOMIC_RELAXED, __HIP_MEMORY_SCOPE_AGENT
#define LDS_WAIT() asm volatile("s_waitcnt lgkmcnt(0)" ::: "memory")
#define VM_WAIT() asm volatile("s_waitcnt vmcnt(0)" ::: "memory")
__device__ __forceinline__ unsigned long long rt() { return __builtin_amdgcn_s_memrealtime(); }
__device__ __forceinline__ unsigned f2bf(float f) { unsigned u = __builtin_bit_cast(unsigned, f); return (u + 0x7fffu + ((u >> 16) & 1u)) >> 16; }
__device__ __forceinline__ unsigned pk2(float lo, float hi) { return f2bf(lo) | (f2bf(hi) << 16); }

#define XB_TMO      128
#define XB_XCNT(j)  (256  + 64 * (j))
#define XB_XSUB(j)  (1280 + 64 * (j))
#define XB_XGEN(j)  (2304 + 64 * (j))
#define XB_TOP      3328
#define XB_TOPGEN   3392
#define XCD_BAR_WORDS 3456
#define XB_SPIN_CAP (1u << 22)

__device__ __forceinline__ unsigned xb_ld(unsigned* p)              { return __hip_atomic_load(p, __ATOMIC_RELAXED, __HIP_MEMORY_SCOPE_AGENT); }
__device__ __forceinline__ unsigned xb_add(unsigned* p, unsigned v) { return __hip_atomic_fetch_add(p, v, __ATOMIC_RELAXED, __HIP_MEMORY_SCOPE_AGENT); }
__device__ __forceinline__ unsigned xb_xcc_id() { return (unsigned)__builtin_amdgcn_s_getreg((3 << 11) | 20) & 0xFu; }
#define XB_SPIN(cond, bar) do { unsigned _sp = 0; while (cond) { __builtin_amdgcn_s_sleep(1); \
    if ((++_sp & 255u) == 0u) { if (xb_ld(&(bar)[XB_TMO])) break; if (_sp > XB_SPIN_CAP) { atomicAdd(&(bar)[XB_TMO], 1u); break; } } } } while (0)

struct XcdBarrier {
    unsigned* bar; unsigned x;
    volatile LAS unsigned* st;
};

__device__ __forceinline__ XcdBarrier xcd_barrier_post(unsigned* bar, volatile LAS unsigned* st) {
    XcdBarrier b; b.bar = bar; b.x = xb_xcc_id(); b.st = st;
    if (threadIdx.x == 0) (void)xb_add(&bar[XB_XCNT(b.x)], 1u);
    return b;
}
__device__ __forceinline__ void xcd_barrier_complete(unsigned* bar, unsigned x, unsigned& nloc, unsigned& nx) {
    const unsigned G = gridDim.x * gridDim.y * gridDim.z;
    unsigned sum, cnt, mine, sp = 0u;
    for (;;) {
        sum = 0u; cnt = 0u; mine = 0u;
#pragma unroll
        for (unsigned j = 0; j < 16; ++j) { const unsigned c = xb_ld(&bar[XB_XCNT(j)]); sum += c; cnt += (c > 0u) ? 1u : 0u; mine = (j == x) ? c : mine; }
        if (sum == G) break;
        __builtin_amdgcn_s_sleep(1);
        if ((++sp & 255u) == 0u) { if (xb_ld(&bar[XB_TMO])) break; if (sp > XB_SPIN_CAP) { atomicAdd(&bar[XB_TMO], 1u); break; } }
    }
    nloc = mine > 0u ? mine : 1u; nx = cnt > 0u ? cnt : 1u;
}

__device__ __forceinline__ void xcd_barrier(const XcdBarrier& b) {
    asm volatile("s_waitcnt vmcnt(0)" ::: "memory");
    __syncthreads();
    if (threadIdx.x == 0) {
        unsigned* bar = b.bar;
        __builtin_amdgcn_s_waitcnt(0);
        unsigned nloc = b.st[0], nx = b.st[1];
        if (nloc == 0u) { xcd_barrier_complete(bar, b.x, nloc, nx); b.st[0] = nloc; b.st[1] = nx; }
        const unsigned old = xb_add(&bar[XB_XSUB(b.x)], 1u);
        const unsigned gen = old / nloc;
        if (old + 1u == (gen + 1u) * nloc) {
            __builtin_amdgcn_fence(__ATOMIC_RELEASE, "agent");
            asm volatile("s_waitcnt vmcnt(0)" ::: "memory");
            const unsigned og = xb_add(&bar[XB_TOP], 1u);
            const unsigned tg = og / nx;
            if (og + 1u == (tg + 1u) * nx) xb_add(&bar[XB_TOPGEN], 1u);
            else XB_SPIN(xb_ld(&bar[XB_TOPGEN]) == tg, bar);
            __builtin_amdgcn_fence(__ATOMIC_ACQUIRE, "agent");
            xb_add(&bar[XB_XGEN(b.x)], 1u);
            asm volatile("s_waitcnt vmcnt(0)" ::: "memory");
        } else {
            XB_SPIN(xb_ld(&bar[XB_XGEN(b.x)]) == gen, bar);
            __builtin_amdgcn_fence(__ATOMIC_ACQUIRE, "agent");
            asm volatile("s_waitcnt vmcnt(0)" ::: "memory");
        }
    }
    __syncthreads();
}

typedef short v4i16_t __attribute__((ext_vector_type(4)));
typedef float f32x2v __attribute__((ext_vector_type(2)));
typedef unsigned u32x2v __attribute__((ext_vector_type(2)));
#define MFMA16(a, b, c) __builtin_amdgcn_mfma_f32_16x16x32_bf16((a), (b), (c), 0, 0, 0)
__device__ __forceinline__ float bf2f(unsigned short u) { return __uint_as_float((unsigned)u << 16); }
__device__ __forceinline__ bf16x8 frag_n(const LAS unsigned char* img, int stride, int rowsel, int k0, int lane) {
    return *(const LAS bf16x8*)(img + rowsel * stride + (k0 + 8 * (lane >> 4)) * 2);
}
__device__ __forceinline__ bf16x8 frag_t(const LAS unsigned char* img, int stride, int row0, int k0, int lane) {
    const int g = lane >> 4, q = (lane >> 2) & 3, p = lane & 3;
    const LAS unsigned char* a = img + (k0 + 8 * g + q) * stride + (row0 + 4 * p) * 2;
    const v4i16_t lo = __builtin_amdgcn_ds_read_tr16_b64_v4i16((LAS v4i16_t*)a);
    const v4i16_t hi = __builtin_amdgcn_ds_read_tr16_b64_v4i16((LAS v4i16_t*)(a + 4 * stride));
    return (bf16x8){lo[0], lo[1], lo[2], lo[3], hi[0], hi[1], hi[2], hi[3]};
}
__device__ __forceinline__ unsigned pkbf(float lo, float hi) { return pg8::cvt_pk_bf16(lo, hi); }
__device__ __forceinline__ float rows_sum(float x) {
    { const auto r = __builtin_amdgcn_permlane16_swap(__float_as_uint(x), __float_as_uint(x), false, false); x = __uint_as_float(r[0]) + __uint_as_float(r[1]); }
    { const auto r = __builtin_amdgcn_permlane32_swap(__float_as_uint(x), __float_as_uint(x), false, false); x = __uint_as_float(r[0]) + __uint_as_float(r[1]); }
    return x; }
__device__ __forceinline__ unsigned rows_or(unsigned x) {
    { const auto r = __builtin_amdgcn_permlane16_swap(x, x, false, false); x = r[0] | r[1]; }
    { const auto r = __builtin_amdgcn_permlane32_swap(x, x, false, false); x = r[0] | r[1]; }
    return x; }
#define TR_RD "ds_read_b64_tr_b16 "
__device__ __forceinline__ bf16x8 tr_pack(u32x2v lo, u32x2v hi) { const v4u w = (v4u){lo[0], lo[1], hi[0], hi[1]}; return __builtin_bit_cast(bf16x8, w); }

constexpr int IMG_STRIDE = 288;
constexpr float RET_KSCALE = 0.08838834764831845f;

__device__ __forceinline__ void rot8(const v4u a, const v4u b, const f32x4 (&cs)[4], float sc, v4u& o1, v4u& o2) {
    float x1[8], x2[8], c[8], s[8];
#pragma unroll
    for (int i = 0; i < 4; ++i) { x1[2 * i] = __uint_as_float(a[i] << 16); x1[2 * i + 1] = __uint_as_float(a[i] & 0xffff0000u); x2[2 * i] = __uint_as_float(b[i] << 16); x2[2 * i + 1] = __uint_as_float(b[i] & 0xffff0000u);
        c[2 * i] = cs[i][0]; s[2 * i] = cs[i][1]; c[2 * i + 1] = cs[i][2]; s[2 * i + 1] = cs[i][3]; }
    float r1[8], r2[8];
#pragma unroll
    for (int i = 0; i < 8; ++i) { r1[i] = (x1[i] * c[i] - x2[i] * s[i]) * sc; r2[i] = (x1[i] * s[i] + x2[i] * c[i]) * sc; }
#pragma unroll
    for (int i = 0; i < 4; ++i) { o1[i] = pkbf(r1[2 * i], r1[2 * i + 1]); o2[i] = pkbf(r2[2 * i], r2[2 * i + 1]); }
}
#define DSA_OPAQUE(x) asm volatile("" : "+v"(x))
constexpr int DSA_CAP = 64;
constexpr int DSA_MSTR = 132;
constexpr int L_HIST = 0, L_MASK = 65536, L_QPAR = L_MASK + 128 * DSA_MSTR * 4, L_CCNT = L_QPAR + 128 * 16, L_BIAS = L_CCNT + 512, L_STAGE = L_BIAS + 8 * 144 * 4, L_DSA_END = L_STAGE + 2 * 8192;
static_assert(L_DSA_END <= LDSCTL_OFF, "DSA LDS map");
constexpr float LOG2E = 1.4426950408889634f;

constexpr int DSA_NB = 128;
#define DSA_SCORE_BODY \
        f32x4 acc = MFMA16(a0, cq[0], ((f32x4){0.f, 0.f, 0.f, 0.f})); acc = MFMA16(a1, cq[1], acc); \
        _Pragma("unroll") for (int h = 0; h < 8; ++h) { \
            f32x4 s = MFMA16(a0, iq[h][0], ((f32x4){0.f, 0.f, 0.f, 0.f})); s = MFMA16(a1, iq[h][1], s); \
            _Pragma("unroll") for (int r = 0; r < 4; ++r) acc[r] = __builtin_fmaf(wh[h], __builtin_fabsf(s[r]), acc[r]); } \
        sc[u] = acc;
__device__ __forceinline__ void idx_tile(const bf16* ikb, int kt, const bf16x8 (&iq)[8][2], const bf16x8 (&cq)[2], const float (&wh)[8], int lane, f32x4 (&sc)[2]) {
    const int i = lane & 15, g = lane >> 4;
#pragma unroll
    for (int u = 0; u < 2; ++u) {
        const bf16* rp = ikb + (size_t)(32 * kt + 8 * (i >> 2) + 4 * u + (i & 3)) * 64 + 8 * g;
        const bf16x8 a0 = *(const GAS bf16x8*)rp, a1 = *(const GAS bf16x8*)(rp + 32);
        DSA_SCORE_BODY
    }
}
__device__ __forceinline__ void idx_tile_lds(const LAS unsigned char* tb, const bf16x8 (&iq)[8][2], const bf16x8 (&cq)[2], const float (&wh)[8], int lane, f32x4 (&sc)[2]) {
#pragma unroll
    for (int u = 0; u < 2; ++u) {
        const bf16x8 a0 = *(const LAS bf16x8*)(tb + (u * 2 + 0) * 1024 + lane * 16), a1 = *(const LAS bf16x8*)(tb + (u * 2 + 1) * 1024 + lane * 16);
        DSA_SCORE_BODY
    }
}
__device__ __forceinline__ float bin_t(float s, float binc, float invw) { return __builtin_fmaf(s, invw, binc); }
__device__ __forceinline__ int bin_of_t(float t) { return (int)__builtin_amdgcn_fmed3f(t, 0.f, (float)(DSA_NB - 1)); }

__device__ __forceinline__ f32x4 idx_sub_lds2(const LAS unsigned char* tb, int u, const bf16x8 (&iq)[8][2], const bf16x8 (&cq)[2], const float (&wh)[8], int lane) {
    const bf16x8 a0 = *(const LAS bf16x8*)(tb + (u * 2 + 0) * 1024 + lane * 16), a1 = *(const LAS bf16x8*)(tb + (u * 2 + 1) * 1024 + lane * 16);
    f32x4 s[9];
#pragma unroll
    for (int h = 0; h < 8; ++h) s[h] = MFMA16(a0, iq[h][0], ((f32x4){0.f, 0.f, 0.f, 0.f}));
    s[8] = MFMA16(a0, cq[0], ((f32x4){0.f, 0.f, 0.f, 0.f}));
#pragma unroll
    for (int h = 0; h < 8; ++h) s[h] = MFMA16(a1, iq[h][1], s[h]);
    s[8] = MFMA16(a1, cq[1], s[8]);
    f32x4 acc = s[8];
#pragma unroll
    for (int h = 0; h < 8; ++h)
#pragma unroll
        for (int r = 0; r < 4; ++r) acc[r] = __builtin_fmaf(wh[h], __builtin_fabsf(s[h][r]), acc[r]);
    __builtin_amdgcn_sched_group_barrier(0x100, 2, 0);
    __builtin_amdgcn_sched_group_barrier(0x008, 18, 0);
    __builtin_amdgcn_sched_group_barrier(0x002, 32, 0);
    return acc;
}
struct IdxAcc { f32x4 s[9]; };
__device__ __forceinline__ IdxAcc idx_mfma_group(const LAS unsigned char* tb, int sub, const bf16x8 (&iq)[8][2], const bf16x8 (&cq)[2], int lane) {
    const LAS unsigned char* ab = tb + (sub >> 1) * 4096 + (sub & 1) * 2048 + lane * 16;
    const bf16x8 a0 = *(const LAS bf16x8*)ab, a1 = *(const LAS bf16x8*)(ab + 1024);
    IdxAcc r;
#pragma unroll
    for (int h = 0; h < 8; ++h) r.s[h] = MFMA16(a0, iq[h][0], ((f32x4){0.f, 0.f, 0.f, 0.f}));
    r.s[8] = MFMA16(a0, cq[0], ((f32x4){0.f, 0.f, 0.f, 0.f}));
#pragma unroll
    for (int h = 0; h < 8; ++h) r.s[h] = MFMA16(a1, iq[h][1], r.s[h]);
    r.s[8] = MFMA16(a1, cq[1], r.s[8]);
    return r;
}
__device__ __forceinline__ f32x4 idx_combine(const IdxAcc& a, const float (&wh)[8]) {
    f32x4 acc = a.s[8];
#pragma unroll
    for (int h = 0; h < 8; ++h)
#pragma unroll
        for (int r = 0; r < 4; ++r) acc[r] = __builtin_fmaf(wh[h], __builtin_fabsf(a.s[h][r]), acc[r]);
    return acc;
}
#define DSA_DMA_K(base, step, buf) __builtin_amdgcn_global_load_lds((const unsigned*)((base) + (size_t)(64 * (step) + dk_row) * 64 + dk_col), (LAS unsigned*)((buf) + wave * 1024), 16, 0, 0)
#define DSA_WAITBAR(N) asm volatile("s_waitcnt vmcnt(" #N ") lgkmcnt(0)\n\ts_barrier" ::: "memory")
#define DSA_LDS_ADDR(p) ((unsigned)(unsigned long long)(p))
#define DSA_PB1(i) (lds + L_MASK + ((i) & 3) * 8192)
#define DSA_PB2(i) (lds + (((i) & 2) ? L_STAGE : 49152) + ((i) & 1) * 8192)
#define DSA_PB3(i) (lds + L_HIST + ((i) & 3) * 16384)
#define DSA_DMA_V(base, step, buf) __builtin_amdgcn_global_load_lds((const unsigned*)((base) + (size_t)dv_row * KROWS + 64 * (step) + dv_col), (LAS unsigned*)((buf) + 8192 + wave * 1024), 16, 0, 0)

template <int NH>
__device__ __forceinline__ void dsa_sweep(LAS unsigned char* lds, int h0, const bf16* kcb, const bf16* vtb, const bf16* qrow, const float* qgain, bf16* yrow, int ns, int p, int pmin, int qloc, int wave, int lane) {
    DSA_OPAQUE(lane);
    const int ql = lane & 15, g4 = lane >> 4;
    const int dk_row = 32 * (wave >> 2) + 8 * (ql >> 2) + 4 * ((wave >> 1) & 1) + (ql & 3), dk_col = 32 * (wave & 1) + 8 * g4;
    const int dv_row = 16 * (wave & 3) + ql, dv_col = 32 * (wave >> 2) + 8 * g4;
    const LAS unsigned* MASK = (const LAS unsigned*)(lds + L_MASK); const LAS float* BIAS = (const LAS float*)(lds + L_BIAS);
    bf16x8 qf[NH][2];
#pragma unroll 1
    for (int pass_ = 0; pass_ < 1; ++pass_) {
#pragma unroll
      for (int hh = 0; hh < NH; ++hh) { v4u qv[2]; float ss = 0.f;
#pragma unroll
          for (int sx = 0; sx < 2; ++sx) { qv[sx] = *(const GAS v4u*)(qrow + 64 * (h0 + hh) + 32 * sx + 8 * g4);
#pragma unroll
              for (int e = 0; e < 4; ++e) { const float a = __uint_as_float(qv[sx][e] << 16), c = __uint_as_float(qv[sx][e] & 0xffff0000u); ss += a * a + c * c; } }
          ss = rows_sum(ss);
          const float scq = (1.f / sqrtf(ss * (1.f / 64.f) + 1e-6f)) * (0.125f * LOG2E);
#pragma unroll
          for (int sx = 0; sx < 2; ++sx) { const f32x4 g0 = *(const GAS f32x4*)(qgain + 32 * sx + 8 * g4), g1 = *(const GAS f32x4*)(qgain + 32 * sx + 8 * g4 + 4); v4u o;
#pragma unroll
              for (int e = 0; e < 4; ++e) { const float a = __uint_as_float(qv[sx][e] << 16), c = __uint_as_float(qv[sx][e] & 0xffff0000u);
                  const float ga = e < 2 ? g0[2 * e] : g1[2 * e - 4], gc = e < 2 ? g0[2 * e + 1] : g1[2 * e - 3]; o[e] = pkbf(a * scq * ga, c * scq * gc); }
              qf[hh][sx] = __builtin_bit_cast(bf16x8, o); } } }
    f32x4 oacc[NH][4]; float lsum[NH];
#pragma unroll
    for (int hh = 0; hh < NH; ++hh) { lsum[hh] = 0.f;
#pragma unroll
        for (int dt = 0; dt < 4; ++dt) oacc[hh][dt] = (f32x4){0.f, 0.f, 0.f, 0.f}; }
    DSA_DMA_K(kcb, 0, DSA_PB3(0)); DSA_DMA_V(vtb, 0, DSA_PB3(0));
    { const int s1 = ns > 1 ? 1 : ns - 1, s2 = ns > 2 ? 2 : ns - 1; DSA_DMA_K(kcb, s1, DSA_PB3(1)); DSA_DMA_V(vtb, s1, DSA_PB3(1)); DSA_DMA_K(kcb, s2, DSA_PB3(2)); DSA_DMA_V(vtb, s2, DSA_PB3(2)); }
    DSA_WAITBAR(4);
    for (int step = 0; step < ns; ++step) {
        { const int sn = step + 3 < ns ? step + 3 : ns - 1; DSA_DMA_K(kcb, sn, DSA_PB3(step + 3)); DSA_DMA_V(vtb, sn, DSA_PB3(step + 3)); }
        const LAS unsigned char* tb = DSA_PB3(step);
#pragma unroll 1
        for (int tt = 0; tt < 2; ++tt) { const int kt = 2 * step + tt; if (32 * kt > pmin + 15) continue;
            const unsigned mw = (MASK[qloc * DSA_MSTR + kt] >> (8 * g4)) & 0xffu;
            bf16x8 ka[2][2], vt[4];
#pragma unroll
            for (int u = 0; u < 2; ++u) { ka[u][0] = *(const LAS bf16x8*)(tb + tt * 4096 + (u * 2 + 0) * 1024 + lane * 16); ka[u][1] = *(const LAS bf16x8*)(tb + tt * 4096 + (u * 2 + 1) * 1024 + lane * 16); }
#pragma unroll
            for (int dt = 0; dt < 4; ++dt) vt[dt] = *(const LAS bf16x8*)(tb + 8192 + tt * 4096 + dt * 1024 + lane * 16);
            f32x4 cm[2];
#pragma unroll
            for (int u = 0; u < 2; ++u)
#pragma unroll
                for (int r = 0; r < 4; ++r) cm[u][r] = ((mw >> (4 * u + r)) & 1u) ? 0.f : -30000.f;
            const bool near = 32 * kt + 31 + 112 >= pmin;
#pragma unroll
            for (int hh = 0; hh < NH; ++hh) {
                f32x4 st[2]; st[0] = cm[0]; st[1] = cm[1];
                if (near) {
                    int d0 = p - (32 * kt + 8 * g4); d0 = d0 < 0 ? 0 : (d0 > 135 ? 135 : d0);
                    const LAS float* bt = BIAS + (h0 + hh) * 144 + 8 + d0 - 7;
#pragma unroll
                    for (int u = 0; u < 2; ++u)
#pragma unroll
                        for (int r = 0; r < 4; ++r) st[u][r] += bt[7 - (4 * u + r)]; }
#pragma unroll
                for (int u = 0; u < 2; ++u) { st[u] = MFMA16(ka[u][0], qf[hh][0], st[u]); st[u] = MFMA16(ka[u][1], qf[hh][1], st[u]); }
                float pe[8];
#pragma unroll
                for (int u = 0; u < 2; ++u)
#pragma unroll
                    for (int r = 0; r < 4; ++r) { pe[4 * u + r] = __builtin_amdgcn_exp2f(st[u][r]); lsum[hh] += pe[4 * u + r]; }
                const v4u pw = (v4u){pkbf(pe[0], pe[1]), pkbf(pe[2], pe[3]), pkbf(pe[4], pe[5]), pkbf(pe[6], pe[7])};
                const bf16x8 pf = __builtin_bit_cast(bf16x8, pw);
#pragma unroll
                for (int dt = 0; dt < 4; ++dt) oacc[hh][dt] = MFMA16(vt[dt], pf, oacc[hh][dt]);
            }
        }
        DSA_WAITBAR(4);
    }
#pragma unroll
    for (int hh = 0; hh < NH; ++hh) { float l = rows_sum(lsum[hh]); const float il = 1.f / l;
        bf16* yp = yrow + 64 * (h0 + hh) + 4 * g4;
#pragma unroll
        for (int dt = 0; dt < 4; ++dt) *(GAS u32x2v*)(yp + 16 * dt) = (u32x2v){pkbf(oacc[hh][dt][0] * il, oacc[hh][dt][1] * il), pkbf(oacc[hh][dt][2] * il, oacc[hh][dt][3] * il)}; }
}

__device__ __forceinline__ void dsa_gather(LAS unsigned char* gbuf, LAS unsigned char* lstb, const LAS float* BIAS, const bf16* kc, const bf16* vc, const unsigned short* lst,
                                           const LAS unsigned* qcnt  , const bf16* projq  , const float* qgain, bf16* y  , int p0  , int lane) {
    DSA_OPAQUE(lane);
    const int h = lane & 15, g4 = lane >> 4, hv = h & 7;
    f32x4 gq[2][2];
#pragma unroll
    for (int sx = 0; sx < 2; ++sx) { gq[sx][0] = *(const GAS f32x4*)(qgain + 32 * sx + 8 * g4); gq[sx][1] = *(const GAS f32x4*)(qgain + 32 * sx + 8 * g4 + 4); }
    u32x2v lwn = *(const GAS u32x2v*)(lst + 4 * lane); v4u qvn[2];
    { const bf16* qp = projq + 64 * hv + 8 * g4; qvn[0] = *(const GAS v4u*)qp; qvn[1] = *(const GAS v4u*)(qp + 32); }
#pragma unroll 1
    for (int qq = 0; qq < 16; ++qq) {
        const int pq = p0 + qq; int nsel = pq + 1 < 256 ? pq + 1 : 256; { const int nl = (int)qcnt[4 * qq]; nsel = nl < nsel ? nl : nsel; }
        nsel = __builtin_amdgcn_readfirstlane(nsel); const int nch = (nsel + 31) >> 5;
        { u32x2v lw = lwn;
          if (4 * lane + 0 >= nsel) lw[0] &= 0xffff0000u; if (4 * lane + 1 >= nsel) lw[0] &= 0x0000ffffu; if (4 * lane + 2 >= nsel) lw[1] &= 0xffff0000u; if (4 * lane + 3 >= nsel) lw[1] &= 0x0000ffffu;
          *(LAS u32x2v*)(lstb + 8 * lane) = lw; }
        bf16x8 qf[2];
        { v4u qv[2]; qv[0] = qvn[0]; qv[1] = qvn[1]; float ss = 0.f;
#pragma unroll
          for (int sx = 0; sx < 2; ++sx) {
#pragma unroll
              for (int e = 0; e < 4; ++e) { const float a = __uint_as_float(qv[sx][e] << 16), c = __uint_as_float(qv[sx][e] & 0xffff0000u); ss += a * a + c * c; } }
          ss = rows_sum(ss);
          const float scq = (1.f / sqrtf(ss * (1.f / 64.f) + 1e-6f)) * (0.125f * LOG2E);
#pragma unroll
          for (int sx = 0; sx < 2; ++sx) { const f32x4 g0 = gq[sx][0], g1 = gq[sx][1]; v4u o;
#pragma unroll
              for (int e = 0; e < 4; ++e) { const float a = __uint_as_float(qv[sx][e] << 16), c = __uint_as_float(qv[sx][e] & 0xffff0000u);
                  const float ga = e < 2 ? g0[2 * e] : g1[2 * e - 4], gc = e < 2 ? g0[2 * e + 1] : g1[2 * e - 3]; o[e] = pkbf(a * scq * ga, c * scq * gc); }
              qf[sx] = __builtin_bit_cast(bf16x8, o); } }
        LDS_WAIT(); asm volatile("" ::: "memory");
        f32x4 oacc[4]; float lsum = 0.f;
#pragma unroll
        for (int dt = 0; dt < 4; ++dt) oacc[dt] = (f32x4){0.f, 0.f, 0.f, 0.f};
#define DSA_GDMA(c, buf) do { _Pragma("unroll") for (int i = 0; i < 4; ++i) { const int r_ = 8 * i + (lane >> 3); unsigned ki_ = *(const LAS unsigned short*)(lstb + 2 * (32 * (c) + r_)); ki_ = ki_ < (unsigned)KROWS ? ki_ : 0u; \
            const int pc_ = (lane & 7) ^ (r_ & 7); \
            __builtin_amdgcn_global_load_lds((const unsigned*)(kc + (size_t)ki_ * 64 + 8 * pc_), (LAS unsigned*)((buf) + i * 1024), 16, 0, 0); \
            __builtin_amdgcn_global_load_lds((const unsigned*)(vc + (size_t)ki_ * 64 + 8 * pc_), (LAS unsigned*)((buf) + 4096 + i * 1024), 16, 0, 0); } } while (0)
        { unsigned k8[8]; const unsigned la_ = DSA_LDS_ADDR(lstb) + 2u * (unsigned)(lane >> 3); const int pc_ = (lane & 7) ^ (lane >> 3);
          asm volatile("ds_read_u16 %0, %8\n\tds_read_u16 %1, %8 offset:16\n\tds_read_u16 %2, %8 offset:32\n\tds_read_u16 %3, %8 offset:48\n\tds_read_u16 %4, %8 offset:64\n\tds_read_u16 %5, %8 offset:80\n\tds_read_u16 %6, %8 offset:96\n\tds_read_u16 %7, %8 offset:112\n\ts_waitcnt lgkmcnt(0)"
                       : "=&v"(k8[0]), "=&v"(k8[1]), "=&v"(k8[2]), "=&v"(k8[3]), "=&v"(k8[4]), "=&v"(k8[5]), "=&v"(k8[6]), "=&v"(k8[7]) : "v"(la_) : "memory");
#pragma unroll
          for (int cc = 0; cc < 2; ++cc) { if (cc < nch) {
#pragma unroll
              for (int i = 0; i < 4; ++i) { const unsigned ki_ = k8[4 * cc + i] < (unsigned)KROWS ? k8[4 * cc + i] : 0u;
                  __builtin_amdgcn_global_load_lds((const unsigned*)(kc + (size_t)ki_ * 64 + 8 * pc_), (LAS unsigned*)(gbuf + cc * 8192 + i * 1024), 16, 0, 0);
                  __builtin_amdgcn_global_load_lds((const unsigned*)(vc + (size_t)ki_ * 64 + 8 * pc_), (LAS unsigned*)(gbuf + cc * 8192 + 4096 + i * 1024), 16, 0, 0); } } } }
        __builtin_amdgcn_sched_barrier(0);
        { const int qn = qq < 15 ? qq + 1 : 15; lwn = *(const GAS u32x2v*)(lst + qn * 256 + 4 * lane); const bf16* qp = projq + (size_t)qn * DP2 + 64 * hv + 8 * g4; qvn[0] = *(const GAS v4u*)qp; qvn[1] = *(const GAS v4u*)(qp + 32); }
        __builtin_amdgcn_sched_barrier(0);
        const int qd = (lane >> 2) & 3, pp = lane & 3, R0 = 4 * g4 + qd, pcl = (lane & 7) ^ (lane >> 3);
        const unsigned gb0 = DSA_LDS_ADDR(gbuf), kof0 = (unsigned)(h * 128 + 16 * (g4 ^ (h & 7))), kof1 = (unsigned)(h * 128 + 16 * ((4 + g4) ^ (h & 7)));
        const unsigned vofb = (unsigned)(R0 * 128 + 8 * (pp & 1)), vsw = (unsigned)((pp >> 1) ^ (R0 & 7));
        const unsigned lsa = DSA_LDS_ADDR(lstb);
#pragma unroll 1
        for (int c = 0; c < nch; ++c) {
            if (c < 2) { if (c + 1 < nch) asm volatile("s_waitcnt vmcnt(11)" ::: "memory"); else asm volatile("s_waitcnt vmcnt(3)" ::: "memory"); }
            else { if (c + 1 < nch) asm volatile("s_waitcnt vmcnt(8)" ::: "memory"); else asm volatile("s_waitcnt vmcnt(0)" ::: "memory"); }
            const unsigned gb = gb0 + (unsigned)(c & 1) * 8192u;
            v4u kf[2][2]; u32x2v kiw[2], tv[4][2]; unsigned nk[4];
            { const unsigned ka0 = gb + kof0, ka1 = gb + kof1, va0 = gb + vofb + 16u * (vsw ^ 0u), va1 = gb + vofb + 16u * (vsw ^ 2u), va2 = gb + vofb + 16u * (vsw ^ 4u), va3 = gb + vofb + 16u * (vsw ^ 6u);
              const unsigned kwa = lsa + 2u * (unsigned)(32 * c + 4 * g4), nka = lsa + 2u * (unsigned)(32 * (c + 2) + (lane >> 3));
              asm volatile("ds_read_b128 %0, %18\n\tds_read_b128 %1, %19\n\tds_read_b128 %2, %18 offset:2048\n\tds_read_b128 %3, %19 offset:2048\n\tds_read_b64 %4, %24\n\tds_read_b64 %5, %24 offset:32\n\t"
                           TR_RD "%6, %20 offset:4096\n\t" TR_RD "%7, %20 offset:6144\n\t" TR_RD "%8, %21 offset:4096\n\t" TR_RD "%9, %21 offset:6144\n\t"
                           TR_RD "%10, %22 offset:4096\n\t" TR_RD "%11, %22 offset:6144\n\t" TR_RD "%12, %23 offset:4096\n\t" TR_RD "%13, %23 offset:6144\n\t"
                           "ds_read_u16 %14, %25\n\tds_read_u16 %15, %25 offset:16\n\tds_read_u16 %16, %25 offset:32\n\tds_read_u16 %17, %25 offset:48\n\ts_waitcnt lgkmcnt(0)"
                           : "=&v"(kf[0][0]), "=&v"(kf[0][1]), "=&v"(kf[1][0]), "=&v"(kf[1][1]), "=&v"(kiw[0]), "=&v"(kiw[1]),
                             "=&v"(tv[0][0]), "=&v"(tv[0][1]), "=&v"(tv[1][0]), "=&v"(tv[1][1]), "=&v"(tv[2][0]), "=&v"(tv[2][1]), "=&v"(tv[3][0]), "=&v"(tv[3][1]),
                             "=&v"(nk[0]), "=&v"(nk[1]), "=&v"(nk[2]), "=&v"(nk[3])
                           : "v"(ka0), "v"(ka1), "v"(va0), "v"(va1), "v"(va2), "v"(va3), "v"(kwa), "v"(nka) : "memory"); }
            if (c + 2 < nch) { LAS unsigned char* nb = gbuf + (c & 1) * 8192;
#pragma unroll
                for (int i = 0; i < 4; ++i) { const unsigned ki_ = nk[i] < (unsigned)KROWS ? nk[i] : 0u;
                    __builtin_amdgcn_global_load_lds((const unsigned*)(kc + (size_t)ki_ * 64 + 8 * pcl), (LAS unsigned*)(nb + i * 1024), 16, 0, 0);
                    __builtin_amdgcn_global_load_lds((const unsigned*)(vc + (size_t)ki_ * 64 + 8 * pcl), (LAS unsigned*)(nb + 4096 + i * 1024), 16, 0, 0); } }
            f32x4 st[2];
#pragma unroll
            for (int u = 0; u < 2; ++u) { st[u] = MFMA16(__builtin_bit_cast(bf16x8, kf[u][0]), qf[0], ((f32x4){0.f, 0.f, 0.f, 0.f})); st[u] = MFMA16(__builtin_bit_cast(bf16x8, kf[u][1]), qf[1], st[u]); }
            float bv[8];
#pragma unroll
            for (int u = 0; u < 2; ++u)
#pragma unroll
                for (int r = 0; r < 4; ++r) { const int ki = (int)((r & 1) ? kiw[u][r >> 1] >> 16 : kiw[u][r >> 1] & 0xffffu); int dd = pq - ki; dd = dd < 0 ? 0 : (dd > 135 ? 135 : dd);
                    bv[4 * u + r] = BIAS[hv * 144 + 8 + dd]; }
            float pe[8];
#pragma unroll
            for (int u = 0; u < 2; ++u)
#pragma unroll
                for (int r = 0; r < 4; ++r) { const float lg = (32 * c + 16 * u + 4 * g4 + r) < nsel ? st[u][r] + bv[4 * u + r] : -30000.f; pe[4 * u + r] = __builtin_amdgcn_exp2f(lg); lsum += pe[4 * u + r]; }
            const v4u pw = (v4u){pkbf(pe[0], pe[1]), pkbf(pe[2], pe[3]), pkbf(pe[4], pe[5]), pkbf(pe[6], pe[7])};
            const bf16x8 pf = __builtin_bit_cast(bf16x8, pw);
#pragma unroll
            for (int dt = 0; dt < 4; ++dt) oacc[dt] = MFMA16(tr_pack(tv[dt][0], tv[dt][1]), pf, oacc[dt]);
        }
#undef DSA_GDMA
        lsum = rows_sum(lsum);
        if (h < 8) { const float il = 1.f / lsum; bf16* yp = y + (size_t)qq * D + 64 * h + 4 * g4;
#pragma unroll
            for (int dt = 0; dt < 4; ++dt) *(GAS u32x2v*)(yp + 16 * dt) = (u32x2v){pkbf(oacc[dt][0] * il, oacc[dt][1] * il), pkbf(oacc[dt][2] * il, oacc[dt][3] * il)}; }
    }
}
__device__ __forceinline__ float wave_sum(float v) {
#pragma unroll
    for (int o = 1; o < 64; o <<= 1) v += __shfl_xor(v, o);
    return v;
}
__device__ __forceinline__ void p0_transpose_item(const float* W, int K, int N, int NP, bf16* WT, LAS float* scr, int item, int lane, const float* kscale = nullptr) {
    const int nblk = NP / 32, kb = item / nblk, nb = item % nblk, k0 = 64 * kb, n0 = 32 * nb;
    const int nn = n0 + (lane & 31); const bool ok = nn < N;
#pragma unroll 8
    for (int i = 0; i < 32; ++i) { const int kk = 2 * i + (lane >> 5); scr[kk * 33 + (lane & 31)] = ok ? W[(size_t)(k0 + kk) * N + nn] * (kscale ? kscale[k0 + kk] : 1.f) : 0.f; }
    LDS_WAIT(); asm volatile("" ::: "memory");
    const int c = lane & 7;
#pragma unroll
    for (int j = 0; j < 4; ++j) { const int n = (lane >> 3) + 8 * j; const LAS float* s = scr + (8 * c) * 33 + n;
        v4u o; o.x = pk2(s[0 * 33], s[1 * 33]); o.y = pk2(s[2 * 33], s[3 * 33]); o.z = pk2(s[4 * 33], s[5 * 33]); o.w = pk2(s[6 * 33], s[7 * 33]);
        *(GAS v4u*)(WT + (size_t)(n0 + n) * K + k0 + 8 * c) = o; }
    LDS_WAIT(); asm volatile("" ::: "memory");
}
__device__ __forceinline__ void rms_row_to_bf16(const float* xrow, const float* w, bf16* orow, int lane) {
    const GAS f32x4* xr = (const GAS f32x4*)xrow + lane; const GAS f32x4* wr = (const GAS f32x4*)w + lane;
    f32x4 v[4]; float s = 0.f;
#pragma unroll
    for (int j = 0; j < 4; ++j) { v[j] = xr[64 * j]; s += (v[j].x * v[j].x + v[j].y * v[j].y) + (v[j].z * v[j].z + v[j].w * v[j].w); }
    const float r = 1.f / sqrtf(wave_sum(s) * (1.f / D) + EPS);
    GAS unsigned long long* o8 = (GAS unsigned long long*)orow + lane;
#pragma unroll
    for (int j = 0; j < 4; ++j) { const f32x4 g = wr[64 * j];
        o8[64 * j] = (unsigned long long)pk2(v[j].x * r * g.x, v[j].y * r * g.y) | ((unsigned long long)pk2(v[j].z * r * g.z, v[j].w * r * g.w) << 32); }
}

__device__ __forceinline__ void rms_row2_to_bf16(const float* xa, const float* xb, const float* w, bf16* oa, bf16* ob, float* xsa, float* xsb, int lane) {
    const GAS f32x4* pa = (const GAS f32x4*)xa + lane; const GAS f32x4* pb = (const GAS f32x4*)xb + lane; const GAS f32x4* wr = (const GAS f32x4*)w + lane;
    f32x4 va[4], vb[4]; float sa = 0.f, sb = 0.f;
#pragma unroll
    for (int j = 0; j < 4; ++j) { va[j] = __builtin_nontemporal_load(pa + 64 * j); vb[j] = __builtin_nontemporal_load(pb + 64 * j); }
#pragma unroll
    for (int j = 0; j < 4; ++j) { sa += (va[j].x * va[j].x + va[j].y * va[j].y) + (va[j].z * va[j].z + va[j].w * va[j].w); sb += (vb[j].x * vb[j].x + vb[j].y * vb[j].y) + (vb[j].z * vb[j].z + vb[j].w * vb[j].w); }
    const float qa_ = sqrtf(wave_sum(sa) * (1.f / D) + EPS), qb_ = sqrtf(wave_sum(sb) * (1.f / D) + EPS); const float ra = 1.f / qa_, rb = 1.f / qb_;
    if (lane == 0) { *xsa = qa_; *xsb = qb_; }
    GAS unsigned long long* qa = (GAS unsigned long long*)oa + lane; GAS unsigned long long* qb = (GAS unsigned long long*)ob + lane;
#pragma unroll
    for (int j = 0; j < 4; ++j) { const f32x4 g = wr[64 * j];
        qa[64 * j] = (unsigned long long)pk2(va[j].x * ra * g.x, va[j].y * ra * g.y) | ((unsigned long long)pk2(va[j].z * ra * g.z, va[j].w * ra * g.w) << 32);
        qb[64 * j] = (unsigned long long)pk2(vb[j].x * rb * g.x, vb[j].y * rb * g.y) | ((unsigned long long)pk2(vb[j].z * rb * g.z, vb[j].w * rb * g.w) << 32); }
}

struct Args { const float* in[12]; float* out; unsigned char* ws; int ph_lo, ph_hi; };
__global__ void __launch_bounds__(NWAVES * 64, 2) mk_fwd(Args args) {
    extern __shared__ __attribute__((aligned(16))) unsigned char lds_raw[];
    LAS unsigned char* lds = (LAS unsigned char*)lds_raw;
    volatile LAS unsigned* MISC = (volatile LAS unsigned*)(lds + MISC_OFF);
    const int tid = threadIdx.x, lane = tid & 63, wave = __builtin_amdgcn_readfirstlane(tid >> 6);
    const int G = gridDim.x; const int bx = blockIdx.x; const int vcu = (G % 8 == 0) ? (bx % 8) * (G / 8) + bx / 8 : bx;
    unsigned char* ws = args.ws;
    gu32* ctl = (gu32*)(ws + WS_CTL);
    const float* x = args.in[0]; const float* meta = args.in[1]; const float* norm1_w = args.in[2]; const float* w_in = args.in[3];
    const float* ret_norm_w = args.in[4]; const float* q_norm_w = args.in[5]; const float* k_norm_w = args.in[6]; const float* rel_bias = args.in[7];
    const float* w_out = args.in[8]; const float* norm2_w = args.in[9]; const float* w_ff1 = args.in[10]; const float* w_ff2 = args.in[11];
    float* out = args.out;
    bf16* WIN_T = (bf16*)(ws + WS_WIN); bf16* WOUT_T = (bf16*)(ws + WS_WOUT); bf16* W1_T = (bf16*)(ws + WS_W1); bf16* W2_T = (bf16*)(ws + WS_W2);
    bf16* U = (bf16*)(ws + WS_U); bf16* PROJ = (bf16*)(ws + WS_PROJ); bf16* Y = (bf16*)(ws + WS_Y); bf16* HB = (bf16*)(ws + WS_H);
    float* ROPE = (float*)(ws + WS_ROPE); float* PMETA = (float*)(ws + WS_PMETA); bf16* PM16 = (bf16*)(ws + WS_PMETA + 512 * 1024); bf16* SPT = (bf16*)(ws + WS_SPT);
    float* XS = (float*)(ws + WS_CTL + 768 * 1024);
    float* SSQ = (float*)(ws + WS_CTL + 512 * 1024);
    bf16* KC = (bf16*)(ws + WS_KC); bf16* IKC = (bf16*)(ws + WS_IKC); bf16* VT = (bf16*)(ws + WS_VT); bf16* VC = (bf16*)(ws + WS_QN + 32 * MiB); unsigned short* LISTG = (unsigned short*)(ws + WS_LIST); bf16* RET = (bf16*)(ws + WS_RET);
    for (int u = tid; u < (LDS_BYTES - LDSCTL_OFF) / 4; u += NWAVES * 64) ((LAS unsigned*)(lds + LDSCTL_OFF))[u] = 0u;
    __syncthreads();
    XcdBarrier bar; bar.bar = (unsigned*)(ctl + CW_BAR); bar.x = 0; bar.st = nullptr;
    if (ONE_LAUNCH) bar = xcd_barrier_post((unsigned*)(ctl + CW_BAR), MISC + 8);
#define GRID_BAR() do { if (ONE_LAUNCH) xcd_barrier(bar); } while (0)
    const int lo = args.ph_lo, hi = args.ph_hi;
#define IN(k) (lo <= (k) && (k) < hi)
#define BOTH(k) (IN(k) && IN((k) + 1 + ((k) == 4)))
    const int gw = vcu * NWAVES + wave, NGW = G * NWAVES;

    if (IN(0)) {
        LAS float* scr = (LAS float*)(lds + RING_OFF + wave * 16384);
        constexpr int I_IN = (D / 64) * (DINP / 32), I_O = (D / 64) * (D / 32), I_1 = (D / 64) * (FF / 32), I_2 = (FF / 64) * (D / 32);
        constexpr int NITEMS = I_IN + I_O + I_1 + I_2;
        for (int it = gw; it < NITEMS; it += NGW) {
            int r = it;
            if (r < I_IN) { p0_transpose_item(w_in, D, DIN, DINP, WIN_T, scr, r, lane); continue; } r -= I_IN;
            if (r < I_O) { p0_transpose_item(w_out, D, D, D, WOUT_T, scr, r, lane); continue; } r -= I_O;
            if (r < I_1) { p0_transpose_item(w_ff1, D, FF, FF, W1_T, scr, r, lane, norm2_w); continue; } r -= I_1;
            p0_transpose_item(w_ff2, FF, D, D, W2_T, scr, r, lane);
        }
        for (int m = gw; m < M; m += 2 * NGW) rms_row2_to_bf16(x + (size_t)m * D, x + (size_t)(m + NGW) * D, norm1_w, U + (size_t)m * D, U + (size_t)(m + NGW) * D, XS + m, XS + m + NGW, lane);

        for (int i = bx * 512 + tid; i < TK * 64; i += G * 512) {
            const int t = i >> 6, fi = i & 63;
            const double inv = exp2(-(double)fi * (13.287712379549449 / 64.0));
            const double ang = (double)t * inv;
            const double nrev = rint(ang * 0.15915494309189535);
            double r = fma(-nrev, 6.283185307179586, ang); r = fma(-nrev, 2.4492935982947064e-16, r);
            const double r2 = r * r; double sn = 1.0, cn = 1.0;
#pragma unroll
            for (int k = 12; k >= 1; --k) { sn = 1.0 - r2 / (double)((2 * k) * (2 * k + 1)) * sn; cn = 1.0 - r2 / (double)((2 * k - 1) * (2 * k)) * cn; }
            sn *= r;
            ((GAS f32x2v*)ROPE)[i] = (f32x2v){(float)cn, (float)sn};
        }
        for (int i = bx * 512 + tid; i < 112 * DINP * 2 / 16; i += G * 512) ((GAS v4u*)PM16)[i] = (v4u){0u, 0u, 0u, 0u};
        {
            __syncthreads();
            LAS float* un = (LAS float*)(lds + RING_OFF);
            LAS float* red = (LAS float*)(lds + RING_OFF + 16 * 1025 * 4);
#pragma unroll
            for (int rr = 0; rr < 2; ++rr) { const int r = 2 * wave + rr; const GAS f32x4* xr = (const GAS f32x4*)(meta + (size_t)r * D) + lane; const GAS f32x4* wr = (const GAS f32x4*)norm1_w + lane;
                f32x4 v[4]; float s = 0.f;
#pragma unroll
                for (int j = 0; j < 4; ++j) { v[j] = xr[64 * j]; s += (v[j].x * v[j].x + v[j].y * v[j].y) + (v[j].z * v[j].z + v[j].w * v[j].w); }
                const float ri = 1.f / sqrtf(wave_sum(s) * (1.f / D) + EPS);
#pragma unroll
                for (int j = 0; j < 4; ++j) { const f32x4 g = wr[64 * j]; const int k = 4 * lane + 256 * j;
                    un[r * 1025 + k] = v[j].x * ri * g.x; un[r * 1025 + k + 1] = v[j].y * ri * g.y; un[r * 1025 + k + 2] = v[j].z * ri * g.z; un[r * 1025 + k + 3] = v[j].w * ri * g.w; } }
            __syncthreads();
            const int c0 = 13 * vcu; float acc[13];
#pragma unroll
            for (int cc = 0; cc < 13; ++cc) acc[cc] = 0.f;
            for (int i = 0; i < 32; ++i) { const int k = 128 * wave + (lane >> 4) + 4 * i; const float uv = un[(lane & 15) * 1025 + k]; const float* wp = w_in + (size_t)k * DIN + c0;
#pragma unroll
                for (int cc = 0; cc < 13; ++cc) { const float wv = (c0 + cc < DIN) ? wp[cc] : 0.f; acc[cc] = fmaf(uv, wv, acc[cc]); } }
#pragma unroll
            for (int cc = 0; cc < 13; ++cc) { acc[cc] += __shfl_xor(acc[cc], 16); acc[cc] += __shfl_xor(acc[cc], 32); if (lane < 16) red[(wave * 16 + lane) * 13 + cc] = acc[cc]; }
            __syncthreads();
            if (tid < 208) { const int r = tid / 13, cc = tid % 13; float s = 0.f;
#pragma unroll
                for (int w8 = 0; w8 < 8; ++w8) s += red[(w8 * 16 + r) * 13 + cc];
                const int c = c0 + cc; if (c >= DIN) s = 0.f;
                PMETA[r * DINP + c] = s; PM16[(size_t)(112 + r) * DINP + c] = (bf16)f2bf(s); }
            __syncthreads();
        }
        if (BOTH(0)) GRID_BAR();
    }
    if (IN(1)) {
        pg8::Gemm g{U, WIN_T, M, DINP, D}; pg8::StaticOrder S; S.init(M, DINP, G, (int)blockIdx.x);
        pg8::EpiProj E{PROJ, DP2, RET, M};
        pg8::gemm_phase<pg8::EpiProj, pg8::StaticOrder, true, true>(lds + RING_OFF, g, S, E);
        if (BOTH(1)) GRID_BAR();
    }
    if (IN(2)) {
        {
            LAS unsigned char* vscr = lds + RING_OFF + 65536 + wave * 1024;
            const int r = lane >> 3, sub = lane & 7;
            const f32x4 kg0 = *(const GAS f32x4*)(k_norm_w + 8 * sub), kg1 = *(const GAS f32x4*)(k_norm_w + 8 * sub + 4);
            for (int unit = gw; unit < BATCH * 520; unit += NGW) {
                const int b = unit / 520, gidx = unit % 520; const bool isx = gidx >= 2 && gidx < 514, ismeta = gidx < 2;
                const bf16* src = ismeta ? PM16 + (size_t)(112 + 8 * gidx + r) * DINP + 2048 : PROJ + ((size_t)b * SEQ + (isx ? 8 * (gidx - 2) + r : 0)) * DP2;
                const size_t krow = ((size_t)b * KROWS + 8 * gidx + r) * 64 + 8 * sub;
                v4u kv = (v4u){0u, 0u, 0u, 0u}, iv = kv, vv = kv;
                if (isx || ismeta) { kv = *(const GAS v4u*)(src + C2_DK + 8 * sub); iv = *(const GAS v4u*)(src + C2_IK + 8 * sub); vv = *(const GAS v4u*)(src + C2_DV + 8 * sub); }
                float xk[8]; float sk = 0.f;
#pragma unroll
                for (int i = 0; i < 4; ++i) { xk[2 * i] = __uint_as_float(kv[i] << 16); xk[2 * i + 1] = __uint_as_float(kv[i] & 0xffff0000u); sk += xk[2 * i] * xk[2 * i] + xk[2 * i + 1] * xk[2 * i + 1]; }
                sk += __shfl_xor(sk, 1); sk += __shfl_xor(sk, 2); sk += __shfl_xor(sk, 4);
                const float sck = 1.f / sqrtf(sk * (1.f / 64.f) + EPS);
                *(GAS v4u*)(KC + krow) = (v4u){pkbf(xk[0] * sck * kg0[0], xk[1] * sck * kg0[1]), pkbf(xk[2] * sck * kg0[2], xk[3] * sck * kg0[3]), pkbf(xk[4] * sck * kg1[0], xk[5] * sck * kg1[1]), pkbf(xk[6] * sck * kg1[2], xk[7] * sck * kg1[3])};
                *(GAS v4u*)(IKC + krow) = iv;
                *(GAS v4u*)(VC + krow) = vv;
                *(LAS v4u*)(vscr + lane * 16) = vv;
                LDS_WAIT(); asm volatile("" ::: "memory");
                { const LAS unsigned short* vs = (const LAS unsigned short*)vscr + lane; v4u o;
#pragma unroll
                  for (int i = 0; i < 4; ++i) o[i] = (unsigned)vs[(2 * i) * 64] | ((unsigned)vs[(2 * i + 1) * 64] << 16);
                  *(GAS v4u*)(VT + ((size_t)b * 64 + lane) * KROWS + 8 * gidx) = o; }
                LDS_WAIT(); asm volatile("" ::: "memory");
            }
            __syncthreads();
        }
        if (vcu < 256) {
            const int b = vcu >> 4, h = (vcu >> 2) & 3, dq = vcu & 3;
            const float lg2 = log2f(1.f - exp2f(-5.f - (float)h));
            const float cdec = exp2f(lg2 * 128.f);
            LAS unsigned char* Kimg = lds + 3 * 40960;
            f32x4 acc[2]; acc[0] = (f32x4){0.f, 0.f, 0.f, 0.f}; acc[1] = acc[0];
            f32x4 rc[4], rc1[4], rstep[4];
            { const int c = (tid >> 1) & 127, jh = tid & 1; int t0 = c - 112; t0 = t0 < 0 ? 0 : t0; const int t1 = 16 + c;
              const GAS f32x4* r0 = (const GAS f32x4*)(ROPE + ((size_t)t0 * 64 + 16 * dq + 8 * jh) * 2); const GAS f32x4* r1 = (const GAS f32x4*)(ROPE + ((size_t)t1 * 64 + 16 * dq + 8 * jh) * 2);
              const GAS f32x4* rs = (const GAS f32x4*)(ROPE + ((size_t)128 * 64 + 16 * dq + 8 * jh) * 2);
#pragma unroll
              for (int i = 0; i < 4; ++i) { rc[i] = r0[i]; rc1[i] = r1[i]; rstep[i] = rs[i]; } }
            const float ksc0 = RET_KSCALE * exp2f(lg2 * (float)(127 - ((tid >> 1) & 127)));
#define R12_DMA(n, slot) do { const bool m0_ = (n) == 0; const size_t rs_ = m0_ ? (size_t)DINP : (size_t)128;     \
                const bf16* kb_ = m0_ ? PM16 + C_RK + 128 * h : RET + ((size_t)(4 + h) * M + (size_t)b * SEQ + 128 * ((n) - 1)) * 128; const bf16* vb_ = m0_ ? PM16 + C_RV + 128 * h : RET + ((size_t)(8 + h) * M + (size_t)b * SEQ + 128 * ((n) - 1)) * 128; \
                _Pragma("unroll") for (int i = 0; i < 4; ++i) __builtin_amdgcn_global_load_lds((const unsigned*)(vb_ + (size_t)(16 * wave + 4 * i + (lane >> 4)) * rs_ + 8 * ((lane & 15) ^ (2 * (lane >> 4)))), (LAS unsigned*)(lds + (slot) * 40960 + (4 * wave + i) * 1024), 16, 0, 0); \
                __builtin_amdgcn_global_load_lds((const unsigned*)(kb_ + (size_t)(16 * wave + (lane >> 2)) * rs_ + 64 * ((lane >> 1) & 1) + 16 * dq + 8 * (lane & 1)), (LAS unsigned*)(lds + (slot) * 40960 + 32768 + wave * 1024), 16, 0, 0); } while (0)
            R12_DMA(0, 0); R12_DMA(1, 1); R12_DMA(2, 2);
            asm volatile("s_waitcnt vmcnt(0)" ::: "memory"); __syncthreads();
            const unsigned kimg_a0 = DSA_LDS_ADDR(Kimg + ((tid >> 1) & 127) * 64 + 16 * (tid & 1));
            const unsigned trk_a = DSA_LDS_ADDR(Kimg + (8 * (lane >> 4) + ((lane >> 2) & 3)) * 64 + 8 * (lane & 3));
            const unsigned trv_off = (unsigned)((8 * (lane >> 4) + ((lane >> 2) & 3)) * 256 + 16 * ((2 * wave + ((lane & 3) >> 1)) ^ (2 * ((lane >> 2) & 3))) + 8 * (lane & 1));
#pragma unroll 1
            for (int n = 0; n < 32; ++n) {
                const LAS unsigned char* slot = lds + (n % 3) * 40960;
                const unsigned slot_a = DSA_LDS_ADDR(slot);
                if (tid < 256) {
                    if (n == 1) {
#pragma unroll
                        for (int i = 0; i < 4; ++i) rc[i] = rc1[i]; }
                    else if (n > 1) {
#pragma unroll
                        for (int i = 0; i < 4; ++i) { const f32x4 a = rc[i], st = rstep[i];
                            rc[i] = (f32x4){a[0] * st[0] - a[1] * st[1], a[1] * st[0] + a[0] * st[1], a[2] * st[2] - a[3] * st[3], a[3] * st[2] + a[2] * st[3]}; } }
                    const LAS unsigned char* rp = slot + 32768 + (tid >> 1) * 64 + 16 * (tid & 1); v4u o1, o2;
                    rot8(*(const LAS v4u*)rp, *(const LAS v4u*)(rp + 32), rc, ksc0, o1, o2);
                    asm volatile("ds_write_b128 %0, %1\n\tds_write_b128 %0, %2 offset:32" :: "v"(kimg_a0), "v"(o1), "v"(o2) : "memory"); }
                asm volatile("s_waitcnt lgkmcnt(0)\n\ts_barrier" ::: "memory");
                acc[0] = acc[0] * cdec; acc[1] = acc[1] * cdec;
                { const unsigned va_ = slot_a + trv_off;
#pragma unroll
                  for (int kp = 0; kp < 2; ++kp) { u32x2v t[12];
                      if (kp == 0) asm volatile(TR_RD "%0, %12\n\t" TR_RD "%1, %12 offset:256\n\t" TR_RD "%2, %12 offset:32\n\t" TR_RD "%3, %12 offset:288\n\t" TR_RD "%4, %13\n\t" TR_RD "%5, %13 offset:1024\n\t"
                                                TR_RD "%6, %12 offset:2048\n\t" TR_RD "%7, %12 offset:2304\n\t" TR_RD "%8, %12 offset:2080\n\t" TR_RD "%9, %12 offset:2336\n\t" TR_RD "%10, %13 offset:8192\n\t" TR_RD "%11, %13 offset:9216\n\ts_waitcnt lgkmcnt(0)"
                                                : "=&v"(t[0]), "=&v"(t[1]), "=&v"(t[2]), "=&v"(t[3]), "=&v"(t[4]), "=&v"(t[5]), "=&v"(t[6]), "=&v"(t[7]), "=&v"(t[8]), "=&v"(t[9]), "=&v"(t[10]), "=&v"(t[11]) : "v"(trk_a), "v"(va_) : "memory");
                      else asm volatile(TR_RD "%0, %12 offset:4096\n\t" TR_RD "%1, %12 offset:4352\n\t" TR_RD "%2, %12 offset:4128\n\t" TR_RD "%3, %12 offset:4384\n\t" TR_RD "%4, %13 offset:16384\n\t" TR_RD "%5, %13 offset:17408\n\t"
                                        TR_RD "%6, %12 offset:6144\n\t" TR_RD "%7, %12 offset:6400\n\t" TR_RD "%8, %12 offset:6176\n\t" TR_RD "%9, %12 offset:6432\n\t" TR_RD "%10, %13 offset:24576\n\t" TR_RD "%11, %13 offset:25600\n\ts_waitcnt lgkmcnt(0)"
                                        : "=&v"(t[0]), "=&v"(t[1]), "=&v"(t[2]), "=&v"(t[3]), "=&v"(t[4]), "=&v"(t[5]), "=&v"(t[6]), "=&v"(t[7]), "=&v"(t[8]), "=&v"(t[9]), "=&v"(t[10]), "=&v"(t[11]) : "v"(trk_a), "v"(va_) : "memory");
#pragma unroll
                      for (int kk = 0; kk < 2; ++kk) { const bf16x8 a0 = tr_pack(t[6 * kk], t[6 * kk + 1]), a1 = tr_pack(t[6 * kk + 2], t[6 * kk + 3]), bv = tr_pack(t[6 * kk + 4], t[6 * kk + 5]);
                          acc[0] = MFMA16(a0, bv, acc[0]); acc[1] = MFMA16(a1, bv, acc[1]); } } }
                bf16* sp = SPT + ((size_t)((b * 4 + h) * 32 + n)) * 16384;
#pragma unroll
                for (int dt = 0; dt < 2; ++dt) { const int e = 16 * wave + (lane & 15), d = 64 * dt + 16 * dq + 4 * (lane >> 4);
                    *(GAS u32x2v*)(sp + e * 128 + d) = (u32x2v){pkbf(acc[dt][0], acc[dt][1]), pkbf(acc[dt][2], acc[dt][3])}; }
                asm volatile("s_waitcnt vmcnt(9) lgkmcnt(0)\n\ts_barrier" ::: "memory");
                { const int nn = n + 3 < 32 ? n + 3 : 31; R12_DMA(nn, n % 3); }
            }
            asm volatile("s_waitcnt vmcnt(0)" ::: "memory"); __syncthreads();
#undef R12_DMA
        }
        if (BOTH(2)) GRID_BAR();
    }
    if (IN(3)) {
        {
            for (int i = tid; i < 8 * 144; i += 512) { const int h = i / 144, d = i % 144 - 8; float v = 0.f;
                if (d >= 0 && d < 113) { int bk = d; if (d >= 16) { bk = 16 + (int)(logf((float)d * (1.f / 16.f)) / logf(8.f) * 16.f); bk = bk > 31 ? 31 : bk; } v = (rel_bias[bk * 8 + h] - rel_bias[31 * 8 + h]) * LOG2E; }
                ((LAS float*)(lds + L_BIAS))[i] = v; }
            __syncthreads();
            LAS unsigned* HIST = (LAS unsigned*)(lds + L_HIST); LAS unsigned* MASK = (LAS unsigned*)(lds + L_MASK); LAS unsigned* QPAR = (LAS unsigned*)(lds + L_QPAR);
            LAS unsigned* CCNT = (LAS unsigned*)(lds + L_CCNT); const LAS float* BIAS = (const LAS float*)(lds + L_BIAS);
            LAS unsigned char* STG = lds + L_STAGE;
            LAS unsigned char* STG3 = lds + L_HIST;
            const int ql = lane & 15, g4 = lane >> 4;
            const int dk_row = 32 * (wave >> 2) + 8 * (ql >> 2) + 4 * ((wave >> 1) & 1) + (ql & 3), dk_col = 32 * (wave & 1) + 8 * g4;
            const int dv_row = 16 * (wave & 3) + ql, dv_col = 32 * (wave >> 2) + 8 * g4;
            const int xq = vcu >> 5;
            for (;;) {
                if (vcu >= 256) break;
                if (tid == 0) MISC[4] = __hip_atomic_fetch_add(ctl + 2048 + 64 * xq, 1u, __ATOMIC_RELAXED, __HIP_MEMORY_SCOPE_AGENT);
                __syncthreads();
                const int uq = (int)MISC[4];
                __syncthreads();
                if (uq >= 64) break;
                const int b = 2 * xq + (uq >> 5), j = 31 - (uq & 31);
                const int nt = 5 + 4 * j, ns = (nt + 1) >> 1;
                const int qloc = 16 * wave + ql;
                const size_t mrow = (size_t)b * SEQ + 128 * j + qloc;
                const int p = 16 + 128 * j + qloc;
                const int pmaxw = 16 + 128 * j + 16 * wave + 15;
                const bf16* ikb = IKC + (size_t)b * KROWS * 64; const bf16* kcb = KC + (size_t)b * KROWS * 64; const bf16* vtb = VT + (size_t)b * 64 * KROWS; const bf16* vcb = VC + (size_t)b * KROWS * 64;
                unsigned char* tqb = (b < 15 ? (unsigned char*)out + (size_t)b * (17u << 20) : ws + WS_QN) + (size_t)(j * j + 2 * j) * 16384 + wave * 1024 + lane * 16;
                LAS unsigned* hrow = HIST + qloc * 128;
                bf16x8 iq[8][2], cq[2]; float wh[8];
                { const bf16* rp = PROJ + mrow * DP2 + C2_IQ + 8 * g4;
#pragma unroll
                  for (int h = 0; h < 8; ++h) { iq[h][0] = *(const GAS bf16x8*)(rp + 64 * h); iq[h][1] = *(const GAS bf16x8*)(rp + 64 * h + 32); }
                  const v4u wv = *(const GAS v4u*)(PROJ + mrow * DP2 + C2_IW);
#pragma unroll
                  for (int i = 0; i < 4; ++i) { wh[2 * i] = __uint_as_float(wv[i] << 16) * (0.5f * 0.35355339059327373f * 0.125f); wh[2 * i + 1] = __uint_as_float(wv[i] & 0xffff0000u) * (0.5f * 0.35355339059327373f * 0.125f); }
#pragma unroll
                  for (int sx = 0; sx < 2; ++sx) { float ca[8];
#pragma unroll
                      for (int e = 0; e < 8; ++e) ca[e] = 0.f;
#pragma unroll
                      for (int h = 0; h < 8; ++h) { const v4u qv = __builtin_bit_cast(v4u, iq[h][sx]);
#pragma unroll
                          for (int e = 0; e < 4; ++e) { ca[2 * e] = __builtin_fmaf(wh[h], __uint_as_float(qv[e] << 16), ca[2 * e]); ca[2 * e + 1] = __builtin_fmaf(wh[h], __uint_as_float(qv[e] & 0xffff0000u), ca[2 * e + 1]); } }
                      const v4u cw = (v4u){pkbf(ca[0], ca[1]), pkbf(ca[2], ca[3]), pkbf(ca[4], ca[5]), pkbf(ca[6], ca[7])}; cq[sx] = __builtin_bit_cast(bf16x8, cw); } }
                float lo, invw, binc;
                { float s1 = 0.f, s2 = 0.f;
                  int lane_p0 = lane; DSA_OPAQUE(lane_p0);
                  for (int kt = 0; kt < 2; ++kt) { f32x4 sc[2]; idx_tile(ikb, kt, iq, cq, wh, lane_p0, sc);
#pragma unroll
                      for (int u = 0; u < 2; ++u)
#pragma unroll
                          for (int r = 0; r < 4; ++r) { s1 += sc[u][r]; s2 += sc[u][r] * sc[u][r]; } }
                  s1 = rows_sum(s1); s2 = rows_sum(s2);
                  const float mean = s1 * (1.f / 64.f); float var = s2 * (1.f / 64.f) - mean * mean; var = var > 1e-30f ? var : 1e-30f;
                  const float sd = sqrtf(var); lo = mean - 3.f * sd; invw = 256.f * (float)DSA_NB / (6.f * sd); binc = -lo * invw; }
                { LAS v4u* hz = (LAS v4u*)(HIST + 16 * wave * 128);
#pragma unroll
                  for (int i = 0; i < 8; ++i) hz[lane + 64 * i] = (v4u){0u, 0u, 0u, 0u}; }
                __syncthreads();
                DSA_DMA_K(ikb, 0, DSA_PB1(0)); DSA_DMA_K(ikb, ns > 1 ? 1 : ns - 1, DSA_PB1(1)); DSA_DMA_K(ikb, ns > 2 ? 2 : ns - 1, DSA_PB1(2));
                DSA_WAITBAR(2);
                { const unsigned hbase = DSA_LDS_ADDR(hrow); unsigned one_v = 1u; DSA_OPAQUE(one_v);
                for (int step = 0; step < ns; ++step) {
                    { const int sn = step + 3 < ns ? step + 3 : ns - 1; DSA_DMA_K(ikb, sn, DSA_PB1(step + 3)); }
                    const LAS unsigned char* tb = DSA_PB1(step);
#pragma unroll 1
                    for (int tt = 0; tt < 2; ++tt) { const int kt = 2 * step + tt; unsigned tqv[4], tqp[4]; if (32 * kt > pmaxw) continue;
                        if (32 * kt + 31 <= pmaxw - 15) {
#pragma unroll
                        for (int u = 0; u < 2; ++u) { const f32x4 scu = idx_sub_lds2(tb + tt * 4096, u, iq, cq, wh, lane);
#pragma unroll
                            for (int r = 0; r < 4; ++r) {
                                const unsigned tq = (unsigned)(int)__builtin_amdgcn_fmed3f(bin_t(scu[r], binc, invw), 0.f, 32767.f);
                                asm volatile("ds_add_u32 %0, %1" :: "v"(hbase | ((tq >> 6) & 0x1fcu)), "v"(one_v) : "memory");
                                tqv[r] = tq; }
                            tqp[2 * u] = tqv[0] | (tqv[1] << 16); tqp[2 * u + 1] = tqv[2] | (tqv[3] << 16);
                            __builtin_amdgcn_sched_barrier(0); }
                        *(GAS v4u*)(tqb + (size_t)kt * 8192) = (v4u){tqp[0], tqp[1], tqp[2], tqp[3]};
                        } else {
#pragma unroll
                        for (int u = 0; u < 2; ++u) { const f32x4 scu = idx_sub_lds2(tb + tt * 4096, u, iq, cq, wh, lane);
#pragma unroll
                            for (int r = 0; r < 4; ++r) { const int kk = 32 * kt + 8 * g4 + 4 * u + r; const bool causal = kk <= p;
                                const unsigned tq = (unsigned)(int)__builtin_amdgcn_fmed3f(bin_t(scu[r], binc, invw), 0.f, 32767.f);
                                asm volatile("ds_add_u32 %0, %1" :: "v"(hbase | ((tq >> 6) & 0x1fcu)), "v"(causal ? 1u : 0u) : "memory");
                                tqv[r] = causal ? tq : 0xffffu; }
                            tqp[2 * u] = tqv[0] | (tqv[1] << 16); tqp[2 * u + 1] = tqv[2] | (tqv[3] << 16);
                            __builtin_amdgcn_sched_barrier(0); }
                        *(GAS v4u*)(tqb + (size_t)kt * 8192) = (v4u){tqp[0], tqp[1], tqp[2], tqp[3]}; } }
                    DSA_WAITBAR(2);
                } }
#pragma unroll 1
                for (int qq = 0; qq < 16; ++qq) { const int q = 16 * wave + qq; const int pq = 16 + 128 * j + q; const int kq = pq + 1 < 256 ? pq + 1 : 256;
                    const u32x2v wv = *(const LAS u32x2v*)(HIST + q * 128 + 2 * lane);
                    const int c0 = (int)wv[0], c1 = (int)wv[1]; const int sl = c0 + c1;
                    int pre = sl;
                    pre += __builtin_amdgcn_update_dpp(0, pre, 0x111, 0xf, 0xf, true); pre += __builtin_amdgcn_update_dpp(0, pre, 0x112, 0xf, 0xf, true);
                    pre += __builtin_amdgcn_update_dpp(0, pre, 0x114, 0xf, 0xf, true); pre += __builtin_amdgcn_update_dpp(0, pre, 0x118, 0xf, 0xf, true);
                    pre += __builtin_amdgcn_update_dpp(0, pre, 0x142, 0xa, 0xf, false); pre += __builtin_amdgcn_update_dpp(0, pre, 0x143, 0xc, 0xf, false);
                    int cum = __builtin_amdgcn_readlane(pre, 63) - pre; int bst = -1, ngt = 0;
                    if (cum < kq && cum + c1 >= kq) { bst = 2 * lane + 1; ngt = cum; } cum += c1;
                    if (cum < kq && cum + c0 >= kq) { bst = 2 * lane + 0; ngt = cum; }
                    if (bst >= 0) { QPAR[q * 4 + 0] = (unsigned)bst; QPAR[q * 4 + 1] = (unsigned)(kq - ngt); } }
                LDS_WAIT(); asm volatile("" ::: "memory");
                const int bstar = (int)QPAR[qloc * 4 + 0];
                int ccnt = 0;
                const unsigned cbase = DSA_LDS_ADDR(lds + L_HIST + qloc * 256), mbase = DSA_LDS_ADDR(MASK + qloc * DSA_MSTR);
                const int thi16 = (bstar + 1) << 8;
                __syncthreads();
                { v4u tw[4];
#pragma unroll
                  for (int i = 0; i < 4; ++i) tw[i] = *(const GAS v4u*)(tqb + (size_t)(i < 2 * ns ? i : 0) * 8192);
                  for (int kt0 = 0; kt0 < 2 * ns; kt0 += 4) {
#pragma unroll
                    for (int i = 0; i < 4; ++i) { const int kt = kt0 + i; if (kt < 2 * ns && 32 * kt <= pmaxw) {
                        const v4u cw = tw[i]; { const int kn = kt + 4 < 2 * ns ? kt + 4 : kt; tw[i] = *(const GAS v4u*)(tqb + (size_t)kn * 8192); }
                        unsigned bits = 0u;
#pragma unroll
                        for (int e = 0; e < 8; ++e) { const unsigned tq = (e & 1) ? cw[e >> 1] >> 16 : cw[e >> 1] & 0xffffu; const int kk = 32 * kt + 8 * g4 + e;
                            bits |= (int)(short)tq >= thi16 ? 1u << (8 * g4 + e) : 0u;
                            const bool cand = (int)(tq >> 8) == bstar; const unsigned long long m = __ballot(cand);
                            if (m) {
                                const unsigned long long mq = (m >> ql) & 0x0001000100010001ull;
                                const int rank = __popcll(mq & ((1ull << (16 * g4)) - 1ull)), tot = __popcll(mq);
                                if (cand) { const int slot = ccnt + rank; if (slot < DSA_CAP) asm volatile("ds_write_b32 %0, %1" :: "v"(cbase + 4u * (unsigned)slot), "v"((tq << 16) | (0xffffu - (unsigned)kk)) : "memory"); }
                                ccnt += tot; } }
                        bits = rows_or(bits);
                        if (g4 == 0) asm volatile("ds_write_b32 %0, %1" :: "v"(mbase + 4u * (unsigned)kt), "v"(bits) : "memory"); } }
                  } }
                if (g4 == 0) CCNT[qloc] = (unsigned)ccnt;
                LDS_WAIT(); asm volatile("" ::: "memory");
#pragma unroll 1
                for (int qq = 0; qq < 16; ++qq) { const int q = 16 * wave + qq;
                    int cnt = (int)CCNT[q]; cnt = cnt < DSA_CAP ? cnt : DSA_CAP; cnt = __builtin_amdgcn_readfirstlane(cnt);
                    const int need = (int)QPAR[q * 4 + 1];
                    const LAS unsigned* cc_ = (const LAS unsigned*)(lds + L_HIST + q * 256);
                    const unsigned cme = lane < cnt ? cc_[lane] : 0u; const unsigned kme = 0xffffu - (cme & 0xffffu); int rank = 0;
                    for (int t = 0; t < cnt; ++t) rank += (unsigned)__builtin_amdgcn_readlane((int)cme, t) > cme ? 1 : 0;
                    if (lane < cnt && rank < need) __hip_atomic_fetch_or(MASK + q * DSA_MSTR + (kme >> 5), 1u << (kme & 31u), __ATOMIC_RELAXED, __HIP_MEMORY_SCOPE_WORKGROUP); }
                if (j >= 17) {
                    unsigned short* lstg = LISTG + ((size_t)((b * 32 + j) * 128 + 16 * wave)) * 256;
                    if (lane < 16) QPAR[(16 * wave + lane) * 4 + 2] = 0u;
#pragma unroll 1
                    for (int qq = 0; qq < 16; ++qq) { const int q = 16 * wave + qq; const int pq = 16 + 128 * j + q;
#pragma unroll 1
                        for (int rr = 0; rr < 3; ++rr) { const int kt = 64 * rr + lane;
                            unsigned w = (kt <= (pq >> 5)) ? MASK[q * DSA_MSTR + (kt < DSA_MSTR ? kt : 0)] : 0u;
                            const int cw = __popc(w);
                            int pos = cw ? (int)__hip_atomic_fetch_add(QPAR + q * 4 + 2, (unsigned)cw, __ATOMIC_RELAXED, __HIP_MEMORY_SCOPE_WORKGROUP) : 0;
                            while (w) { const int bpos = __builtin_ctz(w); w &= w - 1u; if (pos < 256) lstg[qq * 256 + pos] = (unsigned short)(32 * kt + bpos); ++pos; } } }
                    asm volatile("s_waitcnt vmcnt(0)" ::: "memory");
                    __syncthreads();
                    { int mrow_s = (int)((size_t)b * SEQ + 128 * j + 16 * wave); asm volatile("" : "+s"(mrow_s));
                      dsa_gather(lds + wave * 16384, lds + L_STAGE + wave * 1024, BIAS, kcb, vcb, lstg, QPAR + 16 * wave * 4 + 2, PROJ + (size_t)mrow_s * DP2 + C2_DQ, q_norm_w, Y + (size_t)mrow_s * D + 512, 16 + 128 * j + 16 * wave, lane); }
                    __syncthreads();
                } else {
                    __syncthreads();
                    int mrow_s = (int)mrow; asm volatile("" : "+v"(mrow_s));
                    dsa_sweep<4>(lds, 0, kcb, vtb, PROJ + (size_t)mrow_s * DP2 + C2_DQ, q_norm_w, Y + (size_t)mrow_s * D + 512, ns, p, 16 + 128 * j + 16 * wave, qloc, wave, lane);
                    dsa_sweep<4>(lds, 4, kcb, vtb, PROJ + (size_t)mrow_s * DP2 + C2_DQ, q_norm_w, Y + (size_t)mrow_s * D + 512, ns, p, 16 + 128 * j + 16 * wave, qloc, wave, lane);
                }
            }
            __syncthreads();
        }
        {
            LAS unsigned char* Kimg = lds + RING_OFF; LAS unsigned char* Vimg = Kimg + 128 * IMG_STRIDE; LAS unsigned char* Simg = Vimg + 128 * IMG_STRIDE;
            const int cq = 16 * wave + (lane & 15), g4 = lane >> 4;
            v4u pk[2][2], pv[4], ps[4], pq[4];
#define R3_GRAB(dst) do { if (tid == 0) MISC[5] = __hip_atomic_fetch_add(ctl + 2048 + 64 * 16, 1u, __ATOMIC_RELAXED, __HIP_MEMORY_SCOPE_AGENT); __syncthreads(); dst = (int)MISC[5]; __syncthreads(); } while (0)
#define R3_LOAD(U_) do { const int b_ = (U_) >> 7, h_ = ((U_) >> 5) & 3, n_ = ((U_) & 31) + 1; const size_t r0_ = (size_t)b_ * SEQ + 128 * (n_ - 1); \
                _Pragma("unroll") for (int i_ = 0; i_ < 2; ++i_) { const int item = tid + 512 * i_, c = item >> 3, j = item & 7; const bf16* rp = RET + ((size_t)(4 + h_) * M + r0_ + c) * 128 + 8 * j; pk[i_][0] = *(const GAS v4u*)rp; pk[i_][1] = *(const GAS v4u*)(rp + 64); } \
                const bf16* sp_ = SPT + ((size_t)((b_ * 4 + h_) * 32 + (n_ - 1))) * 16384; \
                _Pragma("unroll") for (int i_ = 0; i_ < 4; ++i_) { const int item = tid + 512 * i_, c = item >> 4, part = item & 15; pv[i_] = *(const GAS v4u*)(RET + ((size_t)(8 + h_) * M + r0_ + c) * 128 + 8 * part); ps[i_] = *(const GAS v4u*)(sp_ + c * 128 + 8 * part); } \
                { const bf16* rp = RET + ((size_t)h_ * M + r0_ + cq) * 128 + 8 * g4; pq[0] = *(const GAS v4u*)rp; pq[1] = *(const GAS v4u*)(rp + 32); pq[2] = *(const GAS v4u*)(rp + 64); pq[3] = *(const GAS v4u*)(rp + 96); } } while (0)
            int unit; R3_GRAB(unit);
            if (unit < BATCH * 4 * 32) R3_LOAD(unit);
            for (;;) {
                if (unit >= BATCH * 4 * 32) break;
                int unit_nx; R3_GRAB(unit_nx);
                const int b = unit >> 7, h = (unit >> 5) & 3, n = (unit & 31) + 1;
                const float lg2 = log2f(1.f - exp2f(-5.f - (float)h));
                const size_t row0 = (size_t)b * SEQ + 128 * (n - 1);
#pragma unroll
                for (int i_ = 0; i_ < 2; ++i_) { const int item = tid + 512 * i_, c = item >> 3, j = item & 7;
                    const int t = 128 * n - 112 + c; const GAS f32x4* rq = (const GAS f32x4*)(ROPE + ((size_t)t * 64 + 8 * j) * 2); f32x4 cs[4]; cs[0] = rq[0]; cs[1] = rq[1]; cs[2] = rq[2]; cs[3] = rq[3];
                    v4u o1, o2; rot8(pk[i_][0], pk[i_][1], cs, RET_KSCALE, o1, o2);
                    *(LAS v4u*)(Kimg + c * IMG_STRIDE + 16 * j) = o1; *(LAS v4u*)(Kimg + c * IMG_STRIDE + 128 + 16 * j) = o2; }
#pragma unroll
                for (int i_ = 0; i_ < 4; ++i_) { const int item = tid + 512 * i_, c = item >> 4, part = item & 15;
                    *(LAS v4u*)(Vimg + c * IMG_STRIDE + 16 * part) = pv[i_];
                    *(LAS v4u*)(Simg + c * IMG_STRIDE + 16 * part) = ps[i_]; }
                bf16x8 qf[4];
                { const int t = 128 * n - 112 + cq;
                  const GAS f32x4* ra = (const GAS f32x4*)(ROPE + ((size_t)t * 64 + 8 * g4) * 2); f32x4 c0[4], c1[4];
#pragma unroll
                  for (int i_ = 0; i_ < 4; ++i_) { c0[i_] = ra[i_]; c1[i_] = ra[16 + i_]; }
                  v4u o0, o1, o2, o3; rot8(pq[0], pq[2], c0, 1.f, o0, o2); rot8(pq[1], pq[3], c1, 1.f, o1, o3);
                  qf[0] = __builtin_bit_cast(bf16x8, o0); qf[1] = __builtin_bit_cast(bf16x8, o1); qf[2] = __builtin_bit_cast(bf16x8, o2); qf[3] = __builtin_bit_cast(bf16x8, o3); }
                __syncthreads();
                if (unit_nx < BATCH * 4 * 32) R3_LOAD(unit_nx);
                u32x2v gpre[8];
                { const bf16* gp0 = RET + ((size_t)(12 + h) * M + row0 + cq) * 128 + 4 * g4;
#pragma unroll
                  for (int et = 0; et < 8; ++et) gpre[et] = *(const GAS u32x2v*)(gp0 + 16 * et); }
                f32x4 oin[8], ocr[8];
#pragma unroll
                for (int et = 0; et < 8; ++et) { oin[et] = (f32x4){0.f, 0.f, 0.f, 0.f}; ocr[et] = oin[et]; }
#pragma unroll
                for (int et = 0; et < 8; ++et)
#pragma unroll
                    for (int ks = 0; ks < 4; ++ks) ocr[et] = MFMA16(frag_n(Simg, IMG_STRIDE, 16 * et + (lane & 15), 32 * ks, lane), qf[ks], ocr[et]);
                const int kgmax = wave >> 1;
                for (int kg = 0; kg <= kgmax; ++kg) {
                    f32x4 st[2];
#pragma unroll
                    for (int u = 0; u < 2; ++u) { st[u] = (f32x4){0.f, 0.f, 0.f, 0.f};
                        const int mrow = 32 * kg + 8 * ((lane & 15) >> 2) + 4 * u + (lane & 3);
#pragma unroll
                        for (int ks = 0; ks < 4; ++ks) st[u] = MFMA16(frag_n(Kimg, IMG_STRIDE, mrow, 32 * ks, lane), qf[ks], st[u]); }
                    float pv[8];
#pragma unroll
                    for (int u = 0; u < 2; ++u)
#pragma unroll
                        for (int r = 0; r < 4; ++r) { const int m = 32 * kg + 8 * g4 + 4 * u + r; const int dd = cq - m; pv[4 * u + r] = dd >= 0 ? st[u][r] * exp2f(lg2 * (float)dd) : 0.f; }
                    const v4u pw = (v4u){pkbf(pv[0], pv[1]), pkbf(pv[2], pv[3]), pkbf(pv[4], pv[5]), pkbf(pv[6], pv[7])};
                    const bf16x8 pf = __builtin_bit_cast(bf16x8, pw);
#pragma unroll
                    for (int et = 0; et < 8; ++et) oin[et] = MFMA16(frag_t(Vimg, IMG_STRIDE, 16 * et, 32 * kg, lane), pf, oin[et]);
                }
                const float xi = exp2f(lg2 * (float)(cq + 1)); float ss = 0.f;
#pragma unroll
                for (int et = 0; et < 8; ++et) { oin[et] = oin[et] + ocr[et] * xi; ss += (oin[et][0] * oin[et][0] + oin[et][1] * oin[et][1]) + (oin[et][2] * oin[et][2] + oin[et][3] * oin[et][3]); }
                ss = rows_sum(ss);
                const float rinv = 1.f / sqrtf(ss * (1.f / 128.f) + EPS);
                bf16* yp = Y + (row0 + cq) * D + 128 * h + 4 * g4; const float* wn = ret_norm_w + 128 * h + 4 * g4;
#pragma unroll
                for (int et = 0; et < 8; ++et) { const u32x2v gw2 = gpre[et]; const f32x4 gn = *(const GAS f32x4*)(wn + 16 * et);
                    float gt[4] = {__uint_as_float(gw2[0] << 16), __uint_as_float(gw2[0] & 0xffff0000u), __uint_as_float(gw2[1] << 16), __uint_as_float(gw2[1] & 0xffff0000u)}; float o[4];
#pragma unroll
                    for (int r = 0; r < 4; ++r) { const float sg = gt[r] / (1.f + __expf(-gt[r])); o[r] = oin[et][r] * rinv * gn[r] * sg; }
                    *(GAS u32x2v*)(yp + 16 * et) = (u32x2v){pkbf(o[0], o[1]), pkbf(o[2], o[3])}; }
                __syncthreads();
                unit = unit_nx;
            }
#undef R3_GRAB
#undef R3_LOAD
        }
        if (BOTH(3)) GRID_BAR();
    }
    if (IN(4)) {
        pg8::Gemm g{Y, WOUT_T, M, D, D}; pg8::StaticOrder S; S.init(M, D, G, (int)blockIdx.x);
        pg8::EpiResBf16Stats E{U, XS, norm1_w, SSQ, D};
        pg8::gemm_phase<pg8::EpiResBf16Stats, pg8::StaticOrder, true, true>(lds + RING_OFF, g, S, E);
        if (BOTH(4)) GRID_BAR();
    }
    if (IN(6)) {
        pg8::Gemm g{U, W1_T, M, FF, D}; pg8::StaticOrder S; S.init(M, FF, G, (int)blockIdx.x);
        pg8::EpiBf16RowScaleRelu2 E{HB, FF, SSQ, 1.f / D, EPS};
        pg8::gemm_phase<pg8::EpiBf16RowScaleRelu2, pg8::StaticOrder, true, true>(lds + RING_OFF, g, S, E);
        if (BOTH(6)) GRID_BAR();
    }
    if (IN(7)) {
        pg8::Gemm g{HB, W2_T, M, D, FF}; pg8::StaticOrder S; S.init(M, D, G, (int)blockIdx.x);
        pg8::EpiResFromBf16 E{U, out, D};
        pg8::gemm_phase<pg8::EpiResFromBf16, pg8::StaticOrder, true, true>(lds + RING_OFF, g, S, E);
    }
#undef IN
#undef BOTH
}

extern "C" void kernel_launch(void* const* d_in, const int* in_sizes, int n_in, void* d_out, int out_size, void* d_ws, size_t ws_size, hipStream_t stream) {
    static int grid = 0;
    if (grid == 0) {
        if (n_in != 12 || in_sizes[0] != M * D || out_size != M * D || ws_size < WS_END) { fprintf(stderr, "kernel_launch: unexpected shapes (n_in %d, in0 %d, out %d, ws %zu); nothing launched\n", n_in, n_in > 0 ? in_sizes[0] : -1, out_size, ws_size); grid = -1; return; }
        int dev = 0, cus = 0, per_cu = 0;
        if (hipGetDevice(&dev) != hipSuccess || hipDeviceGetAttribute(&cus, hipDeviceAttributeMultiprocessorCount, dev) != hipSuccess) { grid = -1; return; }
        if (hipFuncSetAttribute((const void*)mk_fwd, hipFuncAttributeMaxDynamicSharedMemorySize, LDS_BYTES) != hipSuccess) { fprintf(stderr, "kernel_launch: hipFuncSetAttribute failed\n"); grid = -1; return; }
        if (hipOccupancyMaxActiveBlocksPerMultiprocessor(&per_cu, (const void*)mk_fwd, NWAVES * 64, LDS_BYTES) != hipSuccess || per_cu < 1)
            fprintf(stderr, "kernel_launch: note: occupancy query reports %d workgroups per CU\n", per_cu);
        (void)hipGetLastError();
        grid = cus;
    }
    if (grid < 0) return;
    if (hipMemsetAsync((char*)d_ws + WS_CTL, 0, CTL_ZERO_BYTES, stream) != hipSuccess) return;
    Args a{};
    for (int i = 0; i < 12; ++i) a.in[i] = (const float*)d_in[i];
    a.out = (float*)d_out; a.ws = (unsigned char*)d_ws;
    if (ONE_LAUNCH) { a.ph_lo = 0; a.ph_hi = N_PHASES; hipLaunchKernelGGL(mk_fwd, dim3(grid), dim3(NWAVES * 64), LDS_BYTES, stream, a); }
    else for (int p = 0; p < N_PHASES; ++p) { a.ph_lo = p; a.ph_hi = p + 1; hipLaunchKernelGGL(mk_fwd, dim3(grid), dim3(NWAVES * 64), LDS_BYTES, stream, a); }
    const hipError_t le = hipPeekAtLastError();
    if (le != hipSuccess) fprintf(stderr, "kernel_launch: launch failed: %s\n", hipGetErrorName(le));
}
```

```cpp
#include <hip/hip_runtime.h>
#include <cstdio>
#include <cstdint>
namespace pg8 {
#define PG8_LAS __attribute__((address_space(3)))
typedef unsigned short bf16_t;
typedef short bf16x8 __attribute__((ext_vector_type(8)));
typedef float f32x4 __attribute__((ext_vector_type(4)));
typedef unsigned u32x4 __attribute__((ext_vector_type(4)));
constexpr int BM = 256, BK = 64, HALF = 128, HTB = HALF * BK * 2  , STAGE_BYTES = 8 * HTB, NXCD = 8, WGM = 8;

__host__ __device__ __forceinline__ int lds_byte(int r, int c) { const int st = (r >> 4) * 2 + (c >> 5), rr = r & 15, cc = c & 31, ob = rr * 64 + cc * 2; return st * 1024 + (ob ^ (((ob >> 9) & 1) << 5)); }
__host__ __device__ __forceinline__ void stage_rc(int b, int& R, int& C) { const int st = b / 1024, sb = b % 1024, swz = sb ^ (((sb >> 9) & 1) << 5); R = (st >> 1) * 16 + swz / 64; C = (st & 1) * 32 + (swz % 64) / 2; }
__host__ __device__ __forceinline__ int perm32(int rho) { const int n = rho >> 4, i = rho & 15; return 8 * (i >> 2) + 4 * n + (i & 3); }

struct Unit { int pm, pn; };
struct Gemm { const bf16_t* A; const bf16_t* Bt; int M, N, K; };

struct StaticOrder {
    int nM, nN, nwg, G, c;
    __host__ __device__ void init(int M, int N, int G_, int c_) { nM = M / BM; nN = N / BM; nwg = nM * nN; G = G_; c = c_; }
    __host__ __device__ bool next(int i, Unit& u) const {
        const long L = (long)i * G + c; if (L >= nwg) return false;
        int wgid = (int)L; { const int q = nwg / NXCD, r = nwg % NXCD, xcd = wgid % NXCD, off = wgid / NXCD; wgid = (xcd < r ? xcd * (q + 1) : r * (q + 1) + (xcd - r) * q) + off; }
        const int nig = WGM * nN, gid = wgid / nig, fm = gid * WGM, gsz = (nM - fm) < WGM ? (nM - fm) : WGM;
        u.pm = fm + ((wgid % nig) % gsz); u.pn = (wgid % nig) / gsz; return true;
    }
    __device__ __forceinline__ void a_ready(const Unit&) const {}
    __device__ __forceinline__ void done(const Unit&) const {}
};

typedef float f32x2c __attribute__((ext_vector_type(2))); typedef __bf16 bf16x2c __attribute__((ext_vector_type(2)));
__device__ __forceinline__ unsigned cvt_pk_bf16(float lo, float hi) { const f32x2c v = {lo, hi}; const bf16x2c b = __builtin_convertvector(v, bf16x2c); return __builtin_bit_cast(unsigned, b); }

template <int ACT  > struct EpiBf16 {
    static constexpr bool PERM = true, AFTER_DRAIN = false;
    bf16_t* O; int ldc;
    __device__ __forceinline__ void operator()(const f32x4 (&acc)[2][2][4][2], const Unit& u, int wr, int wc, int fr, int fq) const {
        const int row0 = u.pm * BM + wr * 64 + fr; const int col0 = u.pn * BM + wc * 32 + 8 * fq;
#pragma unroll
        for (int ai = 0; ai < 2; ++ai)
#pragma unroll
            for (int m = 0; m < 4; ++m) { bf16_t* rowp = O + (size_t)(row0 + ai * HALF + m * 16) * ldc + col0;
#pragma unroll
                for (int bj = 0; bj < 2; ++bj) { f32x4 v0 = acc[ai][bj][m][0], v1 = acc[ai][bj][m][1];
                    if (ACT == 2) {
#pragma unroll
                        for (int e = 0; e < 4; ++e) { const float a = fmaxf(v0[e], 0.f), b = fmaxf(v1[e], 0.f); v0[e] = a * a; v1[e] = b * b; } }
                    u32x4 w; w.x = cvt_pk_bf16(v0[0], v0[1]); w.y = cvt_pk_bf16(v0[2], v0[3]); w.z = cvt_pk_bf16(v1[0], v1[1]); w.w = cvt_pk_bf16(v1[2], v1[3]);
                    __builtin_nontemporal_store(w, (u32x4*)(rowp + bj * HALF)); } }
    }
};

struct EpiProj {
    static constexpr bool PERM = true, AFTER_DRAIN = false;
    bf16_t* O; int ldc; bf16_t* R; int mrows;
    __device__ __forceinline__ void operator()(const f32x4 (&acc)[2][2][4][2], const Unit& u, int wr, int wc, int fr, int fq) const {
        const int row0 = u.pm * BM + wr * 64 + fr; const int col0 = (u.pn - 8) * BM + wc * 32 + 8 * fq; const bool hm = u.pn < 8;
#pragma unroll
        for (int ai = 0; ai < 2; ++ai)
#pragma unroll
            for (int m = 0; m < 4; ++m) { const int row = row0 + ai * HALF + m * 16;
#pragma unroll
                for (int bj = 0; bj < 2; ++bj) { const f32x4 v0 = acc[ai][bj][m][0], v1 = acc[ai][bj][m][1];
                    u32x4 w; w.x = cvt_pk_bf16(v0[0], v0[1]); w.y = cvt_pk_bf16(v0[2], v0[3]); w.z = cvt_pk_bf16(v1[0], v1[1]); w.w = cvt_pk_bf16(v1[2], v1[3]);
                    bf16_t* p = hm ? R + ((size_t)(u.pn * 2 + bj) * mrows + row) * 128 + wc * 32 + 8 * fq : O + (size_t)row * ldc + col0 + bj * HALF;
                    __builtin_nontemporal_store(w, (u32x4*)p); } }
    }
};

struct EpiResF32 {
    static constexpr bool PERM = true, AFTER_DRAIN = false;
    const float* base; float* out; int ldc;
    __device__ __forceinline__ void operator()(const f32x4 (&acc)[2][2][4][2], const Unit& u, int wr, int wc, int fr, int fq) const {
        const int col0 = u.pn * BM + wc * 32 + 8 * fq;
#pragma unroll
        for (int ai = 0; ai < 2; ++ai)
#pragma unroll
            for (int m = 0; m < 4; ++m) { const size_t off = (size_t)(u.pm * BM + ai * HALF + wr * 64 + m * 16 + fr) * ldc + col0;
#pragma unroll
                for (int bj = 0; bj < 2; ++bj)
#pragma unroll
                    for (int n = 0; n < 2; ++n) { const f32x4 bs = *(const f32x4*)(base + off + bj * HALF + n * 4); *(f32x4*)(out + off + bj * HALF + n * 4) = bs + acc[ai][bj][m][n]; }
                if (m & 1) asm volatile("" ::: "memory"); }
    }
};
struct EpiResF32Stats {
    static constexpr bool PERM = true, AFTER_DRAIN = false;
    const float* base; float* out; bf16_t* xn; const float* w; float* ss; int ldc;
    __device__ __forceinline__ void operator()(const f32x4 (&acc)[2][2][4][2], const Unit& u, int wr, int wc, int fr, int fq) const {
        const int col0 = u.pn * BM + wc * 32 + 8 * fq;
        f32x4 wv[2][2];
#pragma unroll
        for (int bj = 0; bj < 2; ++bj)
#pragma unroll
            for (int n = 0; n < 2; ++n) wv[bj][n] = *(const f32x4*)(w + col0 + bj * HALF + n * 4);
#pragma unroll
        for (int ai = 0; ai < 2; ++ai)
#pragma unroll
            for (int m = 0; m < 4; ++m) { const int row = u.pm * BM + ai * HALF + wr * 64 + m * 16 + fr; const size_t off = (size_t)row * ldc + col0; float s = 0.f;
#pragma unroll
                for (int bj = 0; bj < 2; ++bj) { f32x4 a[2];
#pragma unroll
                    for (int n = 0; n < 2; ++n) { const f32x4 h = *(const f32x4*)(base + off + bj * HALF + n * 4) + acc[ai][bj][m][n]; *(f32x4*)(out + off + bj * HALF + n * 4) = h;
                        s += (h[0] * h[0] + h[1] * h[1]) + (h[2] * h[2] + h[3] * h[3]); a[n] = h * wv[bj][n]; }
                    u32x4 o; o.x = cvt_pk_bf16(a[0][0], a[0][1]); o.y = cvt_pk_bf16(a[0][2], a[0][3]); o.z = cvt_pk_bf16(a[1][0], a[1][1]); o.w = cvt_pk_bf16(a[1][2], a[1][3]);
                    *(u32x4*)(xn + off + bj * HALF) = o; }
                s += __shfl_xor(s, 16); s += __shfl_xor(s, 32);
                if (fq == 0) __hip_atomic_fetch_add(ss + row, s, __ATOMIC_RELAXED, __HIP_MEMORY_SCOPE_AGENT);
                if (m & 1) asm volatile("" ::: "memory"); }
    }
};
struct EpiBf16RowScaleRelu2 {
    static constexpr bool PERM = true, AFTER_DRAIN = false;
    bf16_t* O; int ldc; const float* ss; float inv_n, eps;
    __device__ __forceinline__ void operator()(const f32x4 (&acc)[2][2][4][2], const Unit& u, int wr, int wc, int fr, int fq) const {
        const int row0 = u.pm * BM + wr * 64 + fr; const int col0 = u.pn * BM + wc * 32 + 8 * fq;
#pragma unroll
        for (int ai = 0; ai < 2; ++ai)
#pragma unroll
            for (int m = 0; m < 4; ++m) { const int row = row0 + ai * HALF + m * 16; bf16_t* rowp = O + (size_t)row * ldc + col0; const float ri = 1.f / sqrtf(ss[row] * inv_n + eps);
#pragma unroll
                for (int bj = 0; bj < 2; ++bj) { f32x4 v0 = acc[ai][bj][m][0], v1 = acc[ai][bj][m][1];
#pragma unroll
                    for (int e = 0; e < 4; ++e) { const float a = fmaxf(v0[e] * ri, 0.f), b = fmaxf(v1[e] * ri, 0.f); v0[e] = a * a; v1[e] = b * b; }
                    u32x4 w; w.x = cvt_pk_bf16(v0[0], v0[1]); w.y = cvt_pk_bf16(v0[2], v0[3]); w.z = cvt_pk_bf16(v1[0], v1[1]); w.w = cvt_pk_bf16(v1[2], v1[3]);
                    __builtin_nontemporal_store(w, (u32x4*)(rowp + bj * HALF)); } }
    }
};

struct EpiResBf16Stats {
    static constexpr bool PERM = true, AFTER_DRAIN = false;
    bf16_t* xn; const float* xs; const float* w1; float* ss; int ldc;
    __device__ __forceinline__ void operator()(const f32x4 (&acc)[2][2][4][2], const Unit& u, int wr, int wc, int fr, int fq) const {
        const int col0 = u.pn * BM + wc * 32 + 8 * fq;
        f32x4 iw[2][2];
#pragma unroll
        for (int bj = 0; bj < 2; ++bj)
#pragma unroll
            for (int n = 0; n < 2; ++n) { const f32x4 g = *(const f32x4*)(w1 + col0 + bj * HALF + n * 4); iw[bj][n] = (f32x4){1.f / g[0], 1.f / g[1], 1.f / g[2], 1.f / g[3]}; }
#pragma unroll
        for (int ai = 0; ai < 2; ++ai)
#pragma unroll
            for (int m = 0; m < 4; ++m) { const int row = u.pm * BM + ai * HALF + wr * 64 + m * 16 + fr; const size_t off = (size_t)row * ldc + col0; float s = 0.f; const float xr = xs[row];
#pragma unroll
                for (int bj = 0; bj < 2; ++bj) { const u32x4 b = *(const u32x4*)(xn + off + bj * HALF); f32x4 h[2];
                    h[0] = (f32x4){__uint_as_float(b.x << 16), __uint_as_float(b.x & 0xffff0000u), __uint_as_float(b.y << 16), __uint_as_float(b.y & 0xffff0000u)} * iw[bj][0] * xr + acc[ai][bj][m][0];
                    h[1] = (f32x4){__uint_as_float(b.z << 16), __uint_as_float(b.z & 0xffff0000u), __uint_as_float(b.w << 16), __uint_as_float(b.w & 0xffff0000u)} * iw[bj][1] * xr + acc[ai][bj][m][1];
#pragma unroll
                    for (int n = 0; n < 2; ++n) s += (h[n][0] * h[n][0] + h[n][1] * h[n][1]) + (h[n][2] * h[n][2] + h[n][3] * h[n][3]);
                    u32x4 o; o.x = cvt_pk_bf16(h[0][0], h[0][1]); o.y = cvt_pk_bf16(h[0][2], h[0][3]); o.z = cvt_pk_bf16(h[1][0], h[1][1]); o.w = cvt_pk_bf16(h[1][2], h[1][3]);
                    *(u32x4*)(xn + off + bj * HALF) = o; }
                s += __shfl_xor(s, 16); s += __shfl_xor(s, 32);
                if (fq == 0) __hip_atomic_fetch_add(ss + row, s, __ATOMIC_RELAXED, __HIP_MEMORY_SCOPE_AGENT);
                if (m & 1) asm volatile("" ::: "memory"); }
    }
};
struct EpiResFromBf16 {
    static constexpr bool PERM = true, AFTER_DRAIN = false;
    const bf16_t* base; float* out; int ldc;
    __device__ __forceinline__ void operator()(const f32x4 (&acc)[2][2][4][2], const Unit& u, int wr, int wc, int fr, int fq) const {
        const int col0 = u.pn * BM + wc * 32 + 8 * fq;
#pragma unroll
        for (int ai = 0; ai < 2; ++ai)
#pragma unroll
            for (int m = 0; m < 4; ++m) { const size_t off = (size_t)(u.pm * BM + ai * HALF + wr * 64 + m * 16 + fr) * ldc + col0;
#pragma unroll
                for (int bj = 0; bj < 2; ++bj) { const u32x4 b = *(const u32x4*)(base + off + bj * HALF);
                    const f32x4 b0 = (f32x4){__uint_as_float(b.x << 16), __uint_as_float(b.x & 0xffff0000u), __uint_as_float(b.y << 16), __uint_as_float(b.y & 0xffff0000u)};
                    const f32x4 b1 = (f32x4){__uint_as_float(b.z << 16), __uint_as_float(b.z & 0xffff0000u), __uint_as_float(b.w << 16), __uint_as_float(b.w & 0xffff0000u)};
                    __builtin_nontemporal_store(b0 + acc[ai][bj][m][0], (f32x4*)(out + off + bj * HALF)); __builtin_nontemporal_store(b1 + acc[ai][bj][m][1], (f32x4*)(out + off + bj * HALF + 4)); }
                if (m & 1) asm volatile("" ::: "memory"); }
    }
};
template <class Epi, class Sched, bool ALIGN_EPI = false, bool SP2 = false>
__device__ __forceinline__ void gemm_phase(PG8_LAS unsigned char* lds, const Gemm g, const Sched& S, const Epi& E) {
    const int tid = threadIdx.x, wid = __builtin_amdgcn_readfirstlane(tid >> 6), lane = tid & 63, wr = wid >> 2, wc = wid & 3, fr = lane & 15, fq = lane >> 4;
    const int K = g.K, nt = K / BK;
    unsigned voffA[2], voffB[2];
#pragma unroll
    for (int i = 0; i < 2; ++i) { int R, C; stage_rc(tid * 16 + i * 8192, R, C); const int Rb = Epi::PERM ? ((R & ~31) + perm32(R & 31)) : R;
        voffA[i] = (unsigned)(R * K + C) * 2u; voffB[i] = (unsigned)(Rb * K + C) * 2u; }
    const size_t kstep = (size_t)(BK * 2);
    const size_t hstep = (size_t)HALF * K * 2;
    const size_t tstep = 2 * hstep;
    const unsigned ldsw = (unsigned)wid * 1024u;
    const int aoff = lds_byte(wr * 64 + fr, fq * 8), boff = lds_byte(wc * 32 + fr, fq * 8);
#define PG8_SA(b, h) (((b) * 2 + (h)) * HTB)
#define PG8_SB(b, h) ((4 + (b) * 2 + (h)) * HTB)
#define PG8_STAGE(bufoff, gbase, voff) do { _Pragma("unroll") for (int _i = 0; _i < 2; ++_i) \
        __builtin_amdgcn_global_load_lds((const unsigned*)((const char*)(gbase) + (voff)[_i]), (PG8_LAS unsigned*)(lds + (bufoff) + ldsw + _i * 8192), 16, 0, 0); } while (0)
#define PG8_LDA(dst, b, h) do { _Pragma("unroll") for (int m = 0; m < 4; ++m) _Pragma("unroll") for (int k = 0; k < 2; ++k) dst[m][k] = *(const PG8_LAS bf16x8*)(lds + PG8_SA(b, h) + aoff + m * 2048 + k * 1024); } while (0)
#define PG8_LDB(dst, b, h) do { _Pragma("unroll") for (int n = 0; n < 2; ++n) _Pragma("unroll") for (int k = 0; k < 2; ++k) dst[n][k] = *(const PG8_LAS bf16x8*)(lds + PG8_SB(b, h) + boff + n * 2048 + k * 1024); } while (0)
#define PG8_MMA(ai, bj, At, Bt) do { __builtin_amdgcn_s_setprio(1); _Pragma("unroll") for (int m = 0; m < 4; ++m) _Pragma("unroll") for (int n = 0; n < 2; ++n) _Pragma("unroll") for (int k = 0; k < 2; ++k) \
        acc[ai][bj][m][n] = __builtin_amdgcn_mfma_f32_16x16x32_bf16(Bt[n][k], At[m][k], acc[ai][bj][m][n], 0, 0, 0); __builtin_amdgcn_s_setprio(0); } while (0)
#define PG8_MMAZ(ai, bj, At, Bt) do { __builtin_amdgcn_s_setprio(1); _Pragma("unroll") for (int m = 0; m < 4; ++m) _Pragma("unroll") for (int n = 0; n < 2; ++n) { \
        const f32x4 c0_ = __builtin_amdgcn_mfma_f32_16x16x32_bf16(Bt[n][0], At[m][0], ((f32x4){0.f, 0.f, 0.f, 0.f}), 0, 0, 0); acc[ai][bj][m][n] = __builtin_amdgcn_mfma_f32_16x16x32_bf16(Bt[n][1], At[m][1], c0_, 0, 0, 0); } __builtin_amdgcn_s_setprio(0); } while (0)
#define PG8_WAIT_V(n) asm volatile("s_waitcnt vmcnt(" #n ")" ::: "memory")
#define PG8_WAIT_L(n) asm volatile("s_waitcnt lgkmcnt(" #n ")" ::: "memory")
#define PG8_BAR __builtin_amdgcn_s_barrier()
#define PG8_SCHED __builtin_amdgcn_sched_barrier(0)
    Unit cur, nxt; int ui = 0;
    if (!S.next(0, cur)) return;
    f32x4 acc[2][2][4][2];
    if constexpr (!SP2) {
#pragma unroll
    for (int a = 0; a < 2; ++a)
#pragma unroll
        for (int b = 0; b < 2; ++b)
#pragma unroll
            for (int m = 0; m < 4; ++m)
#pragma unroll
                for (int n = 0; n < 2; ++n) acc[a][b][m][n] = (f32x4){0.f, 0.f, 0.f, 0.f};
    }
    bf16x8 At[4][2], B0[2][2], B1[2][2];
    const char* cA = (const char*)g.A + (size_t)cur.pm * tstep; const char* cB = (const char*)g.Bt + (size_t)cur.pn * tstep;
    S.a_ready(cur);
    if constexpr (SP2) {
        PG8_STAGE(PG8_SB(0, 0), cB, voffB); PG8_STAGE(PG8_SB(0, 1), cB + hstep, voffB); PG8_STAGE(PG8_SA(0, 0), cA, voffA); PG8_STAGE(PG8_SA(0, 1), cA + hstep, voffA);
        if (wr == 1) PG8_BAR;
        PG8_WAIT_V(2); PG8_BAR;
        PG8_STAGE(PG8_SB(1, 0), cB + kstep, voffB); PG8_STAGE(PG8_SA(1, 0), cA + kstep, voffA); PG8_STAGE(PG8_SB(1, 1), cB + hstep + kstep, voffB);
        PG8_WAIT_V(6); PG8_BAR;
    } else {
        PG8_STAGE(PG8_SB(0, 0), cB, voffB); PG8_STAGE(PG8_SA(0, 0), cA, voffA); PG8_STAGE(PG8_SB(0, 1), cB + hstep, voffB); PG8_STAGE(PG8_SA(0, 1), cA + hstep, voffA);
        if (wr == 1) PG8_BAR;
        PG8_WAIT_V(4); PG8_BAR;
        PG8_STAGE(PG8_SB(1, 0), cB + kstep, voffB); PG8_STAGE(PG8_SA(1, 0), cA + kstep, voffA); PG8_STAGE(PG8_SB(1, 1), cB + hstep + kstep, voffB);
        PG8_WAIT_V(6); PG8_BAR;
    }
    for (;;) {
        const bool has_next = S.next(ui + 1, nxt);
        const char* nA = has_next ? (const char*)g.A + (size_t)nxt.pm * tstep : cA; const char* nB = has_next ? (const char*)g.Bt + (size_t)nxt.pn * tstep : cB;
#define PG8_KPTRS \
            const bool last = (t == nt - 2); \
            const char* a1 = cA + (size_t)(t + 1) * kstep;                                             \
            const char* a2 = last ? nA : cA + (size_t)(t + 2) * kstep; const char* b2 = last ? nB : cB + (size_t)(t + 2) * kstep;     \
            const char* a3 = a2 + kstep; const char* b3 = b2 + kstep;                                \
            if (last && has_next) S.a_ready(nxt);
#define PG8_KITER(MM0) \
            PG8_LDB(B0, 0, 0); PG8_LDB(B1, 0, 1); PG8_SCHED; PG8_LDA(At, 0, 0); PG8_STAGE(PG8_SA(1, 1), a1 + hstep, voffA); \
            PG8_WAIT_V(8); PG8_WAIT_L(0); PG8_BAR; MM0(0, 0, At, B0); MM0(0, 1, At, B1); PG8_BAR; PG8_SCHED; \
            PG8_LDA(At, 0, 1); PG8_STAGE(PG8_SB(0, 0), b2, voffB); PG8_STAGE(PG8_SB(0, 1), b2 + hstep, voffB); PG8_STAGE(PG8_SA(0, 0), a2, voffA); \
            PG8_WAIT_V(8); PG8_WAIT_L(0); PG8_BAR; MM0(1, 0, At, B0); MM0(1, 1, At, B1); PG8_BAR; PG8_SCHED; \
            PG8_LDB(B0, 1, 0); PG8_LDB(B1, 1, 1); PG8_SCHED; PG8_LDA(At, 1, 0); PG8_STAGE(PG8_SA(0, 1), a2 + hstep, voffA); \
            PG8_WAIT_V(8); PG8_WAIT_L(0); PG8_BAR; PG8_MMA(0, 0, At, B0); PG8_MMA(0, 1, At, B1); PG8_BAR; PG8_SCHED; \
            PG8_LDA(At, 1, 1); PG8_STAGE(PG8_SB(1, 0), b3, voffB); PG8_STAGE(PG8_SB(1, 1), b3 + hstep, voffB); PG8_STAGE(PG8_SA(1, 0), a3, voffA); \
            PG8_WAIT_V(8); PG8_WAIT_L(0); PG8_BAR; PG8_MMA(1, 0, At, B0); PG8_MMA(1, 1, At, B1); PG8_BAR; PG8_SCHED;
        int t0 = 0;
        if constexpr (SP2) { const int t = 0; PG8_KPTRS PG8_KITER(PG8_MMAZ) t0 = 2; }
        for (int t = t0; t < nt; t += 2) {
            PG8_KPTRS
            if constexpr (SP2) {
            PG8_KITER(PG8_MMA)
            } else {
            PG8_LDB(B0, 0, 0); PG8_SCHED; PG8_LDA(At, 0, 0); PG8_STAGE(PG8_SA(1, 1), a1 + hstep, voffA);
            PG8_WAIT_L(8); PG8_BAR; PG8_WAIT_L(0); PG8_MMA(0, 0, At, B0); PG8_BAR; PG8_SCHED;
            PG8_LDB(B1, 0, 1); PG8_STAGE(PG8_SB(0, 0), b2, voffB);
            PG8_BAR; PG8_WAIT_L(0); PG8_MMA(0, 1, At, B1); PG8_BAR;
            PG8_LDA(At, 0, 1); PG8_STAGE(PG8_SA(0, 0), a2, voffA);
            PG8_BAR; PG8_WAIT_L(0); PG8_MMA(1, 0, At, B0); PG8_BAR; PG8_SCHED;
            PG8_STAGE(PG8_SB(0, 1), b2 + hstep, voffB);
            PG8_WAIT_V(6); PG8_BAR; PG8_MMA(1, 1, At, B1); PG8_BAR;
            PG8_LDB(B0, 1, 0); PG8_SCHED; PG8_LDA(At, 1, 0); PG8_STAGE(PG8_SA(0, 1), a2 + hstep, voffA);
            PG8_WAIT_L(8); PG8_BAR; PG8_WAIT_L(0); PG8_MMA(0, 0, At, B0); PG8_BAR; PG8_SCHED;
            PG8_LDB(B1, 1, 1); PG8_STAGE(PG8_SB(1, 0), b3, voffB);
            PG8_BAR; PG8_WAIT_L(0); PG8_MMA(0, 1, At, B1); PG8_BAR;
            PG8_LDA(At, 1, 1); PG8_STAGE(PG8_SA(1, 0), a3, voffA);
            PG8_BAR; PG8_WAIT_L(0); PG8_MMA(1, 0, At, B0); PG8_BAR; PG8_SCHED;
            PG8_STAGE(PG8_SB(1, 1), b3 + hstep, voffB);
            PG8_WAIT_V(6); PG8_BAR; PG8_MMA(1, 1, At, B1); PG8_BAR;
            }
        }
        if constexpr (ALIGN_EPI) { if (wr == 0) PG8_BAR; }
        if constexpr (!Epi::AFTER_DRAIN) { int ln_ = lane; asm volatile("" : "+v"(ln_));
            E(acc, cur, wr, wc, ln_ & 15, ln_ >> 4); S.done(cur); }
        if (!has_next) break;
        if constexpr (!SP2) {
#pragma unroll
        for (int a = 0; a < 2; ++a)
#pragma unroll
            for (int b = 0; b < 2; ++b)
#pragma unroll
                for (int m = 0; m < 4; ++m)
#pragma unroll
                    for (int n = 0; n < 2; ++n) acc[a][b][m][n] = (f32x4){0.f, 0.f, 0.f, 0.f};
        }
        cur = nxt; cA = nA; cB = nB; ++ui;
        if constexpr (ALIGN_EPI) { if (wr == 1) PG8_BAR; }
    }
    PG8_WAIT_V(0);
    if constexpr (!ALIGN_EPI) { if (wr == 0) PG8_BAR; }
    PG8_BAR;
    if constexpr (Epi::AFTER_DRAIN) { E.fused(acc, cur, wr, wc, fr, fq, lds, wid, lane); S.done(cur); }
#undef PG8_SA
#undef PG8_SB
#undef PG8_STAGE
#undef PG8_LDA
#undef PG8_LDB
#undef PG8_MMA
#undef PG8_MMAZ
#undef PG8_KPTRS
#undef PG8_KITER
#undef PG8_WAIT_V
#undef PG8_WAIT_L
#undef PG8_BAR
#undef PG8_SCHED
}
}
constexpr int NWAVES = 8;
#ifndef MK_N_LAUNCHES
#define MK_N_LAUNCHES 1
#endif
constexpr int N_PHASES = 8;
constexpr bool ONE_LAUNCH = (MK_N_LAUNCHES == 1);

constexpr int BATCH = 16, SEQ = 4096, D = 1024, NMETA = 16, TK = SEQ + NMETA, FF = 4096;
constexpr int M = BATCH * SEQ;
constexpr int DIN = 3272, DINP = 3328;
constexpr int C_RQ = 0, C_RK = 512, C_RV = 1024, C_RG = 1536, C_DQ = 2048, C_DK = 2560, C_DV = 2624, C_IQ = 2688, C_IK = 3200, C_IW = 3264;
constexpr int DP2 = 1280;
constexpr int C2_DQ = C_DQ - 2048, C2_DK = C_DK - 2048, C2_DV = C_DV - 2048, C2_IQ = C_IQ - 2048, C2_IK = C_IK - 2048, C2_IW = C_IW - 2048;
constexpr float EPS = 1e-6f;
constexpr int KROWS = 4160;

constexpr size_t MiB = 1u << 20;
constexpr size_t WS_CTL = 0, CTL_ZERO_BYTES = 1 * MiB;
constexpr size_t WS_WIN = 2 * MiB;
constexpr size_t WS_WOUT = 9 * MiB;
constexpr size_t WS_W1 = 11 * MiB;
constexpr size_t WS_W2 = 19 * MiB;
constexpr size_t WS_ROPE = 27 * MiB;
constexpr size_t WS_PMETA = 30 * MiB;
constexpr size_t WS_KC = 32 * MiB;
constexpr size_t WS_IKC = 41 * MiB;
constexpr size_t WS_VT = 50 * MiB;
constexpr size_t WS_U = 64 * MiB;
constexpr size_t WS_PROJ = 192 * MiB;
constexpr size_t WS_RET = 352 * MiB;
constexpr size_t WS_QN = 608 * MiB;
constexpr size_t WS_SPT = 672 * MiB;
constexpr size_t WS_Y = 736 * MiB;
constexpr size_t WS_H = 192 * MiB;
constexpr size_t WS_TQ2 = 864 * MiB;
constexpr size_t WS_LIST = 864 * MiB;
constexpr size_t WS_END = 1024 * MiB;
static_assert(WS_H + (size_t)M * FF * 2 <= WS_Y && WS_Y + (size_t)M * D * 2 <= WS_END, "d_ws map");
constexpr int CW_TMO = 0, CW_CODE = 1;
constexpr int CW_BAR = 4096;

constexpr int RING_OFF = 0, RING_BYTES = 131072;
constexpr int LDS_BYTES = 163840;
constexpr int LDSCTL_OFF = LDS_BYTES - 512, MISC_OFF = LDSCTL_OFF + 320;
static_assert(MISC_OFF + 128 <= LDS_BYTES, "LDS map");
#define GAS __attribute__((address_space(1)))
#define LAS __attribute__((address_space(3)))
typedef unsigned short bf16;
typedef unsigned v4u __attribute__((ext_vector_type(4)));
typedef float f32x4 __attribute__((ext_vector_type(4)));
typedef short bf16x8 __attribute__((ext_vector_type(8)));
typedef GAS unsigned gu32;
typedef GAS unsigned long long gu64;
#define RLX_AGENT __ATOMIC_RELAXED, __HIP_MEMORY_SCOPE_AGENT
#define LDS_WAIT() asm volatile("s_waitcnt lgkmcnt(0)" ::: "memory")
#define VM_WAIT() asm volatile("s_waitcnt vmcnt(0)" ::: "memory")
__device__ __forceinline__ unsigned long long rt() { return __builtin_amdgcn_s_memrealtime(); }
__device__ __forceinline__ unsigned f2bf(float f) { unsigned u = __builtin_bit_cast(unsigned, f); return (u + 0x7fffu + ((u >> 16) & 1u)) >> 16; }
__device__ __forceinline__ unsigned pk2(float lo, float hi) { return f2bf(lo) | (f2bf(hi) << 16); }

#define XB_TMO      128
#define XB_XCNT(j)  (256  + 64 * (j))
#define XB_XSUB(j)  (1280 + 64 * (j))
#define XB_XGEN(j)  (2304 + 64 * (j))
#define XB_TOP      3328
#define XB_TOPGEN   3392
#define XCD_BAR_WORDS 3456
#define XB_SPIN_CAP (1u << 22)

__device__ __forceinline__ unsigned xb_ld(unsigned* p)              { return __hip_atomic_load(p, __ATOMIC_RELAXED, __HIP_MEMORY_SCOPE_AGENT); }
__device__ __forceinline__ unsigned xb_add(unsigned* p, unsigned v) { return __hip_atomic_fetch_add(p, v, __ATOMIC_RELAXED, __HIP_MEMORY_SCOPE_AGENT); }
__device__ __forceinline__ unsigned xb_xcc_id() { return (unsigned)__builtin_amdgcn_s_getreg((3 << 11) | 20) & 0xFu; }
#define XB_SPIN(cond, bar) do { unsigned _sp = 0; while (cond) { __builtin_amdgcn_s_sleep(1); \
    if ((++_sp & 255u) == 0u) { if (xb_ld(&(bar)[XB_TMO])) break; if (_sp > XB_SPIN_CAP) { atomicAdd(&(bar)[XB_TMO], 1u); break; } } } } while (0)

struct XcdBarrier {
    unsigned* bar; unsigned x;
    volatile LAS unsigned* st;
};

__device__ __forceinline__ XcdBarrier xcd_barrier_post(unsigned* bar, volatile LAS unsigned* st) {
    XcdBarrier b; b.bar = bar; b.x = xb_xcc_id(); b.st = st;
    if (threadIdx.x == 0) (void)xb_add(&bar[XB_XCNT(b.x)], 1u);
    return b;
}
__device__ __forceinline__ void xcd_barrier_complete(unsigned* bar, unsigned x, unsigned& nloc, unsigned& nx) {
    const unsigned G = gridDim.x * gridDim.y * gridDim.z;
    unsigned sum, cnt, mine, sp = 0u;
    for (;;) {
        sum = 0u; cnt = 0u; mine = 0u;
#pragma unroll
        for (unsigned j = 0; j < 16; ++j) { const unsigned c = xb_ld(&bar[XB_XCNT(j)]); sum += c; cnt += (c > 0u) ? 1u : 0u; mine = (j == x) ? c : mine; }
        if (sum == G) break;
        __builtin_amdgcn_s_sleep(1);
        if ((++sp & 255u) == 0u) { if (xb_ld(&bar[XB_TMO])) break; if (sp > XB_SPIN_CAP) { atomicAdd(&bar[XB_TMO], 1u); break; } }
    }
    nloc = mine > 0u ? mine : 1u; nx = cnt > 0u ? cnt : 1u;
}

__device__ __forceinline__ void xcd_barrier(const XcdBarrier& b) {
    asm volatile("s_waitcnt vmcnt(0)" ::: "memory");
    __syncthreads();
    if (threadIdx.x == 0) {
        unsigned* bar = b.bar;
        __builtin_amdgcn_s_waitcnt(0);
        unsigned nloc = b.st[0], nx = b.st[1];
        if (nloc == 0u) { xcd_barrier_complete(bar, b.x, nloc, nx); b.st[0] = nloc; b.st[1] = nx; }
        const unsigned old = xb_add(&bar[XB_XSUB(b.x)], 1u);
        const unsigned gen = old / nloc;
        if (old + 1u == (gen + 1u) * nloc) {
            __builtin_amdgcn_fence(__ATOMIC_RELEASE, "agent");
            asm volatile("s_waitcnt vmcnt(0)" ::: "memory");
            const unsigned og = xb_add(&bar[XB_TOP], 1u);
            const unsigned tg = og / nx;
            if (og + 1u == (tg + 1u) * nx) xb_add(&bar[XB_TOPGEN], 1u);
            else XB_SPIN(xb_ld(&bar[XB_TOPGEN]) == tg, bar);
            __builtin_amdgcn_fence(__ATOMIC_ACQUIRE, "agent");
            xb_add(&bar[XB_XGEN(b.x)], 1u);
            asm volatile("s_waitcnt vmcnt(0)" ::: "memory");
        } else {
            XB_SPIN(xb_ld(&bar[XB_XGEN(b.x)]) == gen, bar);
            __builtin_amdgcn_fence(__ATOMIC_ACQUIRE, "agent");
            asm volatile("s_waitcnt vmcnt(0)" ::: "memory");
        }
    }
    __syncthreads();
}

typedef short v4i16_t __attribute__((ext_vector_type(4)));
typedef float f32x2v __attribute__((ext_vector_type(2)));
typedef unsigned u32x2v __attribute__((ext_vector_type(2)));
#define MFMA16(a, b, c) __builtin_amdgcn_mfma_f32_16x16x32_bf16((a), (b), (c), 0, 0, 0)
__device__ __forceinline__ float bf2f(unsigned short u) { return __uint_as_float((unsigned)u << 16); }
__device__ __forceinline__ bf16x8 frag_n(const LAS unsigned char* img, int stride, int rowsel, int k0, int lane) {
    return *(const LAS bf16x8*)(img + rowsel * stride + (k0 + 8 * (lane >> 4)) * 2);
}
__device__ __forceinline__ bf16x8 frag_t(const LAS unsigned char* img, int stride, int row0, int k0, int lane) {
    const int g = lane >> 4, q = (lane >> 2) & 3, p = lane & 3;
    const LAS unsigned char* a = img + (k0 + 8 * g + q) * stride + (row0 + 4 * p) * 2;
    const v4i16_t lo = __builtin_amdgcn_ds_read_tr16_b64_v4i16((LAS v4i16_t*)a);
    const v4i16_t hi = __builtin_amdgcn_ds_read_tr16_b64_v4i16((LAS v4i16_t*)(a + 4 * stride));
    return (bf16x8){lo[0], lo[1], lo[2], lo[3], hi[0], hi[1], hi[2], hi[3]};
}
__device__ __forceinline__ unsigned pkbf(float lo, float hi) { return pg8::cvt_pk_bf16(lo, hi); }
__device__ __forceinline__ float rows_sum(float x) {
    { const auto r = __builtin_amdgcn_permlane16_swap(__float_as_uint(x), __float_as_uint(x), false, false); x = __uint_as_float(r[0]) + __uint_as_float(r[1]); }
    { const auto r = __builtin_amdgcn_permlane32_swap(__float_as_uint(x), __float_as_uint(x), false, false); x = __uint_as_float(r[0]) + __uint_as_float(r[1]); }
    return x; }
__device__ __forceinline__ unsigned rows_or(unsigned x) {
    { const auto r = __builtin_amdgcn_permlane16_swap(x, x, false, false); x = r[0] | r[1]; }
    { const auto r = __builtin_amdgcn_permlane32_swap(x, x, false, false); x = r[0] | r[1]; }
    return x; }
#define TR_RD "ds_read_b64_tr_b16 "
__device__ __forceinline__ bf16x8 tr_pack(u32x2v lo, u32x2v hi) { const v4u w = (v4u){lo[0], lo[1], hi[0], hi[1]}; return __builtin_bit_cast(bf16x8, w); }

constexpr int IMG_STRIDE = 288;
constexpr float RET_KSCALE = 0.08838834764831845f;

__device__ __forceinline__ void rot8(const v4u a, const v4u b, const f32x4 (&cs)[4], float sc, v4u& o1, v4u& o2) {
    float x1[8], x2[8], c[8], s[8];
#pragma unroll
    for (int i = 0; i < 4; ++i) { x1[2 * i] = __uint_as_float(a[i] << 16); x1[2 * i + 1] = __uint_as_float(a[i] & 0xffff0000u); x2[2 * i] = __uint_as_float(b[i] << 16); x2[2 * i + 1] = __uint_as_float(b[i] & 0xffff0000u);
        c[2 * i] = cs[i][0]; s[2 * i] = cs[i][1]; c[2 * i + 1] = cs[i][2]; s[2 * i + 1] = cs[i][3]; }
    float r1[8], r2[8];
#pragma unroll
    for (int i = 0; i < 8; ++i) { r1[i] = (x1[i] * c[i] - x2[i] * s[i]) * sc; r2[i] = (x1[i] * s[i] + x2[i] * c[i]) * sc; }
#pragma unroll
    for (int i = 0; i < 4; ++i) { o1[i] = pkbf(r1[2 * i], r1[2 * i + 1]); o2[i] = pkbf(r2[2 * i], r2[2 * i + 1]); }
}
#define DSA_OPAQUE(x) asm volatile("" : "+v"(x))
constexpr int DSA_CAP = 64;
constexpr int DSA_MSTR = 132;
constexpr int L_HIST = 0, L_MASK = 65536, L_QPAR = L_MASK + 128 * DSA_MSTR * 4, L_CCNT = L_QPAR + 128 * 16, L_BIAS = L_CCNT + 512, L_STAGE = L_BIAS + 8 * 144 * 4, L_DSA_END = L_STAGE + 2 * 8192;
static_assert(L_DSA_END <= LDSCTL_OFF, "DSA LDS map");
constexpr float LOG2E = 1.4426950408889634f;

constexpr int DSA_NB = 128;
#define DSA_SCORE_BODY \
        f32x4 acc = MFMA16(a0, cq[0], ((f32x4){0.f, 0.f, 0.f, 0.f})); acc = MFMA16(a1, cq[1], acc); \
        _Pragma("unroll") for (int h = 0; h < 8; ++h) { \
            f32x4 s = MFMA16(a0, iq[h][0], ((f32x4){0.f, 0.f, 0.f, 0.f})); s = MFMA16(a1, iq[h][1], s); \
            _Pragma("unroll") for (int r = 0; r < 4; ++r) acc[r] = __builtin_fmaf(wh[h], __builtin_fabsf(s[r]), acc[r]); } \
        sc[u] = acc;
__device__ __forceinline__ void idx_tile(const bf16* ikb, int kt, const bf16x8 (&iq)[8][2], const bf16x8 (&cq)[2], const float (&wh)[8], int lane, f32x4 (&sc)[2]) {
    const int i = lane & 15, g = lane >> 4;
#pragma unroll
    for (int u = 0; u < 2; ++u) {
        const bf16* rp = ikb + (size_t)(32 * kt + 8 * (i >> 2) + 4 * u + (i & 3)) * 64 + 8 * g;
        const bf16x8 a0 = *(const GAS bf16x8*)rp, a1 = *(const GAS bf16x8*)(rp + 32);
        DSA_SCORE_BODY
    }
}
__device__ __forceinline__ void idx_tile_lds(const LAS unsigned char* tb, const bf16x8 (&iq)[8][2], const bf16x8 (&cq)[2], const float (&wh)[8], int lane, f32x4 (&sc)[2]) {
#pragma unroll
    for (int u = 0; u < 2; ++u) {
        const bf16x8 a0 = *(const LAS bf16x8*)(tb + (u * 2 + 0) * 1024 + lane * 16), a1 = *(const LAS bf16x8*)(tb + (u * 2 + 1) * 1024 + lane * 16);
        DSA_SCORE_BODY
    }
}
__device__ __forceinline__ float bin_t(float s, float binc, float invw) { return __builtin_fmaf(s, invw, binc); }
__device__ __forceinline__ int bin_of_t(float t) { return (int)__builtin_amdgcn_fmed3f(t, 0.f, (float)(DSA_NB - 1)); }

__device__ __forceinline__ f32x4 idx_sub_lds2(const LAS unsigned char* tb, int u, const bf16x8 (&iq)[8][2], const bf16x8 (&cq)[2], const float (&wh)[8], int lane) {
    const bf16x8 a0 = *(const LAS bf16x8*)(tb + (u * 2 + 0) * 1024 + lane * 16), a1 = *(const LAS bf16x8*)(tb + (u * 2 + 1) * 1024 + lane * 16);
    f32x4 s[9];
#pragma unroll
    for (int h = 0; h < 8; ++h) s[h] = MFMA16(a0, iq[h][0], ((f32x4){0.f, 0.f, 0.f, 0.f}));
    s[8] = MFMA16(a0, cq[0], ((f32x4){0.f, 0.f, 0.f, 0.f}));
#pragma unroll
    for (int h = 0; h < 8; ++h) s[h] = MFMA16(a1, iq[h][1], s[h]);
    s[8] = MFMA16(a1, cq[1], s[8]);
    f32x4 acc = s[8];
#pragma unroll
    for (int h = 0; h < 8; ++h)
#pragma unroll
        for (int r = 0; r < 4; ++r) acc[r] = __builtin_fmaf(wh[h], __builtin_fabsf(s[h][r]), acc[r]);
    __builtin_amdgcn_sched_group_barrier(0x100, 2, 0);
    __builtin_amdgcn_sched_group_barrier(0x008, 18, 0);
    __builtin_amdgcn_sched_group_barrier(0x002, 32, 0);
    return acc;
}
struct IdxAcc { f32x4 s[9]; };
__device__ __forceinline__ IdxAcc idx_mfma_group(const LAS unsigned char* tb, int sub, const bf16x8 (&iq)[8][2], const bf16x8 (&cq)[2], int lane) {
    const LAS unsigned char* ab = tb + (sub >> 1) * 4096 + (sub & 1) * 2048 + lane * 16;
    const bf16x8 a0 = *(const LAS bf16x8*)ab, a1 = *(const LAS bf16x8*)(ab + 1024);
    IdxAcc r;
#pragma unroll
    for (int h = 0; h < 8; ++h) r.s[h] = MFMA16(a0, iq[h][0], ((f32x4){0.f, 0.f, 0.f, 0.f}));
    r.s[8] = MFMA16(a0, cq[0], ((f32x4){0.f, 0.f, 0.f, 0.f}));
#pragma unroll
    for (int h = 0; h < 8; ++h) r.s[h] = MFMA16(a1, iq[h][1], r.s[h]);
    r.s[8] = MFMA16(a1, cq[1], r.s[8]);
    return r;
}
__device__ __forceinline__ f32x4 idx_combine(const IdxAcc& a, const float (&wh)[8]) {
    f32x4 acc = a.s[8];
#pragma unroll
    for (int h = 0; h < 8; ++h)
#pragma unroll
        for (int r = 0; r < 4; ++r) acc[r] = __builtin_fmaf(wh[h], __builtin_fabsf(a.s[h][r]), acc[r]);
    return acc;
}
#define DSA_DMA_K(base, step, buf) __builtin_amdgcn_global_load_lds((const unsigned*)((base) + (size_t)(64 * (step) + dk_row) * 64 + dk_col), (LAS unsigned*)((buf) + wave * 1024), 16, 0, 0)
#define DSA_WAITBAR(N) asm volatile("s_waitcnt vmcnt(" #N ") lgkmcnt(0)\n\ts_barrier" ::: "memory")
#define DSA_LDS_ADDR(p) ((unsigned)(unsigned long long)(p))
#define DSA_PB1(i) (lds + L_MASK + ((i) & 3) * 8192)
#define DSA_PB2(i) (lds + (((i) & 2) ? L_STAGE : 49152) + ((i) & 1) * 8192)
#define DSA_PB3(i) (lds + L_HIST + ((i) & 3) * 16384)
#define DSA_DMA_V(base, step, buf) __builtin_amdgcn_global_load_lds((const unsigned*)((base) + (size_t)dv_row * KROWS + 64 * (step) + dv_col), (LAS unsigned*)((buf) + 8192 + wave * 1024), 16, 0, 0)

template <int NH>
__device__ __forceinline__ void dsa_sweep(LAS unsigned char* lds, int h0, const bf16* kcb, const bf16* vtb, const bf16* qrow, const float* qgain, bf16* yrow, int ns, int p, int pmin, int qloc, int wave, int lane) {
    DSA_OPAQUE(lane);
    const int ql = lane & 15, g4 = lane >> 4;
    const int dk_row = 32 * (wave >> 2) + 8 * (ql >> 2) + 4 * ((wave >> 1) & 1) + (ql & 3), dk_col = 32 * (wave & 1) + 8 * g4;
    const int dv_row = 16 * (wave & 3) + ql, dv_col = 32 * (wave >> 2) + 8 * g4;
    const LAS unsigned* MASK = (const LAS unsigned*)(lds + L_MASK); const LAS float* BIAS = (const LAS float*)(lds + L_BIAS);
    bf16x8 qf[NH][2];
#pragma unroll 1
    for (int pass_ = 0; pass_ < 1; ++pass_) {
#pragma unroll
      for (int hh = 0; hh < NH; ++hh) { v4u qv[2]; float ss = 0.f;
#pragma unroll
          for (int sx = 0; sx < 2; ++sx) { qv[sx] = *(const GAS v4u*)(qrow + 64 * (h0 + hh) + 32 * sx + 8 * g4);
#pragma unroll
              for (int e = 0; e < 4; ++e) { const float a = __uint_as_float(qv[sx][e] << 16), c = __uint_as_float(qv[sx][e] & 0xffff0000u); ss += a * a + c * c; } }
          ss = rows_sum(ss);
          const float scq = (1.f / sqrtf(ss * (1.f / 64.f) + 1e-6f)) * (0.125f * LOG2E);
#pragma unroll
          for (int sx = 0; sx < 2; ++sx) { const f32x4 g0 = *(const GAS f32x4*)(qgain + 32 * sx + 8 * g4), g1 = *(const GAS f32x4*)(qgain + 32 * sx + 8 * g4 + 4); v4u o;
#pragma unroll
              for (int e = 0; e < 4; ++e) { const float a = __uint_as_float(qv[sx][e] << 16), c = __uint_as_float(qv[sx][e] & 0xffff0000u);
                  const float ga = e < 2 ? g0[2 * e] : g1[2 * e - 4], gc = e < 2 ? g0[2 * e + 1] : g1[2 * e - 3]; o[e] = pkbf(a * scq * ga, c * scq * gc); }
              qf[hh][sx] = __builtin_bit_cast(bf16x8, o); } } }
    f32x4 oacc[NH][4]; float lsum[NH];
#pragma unroll
    for (int hh = 0; hh < NH; ++hh) { lsum[hh] = 0.f;
#pragma unroll
        for (int dt = 0; dt < 4; ++dt) oacc[hh][dt] = (f32x4){0.f, 0.f, 0.f, 0.f}; }
    DSA_DMA_K(kcb, 0, DSA_PB3(0)); DSA_DMA_V(vtb, 0, DSA_PB3(0));
    { const int s1 = ns > 1 ? 1 : ns - 1, s2 = ns > 2 ? 2 : ns - 1; DSA_DMA_K(kcb, s1, DSA_PB3(1)); DSA_DMA_V(vtb, s1, DSA_PB3(1)); DSA_DMA_K(kcb, s2, DSA_PB3(2)); DSA_DMA_V(vtb, s2, DSA_PB3(2)); }
    DSA_WAITBAR(4);
    for (int step = 0; step < ns; ++step) {
        { const int sn = step + 3 < ns ? step + 3 : ns - 1; DSA_DMA_K(kcb, sn, DSA_PB3(step + 3)); DSA_DMA_V(vtb, sn, DSA_PB3(step + 3)); }
        const LAS unsigned char* tb = DSA_PB3(step);
#pragma unroll 1
        for (int tt = 0; tt < 2; ++tt) { const int kt = 2 * step + tt; if (32 * kt > pmin + 15) continue;
            const unsigned mw = (MASK[qloc * DSA_MSTR + kt] >> (8 * g4)) & 0xffu;
            bf16x8 ka[2][2], vt[4];
#pragma unroll
            for (int u = 0; u < 2; ++u) { ka[u][0] = *(const LAS bf16x8*)(tb + tt * 4096 + (u * 2 + 0) * 1024 + lane * 16); ka[u][1] = *(const LAS bf16x8*)(tb + tt * 4096 + (u * 2 + 1) * 1024 + lane * 16); }
#pragma unroll
            for (int dt = 0; dt < 4; ++dt) vt[dt] = *(const LAS bf16x8*)(tb + 8192 + tt * 4096 + dt * 1024 + lane * 16);
            f32x4 cm[2];
#pragma unroll
            for (int u = 0; u < 2; ++u)
#pragma unroll
                for (int r = 0; r < 4; ++r) cm[u][r] = ((mw >> (4 * u + r)) & 1u) ? 0.f : -30000.f;
            const bool near = 32 * kt + 31 + 112 >= pmin;
#pragma unroll
            for (int hh = 0; hh < NH; ++hh) {
                f32x4 st[2]; st[0] = cm[0]; st[1] = cm[1];
                if (near) {
                    int d0 = p - (32 * kt + 8 * g4); d0 = d0 < 0 ? 0 : (d0 > 135 ? 135 : d0);
                    const LAS float* bt = BIAS + (h0 + hh) * 144 + 8 + d0 - 7;
#pragma unroll
                    for (int u = 0; u < 2; ++u)
#pragma unroll
                        for (int r = 0; r < 4; ++r) st[u][r] += bt[7 - (4 * u + r)]; }
#pragma unroll
                for (int u = 0; u < 2; ++u) { st[u] = MFMA16(ka[u][0], qf[hh][0], st[u]); st[u] = MFMA16(ka[u][1], qf[hh][1], st[u]); }
                float pe[8];
#pragma unroll
                for (int u = 0; u < 2; ++u)
#pragma unroll
                    for (int r = 0; r < 4; ++r) { pe[4 * u + r] = __builtin_amdgcn_exp2f(st[u][r]); lsum[hh] += pe[4 * u + r]; }
                const v4u pw = (v4u){pkbf(pe[0], pe[1]), pkbf(pe[2], pe[3]), pkbf(pe[4], pe[5]), pkbf(pe[6], pe[7])};
                const bf16x8 pf = __builtin_bit_cast(bf16x8, pw);
#pragma unroll
                for (int dt = 0; dt < 4; ++dt) oacc[hh][dt] = MFMA16(vt[dt], pf, oacc[hh][dt]);
            }
        }
        DSA_WAITBAR(4);
    }
#pragma unroll
    for (int hh = 0; hh < NH; ++hh) { float l = rows_sum(lsum[hh]); const float il = 1.f / l;
        bf16* yp = yrow + 64 * (h0 + hh) + 4 * g4;
#pragma unroll
        for (int dt = 0; dt < 4; ++dt) *(GAS u32x2v*)(yp + 16 * dt) = (u32x2v){pkbf(oacc[hh][dt][0] * il, oacc[hh][dt][1] * il), pkbf(oacc[hh][dt][2] * il, oacc[hh][dt][3] * il)}; }
}

__device__ __forceinline__ void dsa_gather(LAS unsigned char* gbuf, LAS unsigned char* lstb, const LAS float* BIAS, const bf16* kc, const bf16* vc, const unsigned short* lst,
                                           const LAS unsigned* qcnt  , const bf16* projq  , const float* qgain, bf16* y  , int p0  , int lane) {
    DSA_OPAQUE(lane);
    const int h = lane & 15, g4 = lane >> 4, hv = h & 7;
    f32x4 gq[2][2];
#pragma unroll
    for (int sx = 0; sx < 2; ++sx) { gq[sx][0] = *(const GAS f32x4*)(qgain + 32 * sx + 8 * g4); gq[sx][1] = *(const GAS f32x4*)(qgain + 32 * sx + 8 * g4 + 4); }
    u32x2v lwn = *(const GAS u32x2v*)(lst + 4 * lane); v4u qvn[2];
    { const bf16* qp = projq + 64 * hv + 8 * g4; qvn[0] = *(const GAS v4u*)qp; qvn[1] = *(const GAS v4u*)(qp + 32); }
#pragma unroll 1
    for (int qq = 0; qq < 16; ++qq) {
        const int pq = p0 + qq; int nsel = pq + 1 < 256 ? pq + 1 : 256; { const int nl = (int)qcnt[4 * qq]; nsel = nl < nsel ? nl : nsel; }
        nsel = __builtin_amdgcn_readfirstlane(nsel); const int nch = (nsel + 31) >> 5;
        { u32x2v lw = lwn;
          if (4 * lane + 0 >= nsel) lw[0] &= 0xffff0000u; if (4 * lane + 1 >= nsel) lw[0] &= 0x0000ffffu; if (4 * lane + 2 >= nsel) lw[1] &= 0xffff0000u; if (4 * lane + 3 >= nsel) lw[1] &= 0x0000ffffu;
          *(LAS u32x2v*)(lstb + 8 * lane) = lw; }
        bf16x8 qf[2];
        { v4u qv[2]; qv[0] = qvn[0]; qv[1] = qvn[1]; float ss = 0.f;
#pragma unroll
          for (int sx = 0; sx < 2; ++sx) {
#pragma unroll
              for (int e = 0; e < 4; ++e) { const float a = __uint_as_float(qv[sx][e] << 16), c = __uint_as_float(qv[sx][e] & 0xffff0000u); ss += a * a + c * c; } }
          ss = rows_sum(ss);
          const float scq = (1.f / sqrtf(ss * (1.f / 64.f) + 1e-6f)) * (0.125f * LOG2E);
#pragma unroll
          for (int sx = 0; sx < 2; ++sx) { const f32x4 g0 = gq[sx][0], g1 = gq[sx][1]; v4u o;
#pragma unroll
              for (int e = 0; e < 4; ++e) { const float a = __uint_as_float(qv[sx][e] << 16), c = __uint_as_float(qv[sx][e] & 0xffff0000u);
                  const float ga = e < 2 ? g0[2 * e] : g1[2 * e - 4], gc = e < 2 ? g0[2 * e + 1] : g1[2 * e - 3]; o[e] = pkbf(a * scq * ga, c * scq * gc); }
              qf[sx] = __builtin_bit_cast(bf16x8, o); } }
        LDS_WAIT(); asm volatile("" ::: "memory");
        f32x4 oacc[4]; float lsum = 0.f;
#pragma unroll
        for (int dt = 0; dt < 4; ++dt) oacc[dt] = (f32x4){0.f, 0.f, 0.f, 0.f};
#define DSA_GDMA(c, buf) do { _Pragma("unroll") for (int i = 0; i < 4; ++i) { const int r_ = 8 * i + (lane >> 3); unsigned ki_ = *(const LAS unsigned short*)(lstb + 2 * (32 * (c) + r_)); ki_ = ki_ < (unsigned)KROWS ? ki_ : 0u; \
            const int pc_ = (lane & 7) ^ (r_ & 7); \
            __builtin_amdgcn_global_load_lds((const unsigned*)(kc + (size_t)ki_ * 64 + 8 * pc_), (LAS unsigned*)((buf) + i * 1024), 16, 0, 0); \
            __builtin_amdgcn_global_load_lds((const unsigned*)(vc + (size_t)ki_ * 64 + 8 * pc_), (LAS unsigned*)((buf) + 4096 + i * 1024), 16, 0, 0); } } while (0)
        { unsigned k8[8]; const unsigned la_ = DSA_LDS_ADDR(lstb) + 2u * (unsigned)(lane >> 3); const int pc_ = (lane & 7) ^ (lane >> 3);
          asm volatile("ds_read_u16 %0, %8\n\tds_read_u16 %1, %8 offset:16\n\tds_read_u16 %2, %8 offset:32\n\tds_read_u16 %3, %8 offset:48\n\tds_read_u16 %4, %8 offset:64\n\tds_read_u16 %5, %8 offset:80\n\tds_read_u16 %6, %8 offset:96\n\tds_read_u16 %7, %8 offset:112\n\ts_waitcnt lgkmcnt(0)"
                       : "=&v"(k8[0]), "=&v"(k8[1]), "=&v"(k8[2]), "=&v"(k8[3]), "=&v"(k8[4]), "=&v"(k8[5]), "=&v"(k8[6]), "=&v"(k8[7]) : "v"(la_) : "memory");
#pragma unroll
          for (int cc = 0; cc < 2; ++cc) { if (cc < nch) {
#pragma unroll
              for (int i = 0; i < 4; ++i) { const unsigned ki_ = k8[4 * cc + i] < (unsigned)KROWS ? k8[4 * cc + i] : 0u;
                  __builtin_amdgcn_global_load_lds((const unsigned*)(kc + (size_t)ki_ * 64 + 8 * pc_), (LAS unsigned*)(gbuf + cc * 8192 + i * 1024), 16, 0, 0);
                  __builtin_amdgcn_global_load_lds((const unsigned*)(vc + (size_t)ki_ * 64 + 8 * pc_), (LAS unsigned*)(gbuf + cc * 8192 + 4096 + i * 1024), 16, 0, 0); } } } }
        __builtin_amdgcn_sched_barrier(0);
        { const int qn = qq < 15 ? qq + 1 : 15; lwn = *(const GAS u32x2v*)(lst + qn * 256 + 4 * lane); const bf16* qp = projq + (size_t)qn * DP2 + 64 * hv + 8 * g4; qvn[0] = *(const GAS v4u*)qp; qvn[1] = *(const GAS v4u*)(qp + 32); }
        __builtin_amdgcn_sched_barrier(0);
        const int qd = (lane >> 2) & 3, pp = lane & 3, R0 = 4 * g4 + qd, pcl = (lane & 7) ^ (lane >> 3);
        const unsigned gb0 = DSA_LDS_ADDR(gbuf), kof0 = (unsigned)(h * 128 + 16 * (g4 ^ (h & 7))), kof1 = (unsigned)(h * 128 + 16 * ((4 + g4) ^ (h & 7)));
        const unsigned vofb = (unsigned)(R0 * 128 + 8 * (pp & 1)), vsw = (unsigned)((pp >> 1) ^ (R0 & 7));
        const unsigned lsa = DSA_LDS_ADDR(lstb);
#pragma unroll 1
        for (int c = 0; c < nch; ++c) {
            if (c < 2) { if (c + 1 < nch) asm volatile("s_waitcnt vmcnt(11)" ::: "memory"); else asm volatile("s_waitcnt vmcnt(3)" ::: "memory"); }
            else { if (c + 1 < nch) asm volatile("s_waitcnt vmcnt(8)" ::: "memory"); else asm volatile("s_waitcnt vmcnt(0)" ::: "memory"); }
            const unsigned gb = gb0 + (unsigned)(c & 1) * 8192u;
            v4u kf[2][2]; u32x2v kiw[2], tv[4][2]; unsigned nk[4];
            { const unsigned ka0 = gb + kof0, ka1 = gb + kof1, va0 = gb + vofb + 16u * (vsw ^ 0u), va1 = gb + vofb + 16u * (vsw ^ 2u), va2 = gb + vofb + 16u * (vsw ^ 4u), va3 = gb + vofb + 16u * (vsw ^ 6u);
              const unsigned kwa = lsa + 2u * (unsigned)(32 * c + 4 * g4), nka = lsa + 2u * (unsigned)(32 * (c + 2) + (lane >> 3));
              asm volatile("ds_read_b128 %0, %18\n\tds_read_b128 %1, %19\n\tds_read_b128 %2, %18 offset:2048\n\tds_read_b128 %3, %19 offset:2048\n\tds_read_b64 %4, %24\n\tds_read_b64 %5, %24 offset:32\n\t"
                           TR_RD "%6, %20 offset:4096\n\t" TR_RD "%7, %20 offset:6144\n\t" TR_RD "%8, %21 offset:4096\n\t" TR_RD "%9, %21 offset:6144\n\t"
                           TR_RD "%10, %22 offset:4096\n\t" TR_RD "%11, %22 offset:6144\n\t" TR_RD "%12, %23 offset:4096\n\t" TR_RD "%13, %23 offset:6144\n\t"
                           "ds_read_u16 %14, %25\n\tds_read_u16 %15, %25 offset:16\n\tds_read_u16 %16, %25 offset:32\n\tds_read_u16 %17, %25 offset:48\n\ts_waitcnt lgkmcnt(0)"
                           : "=&v"(kf[0][0]), "=&v"(kf[0][1]), "=&v"(kf[1][0]), "=&v"(kf[1][1]), "=&v"(kiw[0]), "=&v"(kiw[1]),
                             "=&v"(tv[0][0]), "=&v"(tv[0][1]), "=&v"(tv[1][0]), "=&v"(tv[1][1]), "=&v"(tv[2][0]), "=&v"(tv[2][1]), "=&v"(tv[3][0]), "=&v"(tv[3][1]),
                             "=&v"(nk[0]), "=&v"(nk[1]), "=&v"(nk[2]), "=&v"(nk[3])
                           : "v"(ka0), "v"(ka1), "v"(va0), "v"(va1), "v"(va2), "v"(va3), "v"(kwa), "v"(nka) : "memory"); }
            if (c + 2 < nch) { LAS unsigned char* nb = gbuf + (c & 1) * 8192;
#pragma unroll
                for (int i = 0; i < 4; ++i) { const unsigned ki_ = nk[i] < (unsigned)KROWS ? nk[i] : 0u;
                    __builtin_amdgcn_global_load_lds((const unsigned*)(kc + (size_t)ki_ * 64 + 8 * pcl), (LAS unsigned*)(nb + i * 1024), 16, 0, 0);
                    __builtin_amdgcn_global_load_lds((const unsigned*)(vc + (size_t)ki_ * 64 + 8 * pcl), (LAS unsigned*)(nb + 4096 + i * 1024), 16, 0, 0); } }
            f32x4 st[2];
#pragma unroll
            for (int u = 0; u < 2; ++u) { st[u] = MFMA16(__builtin_bit_cast(bf16x8, kf[u][0]), qf[0], ((f32x4){0.f, 0.f, 0.f, 0.f})); st[u] = MFMA16(__builtin_bit_cast(bf16x8, kf[u][1]), qf[1], st[u]); }
            float bv[8];
#pragma unroll
            for (int u = 0; u < 2; ++u)
#pragma unroll
                for (int r = 0; r < 4; ++r) { const int ki = (int)((r & 1) ? kiw[u][r >> 1] >> 16 : kiw[u][r >> 1] & 0xffffu); int dd = pq - ki; dd = dd < 0 ? 0 : (dd > 135 ? 135 : dd);
                    bv[4 * u + r] = BIAS[hv * 144 + 8 + dd]; }
            float pe[8];
#pragma unroll
            for (int u = 0; u < 2; ++u)
#pragma unroll
                for (int r = 0; r < 4; ++r) { const float lg = (32 * c + 16 * u + 4 * g4 + r) < nsel ? st[u][r] + bv[4 * u + r] : -30000.f; pe[4 * u + r] = __builtin_amdgcn_exp2f(lg); lsum += pe[4 * u + r]; }
            const v4u pw = (v4u){pkbf(pe[0], pe[1]), pkbf(pe[2], pe[3]), pkbf(pe[4], pe[5]), pkbf(pe[6], pe[7])};
            const bf16x8 pf = __builtin_bit_cast(bf16x8, pw);
#pragma unroll
            for (int dt = 0; dt < 4; ++dt) oacc[dt] = MFMA16(tr_pack(tv[dt][0], tv[dt][1]), pf, oacc[dt]);
        }
#undef DSA_GDMA
        lsum = rows_sum(lsum);
        if (h < 8) { const float il = 1.f / lsum; bf16* yp = y + (size_t)qq * D + 64 * h + 4 * g4;
#pragma unroll
            for (int dt = 0; dt < 4; ++dt) *(GAS u32x2v*)(yp + 16 * dt) = (u32x2v){pkbf(oacc[dt][0] * il, oacc[dt][1] * il), pkbf(oacc[dt][2] * il, oacc[dt][3] * il)}; }
    }
}
__device__ __forceinline__ float wave_sum(float v) {
#pragma unroll
    for (int o = 1; o < 64; o <<= 1) v += __shfl_xor(v, o);
    return v;
}
__device__ __forceinline__ void p0_transpose_item(const float* W, int K, int N, int NP, bf16* WT, LAS float* scr, int item, int lane, const float* kscale = nullptr) {
    const int nblk = NP / 32, kb = item / nblk, nb = item % nblk, k0 = 64 * kb, n0 = 32 * nb;
    const int nn = n0 + (lane & 31); const bool ok = nn < N;
#pragma unroll 8
    for (int i = 0; i < 32; ++i) { const int kk = 2 * i + (lane >> 5); scr[kk * 33 + (lane & 31)] = ok ? W[(size_t)(k0 + kk) * N + nn] * (kscale ? kscale[k0 + kk] : 1.f) : 0.f; }
    LDS_WAIT(); asm volatile("" ::: "memory");
    const int c = lane & 7;
#pragma unroll
    for (int j = 0; j < 4; ++j) { const int n = (lane >> 3) + 8 * j; const LAS float* s = scr + (8 * c) * 33 + n;
        v4u o; o.x = pk2(s[0 * 33], s[1 * 33]); o.y = pk2(s[2 * 33], s[3 * 33]); o.z = pk2(s[4 * 33], s[5 * 33]); o.w = pk2(s[6 * 33], s[7 * 33]);
        *(GAS v4u*)(WT + (size_t)(n0 + n) * K + k0 + 8 * c) = o; }
    LDS_WAIT(); asm volatile("" ::: "memory");
}
__device__ __forceinline__ void rms_row_to_bf16(const float* xrow, const float* w, bf16* orow, int lane) {
    const GAS f32x4* xr = (const GAS f32x4*)xrow + lane; const GAS f32x4* wr = (const GAS f32x4*)w + lane;
    f32x4 v[4]; float s = 0.f;
#pragma unroll
    for (int j = 0; j < 4; ++j) { v[j] = xr[64 * j]; s += (v[j].x * v[j].x + v[j].y * v[j].y) + (v[j].z * v[j].z + v[j].w * v[j].w); }
    const float r = 1.f / sqrtf(wave_sum(s) * (1.f / D) + EPS);
    GAS unsigned long long* o8 = (GAS unsigned long long*)orow + lane;
#pragma unroll
    for (int j = 0; j < 4; ++j) { const f32x4 g = wr[64 * j];
        o8[64 * j] = (unsigned long long)pk2(v[j].x * r * g.x, v[j].y * r * g.y) | ((unsigned long long)pk2(v[j].z * r * g.z, v[j].w * r * g.w) << 32); }
}

__device__ __forceinline__ void rms_row2_to_bf16(const float* xa, const float* xb, const float* w, bf16* oa, bf16* ob, float* xsa, float* xsb, int lane) {
    const GAS f32x4* pa = (const GAS f32x4*)xa + lane; const GAS f32x4* pb = (const GAS f32x4*)xb + lane; const GAS f32x4* wr = (const GAS f32x4*)w + lane;
    f32x4 va[4], vb[4]; float sa = 0.f, sb = 0.f;
#pragma unroll
    for (int j = 0; j < 4; ++j) { va[j] = __builtin_nontemporal_load(pa + 64 * j); vb[j] = __builtin_nontemporal_load(pb + 64 * j); }
#pragma unroll
    for (int j = 0; j < 4; ++j) { sa += (va[j].x * va[j].x + va[j].y * va[j].y) + (va[j].z * va[j].z + va[j].w * va[j].w); sb += (vb[j].x * vb[j].x + vb[j].y * vb[j].y) + (vb[j].z * vb[j].z + vb[j].w * vb[j].w); }
    const float qa_ = sqrtf(wave_sum(sa) * (1.f / D) + EPS), qb_ = sqrtf(wave_sum(sb) * (1.f / D) + EPS); const float ra = 1.f / qa_, rb = 1.f / qb_;
    if (lane == 0) { *xsa = qa_; *xsb = qb_; }
    GAS unsigned long long* qa = (GAS unsigned long long*)oa + lane; GAS unsigned long long* qb = (GAS unsigned long long*)ob + lane;
#pragma unroll
    for (int j = 0; j < 4; ++j) { const f32x4 g = wr[64 * j];
        qa[64 * j] = (unsigned long long)pk2(va[j].x * ra * g.x, va[j].y * ra * g.y) | ((unsigned long long)pk2(va[j].z * ra * g.z, va[j].w * ra * g.w) << 32);
        qb[64 * j] = (unsigned long long)pk2(vb[j].x * rb * g.x, vb[j].y * rb * g.y) | ((unsigned long long)pk2(vb[j].z * rb * g.z, vb[j].w * rb * g.w) << 32); }
}

struct Args { const float* in[12]; float* out; unsigned char* ws; int ph_lo, ph_hi; };
__global__ void __launch_bounds__(NWAVES * 64, 2) mk_fwd(Args args) {
    extern __shared__ __attribute__((aligned(16))) unsigned char lds_raw[];
    LAS unsigned char* lds = (LAS unsigned char*)lds_raw;
    volatile LAS unsigned* MISC = (volatile LAS unsigned*)(lds + MISC_OFF);
    const int tid = threadIdx.x, lane = tid & 63, wave = __builtin_amdgcn_readfirstlane(tid >> 6);
    const int G = gridDim.x; const int bx = blockIdx.x; const int vcu = (G % 8 == 0) ? (bx % 8) * (G / 8) + bx / 8 : bx;
    unsigned char* ws = args.ws;
    gu32* ctl = (gu32*)(ws + WS_CTL);
    const float* x = args.in[0]; const float* meta = args.in[1]; const float* norm1_w = args.in[2]; const float* w_in = args.in[3];
    const float* ret_norm_w = args.in[4]; const float* q_norm_w = args.in[5]; const float* k_norm_w = args.in[6]; const float* rel_bias = args.in[7];
    const float* w_out = args.in[8]; const float* norm2_w = args.in[9]; const float* w_ff1 = args.in[10]; const float* w_ff2 = args.in[11];
    float* out = args.out;
    bf16* WIN_T = (bf16*)(ws + WS_WIN); bf16* WOUT_T = (bf16*)(ws + WS_WOUT); bf16* W1_T = (bf16*)(ws + WS_W1); bf16* W2_T = (bf16*)(ws + WS_W2);
    bf16* U = (bf16*)(ws + WS_U); bf16* PROJ = (bf16*)(ws + WS_PROJ); bf16* Y = (bf16*)(ws + WS_Y); bf16* HB = (bf16*)(ws + WS_H);
    float* ROPE = (float*)(ws + WS_ROPE); float* PMETA = (float*)(ws + WS_PMETA); bf16* PM16 = (bf16*)(ws + WS_PMETA + 512 * 1024); bf16* SPT = (bf16*)(ws + WS_SPT);
    float* XS = (float*)(ws + WS_CTL + 768 * 1024);
    float* SSQ = (float*)(ws + WS_CTL + 512 * 1024);
    bf16* KC = (bf16*)(ws + WS_KC); bf16* IKC = (bf16*)(ws + WS_IKC); bf16* VT = (bf16*)(ws + WS_VT); bf16* VC = (bf16*)(ws + WS_QN + 32 * MiB); unsigned short* LISTG = (unsigned short*)(ws + WS_LIST); bf16* RET = (bf16*)(ws + WS_RET);
    for (int u = tid; u < (LDS_BYTES - LDSCTL_OFF) / 4; u += NWAVES * 64) ((LAS unsigned*)(lds + LDSCTL_OFF))[u] = 0u;
    __syncthreads();
    XcdBarrier bar; bar.bar = (unsigned*)(ctl + CW_BAR); bar.x = 0; bar.st = nullptr;
    if (ONE_LAUNCH) bar = xcd_barrier_post((unsigned*)(ctl + CW_BAR), MISC + 8);
#define GRID_BAR() do { if (ONE_LAUNCH) xcd_barrier(bar); } while (0)
    const int lo = args.ph_lo, hi = args.ph_hi;
#define IN(k) (lo <= (k) && (k) < hi)
#define BOTH(k) (IN(k) && IN((k) + 1 + ((k) == 4)))
    const int gw = vcu * NWAVES + wave, NGW = G * NWAVES;

    if (IN(0)) {
        LAS float* scr = (LAS float*)(lds + RING_OFF + wave * 16384);
        constexpr int I_IN = (D / 64) * (DINP / 32), I_O = (D / 64) * (D / 32), I_1 = (D / 64) * (FF / 32), I_2 = (FF / 64) * (D / 32);
        constexpr int NITEMS = I_IN + I_O + I_1 + I_2;
        for (int it = gw; it < NITEMS; it += NGW) {
            int r = it;
            if (r < I_IN) { p0_transpose_item(w_in, D, DIN, DINP, WIN_T, scr, r, lane); continue; } r -= I_IN;
            if (r < I_O) { p0_transpose_item(w_out, D, D, D, WOUT_T, scr, r, lane); continue; } r -= I_O;
            if (r < I_1) { p0_transpose_item(w_ff1, D, FF, FF, W1_T, scr, r, lane, norm2_w); continue; } r -= I_1;
            p0_transpose_item(w_ff2, FF, D, D, W2_T, scr, r, lane);
        }
        for (int m = gw; m < M; m += 2 * NGW) rms_row2_to_bf16(x + (size_t)m * D, x + (size_t)(m + NGW) * D, norm1_w, U + (size_t)m * D, U + (size_t)(m + NGW) * D, XS + m, XS + m + NGW, lane);

        for (int i = bx * 512 + tid; i < TK * 64; i += G * 512) {
            const int t = i >> 6, fi = i & 63;
            const double inv = exp2(-(double)fi * (13.287712379549449 / 64.0));
            const double ang = (double)t * inv;
            const double nrev = rint(ang * 0.15915494309189535);
            double r = fma(-nrev, 6.283185307179586, ang); r = fma(-nrev, 2.4492935982947064e-16, r);
            const double r2 = r * r; double sn = 1.0, cn = 1.0;
#pragma unroll
            for (int k = 12; k >= 1; --k) { sn = 1.0 - r2 / (double)((2 * k) * (2 * k + 1)) * sn; cn = 1.0 - r2 / (double)((2 * k - 1) * (2 * k)) * cn; }
            sn *= r;
            ((GAS f32x2v*)ROPE)[i] = (f32x2v){(float)cn, (float)sn};
        }
        for (int i = bx * 512 + tid; i < 112 * DINP * 2 / 16; i += G * 512) ((GAS v4u*)PM16)[i] = (v4u){0u, 0u, 0u, 0u};
        {
            __syncthreads();
            LAS float* un = (LAS float*)(lds + RING_OFF);
            LAS float* red = (LAS float*)(lds + RING_OFF + 16 * 1025 * 4);
#pragma unroll
            for (int rr = 0; rr < 2; ++rr) { const int r = 2 * wave + rr; const GAS f32x4* xr = (const GAS f32x4*)(meta + (size_t)r * D) + lane; const GAS f32x4* wr = (const GAS f32x4*)norm1_w + lane;
                f32x4 v[4]; float s = 0.f;
#pragma unroll
                for (int j = 0; j < 4; ++j) { v[j] = xr[64 * j]; s += (v[j].x * v[j].x + v[j].y * v[j].y) + (v[j].z * v[j].z + v[j].w * v[j].w); }
                const float ri = 1.f / sqrtf(wave_sum(s) * (1.f / D) + EPS);
#pragma unroll
                for (int j = 0; j < 4; ++j) { const f32x4 g = wr[64 * j]; const int k = 4 * lane + 256 * j;
                    un[r * 1025 + k] = v[j].x * ri * g.x; un[r * 1025 + k + 1] = v[j].y * ri * g.y; un[r * 1025 + k + 2] = v[j].z * ri * g.z; un[r * 1025 + k + 3] = v[j].w * ri * g.w; } }
            __syncthreads();
            const int c0 = 13 * vcu; float acc[13];
#pragma unroll
            for (int cc = 0; cc < 13; ++cc) acc[cc] = 0.f;
            for (int i = 0; i < 32; ++i) { const int k = 128 * wave + (lane >> 4) + 4 * i; const float uv = un[(lane & 15) * 1025 + k]; const float* wp = w_in + (size_t)k * DIN + c0;
#pragma unroll
                for (int cc = 0; cc < 13; ++cc) { const float wv = (c0 + cc < DIN) ? wp[cc] : 0.f; acc[cc] = fmaf(uv, wv, acc[cc]); } }
#pragma unroll
            for (int cc = 0; cc < 13; ++cc) { acc[cc] += __shfl_xor(acc[cc], 16); acc[cc] += __shfl_xor(acc[cc], 32); if (lane < 16) red[(wave * 16 + lane) * 13 + cc] = acc[cc]; }
            __syncthreads();
            if (tid < 208) { const int r = tid / 13, cc = tid % 13; float s = 0.f;
#pragma unroll
                for (int w8 = 0; w8 < 8; ++w8) s += red[(w8 * 16 + r) * 13 + cc];
                const int c = c0 + cc; if (c >= DIN) s = 0.f;
                PMETA[r * DINP + c] = s; PM16[(size_t)(112 + r) * DINP + c] = (bf16)f2bf(s); }
            __syncthreads();
        }
        if (BOTH(0)) GRID_BAR();
    }
    if (IN(1)) {
        pg8::Gemm g{U, WIN_T, M, DINP, D}; pg8::StaticOrder S; S.init(M, DINP, G, (int)blockIdx.x);
        pg8::EpiProj E{PROJ, DP2, RET, M};
        pg8::gemm_phase<pg8::EpiProj, pg8::StaticOrder, true, true>(lds + RING_OFF, g, S, E);
        if (BOTH(1)) GRID_BAR();
    }
    if (IN(2)) {
        {
            LAS unsigned char* vscr = lds + RING_OFF + 65536 + wave * 1024;
            const int r = lane >> 3, sub = lane & 7;
            const f32x4 kg0 = *(const GAS f32x4*)(k_norm_w + 8 * sub), kg1 = *(const GAS f32x4*)(k_norm_w + 8 * sub + 4);
            for (int unit = gw; unit < BATCH * 520; unit += NGW) {
                const int b = unit / 520, gidx = unit % 520; const bool isx = gidx >= 2 && gidx < 514, ismeta = gidx < 2;
                const bf16* src = ismeta ? PM16 + (size_t)(112 + 8 * gidx + r) * DINP + 2048 : PROJ + ((size_t)b * SEQ + (isx ? 8 * (gidx - 2) + r : 0)) * DP2;
                const size_t krow = ((size_t)b * KROWS + 8 * gidx + r) * 64 + 8 * sub;
                v4u kv = (v4u){0u, 0u, 0u, 0u}, iv = kv, vv = kv;
                if (isx || ismeta) { kv = *(const GAS v4u*)(src + C2_DK + 8 * sub); iv = *(const GAS v4u*)(src + C2_IK + 8 * sub); vv = *(const GAS v4u*)(src + C2_DV + 8 * sub); }
                float xk[8]; float sk = 0.f;
#pragma unroll
                for (int i = 0; i < 4; ++i) { xk[2 * i] = __uint_as_float(kv[i] << 16); xk[2 * i + 1] = __uint_as_float(kv[i] & 0xffff0000u); sk += xk[2 * i] * xk[2 * i] + xk[2 * i + 1] * xk[2 * i + 1]; }
                sk += __shfl_xor(sk, 1); sk += __shfl_xor(sk, 2); sk += __shfl_xor(sk, 4);
                const float sck = 1.f / sqrtf(sk * (1.f / 64.f) + EPS);
                *(GAS v4u*)(KC + krow) = (v4u){pkbf(xk[0] * sck * kg0[0], xk[1] * sck * kg0[1]), pkbf(xk[2] * sck * kg0[2], xk[3] * sck * kg0[3]), pkbf(xk[4] * sck * kg1[0], xk[5] * sck * kg1[1]), pkbf(xk[6] * sck * kg1[2], xk[7] * sck * kg1[3])};
                *(GAS v4u*)(IKC + krow) = iv;
                *(GAS v4u*)(VC + krow) = vv;
                *(LAS v4u*)(vscr + lane * 16) = vv;
                LDS_WAIT(); asm volatile("" ::: "memory");
                { const LAS unsigned short* vs = (const LAS unsigned short*)vscr + lane; v4u o;
#pragma unroll
                  for (int i = 0; i < 4; ++i) o[i] = (unsigned)vs[(2 * i) * 64] | ((unsigned)vs[(2 * i + 1) * 64] << 16);
                  *(GAS v4u*)(VT + ((size_t)b * 64 + lane) * KROWS + 8 * gidx) = o; }
                LDS_WAIT(); asm volatile("" ::: "memory");
            }
            __syncthreads();
        }
        if (vcu < 256) {
            const int b = vcu >> 4, h = (vcu >> 2) & 3, dq = vcu & 3;
            const float lg2 = log2f(1.f - exp2f(-5.f - (float)h));
            const float cdec = exp2f(lg2 * 128.f);
            LAS unsigned char* Kimg = lds + 3 * 40960;
            f32x4 acc[2]; acc[0] = (f32x4){0.f, 0.f, 0.f, 0.f}; acc[1] = acc[0];
            f32x4 rc[4], rc1[4], rstep[4];
            { const int c = (tid >> 1) & 127, jh = tid & 1; int t0 = c - 112; t0 = t0 < 0 ? 0 : t0; const int t1 = 16 + c;
              const GAS f32x4* r0 = (const GAS f32x4*)(ROPE + ((size_t)t0 * 64 + 16 * dq + 8 * jh) * 2); const GAS f32x4* r1 = (const GAS f32x4*)(ROPE + ((size_t)t1 * 64 + 16 * dq + 8 * jh) * 2);
              const GAS f32x4* rs = (const GAS f32x4*)(ROPE + ((size_t)128 * 64 + 16 * dq + 8 * jh) * 2);
#pragma unroll
              for (int i = 0; i < 4; ++i) { rc[i] = r0[i]; rc1[i] = r1[i]; rstep[i] = rs[i]; } }
            const float ksc0 = RET_KSCALE * exp2f(lg2 * (float)(127 - ((tid >> 1) & 127)));
#define R12_DMA(n, slot) do { const bool m0_ = (n) == 0; const size_t rs_ = m0_ ? (size_t)DINP : (size_t)128;     \
                const bf16* kb_ = m0_ ? PM16 + C_RK + 128 * h : RET + ((size_t)(4 + h) * M + (size_t)b * SEQ + 128 * ((n) - 1)) * 128; const bf16* vb_ = m0_ ? PM16 + C_RV + 128 * h : RET + ((size_t)(8 + h) * M + (size_t)b * SEQ + 128 * ((n) - 1)) * 128; \
                _Pragma("unroll") for (int i = 0; i < 4; ++i) __builtin_amdgcn_global_load_lds((const unsigned*)(vb_ + (size_t)(16 * wave + 4 * i + (lane >> 4)) * rs_ + 8 * ((lane & 15) ^ (2 * (lane >> 4)))), (LAS unsigned*)(lds + (slot) * 40960 + (4 * wave + i) * 1024), 16, 0, 0); \
                __builtin_amdgcn_global_load_lds((const unsigned*)(kb_ + (size_t)(16 * wave + (lane >> 2)) * rs_ + 64 * ((lane >> 1) & 1) + 16 * dq + 8 * (lane & 1)), (LAS unsigned*)(lds + (slot) * 40960 + 32768 + wave * 1024), 16, 0, 0); } while (0)
            R12_DMA(0, 0); R12_DMA(1, 1); R12_DMA(2, 2);
            asm volatile("s_waitcnt vmcnt(0)" ::: "memory"); __syncthreads();
            const unsigned kimg_a0 = DSA_LDS_ADDR(Kimg + ((tid >> 1) & 127) * 64 + 16 * (tid & 1));
            const unsigned trk_a = DSA_LDS_ADDR(Kimg + (8 * (lane >> 4) + ((lane >> 2) & 3)) * 64 + 8 * (lane & 3));
            const unsigned trv_off = (unsigned)((8 * (lane >> 4) + ((lane >> 2) & 3)) * 256 + 16 * ((2 * wave + ((lane & 3) >> 1)) ^ (2 * ((lane >> 2) & 3))) + 8 * (lane & 1));
#pragma unroll 1
            for (int n = 0; n < 32; ++n) {
                const LAS unsigned char* slot = lds + (n % 3) * 40960;
                const unsigned slot_a = DSA_LDS_ADDR(slot);
                if (tid < 256) {
                    if (n == 1) {
#pragma unroll
                        for (int i = 0; i < 4; ++i) rc[i] = rc1[i]; }
                    else if (n > 1) {
#pragma unroll
                        for (int i = 0; i < 4; ++i) { const f32x4 a = rc[i], st = rstep[i];
                            rc[i] = (f32x4){a[0] * st[0] - a[1] * st[1], a[1] * st[0] + a[0] * st[1], a[2] * st[2] - a[3] * st[3], a[3] * st[2] + a[2] * st[3]}; } }
                    const LAS unsigned char* rp = slot + 32768 + (tid >> 1) * 64 + 16 * (tid & 1); v4u o1, o2;
                    rot8(*(const LAS v4u*)rp, *(const LAS v4u*)(rp + 32), rc, ksc0, o1, o2);
                    asm volatile("ds_write_b128 %0, %1\n\tds_write_b128 %0, %2 offset:32" :: "v"(kimg_a0), "v"(o1), "v"(o2) : "memory"); }
                asm volatile("s_waitcnt lgkmcnt(0)\n\ts_barrier" ::: "memory");
                acc[0] = acc[0] * cdec; acc[1] = acc[1] * cdec;
                { const unsigned va_ = slot_a + trv_off;
#pragma unroll
                  for (int kp = 0; kp < 2; ++kp) { u32x2v t[12];
                      if (kp == 0) asm volatile(TR_RD "%0, %12\n\t" TR_RD "%1, %12 offset:256\n\t" TR_RD "%2, %12 offset:32\n\t" TR_RD "%3, %12 offset:288\n\t" TR_RD "%4, %13\n\t" TR_RD "%5, %13 offset:1024\n\t"
                                                TR_RD "%6, %12 offset:2048\n\t" TR_RD "%7, %12 offset:2304\n\t" TR_RD "%8, %12 offset:2080\n\t" TR_RD "%9, %12 offset:2336\n\t" TR_RD "%10, %13 offset:8192\n\t" TR_RD "%11, %13 offset:9216\n\ts_waitcnt lgkmcnt(0)"
                                                : "=&v"(t[0]), "=&v"(t[1]), "=&v"(t[2]), "=&v"(t[3]), "=&v"(t[4]), "=&v"(t[5]), "=&v"(t[6]), "=&v"(t[7]), "=&v"(t[8]), "=&v"(t[9]), "=&v"(t[10]), "=&v"(t[11]) : "v"(trk_a), "v"(va_) : "memory");
                      else asm volatile(TR_RD "%0, %12 offset:4096\n\t" TR_RD "%1, %12 offset:4352\n\t" TR_RD "%2, %12 offset:4128\n\t" TR_RD "%3, %12 offset:4384\n\t" TR_RD "%4, %13 offset:16384\n\t" TR_RD "%5, %13 offset:17408\n\t"
                                        TR_RD "%6, %12 offset:6144\n\t" TR_RD "%7, %12 offset:6400\n\t" TR_RD "%8, %12 offset:6176\n\t" TR_RD "%9, %12 offset:6432\n\t" TR_RD "%10, %13 offset:24576\n\t" TR_RD "%11, %13 offset:25600\n\ts_waitcnt lgkmcnt(0)"
                                        : "=&v"(t[0]), "=&v"(t[1]), "=&v"(t[2]), "=&v"(t[3]), "=&v"(t[4]), "=&v"(t[5]), "=&v"(t[6]), "=&v"(t[7]), "=&v"(t[8]), "=&v"(t[9]), "=&v"(t[10]), "=&v"(t[11]) : "v"(trk_a), "v"(va_) : "memory");
#pragma unroll
                      for (int kk = 0; kk < 2; ++kk) { const bf16x8 a0 = tr_pack(t[6 * kk], t[6 * kk + 1]), a1 = tr_pack(t[6 * kk + 2], t[6 * kk + 3]), bv = tr_pack(t[6 * kk + 4], t[6 * kk + 5]);
                          acc[0] = MFMA16(a0, bv, acc[0]); acc[1] = MFMA16(a1, bv, acc[1]); } } }
                bf16* sp = SPT + ((size_t)((b * 4 + h) * 32 + n)) * 16384;
#pragma unroll
                for (int dt = 0; dt < 2; ++dt) { const int e = 16 * wave + (lane & 15), d = 64 * dt + 16 * dq + 4 * (lane >> 4);
                    *(GAS u32x2v*)(sp + e * 128 + d) = (u32x2v){pkbf(acc[dt][0], acc[dt][1]), pkbf(acc[dt][2], acc[dt][3])}; }
                asm volatile("s_waitcnt vmcnt(9) lgkmcnt(0)\n\ts_barrier" ::: "memory");
                { const int nn = n + 3 < 32 ? n + 3 : 31; R12_DMA(nn, n % 3); }
            }
            asm volatile("s_waitcnt vmcnt(0)" ::: "memory"); __syncthreads();
#undef R12_DMA
        }
        if (BOTH(2)) GRID_BAR();
    }
    if (IN(3)) {
        {
            for (int i = tid; i < 8 * 144; i += 512) { const int h = i / 144, d = i % 144 - 8; float v = 0.f;
                if (d >= 0 && d < 113) { int bk = d; if (d >= 16) { bk = 16 + (int)(logf((float)d * (1.f / 16.f)) / logf(8.f) * 16.f); bk = bk > 31 ? 31 : bk; } v = (rel_bias[bk * 8 + h] - rel_bias[31 * 8 + h]) * LOG2E; }
                ((LAS float*)(lds + L_BIAS))[i] = v; }
            __syncthreads();
            LAS unsigned* HIST = (LAS unsigned*)(lds + L_HIST); LAS unsigned* MASK = (LAS unsigned*)(lds + L_MASK); LAS unsigned* QPAR = (LAS unsigned*)(lds + L_QPAR);
            LAS unsigned* CCNT = (LAS unsigned*)(lds + L_CCNT); const LAS float* BIAS = (const LAS float*)(lds + L_BIAS);
            LAS unsigned char* STG = lds + L_STAGE;
            LAS unsigned char* STG3 = lds + L_HIST;
            const int ql = lane & 15, g4 = lane >> 4;
            const int dk_row = 32 * (wave >> 2) + 8 * (ql >> 2) + 4 * ((wave >> 1) & 1) + (ql & 3), dk_col = 32 * (wave & 1) + 8 * g4;
            const int dv_row = 16 * (wave & 3) + ql, dv_col = 32 * (wave >> 2) + 8 * g4;
            const int xq = vcu >> 5;
            for (;;) {
                if (vcu >= 256) break;
                if (tid == 0) MISC[4] = __hip_atomic_fetch_add(ctl + 2048 + 64 * xq, 1u, __ATOMIC_RELAXED, __HIP_MEMORY_SCOPE_AGENT);
                __syncthreads();
                const int uq = (int)MISC[4];
                __syncthreads();
                if (uq >= 64) break;
                const int b = 2 * xq + (uq >> 5), j = 31 - (uq & 31);
                const int nt = 5 + 4 * j, ns = (nt + 1) >> 1;
                const int qloc = 16 * wave + ql;
                const size_t mrow = (size_t)b * SEQ + 128 * j + qloc;
                const int p = 16 + 128 * j + qloc;
                const int pmaxw = 16 + 128 * j + 16 * wave + 15;
                const bf16* ikb = IKC + (size_t)b * KROWS * 64; const bf16* kcb = KC + (size_t)b * KROWS * 64; const bf16* vtb = VT + (size_t)b * 64 * KROWS; const bf16* vcb = VC + (size_t)b * KROWS * 64;
                unsigned char* tqb = (b < 15 ? (unsigned char*)out + (size_t)b * (17u << 20) : ws + WS_QN) + (size_t)(j * j + 2 * j) * 16384 + wave * 1024 + lane * 16;
                LAS unsigned* hrow = HIST + qloc * 128;
                bf16x8 iq[8][2], cq[2]; float wh[8];
                { const bf16* rp = PROJ + mrow * DP2 + C2_IQ + 8 * g4;
#pragma unroll
                  for (int h = 0; h < 8; ++h) { iq[h][0] = *(const GAS bf16x8*)(rp + 64 * h); iq[h][1] = *(const GAS bf16x8*)(rp + 64 * h + 32); }
                  const v4u wv = *(const GAS v4u*)(PROJ + mrow * DP2 + C2_IW);
#pragma unroll
                  for (int i = 0; i < 4; ++i) { wh[2 * i] = __uint_as_float(wv[i] << 16) * (0.5f * 0.35355339059327373f * 0.125f); wh[2 * i + 1] = __uint_as_float(wv[i] & 0xffff0000u) * (0.5f * 0.35355339059327373f * 0.125f); }
#pragma unroll
                  for (int sx = 0; sx < 2; ++sx) { float ca[8];
#pragma unroll
                      for (int e = 0; e < 8; ++e) ca[e] = 0.f;
#pragma unroll
                      for (int h = 0; h < 8; ++h) { const v4u qv = __builtin_bit_cast(v4u, iq[h][sx]);
#pragma unroll
                          for (int e = 0; e < 4; ++e) { ca[2 * e] = __builtin_fmaf(wh[h], __uint_as_float(qv[e] << 16), ca[2 * e]); ca[2 * e + 1] = __builtin_fmaf(wh[h], __uint_as_float(qv[e] & 0xffff0000u), ca[2 * e + 1]); } }
                      const v4u cw = (v4u){pkbf(ca[0], ca[1]), pkbf(ca[2], ca[3]), pkbf(ca[4], ca[5]), pkbf(ca[6], ca[7])}; cq[sx] = __builtin_bit_cast(bf16x8, cw); } }
                float lo, invw, binc;
                { float s1 = 0.f, s2 = 0.f;
                  int lane_p0 = lane; DSA_OPAQUE(lane_p0);
                  for (int kt = 0; kt < 2; ++kt) { f32x4 sc[2]; idx_tile(ikb, kt, iq, cq, wh, lane_p0, sc);
#pragma unroll
                      for (int u = 0; u < 2; ++u)
#pragma unroll
                          for (int r = 0; r < 4; ++r) { s1 += sc[u][r]; s2 += sc[u][r] * sc[u][r]; } }
                  s1 = rows_sum(s1); s2 = rows_sum(s2);
                  const float mean = s1 * (1.f / 64.f); float var = s2 * (1.f / 64.f) - mean * mean; var = var > 1e-30f ? var : 1e-30f;
                  const float sd = sqrtf(var); lo = mean - 3.f * sd; invw = 256.f * (float)DSA_NB / (6.f * sd); binc = -lo * invw; }
                { LAS v4u* hz = (LAS v4u*)(HIST + 16 * wave * 128);
#pragma unroll
                  for (int i = 0; i < 8; ++i) hz[lane + 64 * i] = (v4u){0u, 0u, 0u, 0u}; }
                __syncthreads();
                DSA_DMA_K(ikb, 0, DSA_PB1(0)); DSA_DMA_K(ikb, ns > 1 ? 1 : ns - 1, DSA_PB1(1)); DSA_DMA_K(ikb, ns > 2 ? 2 : ns - 1, DSA_PB1(2));
                DSA_WAITBAR(2);
                { const unsigned hbase = DSA_LDS_ADDR(hrow); unsigned one_v = 1u; DSA_OPAQUE(one_v);
                for (int step = 0; step < ns; ++step) {
                    { const int sn = step + 3 < ns ? step + 3 : ns - 1; DSA_DMA_K(ikb, sn, DSA_PB1(step + 3)); }
                    const LAS unsigned char* tb = DSA_PB1(step);
#pragma unroll 1
                    for (int tt = 0; tt < 2; ++tt) { const int kt = 2 * step + tt; unsigned tqv[4], tqp[4]; if (32 * kt > pmaxw) continue;
                        if (32 * kt + 31 <= pmaxw - 15) {
#pragma unroll
                        for (int u = 0; u < 2; ++u) { const f32x4 scu = idx_sub_lds2(tb + tt * 4096, u, iq, cq, wh, lane);
#pragma unroll
                            for (int r = 0; r < 4; ++r) {
                                const unsigned tq = (unsigned)(int)__builtin_amdgcn_fmed3f(bin_t(scu[r], binc, invw), 0.f, 32767.f);
                                asm volatile("ds_add_u32 %0, %1" :: "v"(hbase | ((tq >> 6) & 0x1fcu)), "v"(one_v) : "memory");
                                tqv[r] = tq; }
                            tqp[2 * u] = tqv[0] | (tqv[1] << 16); tqp[2 * u + 1] = tqv[2] | (tqv[3] << 16);
                            __builtin_amdgcn_sched_barrier(0); }
                        *(GAS v4u*)(tqb + (size_t)kt * 8192) = (v4u){tqp[0], tqp[1], tqp[2], tqp[3]};
                        } else {
#pragma unroll
                        for (int u = 0; u < 2; ++u) { const f32x4 scu = idx_sub_lds2(tb + tt * 4096, u, iq, cq, wh, lane);
#pragma unroll
                            for (int r = 0; r < 4; ++r) { const int kk = 32 * kt + 8 * g4 + 4 * u + r; const bool causal = kk <= p;
                                const unsigned tq = (unsigned)(int)__builtin_amdgcn_fmed3f(bin_t(scu[r], binc, invw), 0.f, 32767.f);
                                asm volatile("ds_add_u32 %0, %1" :: "v"(hbase | ((tq >> 6) & 0x1fcu)), "v"(causal ? 1u : 0u) : "memory");
                                tqv[r] = causal ? tq : 0xffffu; }
                            tqp[2 * u] = tqv[0] | (tqv[1] << 16); tqp[2 * u + 1] = tqv[2] | (tqv[3] << 16);
                            __builtin_amdgcn_sched_barrier(0); }
                        *(GAS v4u*)(tqb + (size_t)kt * 8192) = (v4u){tqp[0], tqp[1], tqp[2], tqp[3]}; } }
                    DSA_WAITBAR(2);
                } }
#pragma unroll 1
                for (int qq = 0; qq < 16; ++qq) { const int q = 16 * wave + qq; const int pq = 16 + 128 * j + q; const int kq = pq + 1 < 256 ? pq + 1 : 256;
                    const u32x2v wv = *(const LAS u32x2v*)(HIST + q * 128 + 2 * lane);
                    const int c0 = (int)wv[0], c1 = (int)wv[1]; const int sl = c0 + c1;
                    int pre = sl;
                    pre += __builtin_amdgcn_update_dpp(0, pre, 0x111, 0xf, 0xf, true); pre += __builtin_amdgcn_update_dpp(0, pre, 0x112, 0xf, 0xf, true);
                    pre += __builtin_amdgcn_update_dpp(0, pre, 0x114, 0xf, 0xf, true); pre += __builtin_amdgcn_update_dpp(0, pre, 0x118, 0xf, 0xf, true);
                    pre += __builtin_amdgcn_update_dpp(0, pre, 0x142, 0xa, 0xf, false); pre += __builtin_amdgcn_update_dpp(0, pre, 0x143, 0xc, 0xf, false);
                    int cum = __builtin_amdgcn_readlane(pre, 63) - pre; int bst = -1, ngt = 0;
                    if (cum < kq && cum + c1 >= kq) { bst = 2 * lane + 1; ngt = cum; } cum += c1;
                    if (cum < kq && cum + c0 >= kq) { bst = 2 * lane + 0; ngt = cum; }
                    if (bst >= 0) { QPAR[q * 4 + 0] = (unsigned)bst; QPAR[q * 4 + 1] = (unsigned)(kq - ngt); } }
                LDS_WAIT(); asm volatile("" ::: "memory");
                const int bstar = (int)QPAR[qloc * 4 + 0];
                int ccnt = 0;
                const unsigned cbase = DSA_LDS_ADDR(lds + L_HIST + qloc * 256), mbase = DSA_LDS_ADDR(MASK + qloc * DSA_MSTR);
                const int thi16 = (bstar + 1) << 8;
                __syncthreads();
                { v4u tw[4];
#pragma unroll
                  for (int i = 0; i < 4; ++i) tw[i] = *(const GAS v4u*)(tqb + (size_t)(i < 2 * ns ? i : 0) * 8192);
                  for (int kt0 = 0; kt0 < 2 * ns; kt0 += 4) {
#pragma unroll
                    for (int i = 0; i < 4; ++i) { const int kt = kt0 + i; if (kt < 2 * ns && 32 * kt <= pmaxw) {
                        const v4u cw = tw[i]; { const int kn = kt + 4 < 2 * ns ? kt + 4 : kt; tw[i] = *(const GAS v4u*)(tqb + (size_t)kn * 8192); }
                        unsigned bits = 0u;
#pragma unroll
                        for (int e = 0; e < 8; ++e) { const unsigned tq = (e & 1) ? cw[e >> 1] >> 16 : cw[e >> 1] & 0xffffu; const int kk = 32 * kt + 8 * g4 + e;
                            bits |= (int)(short)tq >= thi16 ? 1u << (8 * g4 + e) : 0u;
                            const bool cand = (int)(tq >> 8) == bstar; const unsigned long long m = __ballot(cand);
                            if (m) {
                                const unsigned long long mq = (m >> ql) & 0x0001000100010001ull;
                                const int rank = __popcll(mq & ((1ull << (16 * g4)) - 1ull)), tot = __popcll(mq);
                                if (cand) { const int slot = ccnt + rank; if (slot < DSA_CAP) asm volatile("ds_write_b32 %0, %1" :: "v"(cbase + 4u * (unsigned)slot), "v"((tq << 16) | (0xffffu - (unsigned)kk)) : "memory"); }
                                ccnt += tot; } }
                        bits = rows_or(bits);
                        if (g4 == 0) asm volatile("ds_write_b32 %0, %1" :: "v"(mbase + 4u * (unsigned)kt), "v"(bits) : "memory"); } }
                  } }
                if (g4 == 0) CCNT[qloc] = (unsigned)ccnt;
                LDS_WAIT(); asm volatile("" ::: "memory");
#pragma unroll 1
                for (int qq = 0; qq < 16; ++qq) { const int q = 16 * wave + qq;
                    int cnt = (int)CCNT[q]; cnt = cnt < DSA_CAP ? cnt : DSA_CAP; cnt = __builtin_amdgcn_readfirstlane(cnt);
                    const int need = (int)QPAR[q * 4 + 1];
                    const LAS unsigned* cc_ = (const LAS unsigned*)(lds + L_HIST + q * 256);
                    const unsigned cme = lane < cnt ? cc_[lane] : 0u; const unsigned kme = 0xffffu - (cme & 0xffffu); int rank = 0;
                    for (int t = 0; t < cnt; ++t) rank += (unsigned)__builtin_amdgcn_readlane((int)cme, t) > cme ? 1 : 0;
                    if (lane < cnt && rank < need) __hip_atomic_fetch_or(MASK + q * DSA_MSTR + (kme >> 5), 1u << (kme & 31u), __ATOMIC_RELAXED, __HIP_MEMORY_SCOPE_WORKGROUP); }
                if (j >= 17) {
                    unsigned short* lstg = LISTG + ((size_t)((b * 32 + j) * 128 + 16 * wave)) * 256;
#pragma unroll 1
                    for (int qq = 0; qq < 16; ++qq) { const int q = 16 * wave + qq; const int pq = 16 + 128 * j + q;
                        unsigned w3[3];
#pragma unroll
                        for (int rr = 0; rr < 3; ++rr) { const int kt = 64 * rr + lane; w3[rr] = MASK[q * DSA_MSTR + (kt < DSA_MSTR ? kt : 0)]; }
#pragma unroll
                        for (int rr = 0; rr < 3; ++rr) { const int kt = 64 * rr + lane; if (!(kt <= (pq >> 5))) w3[rr] = 0u; }
                        const int cl = __popc(w3[0]) + __popc(w3[1]) + __popc(w3[2]);
                        int pre = cl;
                        pre += __builtin_amdgcn_update_dpp(0, pre, 0x111, 0xf, 0xf, true); pre += __builtin_amdgcn_update_dpp(0, pre, 0x112, 0xf, 0xf, true);
                        pre += __builtin_amdgcn_update_dpp(0, pre, 0x114, 0xf, 0xf, true); pre += __builtin_amdgcn_update_dpp(0, pre, 0x118, 0xf, 0xf, true);
                        pre += __builtin_amdgcn_update_dpp(0, pre, 0x142, 0xa, 0xf, false); pre += __builtin_amdgcn_update_dpp(0, pre, 0x143, 0xc, 0xf, false);
                        if (lane == 63) QPAR[q * 4 + 2] = (unsigned)pre;
                        int pos = pre - cl;
#pragma unroll
                        for (int rr = 0; rr < 3; ++rr) { const int kt = 64 * rr + lane; unsigned w = w3[rr];
                            while (w) { const int bpos = __builtin_ctz(w); w &= w - 1u; if (pos < 256) lstg[qq * 256 + pos] = (unsigned short)(32 * kt + bpos); ++pos; } } }
                    LDS_WAIT();
                    asm volatile("s_waitcnt vmcnt(0)" ::: "memory");
                    __syncthreads();
                    { int mrow_s = (int)((size_t)b * SEQ + 128 * j + 16 * wave); asm volatile("" : "+s"(mrow_s));
                      dsa_gather(lds + wave * 16384, lds + L_STAGE + wave * 1024, BIAS, kcb, vcb, lstg, QPAR + 16 * wave * 4 + 2, PROJ + (size_t)mrow_s * DP2 + C2_DQ, q_norm_w, Y + (size_t)mrow_s * D + 512, 16 + 128 * j + 16 * wave, lane); }
                    __syncthreads();
                } else {
                    __syncthreads();
                    int mrow_s = (int)mrow; asm volatile("" : "+v"(mrow_s));
                    dsa_sweep<4>(lds, 0, kcb, vtb, PROJ + (size_t)mrow_s * DP2 + C2_DQ, q_norm_w, Y + (size_t)mrow_s * D + 512, ns, p, 16 + 128 * j + 16 * wave, qloc, wave, lane);
                    dsa_sweep<4>(lds, 4, kcb, vtb, PROJ + (size_t)mrow_s * DP2 + C2_DQ, q_norm_w, Y + (size_t)mrow_s * D + 512, ns, p, 16 + 128 * j + 16 * wave, qloc, wave, lane);
                }
            }
            __syncthreads();
        }
        {
            LAS unsigned char* Kimg = lds + RING_OFF; LAS unsigned char* Vimg = Kimg + 128 * IMG_STRIDE; LAS unsigned char* Simg = Vimg + 128 * IMG_STRIDE;
            const int cq = 16 * wave + (lane & 15), g4 = lane >> 4;
            v4u pk[2][2], pv[4], ps[4], pq[4];
#define R3_GRAB(dst) do { if (tid == 0) MISC[5] = __hip_atomic_fetch_add(ctl + 2048 + 64 * 16, 1u, __ATOMIC_RELAXED, __HIP_MEMORY_SCOPE_AGENT); __syncthreads(); dst = (int)MISC[5]; __syncthreads(); } while (0)
#define R3_LOAD(U_) do { const int b_ = (U_) >> 7, h_ = ((U_) >> 5) & 3, n_ = ((U_) & 31) + 1; const size_t r0_ = (size_t)b_ * SEQ + 128 * (n_ - 1); \
                _Pragma("unroll") for (int i_ = 0; i_ < 2; ++i_) { const int item = tid + 512 * i_, c = item >> 3, j = item & 7; const bf16* rp = RET + ((size_t)(4 + h_) * M + r0_ + c) * 128 + 8 * j; pk[i_][0] = *(const GAS v4u*)rp; pk[i_][1] = *(const GAS v4u*)(rp + 64); } \
                const bf16* sp_ = SPT + ((size_t)((b_ * 4 + h_) * 32 + (n_ - 1))) * 16384; \
                _Pragma("unroll") for (int i_ = 0; i_ < 4; ++i_) { const int item = tid + 512 * i_, c = item >> 4, part = item & 15; pv[i_] = *(const GAS v4u*)(RET + ((size_t)(8 + h_) * M + r0_ + c) * 128 + 8 * part); ps[i_] = *(const GAS v4u*)(sp_ + c * 128 + 8 * part); } \
                { const bf16* rp = RET + ((size_t)h_ * M + r0_ + cq) * 128 + 8 * g4; pq[0] = *(const GAS v4u*)rp; pq[1] = *(const GAS v4u*)(rp + 32); pq[2] = *(const GAS v4u*)(rp + 64); pq[3] = *(const GAS v4u*)(rp + 96); } } while (0)
            int unit; R3_GRAB(unit);
            if (unit < BATCH * 4 * 32) R3_LOAD(unit);
            for (;;) {
                if (unit >= BATCH * 4 * 32) break;
                int unit_nx; R3_GRAB(unit_nx);
                const int b = unit >> 7, h = (unit >> 5) & 3, n = (unit & 31) + 1;
                const float lg2 = log2f(1.f - exp2f(-5.f - (float)h));
                const size_t row0 = (size_t)b * SEQ + 128 * (n - 1);
#pragma unroll
                for (int i_ = 0; i_ < 2; ++i_) { const int item = tid + 512 * i_, c = item >> 3, j = item & 7;
                    const int t = 128 * n - 112 + c; const GAS f32x4* rq = (const GAS f32x4*)(ROPE + ((size_t)t * 64 + 8 * j) * 2); f32x4 cs[4]; cs[0] = rq[0]; cs[1] = rq[1]; cs[2] = rq[2]; cs[3] = rq[3];
                    v4u o1, o2; rot8(pk[i_][0], pk[i_][1], cs, RET_KSCALE, o1, o2);
                    *(LAS v4u*)(Kimg + c * IMG_STRIDE + 16 * j) = o1; *(LAS v4u*)(Kimg + c * IMG_STRIDE + 128 + 16 * j) = o2; }
#pragma unroll
                for (int i_ = 0; i_ < 4; ++i_) { const int item = tid + 512 * i_, c = item >> 4, part = item & 15;
                    *(LAS v4u*)(Vimg + c * IMG_STRIDE + 16 * part) = pv[i_];
                    *(LAS v4u*)(Simg + c * IMG_STRIDE + 16 * part) = ps[i_]; }
                bf16x8 qf[4];
                { const int t = 128 * n - 112 + cq;
                  const GAS f32x4* ra = (const GAS f32x4*)(ROPE + ((size_t)t * 64 + 8 * g4) * 2); f32x4 c0[4], c1[4];
#pragma unroll
                  for (int i_ = 0; i_ < 4; ++i_) { c0[i_] = ra[i_]; c1[i_] = ra[16 + i_]; }
                  v4u o0, o1, o2, o3; rot8(pq[0], pq[2], c0, 1.f, o0, o2); rot8(pq[1], pq[3], c1, 1.f, o1, o3);
                  qf[0] = __builtin_bit_cast(bf16x8, o0); qf[1] = __builtin_bit_cast(bf16x8, o1); qf[2] = __builtin_bit_cast(bf16x8, o2); qf[3] = __builtin_bit_cast(bf16x8, o3); }
                __syncthreads();
                if (unit_nx < BATCH * 4 * 32) R3_LOAD(unit_nx);
                u32x2v gpre[8];
                { const bf16* gp0 = RET + ((size_t)(12 + h) * M + row0 + cq) * 128 + 4 * g4;
#pragma unroll
                  for (int et = 0; et < 8; ++et) gpre[et] = *(const GAS u32x2v*)(gp0 + 16 * et); }
                f32x4 oin[8], ocr[8];
#pragma unroll
                for (int et = 0; et < 8; ++et) { oin[et] = (f32x4){0.f, 0.f, 0.f, 0.f}; ocr[et] = oin[et]; }
#pragma unroll
                for (int et = 0; et < 8; ++et)
#pragma unroll
                    for (int ks = 0; ks < 4; ++ks) ocr[et] = MFMA16(frag_n(Simg, IMG_STRIDE, 16 * et + (lane & 15), 32 * ks, lane), qf[ks], ocr[et]);
                const int kgmax = wave >> 1;
                for (int kg = 0; kg <= kgmax; ++kg) {
                    f32x4 st[2];
#pragma unroll
                    for (int u = 0; u < 2; ++u) { st[u] = (f32x4){0.f, 0.f, 0.f, 0.f};
                        const int mrow = 32 * kg + 8 * ((lane & 15) >> 2) + 4 * u + (lane & 3);
#pragma unroll
                        for (int ks = 0; ks < 4; ++ks) st[u] = MFMA16(frag_n(Kimg, IMG_STRIDE, mrow, 32 * ks, lane), qf[ks], st[u]); }
                    float pv[8];
#pragma unroll
                    for (int u = 0; u < 2; ++u)
#pragma unroll
                        for (int r = 0; r < 4; ++r) { const int m = 32 * kg + 8 * g4 + 4 * u + r; const int dd = cq - m; pv[4 * u + r] = dd >= 0 ? st[u][r] * exp2f(lg2 * (float)dd) : 0.f; }
                    const v4u pw = (v4u){pkbf(pv[0], pv[1]), pkbf(pv[2], pv[3]), pkbf(pv[4], pv[5]), pkbf(pv[6], pv[7])};
                    const bf16x8 pf = __builtin_bit_cast(bf16x8, pw);
#pragma unroll
                    for (int et = 0; et < 8; ++et) oin[et] = MFMA16(frag_t(Vimg, IMG_STRIDE, 16 * et, 32 * kg, lane), pf, oin[et]);
                }
                const float xi = exp2f(lg2 * (float)(cq + 1)); float ss = 0.f;
#pragma unroll
                for (int et = 0; et < 8; ++et) { oin[et] = oin[et] + ocr[et] * xi; ss += (oin[et][0] * oin[et][0] + oin[et][1] * oin[et][1]) + (oin[et][2] * oin[et][2] + oin[et][3] * oin[et][3]); }
                ss = rows_sum(ss);
                const float rinv = 1.f / sqrtf(ss * (1.f / 128.f) + EPS);
                bf16* yp = Y + (row0 + cq) * D + 128 * h + 4 * g4; const float* wn = ret_norm_w + 128 * h + 4 * g4;
#pragma unroll
                for (int et = 0; et < 8; ++et) { const u32x2v gw2 = gpre[et]; const f32x4 gn = *(const GAS f32x4*)(wn + 16 * et);
                    float gt[4] = {__uint_as_float(gw2[0] << 16), __uint_as_float(gw2[0] & 0xffff0000u), __uint_as_float(gw2[1] << 16), __uint_as_float(gw2[1] & 0xffff0000u)}; float o[4];
#pragma unroll
                    for (int r = 0; r < 4; ++r) { const float sg = gt[r] / (1.f + __expf(-gt[r])); o[r] = oin[et][r] * rinv * gn[r] * sg; }
                    *(GAS u32x2v*)(yp + 16 * et) = (u32x2v){pkbf(o[0], o[1]), pkbf(o[2], o[3])}; }
                __syncthreads();
                unit = unit_nx;
            }
#undef R3_GRAB
#undef R3_LOAD
        }
        if (BOTH(3)) GRID_BAR();
    }
    if (IN(4)) {
        pg8::Gemm g{Y, WOUT_T, M, D, D}; pg8::StaticOrder S; S.init(M, D, G, (int)blockIdx.x);
        pg8::EpiResBf16Stats E{U, XS, norm1_w, SSQ, D};
        pg8::gemm_phase<pg8::EpiResBf16Stats, pg8::StaticOrder, true, true>(lds + RING_OFF, g, S, E);
        if (BOTH(4)) GRID_BAR();
    }
    if (IN(6)) {
        pg8::Gemm g{U, W1_T, M, FF, D}; pg8::StaticOrder S; S.init(M, FF, G, (int)blockIdx.x);
        pg8::EpiBf16RowScaleRelu2 E{HB, FF, SSQ, 1.f / D, EPS};
        pg8::gemm_phase<pg8::EpiBf16RowScaleRelu2, pg8::StaticOrder, true, true>(lds + RING_OFF, g, S, E);
        if (BOTH(6)) GRID_BAR();
    }
    if (IN(7)) {
        pg8::Gemm g{HB, W2_T, M, D, FF}; pg8::StaticOrder S; S.init(M, D, G, (int)blockIdx.x);
        pg8::EpiResFromBf16 E{U, out, D};
        pg8::gemm_phase<pg8::EpiResFromBf16, pg8::StaticOrder, true, true>(lds + RING_OFF, g, S, E);
    }
#undef IN
#undef BOTH
}

extern "C" void kernel_launch(void* const* d_in, const int* in_sizes, int n_in, void* d_out, int out_size, void* d_ws, size_t ws_size, hipStream_t stream) {
    static int grid = 0;
    if (grid == 0) {
        if (n_in != 12 || in_sizes[0] != M * D || out_size != M * D || ws_size < WS_END) { fprintf(stderr, "kernel_launch: unexpected shapes (n_in %d, in0 %d, out %d, ws %zu); nothing launched\n", n_in, n_in > 0 ? in_sizes[0] : -1, out_size, ws_size); grid = -1; return; }
        int dev = 0, cus = 0, per_cu = 0;
        if (hipGetDevice(&dev) != hipSuccess || hipDeviceGetAttribute(&cus, hipDeviceAttributeMultiprocessorCount, dev) != hipSuccess) { grid = -1; return; }
        if (hipFuncSetAttribute((const void*)mk_fwd, hipFuncAttributeMaxDynamicSharedMemorySize, LDS_BYTES) != hipSuccess) { fprintf(stderr, "kernel_launch: hipFuncSetAttribute failed\n"); grid = -1; return; }
        if (hipOccupancyMaxActiveBlocksPerMultiprocessor(&per_cu, (const void*)mk_fwd, NWAVES * 64, LDS_BYTES) != hipSuccess || per_cu < 1)
            fprintf(stderr, "kernel_launch: note: occupancy query reports %d workgroups per CU\n", per_cu);
        (void)hipGetLastError();
        grid = cus;
    }
    if (grid < 0) return;
    if (hipMemsetAsync((char*)d_ws + WS_CTL, 0, CTL_ZERO_BYTES, stream) != hipSuccess) return;
    Args a{};
    for (int i = 0; i < 12; ++i) a.in[i] = (const float*)d_in[i];
    a.out = (float*)d_out; a.ws = (unsigned char*)d_ws;
    if (ONE_LAUNCH) { a.ph_lo = 0; a.ph_hi = N_PHASES; hipLaunchKernelGGL(mk_fwd, dim3(grid), dim3(NWAVES * 64), LDS_BYTES, stream, a); }
    else for (int p = 0; p < N_PHASES; ++p) { a.ph_lo = p; a.ph_hi = p + 1; hipLaunchKernelGGL(mk_fwd, dim3(grid), dim3(NWAVES * 64), LDS_BYTES, stream, a); }
    const hipError_t le = hipPeekAtLastError();
    if (le != hipSuccess) fprintf(stderr, "kernel_launch: launch failed: %s\n", hipGetErrorName(le));
}
```
